# Optimizing an MI355X kernel written in HIP

```python
import math
import jax, jax.numpy as jnp
from jax import lax
import numpy as np

D_MODEL = 2048
BATCH = 8
SEQ = 2048
DEPTH = 4
DEC_BATCH = 4
DEC_SEQ = 8192
PAST_LEN = 128

N_MIXERS = 3
N_RG_LAYERS = (DEPTH + 2) // 3
N_SSD_LAYERS = (DEPTH + 1) // 3
N_NA_LAYERS = DEPTH // 3
ALPHA = (2 * DEPTH) ** 0.25
BETA = (8 * DEPTH) ** -0.25
LN_EPS = 1e-5
CONV_W = 4
CONV_PAD_L = 1
LRU_W = D_MODEL
LRU_BLOCKS = 8
LRU_BW = LRU_W // LRU_BLOCKS
LRU_C = 8.0
SSD_D_INNER = 2 * D_MODEL
SSD_HEAD_DIM = 64
SSD_HEADS = SSD_D_INNER // SSD_HEAD_DIM
SSD_GROUPS = 8
SSD_STATE = 128
SSD_CHUNK = 128
SSD_CONV_DIM = SSD_D_INNER + 2 * SSD_GROUPS * SSD_STATE
SSD_IN_DIM = SSD_D_INNER + SSD_CONV_DIM + 2 * SSD_HEADS
GRID_W = 64
WIN_H = 8
WIN_W = 16
NA_HEAD_DIM = 128
NA_HEADS = D_MODEL // NA_HEAD_DIM
NA_QBLK = WIN_W
NA_KBLK = 2 * WIN_W
NA_NBLK = GRID_W // NA_QBLK
MLP_HIDDEN = 4 * D_MODEL

kernel_name = "hybrid_bidir_rglru_ssd_natten_encoder"


def layer_norm(x, g, b):
    xf = x.astype(jnp.float32)
    mu = jnp.mean(xf, axis=-1, keepdims=True)
    xc = xf - mu
    var = jnp.mean(xc * xc, axis=-1, keepdims=True)
    return (xc * lax.rsqrt(var + LN_EPS) * g + b).astype(x.dtype)


def centred_dwconv(x, w, b):
    L = x.shape[1]
    xp = jnp.pad(x, ((0, 0), (CONV_PAD_L, CONV_W - 1 - CONV_PAD_L), (0, 0)))
    y = b
    for k in range(CONV_W):
        y = y + xp[:, k:k + L] * w[k]
    return y


def _lin_combine(left, right):
    a1, b1 = left
    a2, b2 = right
    return a1 * a2, a2 * b1 + b2


def linear_scan(a, b, reverse):
    if reverse:
        a, b = jnp.flip(a, axis=1), jnp.flip(b, axis=1)
    _, h = lax.associative_scan(_lin_combine, (a, b), axis=1)
    return jnp.flip(h, axis=1) if reverse else h


def rglru_mixer(x, w_in, conv_w, conv_b, w_a, b_a, w_x, b_x, lam, w_out):
    bsz, L, _ = x.shape
    gate, u = jnp.split(x @ w_in, 2, axis=-1)
    gate = jax.nn.gelu(gate)
    u = centred_dwconv(u, conv_w, conv_b)
    ub = u.reshape(bsz, L, LRU_BLOCKS, LRU_BW)
    h = jnp.zeros((bsz, L, LRU_W), jnp.float32)
    for d in range(2):
        r = jax.nn.sigmoid(jnp.einsum('blnk,nkj->blnj', ub, w_a[d]).reshape(bsz, L, LRU_W) + b_a[d])
        i = jax.nn.sigmoid(jnp.einsum('blnk,nkj->blnj', ub, w_x[d]).reshape(bsz, L, LRU_W) + b_x[d])
        log_a = -LRU_C * r.astype(jnp.float32) * jax.nn.softplus(-lam[d].astype(jnp.float32))
        a = jnp.exp(log_a)
        inp = jnp.sqrt(-jnp.expm1(2.0 * log_a)) * (i * u).astype(jnp.float32)
        h = h + linear_scan(a, inp, reverse=(d == 1))
    y = (h * gate.astype(jnp.float32)).astype(x.dtype)
    return y @ w_out


def ssd_chunked(xs, dt, A, B, C):
    bsz, L, H, P = xs.shape
    G, N = B.shape[-2:]
    Hg = H // G
    nc = L // SSD_CHUNK
    f32 = jnp.float32
    x = xs.astype(f32).reshape(bsz, nc, SSD_CHUNK, G, Hg, P)
    dt = dt.astype(f32).reshape(bsz, nc, SSD_CHUNK, G, Hg)
    B = B.astype(f32).reshape(bsz, nc, SSD_CHUNK, G, N)
    C = C.astype(f32).reshape(bsz, nc, SSD_CHUNK, G, N)
    xdt = x * dt[..., None]
    a_cum = jnp.cumsum(dt * A.astype(f32).reshape(G, Hg), axis=2)
    causal = jnp.tril(jnp.ones((SSD_CHUNK, SSD_CHUNK), dtype=bool))
    seg = a_cum[:, :, :, None] - a_cum[:, :, None, :]
    decay = jnp.exp(jnp.where(causal[:, :, None, None], seg, -jnp.inf))
    cb = jnp.einsum('bclgn,bcsgn->bclsg', C, B)
    y_diag = jnp.einsum('bclsgh,bcsghp->bclghp', cb[..., None] * decay, xdt)
    decay_end = jnp.exp(a_cum[:, :, -1:] - a_cum)
    states = jnp.einsum('bclgn,bclghp->bcghpn', B, xdt * decay_end[..., None])
    chunk_decay = jnp.exp(a_cum[:, :, -1])

    def carry_step(h, inp):
        st, dec = inp
        return h * dec[..., None, None] + st, h

    h0 = jnp.zeros((bsz, G, Hg, P, N), f32)
    _, h_in = lax.scan(carry_step, h0, (jnp.moveaxis(states, 1, 0), jnp.moveaxis(chunk_decay, 1, 0)))
    h_in = jnp.moveaxis(h_in, 0, 1)
    y_off = jnp.einsum('bclgn,bcghpn->bclghp', C, h_in) * jnp.exp(a_cum)[..., None]
    return (y_diag + y_off).reshape(bsz, L, H, P)


def ssd_mixer(x, w_in, conv_w, conv_b, dt_bias, a_log, d_skip, norm_g, w_out):
    bsz, L, _ = x.shape
    f32 = jnp.float32
    proj = x @ w_in
    z, xbc, dt = jnp.split(proj, [SSD_D_INNER, SSD_D_INNER + SSD_CONV_DIM], axis=-1)
    xbc = jax.nn.silu(centred_dwconv(xbc, conv_w, conv_b))
    xs, Bm, Cm = jnp.split(xbc, [SSD_D_INNER, SSD_D_INNER + SSD_GROUPS * SSD_STATE], axis=-1)
    xs = xs.reshape(bsz, L, SSD_HEADS, SSD_HEAD_DIM)
    Bm = Bm.reshape(bsz, L, SSD_GROUPS, SSD_STATE)
    Cm = Cm.reshape(bsz, L, SSD_GROUPS, SSD_STATE)
    dt = jax.nn.softplus(dt.astype(f32).reshape(bsz, L, 2, SSD_HEADS) + dt_bias.astype(f32))
    A = -jnp.exp(a_log.astype(f32))
    flip = lambda t: jnp.flip(t, axis=1)
    y_f = ssd_chunked(xs, dt[:, :, 0], A[0], Bm, Cm)
    y_b = flip(ssd_chunked(flip(xs), flip(dt[:, :, 1]), A[1], flip(Bm), flip(Cm)))
    y = y_f + y_b + xs.astype(f32) * d_skip.astype(f32)[:, None]
    y = y.reshape(bsz, L, SSD_D_INNER) * jax.nn.silu(z.astype(f32))
    yg = y.reshape(bsz, L, SSD_GROUPS, SSD_D_INNER // SSD_GROUPS)
    yg = yg * lax.rsqrt(jnp.mean(yg * yg, axis=-1, keepdims=True) + LN_EPS)
    y = (yg.reshape(bsz, L, SSD_D_INNER) * norm_g).astype(x.dtype)
    return y @ w_out


def natten_mixer(x, w_qkv, b_qkv, rpb, w_out):
    bsz, L, _ = x.shape
    rows = L // GRID_W
    kh = min(WIN_H, rows)
    qkv = (x @ w_qkv + b_qkv).reshape(bsz, rows, GRID_W, 3, NA_HEADS, NA_HEAD_DIM)
    q = qkv[:, :, :, 0] * (NA_HEAD_DIM ** -0.5)
    k = qkv[:, :, :, 1]
    v = qkv[:, :, :, 2]
    qcol = np.arange(GRID_W).reshape(NA_NBLK, NA_QBLK)
    kstart = np.clip(np.arange(NA_NBLK) * NA_QBLK - WIN_W // 2, 0, GRID_W - NA_KBLK)
    kcol = kstart[:, None] + np.arange(NA_KBLK)
    wstart = np.clip(qcol - WIN_W // 2, 0, GRID_W - WIN_W)
    col_ok = (kcol[:, None, :] >= wstart[..., None]) & (kcol[:, None, :] < wstart[..., None] + WIN_W)
    dx_idx = np.clip(kcol[:, None, :] - qcol[:, :, None] + WIN_W - 1, 0, 2 * WIN_W - 2)
    col_bias = jnp.transpose(rpb[:, :, dx_idx], (0, 2, 3, 1, 4)).astype(jnp.float32)
    kc = k[:, :, kcol]
    vc = v[:, :, kcol]
    q = q.reshape(bsz, rows, NA_NBLK, NA_QBLK, NA_HEADS, NA_HEAD_DIM)

    def row_block(r):
        rs = jnp.clip(r - kh // 2, 0, rows - kh)
        kr = lax.dynamic_slice_in_dim(kc, rs, kh, axis=1)
        vr = lax.dynamic_slice_in_dim(vc, rs, kh, axis=1)
        qr = lax.dynamic_index_in_dim(q, r, axis=1, keepdims=False)
        s = jnp.einsum('bjqhd,bkjchd->bhjqkc', qr, kr).astype(jnp.float32)
        dy_idx = rs + jnp.arange(kh) - r + (WIN_H - 1)
        s = s + jnp.take(col_bias, dy_idx, axis=3)[None]
        s = jnp.where(col_ok[:, :, None, :], s, -jnp.inf)
        p = jax.nn.softmax(s.reshape(bsz, NA_HEADS, NA_NBLK, NA_QBLK, kh * NA_KBLK), axis=-1)
        p = p.reshape(s.shape).astype(vr.dtype)
        return jnp.einsum('bhjqkc,bkjchd->bjqhd', p, vr)

    o = lax.map(row_block, jnp.arange(rows))
    o = jnp.moveaxis(o, 0, 1).reshape(bsz, L, D_MODEL)
    return o @ w_out


def sq_relu_mlp(x, w_up, w_down):
    return jnp.square(jax.nn.relu(x @ w_up)) @ w_down


def setup_inputs(seed: int = 0) -> dict:
    key = jax.random.key(seed)
    ks = iter(jax.random.split(key, 32))
    f32 = jnp.float32

    def nrm(shape, fan_in, scale=1.0):
        return jax.random.normal(next(ks), shape, f32) * (scale * fan_in ** -0.5)

    def small(shape, s=0.01):
        return jax.random.normal(next(ks), shape, f32) * s

    x_prompt = jax.random.normal(next(ks), (BATCH, SEQ, D_MODEL), f32)
    x_sample = jax.random.normal(next(ks), (DEC_BATCH, DEC_SEQ, D_MODEL), f32)
    nR, nS, nN = N_RG_LAYERS, N_SSD_LAYERS, N_NA_LAYERS
    rg_w_in = nrm((nR, D_MODEL, 2 * LRU_W), D_MODEL)
    rg_conv_w = nrm((nR, CONV_W, LRU_W), CONV_W)
    rg_conv_b = small((nR, LRU_W))
    rg_w_a = nrm((nR, 2, LRU_BLOCKS, LRU_BW, LRU_BW), LRU_BW)
    rg_b_a = small((nR, 2, LRU_W))
    rg_w_x = nrm((nR, 2, LRU_BLOCKS, LRU_BW, LRU_BW), LRU_BW)
    rg_b_x = small((nR, 2, LRU_W))
    a0 = jax.random.uniform(next(ks), (nR, 2, LRU_W), f32, minval=0.9, maxval=0.999)
    s0 = a0 ** (1.0 / LRU_C)
    rg_lambda = jnp.log(s0) - jnp.log1p(-s0)
    rg_w_out = nrm((nR, LRU_W, D_MODEL), LRU_W, BETA)
    ssd_w_in = nrm((nS, D_MODEL, SSD_IN_DIM), D_MODEL)
    ssd_conv_w = nrm((nS, CONV_W, SSD_CONV_DIM), CONV_W)
    ssd_conv_b = small((nS, SSD_CONV_DIM))
    dt0 = jnp.exp(jax.random.uniform(next(ks), (nS, 2, SSD_HEADS), f32, minval=math.log(1e-3), maxval=math.log(1e-1)))
    ssd_dt_bias = dt0 + jnp.log(-jnp.expm1(-dt0))
    ssd_a_log = jnp.log(jax.random.uniform(next(ks), (nS, 2, SSD_HEADS), f32, minval=1.0, maxval=16.0))
    ssd_d = 1.0 + small((nS, SSD_HEADS))
    ssd_norm_g = 1.0 + small((nS, SSD_D_INNER))
    ssd_w_out = nrm((nS, SSD_D_INNER, D_MODEL), SSD_D_INNER, BETA)
    na_w_qkv = nrm((nN, D_MODEL, 3 * D_MODEL), D_MODEL)
    na_b_qkv = small((nN, 3 * D_MODEL))
    na_rpb = small((nN, NA_HEADS, 2 * WIN_H - 1, 2 * WIN_W - 1), 0.02)
    na_w_out = nrm((nN, D_MODEL, D_MODEL), D_MODEL, BETA)
    mlp_w_up = nrm((DEPTH, D_MODEL, MLP_HIDDEN), D_MODEL)
    mlp_w_down = nrm((DEPTH, MLP_HIDDEN, D_MODEL), MLP_HIDDEN, BETA)
    ln1_g = 1.0 + small((DEPTH, D_MODEL))
    ln1_b = small((DEPTH, D_MODEL))
    ln2_g = 1.0 + small((DEPTH, D_MODEL))
    ln2_b = small((DEPTH, D_MODEL))
    return {"x_prompt": x_prompt, "x_sample": x_sample,
            "rg_w_in": rg_w_in, "rg_conv_w": rg_conv_w, "rg_conv_b": rg_conv_b,
            "rg_w_a": rg_w_a, "rg_b_a": rg_b_a, "rg_w_x": rg_w_x, "rg_b_x": rg_b_x,
            "rg_lambda": rg_lambda, "rg_w_out": rg_w_out,
            "ssd_w_in": ssd_w_in, "ssd_conv_w": ssd_conv_w, "ssd_conv_b": ssd_conv_b,
            "ssd_dt_bias": ssd_dt_bias, "ssd_a_log": ssd_a_log, "ssd_d": ssd_d,
            "ssd_norm_g": ssd_norm_g, "ssd_w_out": ssd_w_out,
            "na_w_qkv": na_w_qkv, "na_b_qkv": na_b_qkv, "na_rpb": na_rpb, "na_w_out": na_w_out,
            "mlp_w_up": mlp_w_up, "mlp_w_down": mlp_w_down,
            "ln1_g": ln1_g, "ln1_b": ln1_b, "ln2_g": ln2_g, "ln2_b": ln2_b}


def reference(x_prompt, x_sample,
              rg_w_in, rg_conv_w, rg_conv_b, rg_w_a, rg_b_a, rg_w_x, rg_b_x, rg_lambda, rg_w_out,
              ssd_w_in, ssd_conv_w, ssd_conv_b, ssd_dt_bias, ssd_a_log, ssd_d, ssd_norm_g, ssd_w_out,
              na_w_qkv, na_b_qkv, na_rpb, na_w_out,
              mlp_w_up, mlp_w_down,
              ln1_g, ln1_b, ln2_g, ln2_b):
    def trunk(x):
        for i in range(DEPTH):
            kind = i % N_MIXERS
            j = i // N_MIXERS
            if kind == 0:
                h = rglru_mixer(x, rg_w_in[j], rg_conv_w[j], rg_conv_b[j], rg_w_a[j], rg_b_a[j],
                                rg_w_x[j], rg_b_x[j], rg_lambda[j], rg_w_out[j])
            elif kind == 1:
                h = ssd_mixer(x, ssd_w_in[j], ssd_conv_w[j], ssd_conv_b[j], ssd_dt_bias[j],
                              ssd_a_log[j], ssd_d[j], ssd_norm_g[j], ssd_w_out[j])
            else:
                h = natten_mixer(x, na_w_qkv[j], na_b_qkv[j], na_rpb[j], na_w_out[j])
            x = layer_norm(ALPHA * x + h, ln1_g[i], ln1_b[i])
            x = layer_norm(ALPHA * x + sq_relu_mlp(x, mlp_w_up[i], mlp_w_down[i]), ln2_g[i], ln2_b[i])
        return x

    y_prompt = trunk(x_prompt)
    y_sample = trunk(x_sample)
    return (y_prompt, y_sample)
```

```cpp
#include <hip/hip_runtime.h>
#include <cstdio>
#include <cstdint>

#ifndef MK_N_LAUNCHES
#define MK_N_LAUNCHES 1
#endif
#ifndef MK_CHECK
#define MK_CHECK 0
#endif

#define LAS __attribute__((address_space(3)))
#define GAS __attribute__((address_space(1)))
typedef unsigned short bf16;
typedef short bf16x8 __attribute__((ext_vector_type(8)));
typedef short s16x4 __attribute__((ext_vector_type(4)));
typedef float f32x2 __attribute__((ext_vector_type(2)));
typedef float f32x4 __attribute__((ext_vector_type(4)));
typedef float f32x16 __attribute__((ext_vector_type(16)));
typedef unsigned u32x2 __attribute__((ext_vector_type(2)));
typedef unsigned u32x4 __attribute__((ext_vector_type(4)));
typedef __bf16 bf16x2_t __attribute__((ext_vector_type(2)));
typedef short v4i16_t __attribute__((ext_vector_type(4)));
typedef GAS unsigned gu32;

constexpr int D = 2048, TG = 8192, NGROUP = 6, DEPTH = 4, NWAVES = 8, NTHR = 512;
constexpr int HID = 8192;
constexpr int SSD_DI = 4096, SSD_NH = 64, SSD_NG = 8, SSD_NS = 128, SSD_CH = 128, SSD_XBC = 6144, SSD_NIN = 10368, SSD_NIN_PAD = 10496;
constexpr int NA_H = 16, NA_HD = 128;
constexpr float ALPHA = 1.681792830507429f, LN_EPS = 1e-5f;

constexpr size_t MiB = 1u << 20;
constexpr size_t WS_CTL = 0, CTL_ZERO_BYTES = 256 * 1024;
constexpr size_t WS_W = 1 * MiB;
constexpr size_t W_RGIN = 0;
constexpr size_t W_RGGATE = W_RGIN + 2ull * 4096 * 2048;
constexpr size_t W_RGOUT = W_RGGATE + 2ull * 32 * 256 * 256;
constexpr size_t W_SSDIN = W_RGOUT + 2ull * 2048 * 2048;
constexpr size_t W_SSDOUT = W_SSDIN + (size_t)SSD_NIN_PAD * 2048;
constexpr size_t W_NAQKV = W_SSDOUT + 2048ull * 4096;
constexpr size_t W_NAOUT = W_NAQKV + 6144ull * 2048;
constexpr size_t W_UP = W_NAOUT + 2048ull * 2048;
constexpr size_t W_DOWN = W_UP + 4ull * 8192 * 2048;
constexpr size_t W_END = W_DOWN + 4ull * 8192 * 2048;
constexpr size_t WS_SCR = ((WS_W + W_END * 2 + MiB - 1) / MiB) * MiB;
constexpr size_t S_XB = 0;
constexpr size_t S_YB = 32 * MiB;
constexpr size_t S_MIX = 96 * MiB;
constexpr size_t S_HID = S_MIX;
constexpr size_t S_RG_GATE = S_MIX, S_RG_URAW = S_MIX + 32 * MiB, S_RG_U = S_MIX + 64 * MiB, S_RG_LA = S_MIX + 96 * MiB  , S_RG_INP = S_MIX + 160 * MiB  ;
constexpr size_t S_RG_HEND = S_MIX + 224 * MiB, S_RG_PROD = S_MIX + 226 * MiB, S_RG_HIN = S_MIX + 228 * MiB;
constexpr size_t S_SSD_ZS = S_MIX, S_SSD_XBCR = S_MIX + 64 * MiB, S_SSD_XT = S_MIX + 160 * MiB, S_SSD_BM = S_MIX + 224 * MiB, S_SSD_CM = S_MIX + 240 * MiB;
constexpr size_t S_SSD_DT = S_MIX + 256 * MiB, S_SSD_DEC = S_MIX + 260 * MiB, S_SSD_ST = S_MIX + 261 * MiB;
constexpr size_t S_NA_Q = S_MIX, S_NA_K = S_MIX + 32 * MiB, S_NA_V = S_MIX + 64 * MiB;
constexpr size_t S_END = S_MIX + 389 * MiB;
constexpr size_t WS_NEED = WS_SCR + S_END;

constexpr int CW_BAR = 4096;
constexpr int CW_CHK = 1024;
constexpr size_t WS_SPT = 512 * 1024;

constexpr int RING_BYTES = 131072;
constexpr int LDSCTL_OFF = RING_BYTES, MISC_OFF = LDSCTL_OFF + 320;
constexpr int LDS_BYTES = 147456;

#define RLX_AGENT __ATOMIC_RELAXED, __HIP_MEMORY_SCOPE_AGENT
#define LDS_WAIT() asm volatile("s_waitcnt lgkmcnt(0)" ::: "memory")
#define VM_WAIT() asm volatile("s_waitcnt vmcnt(0)" ::: "memory")
__device__ __forceinline__ unsigned pk2(float lo, float hi) { f32x2 v = {lo, hi}; bf16x2_t b = __builtin_convertvector(v, bf16x2_t); return __builtin_bit_cast(unsigned, b); }
__device__ __forceinline__ float bflo(unsigned w) { return __uint_as_float(w << 16); }
__device__ __forceinline__ float bfhi(unsigned w) { return __uint_as_float(w & 0xffff0000u); }
__device__ __forceinline__ float bf2f(bf16 b) { return __uint_as_float(((unsigned)b) << 16); }
__device__ __forceinline__ float frcp_(float x) { return __builtin_amdgcn_rcpf(x); }
__device__ __forceinline__ float fsqrt_(float x) { return __builtin_amdgcn_sqrtf(x); }
__device__ __forceinline__ float sigmoidf_(float x) { return frcp_(1.0f + __expf(-x)); }
__device__ __forceinline__ float siluf_(float x) { return x * frcp_(1.0f + __expf(-x)); }
__device__ __forceinline__ float gelu_tanh_(float v) { const float u = 1.5957691216057308f * (v + 0.044715f * v * v * v); return v * frcp_(1.0f + __expf(-u)); }
__device__ __forceinline__ float softplusf_(float v) { return v > 20.f ? v : log1pf(__expf(v)); }
__device__ __forceinline__ float shfl_lane(float v, int srclane) { return __int_as_float(__builtin_amdgcn_ds_bpermute(srclane << 2, __float_as_int(v))); }
__device__ __forceinline__ float wave_sum(float v, int lane) {
#pragma unroll
    for (int o = 1; o < 64; o <<= 1) v += shfl_lane(v, lane ^ o);
    return v;
}

#define XB_TMO      128
#define XB_XCNT(j)  (256  + 64 * (j))
#define XB_XSUB(j)  (1280 + 64 * (j))
#define XB_XGEN(j)  (2304 + 64 * (j))
#define XB_TOP      3328
#define XB_TOPGEN   3392
#define XCD_BAR_WORDS 3456
#define XB_SPIN_CAP (1u << 22)

__device__ __forceinline__ unsigned xb_ld(unsigned* p)              { return __hip_atomic_load(p, __ATOMIC_RELAXED, __HIP_MEMORY_SCOPE_AGENT); }
__device__ __forceinline__ unsigned xb_add(unsigned* p, unsigned v) { return __hip_atomic_fetch_add(p, v, __ATOMIC_RELAXED, __HIP_MEMORY_SCOPE_AGENT); }
__device__ __forceinline__ unsigned xb_xcc_id() { return (unsigned)__builtin_amdgcn_s_getreg((3 << 11) | 20) & 0xFu; }
#define XB_SPIN(cond, bar) do { unsigned _sp = 0; while (cond) { __builtin_amdgcn_s_sleep(1); \
    if ((++_sp & 255u) == 0u) { if (xb_ld(&(bar)[XB_TMO])) break; if (_sp > XB_SPIN_CAP) { atomicAdd(&(bar)[XB_TMO], 1u); break; } } } } while (0)

struct XcdBarrier { unsigned* bar; unsigned x; volatile LAS unsigned* st; };

__device__ __forceinline__ XcdBarrier xcd_barrier_post(unsigned* bar, volatile LAS unsigned* st) {
    XcdBarrier b; b.bar = bar; b.x = xb_xcc_id(); b.st = st;
    if (threadIdx.x == 0) (void)xb_add(&bar[XB_XCNT(b.x)], 1u);
    return b;
}
__device__ __forceinline__ void xcd_barrier_complete(unsigned* bar, unsigned x, unsigned& nloc, unsigned& nx) {
    const unsigned G = gridDim.x * gridDim.y * gridDim.z;
    unsigned sum, cnt, mine, sp = 0u;
    for (;;) {
        sum = 0u; cnt = 0u; mine = 0u;
#pragma unroll
        for (unsigned j = 0; j < 16; ++j) { const unsigned c = xb_ld(&bar[XB_XCNT(j)]); sum += c; cnt += (c > 0u) ? 1u : 0u; mine = (j == x) ? c : mine; }
        if (sum == G) break;
        __builtin_amdgcn_s_sleep(1);
        if ((++sp & 255u) == 0u) { if (xb_ld(&bar[XB_TMO])) break; if (sp > XB_SPIN_CAP) { atomicAdd(&bar[XB_TMO], 1u); break; } }
    }
    nloc = mine > 0u ? mine : 1u; nx = cnt > 0u ? cnt : 1u;
}
__device__ __forceinline__ void xcd_barrier(const XcdBarrier& b) {
    asm volatile("s_waitcnt vmcnt(0)" ::: "memory");
    __syncthreads();
    if (threadIdx.x == 0) {
        unsigned* bar = b.bar;
        __builtin_amdgcn_s_waitcnt(0);
        unsigned nloc = b.st[0], nx = b.st[1];
        if (nloc == 0u) { xcd_barrier_complete(bar, b.x, nloc, nx); b.st[0] = nloc; b.st[1] = nx; }
        const unsigned old = xb_add(&bar[XB_XSUB(b.x)], 1u);
        const unsigned gen = old / nloc;
        if (old + 1u == (gen + 1u) * nloc) {
            __builtin_amdgcn_fence(__ATOMIC_RELEASE, "agent");
            asm volatile("s_waitcnt vmcnt(0)" ::: "memory");
            const unsigned og = xb_add(&bar[XB_TOP], 1u);
            const unsigned tg = og / nx;
            if (og + 1u == (tg + 1u) * nx) xb_add(&bar[XB_TOPGEN], 1u);
            else XB_SPIN(xb_ld(&bar[XB_TOPGEN]) == tg, bar);
            __builtin_amdgcn_fence(__ATOMIC_ACQUIRE, "agent");
            xb_add(&bar[XB_XGEN(b.x)], 1u);
            asm volatile("s_waitcnt vmcnt(0)" ::: "memory");
        } else {
            XB_SPIN(xb_ld(&bar[XB_XGEN(b.x)]) == gen, bar);
            __builtin_amdgcn_fence(__ATOMIC_ACQUIRE, "agent");
            asm volatile("s_waitcnt vmcnt(0)" ::: "memory");
        }
    }
    __syncthreads();
}

namespace pg8 {
constexpr int BM = 256, BK = 64, HALF = 128, HTB = HALF * BK * 2, STAGE_BYTES = 8 * HTB, NXCD = 8, WGM = 8;
__host__ __device__ __forceinline__ int lds_byte(int r, int c) { const int st = (r >> 4) * 2 + (c >> 5), rr = r & 15, cc = c & 31, ob = rr * 64 + cc * 2; return st * 1024 + (ob ^ (((ob >> 9) & 1) << 5)); }
__host__ __device__ __forceinline__ void stage_rc(int b, int& R, int& C) { const int st = b / 1024, sb = b % 1024, swz = sb ^ (((sb >> 9) & 1) << 5); R = (st >> 1) * 16 + swz / 64; C = (st & 1) * 32 + (swz % 64) / 2; }
__host__ __device__ __forceinline__ int perm32(int rho) { const int n = rho >> 4, i = rho & 15; return 8 * (i >> 2) + 4 * n + (i & 3); }

struct Unit { int pm, pn; };
struct Gemm { const bf16* A; const bf16* Bt; int lda, ldb, K, mode; };
__device__ __forceinline__ const char* a_base(const Gemm& g, const Unit& u) { return (const char*)(g.A + (size_t)u.pm * BM * g.lda + (g.mode == 1 ? ((u.pn >> 1) & 7) * 256 : 0)); }
__device__ __forceinline__ const char* b_base(const Gemm& g, const Unit& u) { return (const char*)(g.Bt + (size_t)u.pn * BM * g.ldb); }

struct StaticOrder {
    int nM, nN, nwg, G, c;
    __host__ __device__ void init(int M, int N, int G_, int c_) { nM = M / BM; nN = N / BM; nwg = nM * nN; G = G_; c = c_; }
    __host__ __device__ bool next(int i, Unit& u) const {
        const long L = (long)i * G + c; if (L >= nwg) return false;
        int wgid = (int)L; { const int q = nwg / NXCD, r = nwg % NXCD, xcd = wgid % NXCD, off = wgid / NXCD; wgid = (xcd < r ? xcd * (q + 1) : r * (q + 1) + (xcd - r) * q) + off; }
        const int nig = WGM * nN, gid = wgid / nig, fm = gid * WGM, gsz = (nM - fm) < WGM ? (nM - fm) : WGM;
        u.pm = fm + ((wgid % nig) % gsz); u.pn = (wgid % nig) / gsz; return true;
    }
};

template <class Epi, bool ALIGN_EPI = true, bool SP2 = true>
__device__ __forceinline__ void gemm_phase(LAS unsigned char* lds, const Gemm g, const StaticOrder& S, const Epi& E) {
    int tid_o = threadIdx.x; asm volatile("" : "+v"(tid_o));
    const int tid = tid_o, wid = __builtin_amdgcn_readfirstlane(tid >> 6), lane = tid & 63, wr = wid >> 2, wc = wid & 3, fr = lane & 15, fq = lane >> 4;
    const int K = g.K, nt = K / BK;
    unsigned voffA[2], voffB[2];
#pragma unroll
    for (int i = 0; i < 2; ++i) { int R, C; stage_rc(tid * 16 + i * 8192, R, C); const int Rb = Epi::PERM ? ((R & ~31) + perm32(R & 31)) : R;
        voffA[i] = (unsigned)(R * g.lda + C) * 2u; voffB[i] = (unsigned)(Rb * g.ldb + C) * 2u; }
    const size_t kstep = (size_t)(BK * 2);
    const size_t hstepA = (size_t)HALF * g.lda * 2, hstepB = (size_t)HALF * g.ldb * 2;
    const unsigned ldsw = (unsigned)wid * 1024u;
    const int aoff = lds_byte(wr * 64 + fr, fq * 8), boff = lds_byte(wc * 32 + fr, fq * 8);
#define PG8_SA(b, h) (((b) * 2 + (h)) * HTB)
#define PG8_SB(b, h) ((4 + (b) * 2 + (h)) * HTB)
#define PG8_STAGE(bufoff, gbase, voff) do { _Pragma("unroll") for (int _i = 0; _i < 2; ++_i) \
        __builtin_amdgcn_global_load_lds((const unsigned*)((const char*)(gbase) + (voff)[_i]), (LAS unsigned*)(lds + (bufoff) + ldsw + _i * 8192), 16, 0, 0); } while (0)
#define PG8_LDA(dst, b, h) do { _Pragma("unroll") for (int m = 0; m < 4; ++m) _Pragma("unroll") for (int k = 0; k < 2; ++k) dst[m][k] = *(const LAS bf16x8*)(lds + PG8_SA(b, h) + aoff + m * 2048 + k * 1024); } while (0)
#define PG8_LDB(dst, b, h) do { _Pragma("unroll") for (int n = 0; n < 2; ++n) _Pragma("unroll") for (int k = 0; k < 2; ++k) dst[n][k] = *(const LAS bf16x8*)(lds + PG8_SB(b, h) + boff + n * 2048 + k * 1024); } while (0)
#define PG8_MMA(ai, bj, At, Bt) do { __builtin_amdgcn_s_setprio(1); _Pragma("unroll") for (int m = 0; m < 4; ++m) _Pragma("unroll") for (int n = 0; n < 2; ++n) _Pragma("unroll") for (int k = 0; k < 2; ++k) \
        acc[ai][bj][m][n] = __builtin_amdgcn_mfma_f32_16x16x32_bf16(Bt[n][k], At[m][k], acc[ai][bj][m][n], 0, 0, 0); __builtin_amdgcn_s_setprio(0); } while (0)
#define PG8_WAIT_V(n) asm volatile("s_waitcnt vmcnt(" #n ")" ::: "memory")
#define PG8_WAIT_L(n) asm volatile("s_waitcnt lgkmcnt(" #n ")" ::: "memory")
#define PG8_BAR __builtin_amdgcn_s_barrier()
#define PG8_SCHED __builtin_amdgcn_sched_barrier(0)
    Unit cur, nxt; int ui = 0;
    if (!S.next(0, cur)) return;
    f32x4 acc[2][2][4][2];
#pragma unroll
    for (int a = 0; a < 2; ++a)
#pragma unroll
        for (int b = 0; b < 2; ++b)
#pragma unroll
            for (int m = 0; m < 4; ++m)
#pragma unroll
                for (int n = 0; n < 2; ++n) acc[a][b][m][n] = (f32x4){0.f, 0.f, 0.f, 0.f};
    bf16x8 At[4][2], B0[2][2], B1[2][2];
    const char* cA = a_base(g, cur); const char* cB = b_base(g, cur);
    if constexpr (SP2) {
        PG8_STAGE(PG8_SB(0, 0), cB, voffB); PG8_STAGE(PG8_SB(0, 1), cB + hstepB, voffB); PG8_STAGE(PG8_SA(0, 0), cA, voffA); PG8_STAGE(PG8_SA(0, 1), cA + hstepA, voffA);
        if (wr == 1) PG8_BAR;
        PG8_WAIT_V(2); PG8_BAR;
        PG8_STAGE(PG8_SB(1, 0), cB + kstep, voffB); PG8_STAGE(PG8_SA(1, 0), cA + kstep, voffA); PG8_STAGE(PG8_SB(1, 1), cB + hstepB + kstep, voffB);
        PG8_WAIT_V(6); PG8_BAR;
    } else {
        PG8_STAGE(PG8_SB(0, 0), cB, voffB); PG8_STAGE(PG8_SA(0, 0), cA, voffA); PG8_STAGE(PG8_SB(0, 1), cB + hstepB, voffB); PG8_STAGE(PG8_SA(0, 1), cA + hstepA, voffA);
        if (wr == 1) PG8_BAR;
        PG8_WAIT_V(4); PG8_BAR;
        PG8_STAGE(PG8_SB(1, 0), cB + kstep, voffB); PG8_STAGE(PG8_SA(1, 0), cA + kstep, voffA); PG8_STAGE(PG8_SB(1, 1), cB + hstepB + kstep, voffB);
        PG8_WAIT_V(6); PG8_BAR;
    }
    for (;;) {
        const bool has_next = S.next(ui + 1, nxt);
        const char* nA = has_next ? a_base(g, nxt) : cA; const char* nB = has_next ? b_base(g, nxt) : cB;
#pragma unroll 1
        for (int t = 0; t < nt; t += 2) {
            const bool last = (t == nt - 2);
            const char* a1 = cA + (size_t)(t + 1) * kstep;
            const char* a2 = last ? nA : cA + (size_t)(t + 2) * kstep; const char* b2 = last ? nB : cB + (size_t)(t + 2) * kstep;
            const char* a3 = a2 + kstep; const char* b3 = b2 + kstep;
            if constexpr (SP2) {
            PG8_LDB(B0, 0, 0); PG8_LDB(B1, 0, 1); PG8_SCHED; PG8_LDA(At, 0, 0); PG8_STAGE(PG8_SA(1, 1), a1 + hstepA, voffA);
            PG8_WAIT_V(8); PG8_WAIT_L(0); PG8_BAR; PG8_MMA(0, 0, At, B0); PG8_MMA(0, 1, At, B1); PG8_BAR; PG8_SCHED;
            PG8_LDA(At, 0, 1); PG8_STAGE(PG8_SB(0, 0), b2, voffB); PG8_STAGE(PG8_SB(0, 1), b2 + hstepB, voffB); PG8_STAGE(PG8_SA(0, 0), a2, voffA);
            PG8_WAIT_V(8); PG8_WAIT_L(0); PG8_BAR; PG8_MMA(1, 0, At, B0); PG8_MMA(1, 1, At, B1); PG8_BAR; PG8_SCHED;
            PG8_LDB(B0, 1, 0); PG8_LDB(B1, 1, 1); PG8_SCHED; PG8_LDA(At, 1, 0); PG8_STAGE(PG8_SA(0, 1), a2 + hstepA, voffA);
            PG8_WAIT_V(8); PG8_WAIT_L(0); PG8_BAR; PG8_MMA(0, 0, At, B0); PG8_MMA(0, 1, At, B1); PG8_BAR; PG8_SCHED;
            PG8_LDA(At, 1, 1); PG8_STAGE(PG8_SB(1, 0), b3, voffB); PG8_STAGE(PG8_SB(1, 1), b3 + hstepB, voffB); PG8_STAGE(PG8_SA(1, 0), a3, voffA);
            PG8_WAIT_V(8); PG8_WAIT_L(0); PG8_BAR; PG8_MMA(1, 0, At, B0); PG8_MMA(1, 1, At, B1); PG8_BAR; PG8_SCHED;
            } else {
            PG8_LDB(B0, 0, 0); PG8_SCHED; PG8_LDA(At, 0, 0); PG8_STAGE(PG8_SA(1, 1), a1 + hstepA, voffA);
            PG8_WAIT_L(8); PG8_BAR; PG8_WAIT_L(0); PG8_MMA(0, 0, At, B0); PG8_BAR; PG8_SCHED;
            PG8_LDB(B1, 0, 1); PG8_STAGE(PG8_SB(0, 0), b2, voffB);
            PG8_BAR; PG8_WAIT_L(0); PG8_MMA(0, 1, At, B1); PG8_BAR;
            PG8_LDA(At, 0, 1); PG8_STAGE(PG8_SA(0, 0), a2, voffA);
            PG8_BAR; PG8_WAIT_L(0); PG8_MMA(1, 0, At, B0); PG8_BAR; PG8_SCHED;
            PG8_STAGE(PG8_SB(0, 1), b2 + hstepB, voffB);
            PG8_WAIT_V(6); PG8_BAR; PG8_MMA(1, 1, At, B1); PG8_BAR;
            PG8_LDB(B0, 1, 0); PG8_SCHED; PG8_LDA(At, 1, 0); PG8_STAGE(PG8_SA(0, 1), a2 + hstepA, voffA);
            PG8_WAIT_L(8); PG8_BAR; PG8_WAIT_L(0); PG8_MMA(0, 0, At, B0); PG8_BAR; PG8_SCHED;
            PG8_LDB(B1, 1, 1); PG8_STAGE(PG8_SB(1, 0), b3, voffB);
            PG8_BAR; PG8_WAIT_L(0); PG8_MMA(0, 1, At, B1); PG8_BAR;
            PG8_LDA(At, 1, 1); PG8_STAGE(PG8_SA(1, 0), a3, voffA);
            PG8_BAR; PG8_WAIT_L(0); PG8_MMA(1, 0, At, B0); PG8_BAR; PG8_SCHED;
            PG8_STAGE(PG8_SB(1, 1), b3 + hstepB, voffB);
            PG8_WAIT_V(6); PG8_BAR; PG8_MMA(1, 1, At, B1); PG8_BAR;
            }
        }
        if constexpr (ALIGN_EPI) { if (wr == 0) PG8_BAR; }
        E(acc, cur, wr, wc, fr, fq);
        if (!has_next) break;
#pragma unroll
        for (int a = 0; a < 2; ++a)
#pragma unroll
            for (int b = 0; b < 2; ++b)
#pragma unroll
                for (int m = 0; m < 4; ++m)
#pragma unroll
                    for (int n = 0; n < 2; ++n) acc[a][b][m][n] = (f32x4){0.f, 0.f, 0.f, 0.f};
        cur = nxt; cA = nA; cB = nB; ++ui;
        if constexpr (ALIGN_EPI) { if (wr == 1) PG8_BAR; }
    }
    PG8_WAIT_V(0);
    if constexpr (!ALIGN_EPI) { if (wr == 0) PG8_BAR; }
    PG8_BAR;
#undef PG8_SA
#undef PG8_SB
#undef PG8_STAGE
#undef PG8_LDA
#undef PG8_LDB
#undef PG8_MMA
#undef PG8_WAIT_V
#undef PG8_WAIT_L
#undef PG8_BAR
#undef PG8_SCHED
}

typedef f32x4 AccT[2][2][4][2];
struct EpiResid {
    static constexpr bool PERM = false;
    float* X; int ldc; float alpha;
    __device__ __forceinline__ void operator()(const AccT& acc, const Unit& u, int wr, int wc, int fr_in, int fq_in) const {
        int fr = fr_in, fq = fq_in; asm volatile("" : "+v"(fr), "+v"(fq));
        const int row0 = u.pm * BM + wr * 64 + fr, col0 = u.pn * BM + wc * 32 + 4 * fq;
#pragma unroll
        for (int ai = 0; ai < 2; ++ai)
#pragma unroll
            for (int m = 0; m < 4; ++m) { float* rowp = X + (size_t)(row0 + ai * HALF + m * 16) * ldc + col0;
                f32x4 xv[2][2];
#pragma unroll
                for (int bj = 0; bj < 2; ++bj)
#pragma unroll
                    for (int n = 0; n < 2; ++n) xv[bj][n] = *(const f32x4*)(rowp + bj * HALF + n * 16);
#pragma unroll
                for (int bj = 0; bj < 2; ++bj)
#pragma unroll
                    for (int n = 0; n < 2; ++n) *(f32x4*)(rowp + bj * HALF + n * 16) = xv[bj][n] * alpha + acc[ai][bj][m][n]; }
    }
};
struct EpiRelu2 {
    static constexpr bool PERM = true;
    bf16* O; int ldc;
    __device__ __forceinline__ void operator()(const AccT& acc, const Unit& u, int wr, int wc, int fr_in, int fq_in) const {
        int fr = fr_in, fq = fq_in; asm volatile("" : "+v"(fr), "+v"(fq));
        const int row0 = u.pm * BM + wr * 64 + fr, col0 = u.pn * BM + wc * 32 + 8 * fq;
#pragma unroll
        for (int ai = 0; ai < 2; ++ai)
#pragma unroll
            for (int m = 0; m < 4; ++m) { bf16* rowp = O + (size_t)(row0 + ai * HALF + m * 16) * ldc + col0;
#pragma unroll
                for (int bj = 0; bj < 2; ++bj) { f32x4 v0 = acc[ai][bj][m][0], v1 = acc[ai][bj][m][1];
#pragma unroll
                    for (int j = 0; j < 4; ++j) { const float a = fmaxf(v0[j], 0.f), b = fmaxf(v1[j], 0.f); v0[j] = a * a; v1[j] = b * b; }
                    u32x4 w; w.x = pk2(v0[0], v0[1]); w.y = pk2(v0[2], v0[3]); w.z = pk2(v1[0], v1[1]); w.w = pk2(v1[2], v1[3]);
                    *(u32x4*)(rowp + bj * HALF) = w; } }
    }
};
struct EpiRgIn {
    static constexpr bool PERM = true;
    bf16* GATE; bf16* URAW;
    __device__ __forceinline__ void operator()(const AccT& acc, const Unit& u, int wr, int wc, int fr_in, int fq_in) const {
        int fr = fr_in, fq = fq_in; asm volatile("" : "+v"(fr), "+v"(fq));
        const bool isg = u.pn < 8; bf16* base = isg ? GATE : URAW;
        const int row0 = u.pm * BM + wr * 64 + fr, col0 = (u.pn & 7) * BM + wc * 32 + 8 * fq;
#pragma unroll
        for (int ai = 0; ai < 2; ++ai)
#pragma unroll
            for (int m = 0; m < 4; ++m) { bf16* rowp = base + (size_t)(row0 + ai * HALF + m * 16) * D + col0;
#pragma unroll
                for (int bj = 0; bj < 2; ++bj) { f32x4 v0 = acc[ai][bj][m][0], v1 = acc[ai][bj][m][1];
                    if (isg) {
#pragma unroll
                        for (int j = 0; j < 4; ++j) { v0[j] = gelu_tanh_(v0[j]); v1[j] = gelu_tanh_(v1[j]); } }
                    u32x4 w; w.x = pk2(v0[0], v0[1]); w.y = pk2(v0[2], v0[3]); w.z = pk2(v1[0], v1[1]); w.w = pk2(v1[2], v1[3]);
                    *(u32x4*)(rowp + bj * HALF) = w; } }
    }
};
struct EpiRgGates {
    static constexpr bool PERM = true;
    const bf16* U; bf16* LA; bf16* INP; const float* ba; const float* bx; const float* spt;
    __device__ __forceinline__ void operator()(const AccT& acc, const Unit& u, int wr, int wc, int fr_in, int fq_in) const {
        int fr = fr_in, fq = fq_in; asm volatile("" : "+v"(fr), "+v"(fq));
        const int d = u.pn >> 4, nb = (u.pn >> 1) & 7, half = u.pn & 1;
        const int c0 = nb * 256 + half * 128 + wc * 32 + 8 * fq;
        const int row0 = u.pm * BM + wr * 64 + fr;
        bf16* la = LA + (size_t)d * TG * D; bf16* inp = INP + (size_t)d * TG * D;
#pragma unroll
        for (int n = 0; n < 2; ++n) {
            const f32x4 pba = *(const f32x4*)(ba + d * D + c0 + 4 * n), pbx = *(const f32x4*)(bx + d * D + c0 + 4 * n), psp = *(const f32x4*)(spt + d * D + c0 + 4 * n);
#pragma unroll
            for (int ai = 0; ai < 2; ++ai)
#pragma unroll
                for (int m = 0; m < 4; ++m) { const size_t off = (size_t)(row0 + ai * HALF + m * 16) * D + c0 + 4 * n;
                    const u32x2 uw = *(const u32x2*)(U + off);
                    const float uv[4] = {bflo(uw.x), bfhi(uw.x), bflo(uw.y), bfhi(uw.y)};
                    float lv[4], iv[4];
#pragma unroll
                    for (int j = 0; j < 4; ++j) { const float r = sigmoidf_(acc[ai][0][m][n][j] + pba[j]); const float ig = sigmoidf_(acc[ai][1][m][n][j] + pbx[j]);
                        const float l = r * psp[j]; const float a2 = __expf(2.0f * l); lv[j] = l; iv[j] = fsqrt_(fmaxf(1.0f - a2, 0.f)) * ig * uv[j]; }
                    u32x2 w; w.x = pk2(lv[0], lv[1]); w.y = pk2(lv[2], lv[3]); *(u32x2*)(la + off) = w;
                    u32x2 v; v.x = pk2(iv[0], iv[1]); v.y = pk2(iv[2], iv[3]); *(u32x2*)(inp + off) = v; }
            asm volatile("" ::: "memory");
        }
    }
};
struct EpiSsdIn {
    static constexpr bool PERM = true;
    bf16* ZS; bf16* XBCR; float* DT; const float* dtb;
    __device__ __forceinline__ void operator()(const AccT& acc, const Unit& u, int wr, int wc, int fr_in, int fq_in) const {
        int fr = fr_in, fq = fq_in; asm volatile("" : "+v"(fr), "+v"(fq));
        const int row0 = u.pm * BM + wr * 64 + fr, cw = wc * 32 + 8 * fq;
        if (u.pn < 40) {
            const bool isz = u.pn < 16; bf16* base = isz ? ZS + (size_t)u.pn * BM : XBCR + (size_t)(u.pn - 16) * BM; const int ldc = isz ? SSD_DI : SSD_XBC;
#pragma unroll
            for (int ai = 0; ai < 2; ++ai)
#pragma unroll
                for (int m = 0; m < 4; ++m) { bf16* rowp = base + (size_t)(row0 + ai * HALF + m * 16) * ldc + cw;
#pragma unroll
                    for (int bj = 0; bj < 2; ++bj) { f32x4 v0 = acc[ai][bj][m][0], v1 = acc[ai][bj][m][1];
                        if (isz) {
#pragma unroll
                            for (int j = 0; j < 4; ++j) { v0[j] = siluf_(v0[j]); v1[j] = siluf_(v1[j]); } }
                        u32x4 w; w.x = pk2(v0[0], v0[1]); w.y = pk2(v0[2], v0[3]); w.z = pk2(v1[0], v1[1]); w.w = pk2(v1[2], v1[3]);
                        *(u32x4*)(rowp + bj * HALF) = w; } }
        } else {
            f32x4 b0 = *(const f32x4*)(dtb + cw), b1 = *(const f32x4*)(dtb + cw + 4);
#pragma unroll
            for (int ai = 0; ai < 2; ++ai)
#pragma unroll
                for (int m = 0; m < 4; ++m) { float* rowp = DT + (size_t)(row0 + ai * HALF + m * 16) * 128 + cw;
                    f32x4 v0 = acc[ai][0][m][0] + b0, v1 = acc[ai][0][m][1] + b1;
#pragma unroll
                    for (int j = 0; j < 4; ++j) { v0[j] = softplusf_(v0[j]); v1[j] = softplusf_(v1[j]); }
                    *(f32x4*)(rowp) = v0; *(f32x4*)(rowp + 4) = v1; }
        }
    }
};
struct EpiQkv {
    static constexpr bool PERM = true;
    bf16* Q; const float* bias;
    __device__ __forceinline__ void operator()(const AccT& acc, const Unit& u, int wr, int wc, int fr_in, int fq_in) const {
        int fr = fr_in, fq = fq_in; asm volatile("" : "+v"(fr), "+v"(fq));
        const int t = u.pn >> 3; bf16* base = Q + (size_t)t * TG * D; const float sc = t == 0 ? 0.08838834764831845f : 1.0f;
        const int row0 = u.pm * BM + wr * 64 + fr, col0 = (u.pn & 7) * BM + wc * 32 + 8 * fq, bcol0 = u.pn * BM + wc * 32 + 8 * fq;
#pragma unroll
        for (int bj = 0; bj < 2; ++bj) {
            const f32x4 bv0 = *(const f32x4*)(bias + bcol0 + bj * HALF), bv1 = *(const f32x4*)(bias + bcol0 + bj * HALF + 4);
#pragma unroll
            for (int ai = 0; ai < 2; ++ai)
#pragma unroll
                for (int m = 0; m < 4; ++m) { bf16* rowp = base + (size_t)(row0 + ai * HALF + m * 16) * D + col0;
                    const f32x4 v0 = (acc[ai][bj][m][0] + bv0) * sc, v1 = (acc[ai][bj][m][1] + bv1) * sc;
                    u32x4 w; w.x = pk2(v0[0], v0[1]); w.y = pk2(v0[2], v0[3]); w.z = pk2(v1[0], v1[1]); w.w = pk2(v1[2], v1[3]);
                    *(u32x4*)(rowp + bj * HALF) = w; }
            asm volatile("" ::: "memory");
        }
    }
};
}

struct Frame {
    LAS unsigned char* lds;
    int tid, lane, wave, G, gw, ngw;
};

__device__ __forceinline__ Frame phase_frame(const Frame& F0) {
    Frame F = F0; int t = threadIdx.x; asm volatile("" : "+v"(t));
    F.tid = t; F.lane = t & 63; F.wave = __builtin_amdgcn_readfirstlane(t >> 6); F.gw = blockIdx.x * NWAVES + F.wave; return F;
}
__device__ __forceinline__ void transpose_item(const float* W, int ldw, bf16* WT, int ldt, int k0, int n0, int drow0, LAS float* scr, int lane) {
#pragma unroll 8
    for (int i = 0; i < 32; ++i) { const int kk = 2 * i + (lane >> 5); scr[kk * 33 + (lane & 31)] = W[(size_t)(k0 + kk) * ldw + n0 + (lane & 31)]; }
    LDS_WAIT(); asm volatile("" ::: "memory");
    const int c = lane & 7;
#pragma unroll
    for (int j = 0; j < 4; ++j) { const int n = (lane >> 3) + 8 * j; const LAS float* s = scr + (8 * c) * 33 + n;
        u32x4 o; o.x = pk2(s[0 * 33], s[1 * 33]); o.y = pk2(s[2 * 33], s[3 * 33]); o.z = pk2(s[4 * 33], s[5 * 33]); o.w = pk2(s[6 * 33], s[7 * 33]);
        *(GAS u32x4*)(WT + (size_t)(drow0 + n) * ldt + k0 + 8 * c) = o; }
    LDS_WAIT(); asm volatile("" ::: "memory");
}
__device__ __forceinline__ void conv_matrix(const Frame& F, const float* W, int K, int N, bf16* WT, LAS float* scr) {
    const int nblk = N / 32, nitems = (K / 64) * nblk;
    for (int it = F.gw; it < nitems; it += F.ngw) { const int kb = it / nblk, nb = it % nblk; transpose_item(W, N, WT, K, 64 * kb, 32 * nb, 32 * nb, scr, F.lane); }
}
__device__ __forceinline__ void p_prologue(const Frame& F0, const float* const* in, bf16* Wb, float* spt) {
    const Frame F = phase_frame(F0);
    LAS float* scr = (LAS float*)(F.lds + F.wave * 16384);
    for (int l = 0; l < 2; ++l) {
        conv_matrix(F, in[2] + (size_t)l * 2048 * 4096, 2048, 4096, Wb + W_RGIN + (size_t)l * 4096 * 2048, scr);
        conv_matrix(F, in[10] + (size_t)l * 2048 * 2048, 2048, 2048, Wb + W_RGOUT + (size_t)l * 2048 * 2048, scr);
    }
    for (int it = F.gw; it < 2 * 2 * 16 * 32; it += F.ngw) {
        const int sub = it & 31, mat = it >> 5;
        const int dn = mat & 15, ax = (mat >> 4) & 1, l = mat >> 5;
        const int kb = sub >> 3, nb = sub & 7, j0 = 32 * nb;
        const float* W = in[ax ? 7 : 5] + ((size_t)(l * 16 + dn)) * 65536;
        bf16* WT = Wb + W_RGGATE + (size_t)l * 32 * 65536 + (size_t)(dn * 2 + (j0 >> 7)) * 65536;
        transpose_item(W, 256, WT, 256, 64 * kb, j0, (j0 & 127) + 128 * ax, scr, F.lane);
    }
    for (int i = F.gw * 64 + F.lane; i < 2 * 2 * 2048; i += F.ngw * 64) spt[i] = -8.0f * softplusf_(-in[9][i]);
    conv_matrix(F, in[11], 2048, SSD_NIN, Wb + W_SSDIN, scr);
    { u32x4* z = (u32x4*)(Wb + W_SSDIN + (size_t)SSD_NIN * 2048); const int n16 = (SSD_NIN_PAD - SSD_NIN) * 2048 / 8;
      for (int i = F.gw * 64 + F.lane; i < n16; i += F.ngw * 64) z[i] = (u32x4){0u, 0u, 0u, 0u}; }
    conv_matrix(F, in[18], 4096, 2048, Wb + W_SSDOUT, scr);
    conv_matrix(F, in[19], 2048, 6144, Wb + W_NAQKV, scr);
    conv_matrix(F, in[22], 2048, 2048, Wb + W_NAOUT, scr);
    for (int l = 0; l < 4; ++l) {
        conv_matrix(F, in[23] + (size_t)l * 2048 * 8192, 2048, 8192, Wb + W_UP + (size_t)l * 8192 * 2048, scr);
        conv_matrix(F, in[24] + (size_t)l * 8192 * 2048, 8192, 2048, Wb + W_DOWN + (size_t)l * 2048 * 8192, scr);
    }
}

__device__ __forceinline__ void p_copy(const Frame& F0, const float* src, float* X, bf16* XB) {
    const Frame F = phase_frame(F0);
    const int n4 = TG * D / 4;
    for (int i = F.gw * 64 + F.lane; i < n4; i += F.ngw * 64) { const f32x4 v = ((const f32x4*)src)[i]; ((f32x4*)X)[i] = v; u32x2 w; w.x = pk2(v.x, v.y); w.y = pk2(v.z, v.w); ((u32x2*)XB)[i] = w; }
}
__device__ __forceinline__ void p_ln(const Frame& F0, float* X, bf16* XB, const float* g, const float* b) {
    const Frame F = phase_frame(F0);
    for (int m = F.gw; m < TG; m += F.ngw) {
        f32x4* xr = (f32x4*)(X + (size_t)m * D) + F.lane;
        f32x4 v[8]; float s = 0.f;
#pragma unroll
        for (int j = 0; j < 8; ++j) { v[j] = xr[64 * j]; s += (v[j].x + v[j].y) + (v[j].z + v[j].w); }
        const float mean = wave_sum(s, F.lane) * (1.f / D); float s2 = 0.f;
#pragma unroll
        for (int j = 0; j < 8; ++j) { v[j] = v[j] - mean; s2 += (v[j].x * v[j].x + v[j].y * v[j].y) + (v[j].z * v[j].z + v[j].w * v[j].w); }
        const float rstd = rsqrtf(wave_sum(s2, F.lane) * (1.f / D) + LN_EPS);
        u32x2* o8 = (u32x2*)(XB + (size_t)m * D) + F.lane;
#pragma unroll
        for (int j = 0; j < 8; ++j) { const f32x4 gg = ((const f32x4*)g)[F.lane + 64 * j], bb = ((const f32x4*)b)[F.lane + 64 * j];
            const f32x4 y = v[j] * rstd * gg + bb; xr[64 * j] = y; u32x2 w; w.x = pk2(y.x, y.y); w.y = pk2(y.z, y.w); o8[64 * j] = w; }
    }
}

template <int MODE>
__device__ __forceinline__ void p_conv(const Frame& F0, const bf16* in, int C, int L, const float* cw, const float* cb, bf16* out0, bf16* out1, bf16* out2) {
    const Frame F = phase_frame(F0);
    const int ncb = C / 512, nitems = (TG / 16) * ncb;
    for (int it = F.gw; it < nitems; it += F.ngw) {
        const int cbk = it % ncb, run = it / ncb, t0 = run * 16, c0 = cbk * 512 + F.lane * 8;
        const int tl = t0 % L;
        float w[4][8], bias[8];
#pragma unroll
        for (int k = 0; k < 4; ++k) { const f32x4 a = *(const f32x4*)(cw + (size_t)k * C + c0), b = *(const f32x4*)(cw + (size_t)k * C + c0 + 4);
            w[k][0] = a.x; w[k][1] = a.y; w[k][2] = a.z; w[k][3] = a.w; w[k][4] = b.x; w[k][5] = b.y; w[k][6] = b.z; w[k][7] = b.w; }
        { const f32x4 a = *(const f32x4*)(cb + c0), b = *(const f32x4*)(cb + c0 + 4); bias[0] = a.x; bias[1] = a.y; bias[2] = a.z; bias[3] = a.w; bias[4] = b.x; bias[5] = b.y; bias[6] = b.z; bias[7] = b.w; }
        u32x4 rows[19];
#pragma unroll
        for (int i = 0; i < 19; ++i) { const int tt = tl - 1 + i; const bool ok = (tt >= 0) && (tt < L);
            rows[i] = ok ? *(const u32x4*)(in + (size_t)(t0 - 1 + i) * C + c0) : (u32x4){0u, 0u, 0u, 0u}; }
        unsigned outw[16][4];
#pragma unroll
        for (int i = 0; i < 16; ++i) {
            float y[8];
#pragma unroll
            for (int j = 0; j < 8; ++j) y[j] = bias[j];
#pragma unroll
            for (int k = 0; k < 4; ++k) { const u32x4 r = rows[i + k];
                y[0] += w[k][0] * bflo(r.x); y[1] += w[k][1] * bfhi(r.x); y[2] += w[k][2] * bflo(r.y); y[3] += w[k][3] * bfhi(r.y);
                y[4] += w[k][4] * bflo(r.z); y[5] += w[k][5] * bfhi(r.z); y[6] += w[k][6] * bflo(r.w); y[7] += w[k][7] * bfhi(r.w); }
            if (MODE == 1) {
#pragma unroll
                for (int j = 0; j < 8; ++j) y[j] = siluf_(y[j]); }
            outw[i][0] = pk2(y[0], y[1]); outw[i][1] = pk2(y[2], y[3]); outw[i][2] = pk2(y[4], y[5]); outw[i][3] = pk2(y[6], y[7]);
        }
        if (MODE == 0 || c0 >= 4096) {
            bf16* ob; int ldo, cc;
            if (MODE == 0) { ob = out0; ldo = C; cc = c0; } else if (c0 < 5120) { ob = out1; ldo = 1024; cc = c0 - 4096; } else { ob = out2; ldo = 1024; cc = c0 - 5120; }
#pragma unroll
            for (int i = 0; i < 16; ++i) *(u32x4*)(ob + (size_t)(t0 + i) * ldo + cc) = (u32x4){outw[i][0], outw[i][1], outw[i][2], outw[i][3]};
        } else {
            const int chunk = t0 >> 7, s0 = t0 & 127, head = c0 >> 6, p0 = c0 & 63;
            bf16* xb = out0 + ((size_t)(chunk * 64 + head) * 64 + p0) * 128 + s0;
#pragma unroll
            for (int j = 0; j < 8; ++j) {
                unsigned e[8];
#pragma unroll
                for (int q = 0; q < 8; ++q) { const unsigned a = outw[2 * q][j >> 1], b = outw[2 * q + 1][j >> 1];
                    e[q] = (j & 1) ? ((a >> 16) | (b & 0xffff0000u)) : ((a & 0xffffu) | (b << 16)); }
                *(u32x4*)(xb + (size_t)j * 128) = (u32x4){e[0], e[1], e[2], e[3]}; *(u32x4*)(xb + (size_t)j * 128 + 8) = (u32x4){e[4], e[5], e[6], e[7]};
            }
        }
    }
}

__device__ __forceinline__ void p_rg_scan_a(const Frame& F0, const bf16* LA, const bf16* INP, float* HEND, float* PROD) {
    const Frame F = phase_frame(F0);
    for (int it = F.gw; it < 128 * 2 * 4; it += F.ngw) {
        const int cb = it & 3, d = (it >> 2) & 1, ck = it >> 3, c0 = cb * 512 + F.lane * 8;
        const bf16* la = LA + (size_t)d * TG * D + (size_t)ck * 64 * D + c0; const bf16* ip = INP + (size_t)d * TG * D + (size_t)ck * 64 * D + c0;
        float h[8], ls[8];
#pragma unroll
        for (int j = 0; j < 8; ++j) { h[j] = 0.f; ls[j] = 0.f; }
#pragma unroll 8
        for (int i = 0; i < 64; ++i) { const int t = d ? 63 - i : i;
            const u32x4 lw = *(const u32x4*)(la + (size_t)t * D), iw = *(const u32x4*)(ip + (size_t)t * D);
            const float l[8] = {bflo(lw.x), bfhi(lw.x), bflo(lw.y), bfhi(lw.y), bflo(lw.z), bfhi(lw.z), bflo(lw.w), bfhi(lw.w)};
            const float x[8] = {bflo(iw.x), bfhi(iw.x), bflo(iw.y), bfhi(iw.y), bflo(iw.z), bfhi(iw.z), bflo(iw.w), bfhi(iw.w)};
#pragma unroll
            for (int j = 0; j < 8; ++j) { h[j] = __expf(l[j]) * h[j] + x[j]; ls[j] += l[j]; } }
        float* he = HEND + ((size_t)ck * 2 + d) * D + c0; float* pr = PROD + ((size_t)ck * 2 + d) * D + c0;
        *(f32x4*)he = (f32x4){h[0], h[1], h[2], h[3]}; *(f32x4*)(he + 4) = (f32x4){h[4], h[5], h[6], h[7]};
        *(f32x4*)pr = (f32x4){__expf(ls[0]), __expf(ls[1]), __expf(ls[2]), __expf(ls[3])}; *(f32x4*)(pr + 4) = (f32x4){__expf(ls[4]), __expf(ls[5]), __expf(ls[6]), __expf(ls[7])};
    }
}
__device__ __forceinline__ void p_rg_scan_b(const Frame& F0, const float* HEND, const float* PROD, float* HIN, int L) {
    const Frame F = phase_frame(F0);
    const int nck = L / 64, nseq = TG / L, total = nseq * 2 * D;
    for (int e = F.gw * 64 + F.lane; e < total; e += F.ngw * 64) {
        const int c = e % D, d = (e / D) & 1, sq = e / (2 * D);
        float h = 0.f;
        for (int k = 0; k < nck; ++k) { const int ck = sq * nck + (d ? nck - 1 - k : k); const size_t o = ((size_t)ck * 2 + d) * D + c;
            const float p = PROD[o], he = HEND[o]; HIN[o] = h; h = p * h + he; }
    }
}
__device__ __forceinline__ void p_rg_scan_c(const Frame& F0, const bf16* LA, const bf16* INP, const float* HIN, const bf16* GATE, bf16* Y) {
    const Frame F = phase_frame(F0);
    for (int it = F.gw; it < 128 * 16; it += F.ngw) {
        const int cb = it & 15, ck = it >> 4, c0 = cb * 128 + F.lane * 2;
        const size_t base = (size_t)ck * 64 * D + c0;
        const unsigned* la0 = (const unsigned*)(LA + base); const unsigned* ip0 = (const unsigned*)(INP + base);
        const unsigned* la1 = (const unsigned*)(LA + (size_t)TG * D + base); const unsigned* ip1 = (const unsigned*)(INP + (size_t)TG * D + base);
        const unsigned* gt = (const unsigned*)(GATE + base); unsigned* yo = (unsigned*)(Y + base);
        f32x2 hf[64];
        { const f32x2 hi = *(const f32x2*)(HIN + ((size_t)ck * 2 + 0) * D + c0); float h0 = hi.x, h1 = hi.y;
#pragma unroll
          for (int t = 0; t < 64; ++t) { const unsigned lw = la0[(size_t)t * (D / 2)], iw = ip0[(size_t)t * (D / 2)];
              h0 = __expf(bflo(lw)) * h0 + bflo(iw); h1 = __expf(bfhi(lw)) * h1 + bfhi(iw); hf[t] = (f32x2){h0, h1}; } }
        { const f32x2 hi = *(const f32x2*)(HIN + ((size_t)ck * 2 + 1) * D + c0); float h0 = hi.x, h1 = hi.y;
#pragma unroll
          for (int i = 0; i < 64; ++i) { const int t = 63 - i; const unsigned lw = la1[(size_t)t * (D / 2)], iw = ip1[(size_t)t * (D / 2)], gw = gt[(size_t)t * (D / 2)];
              h0 = __expf(bflo(lw)) * h0 + bflo(iw); h1 = __expf(bfhi(lw)) * h1 + bfhi(iw);
              yo[(size_t)t * (D / 2)] = pk2((hf[t].x + h0) * bflo(gw), (hf[t].y + h1) * bfhi(gw)); } }
    }
}

constexpr int PB = 272;
__device__ __forceinline__ s16x4 tr_read(const LAS unsigned char* p) { return __builtin_bit_cast(s16x4, __builtin_amdgcn_ds_read_tr16_b64_v4i16((LAS v4i16_t*)p)); }
__device__ __forceinline__ bf16x8 cat8(s16x4 lo, s16x4 hi) { return __builtin_shufflevector(lo, hi, 0, 1, 2, 3, 4, 5, 6, 7); }
__device__ __forceinline__ bf16x8 scale8(bf16x8 v, const float* w) {
    const u32x4 u = __builtin_bit_cast(u32x4, v); u32x4 o;
    o.x = pk2(bflo(u.x) * w[0], bfhi(u.x) * w[1]); o.y = pk2(bflo(u.y) * w[2], bfhi(u.y) * w[3]); o.z = pk2(bflo(u.z) * w[4], bfhi(u.z) * w[5]); o.w = pk2(bflo(u.w) * w[6], bfhi(u.w) * w[7]);
    return __builtin_bit_cast(bf16x8, o);
}
__device__ __forceinline__ bf16x8 scale8s(bf16x8 v, float w) {
    const u32x4 u = __builtin_bit_cast(u32x4, v); u32x4 o;
    o.x = pk2(bflo(u.x) * w, bfhi(u.x) * w); o.y = pk2(bflo(u.y) * w, bfhi(u.y) * w); o.z = pk2(bflo(u.z) * w, bfhi(u.z) * w); o.w = pk2(bflo(u.w) * w, bfhi(u.w) * w);
    return __builtin_bit_cast(bf16x8, o);
}
__device__ __forceinline__ void stage_img(const Frame& F, const bf16* src, int ld, LAS unsigned char* img) {
#pragma unroll
    for (int i = 0; i < 4; ++i) { const int idx = F.tid + 512 * i, r = idx >> 4, ch = idx & 15; *(LAS u32x4*)(img + r * PB + ch * 16) = *(const u32x4*)(src + (size_t)r * ld + ch * 8); }
}
__device__ __forceinline__ void ssd_tables(const Frame& F, const float* DT, int t0, int head, float A0, float A1, LAS float* tab) {
    const int L = F.lane; const float* dp = DT + (size_t)(t0 + 2 * L) * 128 + head;
    const float a0 = dp[0], a1 = dp[128], b0 = dp[64], b1 = dp[128 + 64];
    float sa = a0 + a1, sb = b0 + b1, ia = sa, ib = sb;
#pragma unroll
    for (int o = 1; o < 64; o <<= 1) { const float xa = shfl_lane(ia, (L - o) & 63), xb = shfl_lane(ib, (L - o) & 63); if (L >= o) { ia += xa; ib += xb; } }
    const float totb = shfl_lane(ib, 63);
    const float ea = ia - sa, eb = ib - sb;
    tab[2 * L] = A0 * (ea + a0); tab[2 * L + 1] = A0 * (ea + a0 + a1);
    tab[128 + 2 * L] = A1 * (totb - eb); tab[128 + 2 * L + 1] = A1 * (totb - eb - b0);
    tab[256 + 2 * L] = a0; tab[256 + 2 * L + 1] = a1; tab[384 + 2 * L] = b0; tab[384 + 2 * L + 1] = b1;
}
__device__ __forceinline__ void p_ssd_states(const Frame& F0, const bf16* XT, const bf16* BMt, const float* DT, const float* alog, bf16* ST, float* DEC) {
    const Frame F = phase_frame(F0);
    LAS unsigned char* img = F.lds; LAS float* tab = (LAS float*)(F.lds + 36864 + F.wave * 2048);
    const int L = F.lane, h = L >> 5, l31 = L & 31, q = (L & 15) >> 2, p4 = L & 3, blk = (L >> 4) & 1;
    for (int it = blockIdx.x; it < 64 * 8; it += F.G) {
        const int c = it >> 3, g = it & 7, head = g * 8 + F.wave, t0 = c * 128;
        stage_img(F, BMt + (size_t)t0 * 1024 + g * 128, 1024, img);
        const float A0 = -__expf(alog[head]), A1 = -__expf(alog[64 + head]);
        ssd_tables(F, DT, t0, head, A0, A1, tab);
        __syncthreads();
        const float afe = tab[127], ab0 = tab[128];
        if (L == 0) { DEC[(c * 2 + 0) * 64 + head] = __expf(afe); DEC[(c * 2 + 1) * 64 + head] = __expf(ab0); }
        const bf16* xt = XT + (size_t)(c * 64 + head) * 64 * 128;
#pragma unroll 1
        for (int dir = 0; dir < 2; ++dir) {
            f32x16 acc[4][2];
#pragma unroll
            for (int a = 0; a < 4; ++a)
#pragma unroll
                for (int b = 0; b < 2; ++b)
#pragma unroll
                    for (int r = 0; r < 16; ++r) acc[a][b][r] = 0.f;
            const float eref = dir ? ab0 : afe;
#pragma unroll 2
            for (int ks = 0; ks < 8; ++ks) {
                const int s0 = 16 * ks + 8 * h;
                float w[8];
#pragma unroll
                for (int j = 0; j < 8; ++j) w[j] = __expf(eref - tab[dir * 128 + s0 + j]) * tab[256 + dir * 128 + s0 + j];
                bf16x8 bfr[2];
#pragma unroll
                for (int pt = 0; pt < 2; ++pt) bfr[pt] = scale8(*(const bf16x8*)(xt + (size_t)(32 * pt + l31) * 128 + s0), w);
#pragma unroll
                for (int nt = 0; nt < 4; ++nt) {
                    const LAS unsigned char* ad = img + (16 * ks + 8 * h + q) * PB + (32 * nt + 16 * blk + 4 * p4) * 2;
                    const bf16x8 afr = cat8(tr_read(ad), tr_read(ad + 4 * PB));
#pragma unroll
                    for (int pt = 0; pt < 2; ++pt) acc[nt][pt] = __builtin_amdgcn_mfma_f32_32x32x16_bf16(afr, bfr[pt], acc[nt][pt], 0, 0, 0);
                }
            }
            bf16* st = ST + ((size_t)(c * 2 + dir) * 64 + head) * 8192;
#pragma unroll
            for (int nt = 0; nt < 4; ++nt)
#pragma unroll
                for (int pt = 0; pt < 2; ++pt)
#pragma unroll
                    for (int qd = 0; qd < 4; ++qd) { u32x2 w2; w2.x = pk2(acc[nt][pt][4 * qd], acc[nt][pt][4 * qd + 1]); w2.y = pk2(acc[nt][pt][4 * qd + 2], acc[nt][pt][4 * qd + 3]);
                        *(u32x2*)(st + (size_t)(32 * pt + l31) * 128 + 32 * nt + 8 * qd + 4 * h) = w2; }
        }
        __syncthreads();
    }
}
__device__ __forceinline__ void p_ssd_rec(const Frame& F0, bf16* ST, const float* DEC, int L) {
    const Frame F = phase_frame(F0);
    const int nck = L / 128, nseq = TG / L, total = nseq * 131072;
    for (int e = F.gw * 64 + F.lane; e < total; e += F.ngw * 64) {
        const int oct = e & 1023, head = (e >> 10) & 63, dir = (e >> 16) & 1, sq = e >> 17;
        float hst[8];
#pragma unroll
        for (int j = 0; j < 8; ++j) hst[j] = 0.f;
#pragma unroll 4
        for (int k = 0; k < nck; ++k) { const int c = sq * nck + (dir ? nck - 1 - k : k);
            u32x4* p = (u32x4*)(ST + ((size_t)(c * 2 + dir) * 64 + head) * 8192 + oct * 8);
            const u32x4 v = *p; const float dec = DEC[(c * 2 + dir) * 64 + head];
            u32x4 o; o.x = pk2(hst[0], hst[1]); o.y = pk2(hst[2], hst[3]); o.z = pk2(hst[4], hst[5]); o.w = pk2(hst[6], hst[7]); *p = o;
            hst[0] = hst[0] * dec + bflo(v.x); hst[1] = hst[1] * dec + bfhi(v.x); hst[2] = hst[2] * dec + bflo(v.y); hst[3] = hst[3] * dec + bfhi(v.y);
            hst[4] = hst[4] * dec + bflo(v.z); hst[5] = hst[5] * dec + bfhi(v.z); hst[6] = hst[6] * dec + bflo(v.w); hst[7] = hst[7] * dec + bfhi(v.w); }
    }
}
__device__ __forceinline__ void p_ssd_out(const Frame& F0, const bf16* XT, const bf16* BMt, const bf16* CMt, const float* DT, const float* alog, const float* dskip, const bf16* ST,
                                          const bf16* ZS, const float* ng, bf16* Y) {
    const Frame F = phase_frame(F0);
    LAS unsigned char* imgB = F.lds; LAS unsigned char* imgC = F.lds + 34816; LAS float* tab = (LAS float*)(F.lds + 69632 + F.wave * 2048); LAS float* part = (LAS float*)(F.lds + 69632 + 16384);
    const int L0 = F.lane;
    for (int it = blockIdx.x; it < 64 * 8; it += F.G) {
        const int c = it >> 3, g = it & 7, head = g * 8 + F.wave, t0 = c * 128;
        stage_img(F, BMt + (size_t)t0 * 1024 + g * 128, 1024, imgB);
        stage_img(F, CMt + (size_t)t0 * 1024 + g * 128, 1024, imgC);
        const float A0 = -__expf(alog[head]), A1 = -__expf(alog[64 + head]), dsk = dskip[head];
        ssd_tables(F, DT, t0, head, A0, A1, tab);
        __syncthreads();
        const bf16* xt = XT + (size_t)(c * 64 + head) * 64 * 128;
#pragma unroll 1
        for (int half = 0; half < 2; ++half) {
            f32x16 acc[2][2];
#pragma unroll
            for (int a = 0; a < 2; ++a)
#pragma unroll
                for (int b = 0; b < 2; ++b)
#pragma unroll
                    for (int r = 0; r < 16; ++r) acc[a][b][r] = 0.f;
            { int L = L0; asm volatile("" : "+v"(L)); const int h = L >> 5, l31 = L & 31;
#pragma unroll 1
            for (int st = 0; st < 4; ++st) {
                bf16x8 xa[2][2];
#pragma unroll
                for (int ks = 0; ks < 2; ++ks)
#pragma unroll
                    for (int pt = 0; pt < 2; ++pt) { const bf16* xp = xt + (size_t)(32 * pt + l31) * 128 + 32 * st + 16 * ks + 4 * h;
                        const s16x4 lo = *(const s16x4*)xp, hi = *(const s16x4*)(xp + 8); xa[ks][pt] = cat8(lo, hi); }
#pragma unroll
                for (int tt = 0; tt < 2; ++tt) {
                    const int tg = 2 * half + tt;
                    f32x16 dg;
#pragma unroll
                    for (int r = 0; r < 16; ++r) dg[r] = 0.f;
#pragma unroll 2
                    for (int kn = 0; kn < 8; ++kn) { const bf16x8 a = *(const LAS bf16x8*)(imgB + (32 * st + l31) * PB + (16 * kn + 8 * h) * 2), b = *(const LAS bf16x8*)(imgC + (32 * tg + l31) * PB + (16 * kn + 8 * h) * 2);
                        dg = __builtin_amdgcn_mfma_f32_32x32x16_bf16(a, b, dg, 0, 0, 0); }
                    const int t = 32 * tg + l31; const float aft = tab[t], abt = tab[128 + t];
                    float v[16];
#pragma unroll
                    for (int qd = 0; qd < 4; ++qd) { const int sb = 32 * st + 8 * qd + 4 * h;
                        const f32x4 afs = *(const LAS f32x4*)(tab + sb), abs_ = *(const LAS f32x4*)(tab + 128 + sb), d0 = *(const LAS f32x4*)(tab + 256 + sb), d1 = *(const LAS f32x4*)(tab + 384 + sb);
#pragma unroll
                        for (int e = 0; e < 4; ++e) { const int s = sb + e; float m = 0.f;
                            if (s <= t) m += __expf(aft - afs[e]) * d0[e];
                            if (s >= t) m += __expf(abt - abs_[e]) * d1[e];
                            float x = dg[4 * qd + e] * m; if (s == t) x += dsk; v[4 * qd + e] = x; } }
                    bf16x8 gf[2];
#pragma unroll
                    for (int ks = 0; ks < 2; ++ks) { u32x4 o; o.x = pk2(v[8 * ks], v[8 * ks + 1]); o.y = pk2(v[8 * ks + 2], v[8 * ks + 3]); o.z = pk2(v[8 * ks + 4], v[8 * ks + 5]); o.w = pk2(v[8 * ks + 6], v[8 * ks + 7]); gf[ks] = __builtin_bit_cast(bf16x8, o); }
#pragma unroll
                    for (int pt = 0; pt < 2; ++pt)
#pragma unroll
                        for (int ks = 0; ks < 2; ++ks) acc[tt][pt] = __builtin_amdgcn_mfma_f32_32x32x16_bf16(xa[ks][pt], gf[ks], acc[tt][pt], 0, 0, 0);
                }
            }
            }
            { int L = L0; asm volatile("" : "+v"(L)); const int h = L >> 5, l31 = L & 31;
#pragma unroll 1
            for (int dir = 0; dir < 2; ++dir) {
                const bf16* hs = ST + ((size_t)(c * 2 + dir) * 64 + head) * 8192;
                float et[2];
#pragma unroll
                for (int tt = 0; tt < 2; ++tt) et[tt] = __expf(tab[dir * 128 + 32 * (2 * half + tt) + l31]);
#pragma unroll 2
                for (int kn = 0; kn < 8; ++kn) {
                    bf16x8 ha[2];
#pragma unroll
                    for (int pt = 0; pt < 2; ++pt) ha[pt] = *(const bf16x8*)(hs + (size_t)(32 * pt + l31) * 128 + 16 * kn + 8 * h);
#pragma unroll
                    for (int tt = 0; tt < 2; ++tt) { const bf16x8 cb = scale8s(*(const LAS bf16x8*)(imgC + (32 * (2 * half + tt) + l31) * PB + (16 * kn + 8 * h) * 2), et[tt]);
#pragma unroll
                        for (int pt = 0; pt < 2; ++pt) acc[tt][pt] = __builtin_amdgcn_mfma_f32_32x32x16_bf16(ha[pt], cb, acc[tt][pt], 0, 0, 0); }
                }
            }
            }
            { int L = L0; asm volatile("" : "+v"(L)); const int h = L >> 5, l31 = L & 31;
#pragma unroll
            for (int tt = 0; tt < 2; ++tt) { const size_t row = (size_t)(t0 + 32 * (2 * half + tt) + l31); float ssq = 0.f;
#pragma unroll
                for (int pt = 0; pt < 2; ++pt)
#pragma unroll
                    for (int qd = 0; qd < 4; ++qd) { const u32x2 z = *(const u32x2*)(ZS + row * SSD_DI + head * 64 + 32 * pt + 8 * qd + 4 * h);
                        const float y0 = acc[tt][pt][4 * qd] * bflo(z.x), y1 = acc[tt][pt][4 * qd + 1] * bfhi(z.x), y2 = acc[tt][pt][4 * qd + 2] * bflo(z.y), y3 = acc[tt][pt][4 * qd + 3] * bfhi(z.y);
                        acc[tt][pt][4 * qd] = y0; acc[tt][pt][4 * qd + 1] = y1; acc[tt][pt][4 * qd + 2] = y2; acc[tt][pt][4 * qd + 3] = y3; ssq += (y0 * y0 + y1 * y1) + (y2 * y2 + y3 * y3); }
                ssq += shfl_lane(ssq, L ^ 32);
                if (h == 0) part[F.wave * 64 + 32 * tt + l31] = ssq; }
            __syncthreads();
#pragma unroll
            for (int tt = 0; tt < 2; ++tt) { const int tl = 32 * tt + l31; const size_t row = (size_t)(t0 + 64 * half + tl); float tot = 0.f;
#pragma unroll
                for (int w = 0; w < 8; ++w) tot += part[w * 64 + tl];
                const float rstd = rsqrtf(tot * (1.0f / 512.0f) + LN_EPS);
#pragma unroll
                for (int pt = 0; pt < 2; ++pt)
#pragma unroll
                    for (int qd = 0; qd < 4; ++qd) { const int cc = head * 64 + 32 * pt + 8 * qd + 4 * h; const f32x4 gg = *(const f32x4*)(ng + cc);
                        u32x2 o; o.x = pk2(acc[tt][pt][4 * qd] * rstd * gg.x, acc[tt][pt][4 * qd + 1] * rstd * gg.y); o.y = pk2(acc[tt][pt][4 * qd + 2] * rstd * gg.z, acc[tt][pt][4 * qd + 3] * rstd * gg.w);
                        *(u32x2*)(Y + row * SSD_DI + cc) = o; } }
            }
            __syncthreads();
        }
    }
}

__device__ __forceinline__ void p_natt(const Frame& F0, const bf16* Q, const bf16* Kb, const bf16* V, const float* rpb, bf16* O, int L) {
    const Frame F = phase_frame(F0);
    LAS unsigned char* vimg = F.lds;
    LAS float* rp = (LAS float*)(F.lds + 4 * 64 * PB);
    const int Ln = F.lane, g = Ln >> 4, l15 = Ln & 15, q4 = l15 >> 2, p4 = Ln & 3;
    const int rps = L / 64, hh = F.wave >> 2, j = F.wave & 3;
    const int kstart = (j == 0) ? 0 : (j == 1 ? 8 : (j == 2 ? 24 : 32));
    for (int it = blockIdx.x; it < 128 * 8; it += F.G) {
        const int hp = it & 7, grow = it >> 3, sq = grow / rps, r = grow % rps;
        int rs = r - 4; rs = rs < 0 ? 0 : (rs > rps - 8 ? rps - 8 : rs);
        const int head = 2 * hp + hh;
        const size_t rowbase = (size_t)sq * rps * 64;
        for (int i = F.tid; i < 2 * 465; i += NTHR) { const int a = i / 465, b = i % 465; rp[a * 480 + b] = rpb[(size_t)(2 * hp + a) * 465 + b]; }
        u32x4 vreg[4];
#pragma unroll
        for (int i = 0; i < 4; ++i) { const int idx = F.tid + 512 * i, a = idx >> 10, key = (idx >> 4) & 63, ch = idx & 15;
            vreg[i] = *(const u32x4*)(V + (rowbase + (size_t)(rs + 0) * 64 + key) * D + (2 * hp + a) * 128 + ch * 8); }
#pragma unroll
        for (int i = 0; i < 4; ++i) { const int idx = F.tid + 512 * i, a = idx >> 10, key = (idx >> 4) & 63, ch = idx & 15; *(LAS u32x4*)(vimg + ((0 * 2 + a) * 64 + key) * PB + ch * 16) = vreg[i]; }
        const int qcol = 16 * j + l15;
        bf16x8 qf[4];
#pragma unroll
        for (int kd = 0; kd < 4; ++kd) qf[kd] = *(const bf16x8*)(Q + (rowbase + (size_t)r * 64 + qcol) * D + head * 128 + 32 * kd + 8 * g);
        __syncthreads();
        int wst = qcol - 8; wst = wst < 0 ? 0 : (wst > 48 ? 48 : wst);
        float sc[16][4]; float mx = -3.0e38f;
#pragma unroll
        for (int kt = 0; kt < 16; ++kt) { const int kr = kt >> 1, kc0 = kstart + 16 * (kt & 1);
            f32x4 a4 = {0.f, 0.f, 0.f, 0.f};
            const bf16* kp = Kb + (rowbase + (size_t)(rs + kr) * 64 + kc0 + l15) * D + head * 128 + 8 * g;
#pragma unroll
            for (int kd = 0; kd < 4; ++kd) { const bf16x8 kf = *(const bf16x8*)(kp + 32 * kd); a4 = __builtin_amdgcn_mfma_f32_16x16x32_bf16(kf, qf[kd], a4, 0, 0, 0); }
            const int dy = rs + kr - r + 7;
#pragma unroll
            for (int e = 0; e < 4; ++e) { const int kcol = kc0 + 4 * g + e; const bool ok = (kcol >= wst) && (kcol < wst + 16);
                int dx = kcol - qcol + 15; dx = dx < 0 ? 0 : (dx > 30 ? 30 : dx);
                const float s = ok ? a4[e] + rp[hh * 480 + dy * 31 + dx] : -3.0e38f; sc[kt][e] = s; mx = fmaxf(mx, s); } }
        mx = fmaxf(mx, shfl_lane(mx, Ln ^ 16)); mx = fmaxf(mx, shfl_lane(mx, Ln ^ 32));
        float lsum = 0.f;
#pragma unroll
        for (int kt = 0; kt < 16; ++kt)
#pragma unroll
            for (int e = 0; e < 4; ++e) { const float p = __expf(sc[kt][e] - mx); sc[kt][e] = p; lsum += p; }
        lsum += shfl_lane(lsum, Ln ^ 16); lsum += shfl_lane(lsum, Ln ^ 32);
        const float inv = 1.0f / lsum;
        f32x4 oacc[8];
#pragma unroll
        for (int dt = 0; dt < 8; ++dt) oacc[dt] = (f32x4){0.f, 0.f, 0.f, 0.f};
#pragma unroll
        for (int kk = 0; kk < 8; ++kk) {
            if (kk + 1 < 8) {
#pragma unroll
                for (int i = 0; i < 4; ++i) { const int idx = F.tid + 512 * i, a = idx >> 10, key = (idx >> 4) & 63, ch = idx & 15;
                    vreg[i] = *(const u32x4*)(V + (rowbase + (size_t)(rs + kk + 1) * 64 + key) * D + (2 * hp + a) * 128 + ch * 8); } }
            u32x4 pw; pw.x = pk2(sc[2 * kk][0], sc[2 * kk][1]); pw.y = pk2(sc[2 * kk][2], sc[2 * kk][3]); pw.z = pk2(sc[2 * kk + 1][0], sc[2 * kk + 1][1]); pw.w = pk2(sc[2 * kk + 1][2], sc[2 * kk + 1][3]);
            const bf16x8 pf = __builtin_bit_cast(bf16x8, pw);
            const LAS unsigned char* vb = vimg + (((kk & 1) * 2 + hh) * 64) * PB;
#pragma unroll
            for (int dt = 0; dt < 8; ++dt) { const LAS unsigned char* ad = vb + (kstart + 4 * g + q4) * PB + (16 * dt + 4 * p4) * 2;
                const bf16x8 vf = cat8(tr_read(ad), tr_read(ad + 16 * PB));
                oacc[dt] = __builtin_amdgcn_mfma_f32_16x16x32_bf16(vf, pf, oacc[dt], 0, 0, 0); }
            if (kk + 1 < 8) {
#pragma unroll
                for (int i = 0; i < 4; ++i) { const int idx = F.tid + 512 * i, a = idx >> 10, key = (idx >> 4) & 63, ch = idx & 15; *(LAS u32x4*)(vimg + ((((kk + 1) & 1) * 2 + a) * 64 + key) * PB + ch * 16) = vreg[i]; }
            }
            __syncthreads();
        }
        bf16* op = O + (rowbase + (size_t)r * 64 + qcol) * D + head * 128 + 4 * g;
#pragma unroll
        for (int dt = 0; dt < 8; ++dt) { u32x2 o; o.x = pk2(oacc[dt][0] * inv, oacc[dt][1] * inv); o.y = pk2(oacc[dt][2] * inv, oacc[dt][3] * inv); *(u32x2*)(op + 16 * dt) = o; }
    }
}

struct Args { const float* in[29]; float* out; unsigned char* ws; int g_lo, g_hi, l_lo, l_hi, ph, pad; };

__global__ void __launch_bounds__(NTHR, 2) enc_fwd(Args args) {
    extern __shared__ __attribute__((aligned(16))) unsigned char lds[];
    Frame F;
    F.lds = (LAS unsigned char*)lds;
    F.tid = threadIdx.x; F.lane = F.tid & 63; F.wave = __builtin_amdgcn_readfirstlane(F.tid >> 6);
    F.G = gridDim.x; F.gw = blockIdx.x * NWAVES + F.wave; F.ngw = F.G * NWAVES;
    unsigned char* ws = args.ws;
    gu32* ctl = (gu32*)(ws + WS_CTL);
    for (int u = F.tid; u < (LDS_BYTES - LDSCTL_OFF) / 4; u += NTHR) ((LAS unsigned*)(F.lds + LDSCTL_OFF))[u] = 0u;
    __syncthreads();
    const int ph = args.ph;
    XcdBarrier bar; bar.bar = (unsigned*)(ctl + CW_BAR); bar.x = 0; bar.st = nullptr;
    if (ph < 0) bar = xcd_barrier_post((unsigned*)(ctl + CW_BAR), (volatile LAS unsigned*)(F.lds + MISC_OFF) + 8);
#define RUN(k) (ph < 0 || ph == (k))
#define GRID_BAR() do { if (ph < 0) xcd_barrier(bar); } while (0)

    bf16* Wb = (bf16*)(ws + WS_W);
    unsigned char* scr = ws + WS_SCR;
    bf16* XB = (bf16*)(scr + S_XB); bf16* YB = (bf16*)(scr + S_YB); bf16* HB = (bf16*)(scr + S_HID);
    LAS unsigned char* ring = F.lds;

    if (RUN(0) && args.g_lo == 0 && args.l_lo == 0) { p_prologue(F, args.in, Wb, (float*)(ws + WS_SPT)); GRID_BAR(); }

    for (int grp = args.g_lo; grp < args.g_hi; ++grp) {
        float* X = args.out + (size_t)grp * TG * D;
        const int L = grp < 2 ? 2048 : 8192;
        if (RUN(1) && args.l_lo == 0) { const float* src = grp < 2 ? args.in[0] + (size_t)grp * TG * D : args.in[1] + (size_t)(grp - 2) * TG * D; p_copy(F, src, X, XB); GRID_BAR(); }
        for (int layer = args.l_lo; layer < args.l_hi; ++layer) {
            const int kind = layer % 3, jl = layer / 3;
            int Kout = 2048; const bf16* Wout;
            if (kind == 0) {
                bf16* GATE = (bf16*)(scr + S_RG_GATE); bf16* URAW = (bf16*)(scr + S_RG_URAW); bf16* U = (bf16*)(scr + S_RG_U); bf16* LA = (bf16*)(scr + S_RG_LA); bf16* INP = (bf16*)(scr + S_RG_INP);
                float* HEND = (float*)(scr + S_RG_HEND); float* PROD = (float*)(scr + S_RG_PROD); float* HIN = (float*)(scr + S_RG_HIN);
                if (RUN(10)) { pg8::Gemm g{XB, Wb + W_RGIN + (size_t)jl * 4096 * 2048, 2048, 2048, 2048, 0}; pg8::StaticOrder S; S.init(TG, 4096, F.G, (int)blockIdx.x);
                    pg8::EpiRgIn E{GATE, URAW}; pg8::gemm_phase<pg8::EpiRgIn>(ring, g, S, E); GRID_BAR(); }
                if (RUN(11)) { p_conv<0>(F, URAW, 2048, L, args.in[3] + (size_t)jl * 4 * 2048, args.in[4] + (size_t)jl * 2048, U, nullptr, nullptr); GRID_BAR(); }
                if (RUN(12)) { pg8::Gemm g{U, Wb + W_RGGATE + (size_t)jl * 32 * 65536, 2048, 256, 256, 1}; pg8::StaticOrder S; S.init(TG, 32 * 256, F.G, (int)blockIdx.x);
                    pg8::EpiRgGates E{U, LA, INP, args.in[6] + (size_t)jl * 2 * 2048, args.in[8] + (size_t)jl * 2 * 2048, (const float*)(ws + WS_SPT) + (size_t)jl * 2 * 2048};
                    pg8::gemm_phase<pg8::EpiRgGates>(ring, g, S, E); GRID_BAR(); }
                if (RUN(13)) { p_rg_scan_a(F, LA, INP, HEND, PROD); GRID_BAR(); }
                if (RUN(14)) { p_rg_scan_b(F, HEND, PROD, HIN, L); GRID_BAR(); }
                if (RUN(15)) { p_rg_scan_c(F, LA, INP, HIN, GATE, YB); GRID_BAR(); }
                Wout = Wb + W_RGOUT + (size_t)jl * 2048 * 2048;
            } else if (kind == 1) {
                bf16* ZS = (bf16*)(scr + S_SSD_ZS); bf16* XBCR = (bf16*)(scr + S_SSD_XBCR); bf16* XT = (bf16*)(scr + S_SSD_XT); bf16* BMt = (bf16*)(scr + S_SSD_BM); bf16* CMt = (bf16*)(scr + S_SSD_CM);
                float* DT = (float*)(scr + S_SSD_DT); float* DEC = (float*)(scr + S_SSD_DEC); bf16* ST = (bf16*)(scr + S_SSD_ST);
                if (RUN(20)) { pg8::Gemm g{XB, Wb + W_SSDIN, 2048, 2048, 2048, 0}; pg8::StaticOrder S; S.init(TG, SSD_NIN_PAD, F.G, (int)blockIdx.x);
                    pg8::EpiSsdIn E{ZS, XBCR, DT, args.in[14]}; pg8::gemm_phase<pg8::EpiSsdIn>(ring, g, S, E); GRID_BAR(); }
                if (RUN(21)) { p_conv<1>(F, XBCR, SSD_XBC, L, args.in[12], args.in[13], XT, BMt, CMt); GRID_BAR(); }
                if (RUN(22)) { p_ssd_states(F, XT, BMt, DT, args.in[15], ST, DEC); GRID_BAR(); }
                if (RUN(23)) { p_ssd_rec(F, ST, DEC, L); GRID_BAR(); }
                if (RUN(24)) { p_ssd_out(F, XT, BMt, CMt, DT, args.in[15], args.in[16], ST, ZS, args.in[17], YB); GRID_BAR(); }
                Wout = Wb + W_SSDOUT; Kout = 4096;
            } else {
                bf16* Qb = (bf16*)(scr + S_NA_Q); bf16* Kb = (bf16*)(scr + S_NA_K); bf16* Vb = (bf16*)(scr + S_NA_V);
                if (RUN(30)) { pg8::Gemm g{XB, Wb + W_NAQKV, 2048, 2048, 2048, 0}; pg8::StaticOrder S; S.init(TG, 6144, F.G, (int)blockIdx.x);
                    pg8::EpiQkv E{Qb, args.in[20]}; pg8::gemm_phase<pg8::EpiQkv>(ring, g, S, E); GRID_BAR(); }
                if (RUN(31)) { p_natt(F, Qb, Kb, Vb, args.in[21], YB, L); GRID_BAR(); }
                Wout = Wb + W_NAOUT;
            }
            if (RUN(40)) { pg8::Gemm g{YB, Wout, Kout, Kout, Kout, 0}; pg8::StaticOrder S; S.init(TG, D, F.G, (int)blockIdx.x);
                pg8::EpiResid E{X, D, ALPHA}; pg8::gemm_phase<pg8::EpiResid>(ring, g, S, E); GRID_BAR(); }
            if (RUN(41)) { p_ln(F, X, XB, args.in[25] + (size_t)layer * D, args.in[26] + (size_t)layer * D); GRID_BAR(); }
            if (RUN(42)) { pg8::Gemm g{XB, Wb + W_UP + (size_t)layer * 8192 * 2048, 2048, 2048, 2048, 0}; pg8::StaticOrder S; S.init(TG, HID, F.G, (int)blockIdx.x);
                pg8::EpiRelu2 E{HB, HID}; pg8::gemm_phase<pg8::EpiRelu2>(ring, g, S, E); GRID_BAR(); }
            if (RUN(43)) { pg8::Gemm g{HB, Wb + W_DOWN + (size_t)layer * 2048 * 8192, 8192, 8192, 8192, 0}; pg8::StaticOrder S; S.init(TG, D, F.G, (int)blockIdx.x);
                pg8::EpiResid E{X, D, ALPHA}; pg8::gemm_phase<pg8::EpiResid>(ring, g, S, E); GRID_BAR(); }
            if (RUN(44)) { p_ln(F, X, XB, args.in[27] + (size_t)layer * D, args.in[28] + (size_t)layer * D); GRID_BAR(); }
        }
    }
#undef RUN
#undef GRID_BAR
}

extern "C" void kernel_launch(void* const* d_in, const int* in_sizes, int n_in, void* d_out, int out_size, void* d_ws, size_t ws_size, hipStream_t stream) {
    static int grid = 0;
    if (grid == 0) {
        if (n_in != 29 || out_size != NGROUP * TG * D || ws_size < WS_NEED) { fprintf(stderr, "kernel_launch: unexpected problem (n_in %d, out %d, ws %zu, need %zu)\n", n_in, out_size, ws_size, (size_t)WS_NEED); grid = -1; return; }
        int dev = 0, cus = 0, per_cu = 0;
        if (hipGetDevice(&dev) != hipSuccess || hipDeviceGetAttribute(&cus, hipDeviceAttributeMultiprocessorCount, dev) != hipSuccess) { grid = -1; return; }
        if (hipFuncSetAttribute((const void*)enc_fwd, hipFuncAttributeMaxDynamicSharedMemorySize, LDS_BYTES) != hipSuccess) { fprintf(stderr, "kernel_launch: hipFuncSetAttribute failed\n"); grid = -1; return; }
        if (hipOccupancyMaxActiveBlocksPerMultiprocessor(&per_cu, (const void*)enc_fwd, NTHR, LDS_BYTES) != hipSuccess || per_cu < 1) { fprintf(stderr, "kernel_launch: occupancy query says %d\n", per_cu); }
        (void)hipGetLastError();
        grid = cus;
    }
    if (grid < 0) return;
    (void)hipMemsetAsync((char*)d_ws + WS_CTL, 0, CTL_ZERO_BYTES, stream);
    Args a{};
    for (int i = 0; i < 29; ++i) a.in[i] = (const float*)d_in[i];
    a.out = (float*)d_out; a.ws = (unsigned char*)d_ws; a.pad = 0;
#if MK_N_LAUNCHES == 1
    a.g_lo = 0; a.g_hi = NGROUP; a.l_lo = 0; a.l_hi = DEPTH; a.ph = -1;
    hipLaunchKernelGGL(enc_fwd, dim3(grid), dim3(NTHR), LDS_BYTES, stream, a);
#else
    auto launch = [&](int g, int l, int ph) { a.g_lo = g; a.g_hi = g + 1; a.l_lo = l; a.l_hi = l + 1; a.ph = ph; hipLaunchKernelGGL(enc_fwd, dim3(grid), dim3(NTHR), LDS_BYTES, stream, a); };
    launch(0, 0, 0);
    for (int g = 0; g < NGROUP; ++g) {
        launch(g, 0, 1);
        for (int l = 0; l < DEPTH; ++l) {
            const int kind = l % 3;
            if (kind == 0) for (int p = 10; p <= 15; ++p) launch(g, l, p);
            else if (kind == 1) for (int p = 20; p <= 24; ++p) launch(g, l, p);
            else for (int p = 30; p <= 31; ++p) launch(g, l, p);
            for (int p = 40; p <= 44; ++p) launch(g, l, p);
        }
    }
#endif
}
```

```cpp
#include <hip/hip_runtime.h>
#include <cstdio>
#include <cstdint>

#ifndef MK_N_LAUNCHES
#define MK_N_LAUNCHES 1
#endif
#ifndef MK_CHECK
#define MK_CHECK 0
#endif

#define LAS __attribute__((address_space(3)))
#define GAS __attribute__((address_space(1)))
typedef unsigned short bf16;
typedef short bf16x8 __attribute__((ext_vector_type(8)));
typedef short s16x4 __attribute__((ext_vector_type(4)));
typedef float f32x2 __attribute__((ext_vector_type(2)));
typedef float f32x4 __attribute__((ext_vector_type(4)));
typedef float f32x16 __attribute__((ext_vector_type(16)));
typedef unsigned u32x2 __attribute__((ext_vector_type(2)));
typedef unsigned u32x4 __attribute__((ext_vector_type(4)));
typedef __bf16 bf16x2_t __attribute__((ext_vector_type(2)));
typedef short v4i16_t __attribute__((ext_vector_type(4)));
typedef GAS unsigned gu32;

constexpr int D = 2048, TG = 8192, NGROUP = 6, DEPTH = 4, NWAVES = 8, NTHR = 512;
constexpr int HID = 8192;
constexpr int SSD_DI = 4096, SSD_NH = 64, SSD_NG = 8, SSD_NS = 128, SSD_CH = 128, SSD_XBC = 6144, SSD_NIN = 10368, SSD_NIN_PAD = 10496;
constexpr int NA_H = 16, NA_HD = 128;
constexpr float ALPHA = 1.681792830507429f, LN_EPS = 1e-5f;

constexpr size_t MiB = 1u << 20;
constexpr size_t WS_CTL = 0, CTL_ZERO_BYTES = 256 * 1024;
constexpr size_t WS_XSLOT = 1 * MiB;
constexpr size_t WS_W = 2 * MiB;
constexpr size_t W_RGIN = 0;
constexpr size_t W_RGGATE = W_RGIN + 2ull * 4096 * 2048;
constexpr size_t W_RGOUT = W_RGGATE + 2ull * 32 * 256 * 256;
constexpr size_t W_SSDIN = W_RGOUT + 2ull * 2048 * 2048;
constexpr size_t W_SSDOUT = W_SSDIN + (size_t)SSD_NIN_PAD * 2048;
constexpr size_t W_NAQKV = W_SSDOUT + 2048ull * 4096;
constexpr size_t W_NAOUT = W_NAQKV + 6144ull * 2048;
constexpr size_t W_UP = W_NAOUT + 2048ull * 2048;
constexpr size_t W_DOWN = W_UP + 4ull * 8192 * 2048;
constexpr size_t W_END = W_DOWN + 4ull * 8192 * 2048;
constexpr size_t WS_SCR = ((WS_W + W_END * 2 + MiB - 1) / MiB) * MiB;
constexpr size_t S_XB = 0;
constexpr size_t S_YB = 32 * MiB;
constexpr size_t S_MIX = 96 * MiB;
constexpr size_t S_HID = S_MIX;
constexpr size_t S_RG_GATE = S_MIX, S_RG_URAW = S_MIX + 32 * MiB, S_RG_U = S_MIX + 64 * MiB, S_RG_LA = S_MIX + 96 * MiB  , S_RG_INP = S_MIX + 160 * MiB  ;
constexpr size_t S_RG_HEND = S_MIX + 224 * MiB, S_RG_PROD = S_MIX + 226 * MiB, S_RG_HIN = S_MIX + 228 * MiB;
constexpr size_t S_SSD_ZS = S_MIX, S_SSD_XBCR = S_MIX + 64 * MiB, S_SSD_XT = S_MIX + 160 * MiB, S_SSD_BM = S_MIX + 224 * MiB, S_SSD_CM = S_MIX + 240 * MiB;
constexpr size_t S_SSD_DT = S_MIX + 256 * MiB, S_SSD_DEC = S_MIX + 260 * MiB, S_SSD_ST = S_MIX + 261 * MiB;
constexpr size_t S_NA_Q = S_MIX, S_NA_K = S_MIX + 32 * MiB, S_NA_V = S_MIX + 64 * MiB;
constexpr size_t S_END = S_MIX + 389 * MiB;
constexpr size_t S_XB0 = S_END;
constexpr size_t S_DUM = S_XB0 + 192 * MiB;
#ifndef PROBE_MASK
#define PROBE_MASK 0
#endif
constexpr size_t WS_NEED = WS_SCR + S_DUM + (PROBE_MASK ? 96 * MiB : 0);

constexpr int CW_BAR = 4096;
constexpr int CW_SEAM = 16384;
constexpr int CW_TMO = 0;
constexpr int CW_CHK = 1024;
constexpr size_t WS_SPT = 512 * 1024;

constexpr int RING_BYTES = 131072;
constexpr int LDSCTL_OFF = RING_BYTES, MISC_OFF = LDSCTL_OFF + 320;
constexpr int LDS_BYTES = 147456;

#define RLX_AGENT __ATOMIC_RELAXED, __HIP_MEMORY_SCOPE_AGENT
#define LDS_WAIT() asm volatile("s_waitcnt lgkmcnt(0)" ::: "memory")
#define VM_WAIT() asm volatile("s_waitcnt vmcnt(0)" ::: "memory")
__device__ __forceinline__ unsigned pk2(float lo, float hi) { f32x2 v = {lo, hi}; bf16x2_t b = __builtin_convertvector(v, bf16x2_t); return __builtin_bit_cast(unsigned, b); }
__device__ __forceinline__ float bflo(unsigned w) { return __uint_as_float(w << 16); }
__device__ __forceinline__ float bfhi(unsigned w) { return __uint_as_float(w & 0xffff0000u); }
__device__ __forceinline__ float bf2f(bf16 b) { return __uint_as_float(((unsigned)b) << 16); }
__device__ __forceinline__ float frcp_(float x) { return __builtin_amdgcn_rcpf(x); }
__device__ __forceinline__ float fsqrt_(float x) { return __builtin_amdgcn_sqrtf(x); }
__device__ __forceinline__ float sigmoidf_(float x) { return frcp_(1.0f + __expf(-x)); }
__device__ __forceinline__ float siluf_(float x) { return x * frcp_(1.0f + __expf(-x)); }
__device__ __forceinline__ float gelu_tanh_(float v) { const float u = 1.5957691216057308f * (v + 0.044715f * v * v * v); return v * frcp_(1.0f + __expf(-u)); }
__device__ __forceinline__ float softplusf_(float v) { return v > 20.f ? v : log1pf(__expf(v)); }
__device__ __forceinline__ float shfl_lane(float v, int srclane) { return __int_as_float(__builtin_amdgcn_ds_bpermute(srclane << 2, __float_as_int(v))); }
__device__ __forceinline__ float wave_sum(float v, int lane) {
#pragma unroll
    for (int o = 1; o < 64; o <<= 1) v += shfl_lane(v, lane ^ o);
    return v;
}

#define XB_TMO      128
#define XB_XCNT(j)  (256  + 64 * (j))
#define XB_XSUB(j)  (1280 + 64 * (j))
#define XB_XGEN(j)  (2304 + 64 * (j))
#define XB_TOP      3328
#define XB_TOPGEN   3392
#define XCD_BAR_WORDS 3456
#define XB_SPIN_CAP (1u << 22)

__device__ __forceinline__ unsigned xb_ld(unsigned* p)              { return __hip_atomic_load(p, __ATOMIC_RELAXED, __HIP_MEMORY_SCOPE_AGENT); }
__device__ __forceinline__ unsigned xb_add(unsigned* p, unsigned v) { return __hip_atomic_fetch_add(p, v, __ATOMIC_RELAXED, __HIP_MEMORY_SCOPE_AGENT); }
__device__ __forceinline__ unsigned xb_xcc_id() { return (unsigned)__builtin_amdgcn_s_getreg((3 << 11) | 20) & 0xFu; }
#define XB_SPIN(cond, bar) do { unsigned _sp = 0; while (cond) { __builtin_amdgcn_s_sleep(1); \
    if ((++_sp & 255u) == 0u) { if (xb_ld(&(bar)[XB_TMO])) break; if (_sp > XB_SPIN_CAP) { atomicAdd(&(bar)[XB_TMO], 1u); break; } } } } while (0)

struct XcdBarrier { unsigned* bar; unsigned x; volatile LAS unsigned* st; };

__device__ __forceinline__ XcdBarrier xcd_barrier_post(unsigned* bar, volatile LAS unsigned* st) {
    XcdBarrier b; b.bar = bar; b.x = xb_xcc_id(); b.st = st;
    if (threadIdx.x == 0) (void)xb_add(&bar[XB_XCNT(b.x)], 1u);
    return b;
}
__device__ __forceinline__ void xcd_barrier_complete(unsigned* bar, unsigned x, unsigned& nloc, unsigned& nx) {
    const unsigned G = gridDim.x * gridDim.y * gridDim.z;
    unsigned sum, cnt, mine, sp = 0u;
    for (;;) {
        sum = 0u; cnt = 0u; mine = 0u;
#pragma unroll
        for (unsigned j = 0; j < 16; ++j) { const unsigned c = xb_ld(&bar[XB_XCNT(j)]); sum += c; cnt += (c > 0u) ? 1u : 0u; mine = (j == x) ? c : mine; }
        if (sum == G) break;
        __builtin_amdgcn_s_sleep(1);
        if ((++sp & 255u) == 0u) { if (xb_ld(&bar[XB_TMO])) break; if (sp > XB_SPIN_CAP) { atomicAdd(&bar[XB_TMO], 1u); break; } }
    }
    nloc = mine > 0u ? mine : 1u; nx = cnt > 0u ? cnt : 1u;
}
__device__ __forceinline__ void xcd_barrier(const XcdBarrier& b) {
    asm volatile("s_waitcnt vmcnt(0)" ::: "memory");
    __syncthreads();
    if (threadIdx.x == 0) {
        unsigned* bar = b.bar;
        __builtin_amdgcn_s_waitcnt(0);
        unsigned nloc = b.st[0], nx = b.st[1];
        if (nloc == 0u) { xcd_barrier_complete(bar, b.x, nloc, nx); b.st[0] = nloc; b.st[1] = nx; }
        const unsigned old = xb_add(&bar[XB_XSUB(b.x)], 1u);
        const unsigned gen = old / nloc;
        if (old + 1u == (gen + 1u) * nloc) {
            __builtin_amdgcn_fence(__ATOMIC_RELEASE, "agent");
            asm volatile("s_waitcnt vmcnt(0)" ::: "memory");
            const unsigned og = xb_add(&bar[XB_TOP], 1u);
            const unsigned tg = og / nx;
            if (og + 1u == (tg + 1u) * nx) xb_add(&bar[XB_TOPGEN], 1u);
            else XB_SPIN(xb_ld(&bar[XB_TOPGEN]) == tg, bar);
            __builtin_amdgcn_fence(__ATOMIC_ACQUIRE, "agent");
            xb_add(&bar[XB_XGEN(b.x)], 1u);
            asm volatile("s_waitcnt vmcnt(0)" ::: "memory");
        } else {
            XB_SPIN(xb_ld(&bar[XB_XGEN(b.x)]) == gen, bar);
            __builtin_amdgcn_fence(__ATOMIC_ACQUIRE, "agent");
            asm volatile("s_waitcnt vmcnt(0)" ::: "memory");
        }
    }
    __syncthreads();
}

namespace pg8 {
constexpr int BM = 256, BK = 64, HALF = 128, HTB = HALF * BK * 2, STAGE_BYTES = 8 * HTB, NXCD = 8, WGM = 8;
__host__ __device__ __forceinline__ int lds_byte(int r, int c) { const int st = (r >> 4) * 2 + (c >> 5), rr = r & 15, cc = c & 31, ob = rr * 64 + cc * 2; return st * 1024 + (ob ^ (((ob >> 9) & 1) << 5)); }
__host__ __device__ __forceinline__ void stage_rc(int b, int& R, int& C) { const int st = b / 1024, sb = b % 1024, swz = sb ^ (((sb >> 9) & 1) << 5); R = (st >> 1) * 16 + swz / 64; C = (st & 1) * 32 + (swz % 64) / 2; }
__host__ __device__ __forceinline__ int perm32(int rho) { const int n = rho >> 4, i = rho & 15; return 8 * (i >> 2) + 4 * n + (i & 3); }

struct Unit { int pm, pn; };
struct Gemm { const bf16* A; const bf16* Bt; int lda, ldb, K, mode; };
__device__ __forceinline__ const char* a_base(const Gemm& g, const Unit& u) { return (const char*)(g.A + (size_t)u.pm * BM * g.lda + (g.mode == 1 ? ((u.pn >> 1) & 7) * 256 : 0)); }
__device__ __forceinline__ const char* b_base(const Gemm& g, const Unit& u) { return (const char*)(g.Bt + (size_t)u.pn * BM * g.ldb); }

struct StaticOrder {
    int nM, nN, nwg, G, c;
    __host__ __device__ void init(int M, int N, int G_, int c_) { nM = M / BM; nN = N / BM; nwg = nM * nN; G = G_; c = c_; }
    __host__ __device__ bool next(int i, Unit& u) const {
        const long L = (long)i * G + c; if (L >= nwg) return false;
        int wgid = (int)L; { const int q = nwg / NXCD, r = nwg % NXCD, xcd = wgid % NXCD, off = wgid / NXCD; wgid = (xcd < r ? xcd * (q + 1) : r * (q + 1) + (xcd - r) * q) + off; }
        const int nig = WGM * nN, gid = wgid / nig, fm = gid * WGM, gsz = (nM - fm) < WGM ? (nM - fm) : WGM;
        u.pm = fm + ((wgid % nig) % gsz); u.pn = (wgid % nig) / gsz; return true;
    }
};

template <class Epi, bool ALIGN_EPI = true, bool SP2 = true>
__device__ __forceinline__ void gemm_phase(LAS unsigned char* lds, const Gemm g, const StaticOrder& S, const Epi& E) {
    int tid_o = threadIdx.x; asm volatile("" : "+v"(tid_o));
    const int tid = tid_o, wid = __builtin_amdgcn_readfirstlane(tid >> 6), lane = tid & 63, wr = wid >> 2, wc = wid & 3, fr = lane & 15, fq = lane >> 4;
    const int K = g.K, nt = K / BK;
    unsigned voffA[2], voffB[2];
#pragma unroll
    for (int i = 0; i < 2; ++i) { int R, C; stage_rc(tid * 16 + i * 8192, R, C); const int Rb = Epi::PERM ? ((R & ~31) + perm32(R & 31)) : R;
        voffA[i] = (unsigned)(R * g.lda + C) * 2u; voffB[i] = (unsigned)(Rb * g.ldb + C) * 2u; }
    const size_t kstep = (size_t)(BK * 2);
    const size_t hstepA = (size_t)HALF * g.lda * 2, hstepB = (size_t)HALF * g.ldb * 2;
    const unsigned ldsw = (unsigned)wid * 1024u;
    const int aoff = lds_byte(wr * 64 + fr, fq * 8), boff = lds_byte(wc * 32 + fr, fq * 8);
#define PG8_SA(b, h) (((b) * 2 + (h)) * HTB)
#define PG8_SB(b, h) ((4 + (b) * 2 + (h)) * HTB)
#define PG8_STAGE(bufoff, gbase, voff) do { _Pragma("unroll") for (int _i = 0; _i < 2; ++_i) \
        __builtin_amdgcn_global_load_lds((const unsigned*)((const char*)(gbase) + (voff)[_i]), (LAS unsigned*)(lds + (bufoff) + ldsw + _i * 8192), 16, 0, 0); } while (0)
#define PG8_LDA(dst, b, h) do { _Pragma("unroll") for (int m = 0; m < 4; ++m) _Pragma("unroll") for (int k = 0; k < 2; ++k) dst[m][k] = *(const LAS bf16x8*)(lds + PG8_SA(b, h) + aoff + m * 2048 + k * 1024); } while (0)
#define PG8_LDB(dst, b, h) do { _Pragma("unroll") for (int n = 0; n < 2; ++n) _Pragma("unroll") for (int k = 0; k < 2; ++k) dst[n][k] = *(const LAS bf16x8*)(lds + PG8_SB(b, h) + boff + n * 2048 + k * 1024); } while (0)
#define PG8_MMA(ai, bj, At, Bt) do { __builtin_amdgcn_s_setprio(1); _Pragma("unroll") for (int m = 0; m < 4; ++m) _Pragma("unroll") for (int n = 0; n < 2; ++n) _Pragma("unroll") for (int k = 0; k < 2; ++k) \
        acc[ai][bj][m][n] = __builtin_amdgcn_mfma_f32_16x16x32_bf16(Bt[n][k], At[m][k], acc[ai][bj][m][n], 0, 0, 0); __builtin_amdgcn_s_setprio(0); } while (0)
#define PG8_WAIT_V(n) asm volatile("s_waitcnt vmcnt(" #n ")" ::: "memory")
#define PG8_WAIT_L(n) asm volatile("s_waitcnt lgkmcnt(" #n ")" ::: "memory")
#define PG8_BAR __builtin_amdgcn_s_barrier()
#define PG8_SCHED __builtin_amdgcn_sched_barrier(0)
    Unit cur, nxt; int ui = 0;
    if (!S.next(0, cur)) return;
    f32x4 acc[2][2][4][2];
#pragma unroll
    for (int a = 0; a < 2; ++a)
#pragma unroll
        for (int b = 0; b < 2; ++b)
#pragma unroll
            for (int m = 0; m < 4; ++m)
#pragma unroll
                for (int n = 0; n < 2; ++n) acc[a][b][m][n] = (f32x4){0.f, 0.f, 0.f, 0.f};
    bf16x8 At[4][2], B0[2][2], B1[2][2];
    const char* cA = a_base(g, cur); const char* cB = b_base(g, cur);
    if constexpr (SP2) {
        PG8_STAGE(PG8_SB(0, 0), cB, voffB); PG8_STAGE(PG8_SB(0, 1), cB + hstepB, voffB); PG8_STAGE(PG8_SA(0, 0), cA, voffA); PG8_STAGE(PG8_SA(0, 1), cA + hstepA, voffA);
        if (wr == 1) PG8_BAR;
        PG8_WAIT_V(2); PG8_BAR;
        PG8_STAGE(PG8_SB(1, 0), cB + kstep, voffB); PG8_STAGE(PG8_SA(1, 0), cA + kstep, voffA); PG8_STAGE(PG8_SB(1, 1), cB + hstepB + kstep, voffB);
        PG8_WAIT_V(6); PG8_BAR;
    } else {
        PG8_STAGE(PG8_SB(0, 0), cB, voffB); PG8_STAGE(PG8_SA(0, 0), cA, voffA); PG8_STAGE(PG8_SB(0, 1), cB + hstepB, voffB); PG8_STAGE(PG8_SA(0, 1), cA + hstepA, voffA);
        if (wr == 1) PG8_BAR;
        PG8_WAIT_V(4); PG8_BAR;
        PG8_STAGE(PG8_SB(1, 0), cB + kstep, voffB); PG8_STAGE(PG8_SA(1, 0), cA + kstep, voffA); PG8_STAGE(PG8_SB(1, 1), cB + hstepB + kstep, voffB);
        PG8_WAIT_V(6); PG8_BAR;
    }
    for (;;) {
        const bool has_next = S.next(ui + 1, nxt);
        const char* nA = has_next ? a_base(g, nxt) : cA; const char* nB = has_next ? b_base(g, nxt) : cB;
#pragma unroll 1
        for (int t = 0; t < nt; t += 2) {
            const bool last = (t == nt - 2);
            const char* a1 = cA + (size_t)(t + 1) * kstep;
            const char* a2 = last ? nA : cA + (size_t)(t + 2) * kstep; const char* b2 = last ? nB : cB + (size_t)(t + 2) * kstep;
            const char* a3 = a2 + kstep; const char* b3 = b2 + kstep;
            if constexpr (SP2) {
            PG8_LDB(B0, 0, 0); PG8_LDB(B1, 0, 1); PG8_SCHED; PG8_LDA(At, 0, 0); PG8_STAGE(PG8_SA(1, 1), a1 + hstepA, voffA);
            PG8_WAIT_V(8); PG8_WAIT_L(0); PG8_BAR; PG8_MMA(0, 0, At, B0); PG8_MMA(0, 1, At, B1); PG8_BAR; PG8_SCHED;
            PG8_LDA(At, 0, 1); PG8_STAGE(PG8_SB(0, 0), b2, voffB); PG8_STAGE(PG8_SB(0, 1), b2 + hstepB, voffB); PG8_STAGE(PG8_SA(0, 0), a2, voffA);
            PG8_WAIT_V(8); PG8_WAIT_L(0); PG8_BAR; PG8_MMA(1, 0, At, B0); PG8_MMA(1, 1, At, B1); PG8_BAR; PG8_SCHED;
            PG8_LDB(B0, 1, 0); PG8_LDB(B1, 1, 1); PG8_SCHED; PG8_LDA(At, 1, 0); PG8_STAGE(PG8_SA(0, 1), a2 + hstepA, voffA);
            PG8_WAIT_V(8); PG8_WAIT_L(0); PG8_BAR; PG8_MMA(0, 0, At, B0); PG8_MMA(0, 1, At, B1); PG8_BAR; PG8_SCHED;
            PG8_LDA(At, 1, 1); PG8_STAGE(PG8_SB(1, 0), b3, voffB); PG8_STAGE(PG8_SB(1, 1), b3 + hstepB, voffB); PG8_STAGE(PG8_SA(1, 0), a3, voffA);
            PG8_WAIT_V(8); PG8_WAIT_L(0); PG8_BAR; PG8_MMA(1, 0, At, B0); PG8_MMA(1, 1, At, B1); PG8_BAR; PG8_SCHED;
            } else {
            PG8_LDB(B0, 0, 0); PG8_SCHED; PG8_LDA(At, 0, 0); PG8_STAGE(PG8_SA(1, 1), a1 + hstepA, voffA);
            PG8_WAIT_L(8); PG8_BAR; PG8_WAIT_L(0); PG8_MMA(0, 0, At, B0); PG8_BAR; PG8_SCHED;
            PG8_LDB(B1, 0, 1); PG8_STAGE(PG8_SB(0, 0), b2, voffB);
            PG8_BAR; PG8_WAIT_L(0); PG8_MMA(0, 1, At, B1); PG8_BAR;
            PG8_LDA(At, 0, 1); PG8_STAGE(PG8_SA(0, 0), a2, voffA);
            PG8_BAR; PG8_WAIT_L(0); PG8_MMA(1, 0, At, B0); PG8_BAR; PG8_SCHED;
            PG8_STAGE(PG8_SB(0, 1), b2 + hstepB, voffB);
            PG8_WAIT_V(6); PG8_BAR; PG8_MMA(1, 1, At, B1); PG8_BAR;
            PG8_LDB(B0, 1, 0); PG8_SCHED; PG8_LDA(At, 1, 0); PG8_STAGE(PG8_SA(0, 1), a2 + hstepA, voffA);
            PG8_WAIT_L(8); PG8_BAR; PG8_WAIT_L(0); PG8_MMA(0, 0, At, B0); PG8_BAR; PG8_SCHED;
            PG8_LDB(B1, 1, 1); PG8_STAGE(PG8_SB(1, 0), b3, voffB);
            PG8_BAR; PG8_WAIT_L(0); PG8_MMA(0, 1, At, B1); PG8_BAR;
            PG8_LDA(At, 1, 1); PG8_STAGE(PG8_SA(1, 0), a3, voffA);
            PG8_BAR; PG8_WAIT_L(0); PG8_MMA(1, 0, At, B0); PG8_BAR; PG8_SCHED;
            PG8_STAGE(PG8_SB(1, 1), b3 + hstepB, voffB);
            PG8_WAIT_V(6); PG8_BAR; PG8_MMA(1, 1, At, B1); PG8_BAR;
            }
        }
        if constexpr (ALIGN_EPI) { if (wr == 0) PG8_BAR; }
        if constexpr (!Epi::AFTER_DRAIN) E(acc, cur, wr, wc, fr, fq);
        if (!has_next) break;
#pragma unroll
        for (int a = 0; a < 2; ++a)
#pragma unroll
            for (int b = 0; b < 2; ++b)
#pragma unroll
                for (int m = 0; m < 4; ++m)
#pragma unroll
                    for (int n = 0; n < 2; ++n) acc[a][b][m][n] = (f32x4){0.f, 0.f, 0.f, 0.f};
        cur = nxt; cA = nA; cB = nB; ++ui;
        if constexpr (ALIGN_EPI) { if (wr == 1) PG8_BAR; }
    }
    PG8_WAIT_V(0);
    if constexpr (!ALIGN_EPI) { if (wr == 0) PG8_BAR; }
    PG8_BAR;
    if constexpr (Epi::AFTER_DRAIN) E.fused(acc, cur, wr, wc, fr, fq, lds, wid, lane);
#undef PG8_SA
#undef PG8_SB
#undef PG8_STAGE
#undef PG8_LDA
#undef PG8_LDB
#undef PG8_MMA
#undef PG8_WAIT_V
#undef PG8_WAIT_L
#undef PG8_BAR
#undef PG8_SCHED
}

typedef f32x4 AccT[2][2][4][2];
struct EpiResid {
    static constexpr bool PERM = false, AFTER_DRAIN = false;
    float* X; int ldc; float alpha;
    __device__ __forceinline__ void operator()(const AccT& acc, const Unit& u, int wr, int wc, int fr_in, int fq_in) const {
        int fr = fr_in, fq = fq_in; asm volatile("" : "+v"(fr), "+v"(fq));
        const int row0 = u.pm * BM + wr * 64 + fr, col0 = u.pn * BM + wc * 32 + 4 * fq;
#pragma unroll
        for (int ai = 0; ai < 2; ++ai)
#pragma unroll
            for (int m = 0; m < 4; ++m) { float* rowp = X + (size_t)(row0 + ai * HALF + m * 16) * ldc + col0;
                f32x4 xv[2][2];
#pragma unroll
                for (int bj = 0; bj < 2; ++bj)
#pragma unroll
                    for (int n = 0; n < 2; ++n) xv[bj][n] = *(const f32x4*)(rowp + bj * HALF + n * 16);
#pragma unroll
                for (int bj = 0; bj < 2; ++bj)
#pragma unroll
                    for (int n = 0; n < 2; ++n) *(f32x4*)(rowp + bj * HALF + n * 16) = xv[bj][n] * alpha + acc[ai][bj][m][n]; }
    }
};
struct EpiResidLn {
    static constexpr bool PERM = false, AFTER_DRAIN = true;
    const float* Xin; float* Xout; bf16* XBout; const float* g; const float* b; float alpha;
    unsigned long long* xbuf; unsigned* cnt; unsigned want; unsigned* tmo;
    __device__ __forceinline__ void operator()(const AccT&, const Unit&, int, int, int, int) const {}
    __device__ __forceinline__ void fused(AccT& acc, const Unit& u, int wr, int wc, int fr_in, int fq_in, LAS unsigned char* lds, int wid, int lane_in) const {
        int fr = fr_in, fq = fq_in, lane = lane_in; asm volatile("" : "+v"(fr), "+v"(fq), "+v"(lane));
        LAS f32x2* P = (LAS f32x2*)lds;
        LAS f32x2* S = (LAS f32x2*)(lds + 8192);
        const int col0 = u.pn * BM + wc * 32 + 4 * fq;
#pragma unroll
        for (int ai = 0; ai < 2; ++ai)
#pragma unroll
            for (int m = 0; m < 4; ++m) { const float* rowp = Xin + (size_t)(u.pm * BM + ai * HALF + wr * 64 + m * 16 + fr) * D + col0;
#pragma unroll
                for (int bj = 0; bj < 2; ++bj) {
#pragma unroll
                    for (int n = 0; n < 2; ++n) acc[ai][bj][m][n] += *(const f32x4*)(rowp + bj * HALF + n * 16) * alpha;
                    asm volatile("" : "+v"(acc[ai][bj][m][0]), "+v"(acc[ai][bj][m][1]) :: "memory"); } }
#pragma unroll
        for (int ai = 0; ai < 2; ++ai)
#pragma unroll
            for (int m = 0; m < 4; ++m) {
                float s = 0.f;
#pragma unroll
                for (int bj = 0; bj < 2; ++bj)
#pragma unroll
                    for (int n = 0; n < 2; ++n) { const f32x4 x = acc[ai][bj][m][n]; s += (x[0] + x[1]) + (x[2] + x[3]); }
                s += shfl_lane(s, lane ^ 16); s += shfl_lane(s, lane ^ 32);
                const float mw = s * (1.0f / 64.0f); float q = 0.f;
#pragma unroll
                for (int bj = 0; bj < 2; ++bj)
#pragma unroll
                    for (int n = 0; n < 2; ++n) { const f32x4 d = acc[ai][bj][m][n] - mw; q += (d[0] * d[0] + d[1] * d[1]) + (d[2] * d[2] + d[3] * d[3]); }
                q += shfl_lane(q, lane ^ 16); q += shfl_lane(q, lane ^ 32);
                if (fq == 0) P[(ai * HALF + wr * 64 + m * 16 + fr) * 4 + wc] = (f32x2){mw, q};
            }
        asm volatile("s_waitcnt lgkmcnt(0)" ::: "memory"); __builtin_amdgcn_s_barrier(); asm volatile("" ::: "memory");
        const int row = wid * 32 + (lane & 31);
        if (lane < 32) {
            const f32x2 a = P[row * 4 + 0], bb = P[row * 4 + 1], c = P[row * 4 + 2], d = P[row * 4 + 3];
            const float mt = (a.x + bb.x + c.x + d.x) * 0.25f;
            const float da = a.x - mt, db = bb.x - mt, dc = c.x - mt, dd = d.x - mt;
            const float m2 = (a.y + bb.y) + (c.y + d.y) + 64.0f * ((da * da + db * db) + (dc * dc + dd * dd));
            unsigned long long* slot = xbuf + ((size_t)(u.pm * BM + row) * 8 + u.pn);
            __hip_atomic_store(slot, ((unsigned long long)__float_as_uint(m2) << 32) | __float_as_uint(mt), __ATOMIC_RELAXED, __HIP_MEMORY_SCOPE_AGENT);
        }
        asm volatile("s_waitcnt vmcnt(0)" ::: "memory");
        if (lane == 0) __hip_atomic_fetch_add(cnt + 64 * u.pm, 1u, __ATOMIC_RELAXED, __HIP_MEMORY_SCOPE_AGENT);
        if (wid == 0) {
            unsigned sp = 0;
            while ((unsigned)__builtin_amdgcn_readfirstlane(__hip_atomic_load(cnt + 64 * u.pm, __ATOMIC_RELAXED, __HIP_MEMORY_SCOPE_AGENT)) < want) {
                __builtin_amdgcn_s_sleep(1);
                if ((++sp & 1023u) == 0u) { if (__builtin_amdgcn_readfirstlane(__hip_atomic_load(tmo, __ATOMIC_RELAXED, __HIP_MEMORY_SCOPE_AGENT)) != 0u) break;
                    if (sp > (1u << 22)) { if (lane == 0) __hip_atomic_store(tmo, 1u, __ATOMIC_RELAXED, __HIP_MEMORY_SCOPE_AGENT); break; } } }
            __builtin_amdgcn_fence(__ATOMIC_ACQUIRE, "agent");
        }
        asm volatile("s_waitcnt vmcnt(0) lgkmcnt(0)" ::: "memory"); __builtin_amdgcn_s_barrier(); asm volatile("" ::: "memory");
        if (lane < 32) {
            const unsigned long long* slot = xbuf + (size_t)(u.pm * BM + row) * 8; float mt[8], m2[8]; float ms = 0.f;
#pragma unroll
            for (int t = 0; t < 8; ++t) { const unsigned long long w = __hip_atomic_load(slot + t, __ATOMIC_RELAXED, __HIP_MEMORY_SCOPE_AGENT); mt[t] = __uint_as_float((unsigned)w); m2[t] = __uint_as_float((unsigned)(w >> 32)); ms += mt[t]; }
            const float mean = ms * 0.125f; float q = 0.f;
#pragma unroll
            for (int t = 0; t < 8; ++t) { const float dm = mt[t] - mean; q += m2[t] + 256.0f * dm * dm; }
            S[row] = (f32x2){mean, rsqrtf(q * (1.0f / 2048.0f) + LN_EPS)};
        }
        asm volatile("s_waitcnt lgkmcnt(0)" ::: "memory"); __builtin_amdgcn_s_barrier(); asm volatile("" ::: "memory");
        asm volatile("" : "+v"(fr), "+v"(fq));
        const int col5 = u.pn * BM + wc * 32 + 4 * fq;
#pragma unroll
        for (int bj = 0; bj < 2; ++bj)
#pragma unroll
            for (int n = 0; n < 2; ++n) { const int cc = col5 + bj * HALF + n * 16; const f32x4 gg = *(const f32x4*)(g + cc), bv = *(const f32x4*)(b + cc);
#pragma unroll
                for (int ai = 0; ai < 2; ++ai)
#pragma unroll
                    for (int m = 0; m < 4; ++m) { const int r = ai * HALF + wr * 64 + m * 16 + fr; const f32x2 sr = S[r]; const size_t off = (size_t)(u.pm * BM + r) * D + cc;
                        const f32x4 o = (acc[ai][bj][m][n] - sr.x) * sr.y * gg + bv; *(f32x4*)(Xout + off) = o;
                        u32x2 w; w.x = pk2(o[0], o[1]); w.y = pk2(o[2], o[3]); *(u32x2*)(XBout + off) = w; }
                asm volatile("" ::: "memory"); }
    }
};
struct EpiRelu2 {
    static constexpr bool PERM = true, AFTER_DRAIN = false;
    bf16* O; int ldc;
    __device__ __forceinline__ void operator()(const AccT& acc, const Unit& u, int wr, int wc, int fr_in, int fq_in) const {
        int fr = fr_in, fq = fq_in; asm volatile("" : "+v"(fr), "+v"(fq));
        const int row0 = u.pm * BM + wr * 64 + fr, col0 = u.pn * BM + wc * 32 + 8 * fq;
#pragma unroll
        for (int ai = 0; ai < 2; ++ai)
#pragma unroll
            for (int m = 0; m < 4; ++m) { bf16* rowp = O + (size_t)(row0 + ai * HALF + m * 16) * ldc + col0;
#pragma unroll
                for (int bj = 0; bj < 2; ++bj) { f32x4 v0 = acc[ai][bj][m][0], v1 = acc[ai][bj][m][1];
#pragma unroll
                    for (int j = 0; j < 4; ++j) { const float a = fmaxf(v0[j], 0.f), b = fmaxf(v1[j], 0.f); v0[j] = a * a; v1[j] = b * b; }
                    u32x4 w; w.x = pk2(v0[0], v0[1]); w.y = pk2(v0[2], v0[3]); w.z = pk2(v1[0], v1[1]); w.w = pk2(v1[2], v1[3]);
                    *(u32x4*)(rowp + bj * HALF) = w; } }
    }
};
struct EpiRgIn {
    static constexpr bool PERM = true, AFTER_DRAIN = false;
    bf16* GATE; bf16* URAW;
    __device__ __forceinline__ void operator()(const AccT& acc, const Unit& u, int wr, int wc, int fr_in, int fq_in) const {
        int fr = fr_in, fq = fq_in; asm volatile("" : "+v"(fr), "+v"(fq));
        const bool isg = u.pn < 8; bf16* base = isg ? GATE : URAW;
        const int row0 = u.pm * BM + wr * 64 + fr, col0 = (u.pn & 7) * BM + wc * 32 + 8 * fq;
#pragma unroll
        for (int ai = 0; ai < 2; ++ai)
#pragma unroll
            for (int m = 0; m < 4; ++m) { bf16* rowp = base + (size_t)(row0 + ai * HALF + m * 16) * D + col0;
#pragma unroll
                for (int bj = 0; bj < 2; ++bj) { f32x4 v0 = acc[ai][bj][m][0], v1 = acc[ai][bj][m][1];
                    if (isg) {
#pragma unroll
                        for (int j = 0; j < 4; ++j) { v0[j] = gelu_tanh_(v0[j]); v1[j] = gelu_tanh_(v1[j]); } }
                    u32x4 w; w.x = pk2(v0[0], v0[1]); w.y = pk2(v0[2], v0[3]); w.z = pk2(v1[0], v1[1]); w.w = pk2(v1[2], v1[3]);
                    *(u32x4*)(rowp + bj * HALF) = w; } }
    }
};
struct EpiRgGates {
    static constexpr bool PERM = true, AFTER_DRAIN = false;
    const bf16* U; bf16* LA; bf16* INP; const float* ba; const float* bx; const float* spt;
    __device__ __forceinline__ void operator()(const AccT& acc, const Unit& u, int wr, int wc, int fr_in, int fq_in) const {
        int fr = fr_in, fq = fq_in; asm volatile("" : "+v"(fr), "+v"(fq));
        const int d = u.pn >> 4, nb = (u.pn >> 1) & 7, half = u.pn & 1;
        const int c0 = nb * 256 + half * 128 + wc * 32 + 8 * fq;
        const int row0 = u.pm * BM + wr * 64 + fr;
        bf16* la = LA + (size_t)d * TG * D; bf16* inp = INP + (size_t)d * TG * D;
#pragma unroll
        for (int n = 0; n < 2; ++n) {
            const f32x4 pba = *(const f32x4*)(ba + d * D + c0 + 4 * n), pbx = *(const f32x4*)(bx + d * D + c0 + 4 * n), psp = *(const f32x4*)(spt + d * D + c0 + 4 * n);
#pragma unroll
            for (int ai = 0; ai < 2; ++ai)
#pragma unroll
                for (int m = 0; m < 4; ++m) { const size_t off = (size_t)(row0 + ai * HALF + m * 16) * D + c0 + 4 * n;
                    const u32x2 uw = *(const u32x2*)(U + off);
                    const float uv[4] = {bflo(uw.x), bfhi(uw.x), bflo(uw.y), bfhi(uw.y)};
                    float lv[4], iv[4];
#pragma unroll
                    for (int j = 0; j < 4; ++j) { const float r = sigmoidf_(acc[ai][0][m][n][j] + pba[j]); const float ig = sigmoidf_(acc[ai][1][m][n][j] + pbx[j]);
                        const float l = r * psp[j]; const float a2 = __expf(2.0f * l); lv[j] = l; iv[j] = fsqrt_(fmaxf(1.0f - a2, 0.f)) * ig * uv[j]; }
                    u32x2 w; w.x = pk2(lv[0], lv[1]); w.y = pk2(lv[2], lv[3]); *(u32x2*)(la + off) = w;
                    u32x2 v; v.x = pk2(iv[0], iv[1]); v.y = pk2(iv[2], iv[3]); *(u32x2*)(inp + off) = v; }
            asm volatile("" ::: "memory");
        }
    }
};
struct EpiSsdIn {
    static constexpr bool PERM = true, AFTER_DRAIN = false;
    bf16* ZS; bf16* XBCR; float* DT; const float* dtb;
    __device__ __forceinline__ void operator()(const AccT& acc, const Unit& u, int wr, int wc, int fr_in, int fq_in) const {
        int fr = fr_in, fq = fq_in; asm volatile("" : "+v"(fr), "+v"(fq));
        const int row0 = u.pm * BM + wr * 64 + fr, cw = wc * 32 + 8 * fq;
        if (u.pn < 40) {
            const bool isz = u.pn < 16; bf16* base = isz ? ZS + (size_t)u.pn * BM : XBCR + (size_t)(u.pn - 16) * BM; const int ldc = isz ? SSD_DI : SSD_XBC;
#pragma unroll
            for (int ai = 0; ai < 2; ++ai)
#pragma unroll
                for (int m = 0; m < 4; ++m) { bf16* rowp = base + (size_t)(row0 + ai * HALF + m * 16) * ldc + cw;
#pragma unroll
                    for (int bj = 0; bj < 2; ++bj) { f32x4 v0 = acc[ai][bj][m][0], v1 = acc[ai][bj][m][1];
                        if (isz) {
#pragma unroll
                            for (int j = 0; j < 4; ++j) { v0[j] = siluf_(v0[j]); v1[j] = siluf_(v1[j]); } }
                        u32x4 w; w.x = pk2(v0[0], v0[1]); w.y = pk2(v0[2], v0[3]); w.z = pk2(v1[0], v1[1]); w.w = pk2(v1[2], v1[3]);
                        *(u32x4*)(rowp + bj * HALF) = w; } }
        } else {
            f32x4 b0 = *(const f32x4*)(dtb + cw), b1 = *(const f32x4*)(dtb + cw + 4);
#pragma unroll
            for (int ai = 0; ai < 2; ++ai)
#pragma unroll
                for (int m = 0; m < 4; ++m) { float* rowp = DT + (size_t)(row0 + ai * HALF + m * 16) * 128 + cw;
                    f32x4 v0 = acc[ai][0][m][0] + b0, v1 = acc[ai][0][m][1] + b1;
#pragma unroll
                    for (int j = 0; j < 4; ++j) { v0[j] = softplusf_(v0[j]); v1[j] = softplusf_(v1[j]); }
                    *(f32x4*)(rowp) = v0; *(f32x4*)(rowp + 4) = v1; }
        }
    }
};
struct EpiQkv {
    static constexpr bool PERM = true, AFTER_DRAIN = false;
    bf16* Q; const float* bias;
    __device__ __forceinline__ void operator()(const AccT& acc, const Unit& u, int wr, int wc, int fr_in, int fq_in) const {
        int fr = fr_in, fq = fq_in; asm volatile("" : "+v"(fr), "+v"(fq));
        const int t = u.pn >> 3; bf16* base = Q + (size_t)t * TG * D; const float sc = t == 0 ? 0.08838834764831845f : 1.0f;
        const int row0 = u.pm * BM + wr * 64 + fr, col0 = (u.pn & 7) * BM + wc * 32 + 8 * fq, bcol0 = u.pn * BM + wc * 32 + 8 * fq;
#pragma unroll
        for (int bj = 0; bj < 2; ++bj) {
            const f32x4 bv0 = *(const f32x4*)(bias + bcol0 + bj * HALF), bv1 = *(const f32x4*)(bias + bcol0 + bj * HALF + 4);
#pragma unroll
            for (int ai = 0; ai < 2; ++ai)
#pragma unroll
                for (int m = 0; m < 4; ++m) { bf16* rowp = base + (size_t)(row0 + ai * HALF + m * 16) * D + col0;
                    const f32x4 v0 = (acc[ai][bj][m][0] + bv0) * sc, v1 = (acc[ai][bj][m][1] + bv1) * sc;
                    u32x4 w; w.x = pk2(v0[0], v0[1]); w.y = pk2(v0[2], v0[3]); w.z = pk2(v1[0], v1[1]); w.w = pk2(v1[2], v1[3]);
                    *(u32x4*)(rowp + bj * HALF) = w; }
            asm volatile("" ::: "memory");
        }
    }
};
}

struct Frame {
    LAS unsigned char* lds;
    int tid, lane, wave, G, gw, ngw;
};

__device__ __forceinline__ Frame phase_frame(const Frame& F0) {
    Frame F = F0; int t = threadIdx.x; asm volatile("" : "+v"(t));
    F.tid = t; F.lane = t & 63; F.wave = __builtin_amdgcn_readfirstlane(t >> 6); F.gw = blockIdx.x * NWAVES + F.wave; return F;
}
__device__ __forceinline__ void transpose_item(const float* W, int ldw, bf16* WT, int ldt, int k0, int n0, int drow0, LAS float* scr, int lane) {
#pragma unroll 8
    for (int i = 0; i < 32; ++i) { const int kk = 2 * i + (lane >> 5); scr[kk * 33 + (lane & 31)] = W[(size_t)(k0 + kk) * ldw + n0 + (lane & 31)]; }
    LDS_WAIT(); asm volatile("" ::: "memory");
    const int c = lane & 7;
#pragma unroll
    for (int j = 0; j < 4; ++j) { const int n = (lane >> 3) + 8 * j; const LAS float* s = scr + (8 * c) * 33 + n;
        u32x4 o; o.x = pk2(s[0 * 33], s[1 * 33]); o.y = pk2(s[2 * 33], s[3 * 33]); o.z = pk2(s[4 * 33], s[5 * 33]); o.w = pk2(s[6 * 33], s[7 * 33]);
        *(GAS u32x4*)(WT + (size_t)(drow0 + n) * ldt + k0 + 8 * c) = o; }
    LDS_WAIT(); asm volatile("" ::: "memory");
}
__device__ __forceinline__ void conv_matrix(const Frame& F, const float* W, int K, int N, bf16* WT, LAS float* scr) {
    const int nblk = N / 32, nitems = (K / 64) * nblk;
    for (int it = F.gw; it < nitems; it += F.ngw) { const int kb = it / nblk, nb = it % nblk; transpose_item(W, N, WT, K, 64 * kb, 32 * nb, 32 * nb, scr, F.lane); }
}
__device__ __forceinline__ void p_prologue(const Frame& F0, const float* const* in, bf16* Wb, float* spt, bf16* XB0) {
    const Frame F = phase_frame(F0);
    { const int n4 = NGROUP * TG * D / 4, n4p = 2 * TG * D / 4;
      for (int i = F.gw * 64 + F.lane; i < n4; i += F.ngw * 64) { const f32x4 v = i < n4p ? ((const f32x4*)in[0])[i] : ((const f32x4*)in[1])[i - n4p]; u32x2 w; w.x = pk2(v.x, v.y); w.y = pk2(v.z, v.w); ((u32x2*)XB0)[i] = w; } }
    LAS float* scr = (LAS float*)(F.lds + F.wave * 16384);
    for (int l = 0; l < 2; ++l) {
        conv_matrix(F, in[2] + (size_t)l * 2048 * 4096, 2048, 4096, Wb + W_RGIN + (size_t)l * 4096 * 2048, scr);
        conv_matrix(F, in[10] + (size_t)l * 2048 * 2048, 2048, 2048, Wb + W_RGOUT + (size_t)l * 2048 * 2048, scr);
    }
    for (int it = F.gw; it < 2 * 2 * 16 * 32; it += F.ngw) {
        const int sub = it & 31, mat = it >> 5;
        const int dn = mat & 15, ax = (mat >> 4) & 1, l = mat >> 5;
        const int kb = sub >> 3, nb = sub & 7, j0 = 32 * nb;
        const float* W = in[ax ? 7 : 5] + ((size_t)(l * 16 + dn)) * 65536;
        bf16* WT = Wb + W_RGGATE + (size_t)l * 32 * 65536 + (size_t)(dn * 2 + (j0 >> 7)) * 65536;
        transpose_item(W, 256, WT, 256, 64 * kb, j0, (j0 & 127) + 128 * ax, scr, F.lane);
    }
    for (int i = F.gw * 64 + F.lane; i < 2 * 2 * 2048; i += F.ngw * 64) spt[i] = -8.0f * softplusf_(-in[9][i]);
    conv_matrix(F, in[11], 2048, SSD_NIN, Wb + W_SSDIN, scr);
    { u32x4* z = (u32x4*)(Wb + W_SSDIN + (size_t)SSD_NIN * 2048); const int n16 = (SSD_NIN_PAD - SSD_NIN) * 2048 / 8;
      for (int i = F.gw * 64 + F.lane; i < n16; i += F.ngw * 64) z[i] = (u32x4){0u, 0u, 0u, 0u}; }
    conv_matrix(F, in[18], 4096, 2048, Wb + W_SSDOUT, scr);
    conv_matrix(F, in[19], 2048, 6144, Wb + W_NAQKV, scr);
    conv_matrix(F, in[22], 2048, 2048, Wb + W_NAOUT, scr);
    for (int l = 0; l < 4; ++l) {
        conv_matrix(F, in[23] + (size_t)l * 2048 * 8192, 2048, 8192, Wb + W_UP + (size_t)l * 8192 * 2048, scr);
        conv_matrix(F, in[24] + (size_t)l * 8192 * 2048, 8192, 2048, Wb + W_DOWN + (size_t)l * 2048 * 8192, scr);
    }
}

__device__ __forceinline__ void p_copy(const Frame& F0, const float* src, float* X, bf16* XB) {
    const Frame F = phase_frame(F0);
    const int n4 = TG * D / 4;
    for (int i = F.gw * 64 + F.lane; i < n4; i += F.ngw * 64) { const f32x4 v = ((const f32x4*)src)[i]; ((f32x4*)X)[i] = v; u32x2 w; w.x = pk2(v.x, v.y); w.y = pk2(v.z, v.w); ((u32x2*)XB)[i] = w; }
}
__device__ __forceinline__ void p_ln(const Frame& F0, const float* Xi, float* X, bf16* XB, const float* g, const float* b) {
    const Frame F = phase_frame(F0);
    for (int m = F.gw; m < TG; m += F.ngw) {
        f32x4* xr = (f32x4*)(X + (size_t)m * D) + F.lane; const f32x4* xi = (const f32x4*)(Xi + (size_t)m * D) + F.lane;
        f32x4 v[8]; float s = 0.f;
#pragma unroll
        for (int j = 0; j < 8; ++j) { v[j] = xi[64 * j]; s += (v[j].x + v[j].y) + (v[j].z + v[j].w); }
        const float mean = wave_sum(s, F.lane) * (1.f / D); float s2 = 0.f;
#pragma unroll
        for (int j = 0; j < 8; ++j) { v[j] = v[j] - mean; s2 += (v[j].x * v[j].x + v[j].y * v[j].y) + (v[j].z * v[j].z + v[j].w * v[j].w); }
        const float rstd = rsqrtf(wave_sum(s2, F.lane) * (1.f / D) + LN_EPS);
        u32x2* o8 = (u32x2*)(XB + (size_t)m * D) + F.lane;
#pragma unroll
        for (int j = 0; j < 8; ++j) { const f32x4 gg = ((const f32x4*)g)[F.lane + 64 * j], bb = ((const f32x4*)b)[F.lane + 64 * j];
            const f32x4 y = v[j] * rstd * gg + bb; xr[64 * j] = y; u32x2 w; w.x = pk2(y.x, y.y); w.y = pk2(y.z, y.w); o8[64 * j] = w; }
    }
}

template <int MODE>
__device__ __forceinline__ void p_conv(const Frame& F0, const bf16* in, int C, int L, const float* cw, const float* cb, bf16* out0, bf16* out1, bf16* out2) {
    const Frame F = phase_frame(F0);
    const int ncb = C / 512, nitems = (TG / 16) * ncb;
    for (int it = F.gw; it < nitems; it += F.ngw) {
        const int cbk = it % ncb, run = it / ncb, t0 = run * 16, c0 = cbk * 512 + F.lane * 8;
        const int tl = t0 % L;
        float w[4][8], bias[8];
#pragma unroll
        for (int k = 0; k < 4; ++k) { const f32x4 a = *(const f32x4*)(cw + (size_t)k * C + c0), b = *(const f32x4*)(cw + (size_t)k * C + c0 + 4);
            w[k][0] = a.x; w[k][1] = a.y; w[k][2] = a.z; w[k][3] = a.w; w[k][4] = b.x; w[k][5] = b.y; w[k][6] = b.z; w[k][7] = b.w; }
        { const f32x4 a = *(const f32x4*)(cb + c0), b = *(const f32x4*)(cb + c0 + 4); bias[0] = a.x; bias[1] = a.y; bias[2] = a.z; bias[3] = a.w; bias[4] = b.x; bias[5] = b.y; bias[6] = b.z; bias[7] = b.w; }
        u32x4 rows[19];
#pragma unroll
        for (int i = 0; i < 19; ++i) { const int tt = tl - 1 + i; const bool ok = (tt >= 0) && (tt < L);
            rows[i] = ok ? *(const u32x4*)(in + (size_t)(t0 - 1 + i) * C + c0) : (u32x4){0u, 0u, 0u, 0u}; }
        unsigned outw[16][4];
#pragma unroll
        for (int i = 0; i < 16; ++i) {
            float y[8];
#pragma unroll
            for (int j = 0; j < 8; ++j) y[j] = bias[j];
#pragma unroll
            for (int k = 0; k < 4; ++k) { const u32x4 r = rows[i + k];
                y[0] += w[k][0] * bflo(r.x); y[1] += w[k][1] * bfhi(r.x); y[2] += w[k][2] * bflo(r.y); y[3] += w[k][3] * bfhi(r.y);
                y[4] += w[k][4] * bflo(r.z); y[5] += w[k][5] * bfhi(r.z); y[6] += w[k][6] * bflo(r.w); y[7] += w[k][7] * bfhi(r.w); }
            if (MODE == 1) {
#pragma unroll
                for (int j = 0; j < 8; ++j) y[j] = siluf_(y[j]); }
            outw[i][0] = pk2(y[0], y[1]); outw[i][1] = pk2(y[2], y[3]); outw[i][2] = pk2(y[4], y[5]); outw[i][3] = pk2(y[6], y[7]);
        }
        if (MODE == 0 || c0 >= 4096) {
            bf16* ob; int ldo, cc;
            if (MODE == 0) { ob = out0; ldo = C; cc = c0; } else if (c0 < 5120) { ob = out1; ldo = 1024; cc = c0 - 4096; } else { ob = out2; ldo = 1024; cc = c0 - 5120; }
#pragma unroll
            for (int i = 0; i < 16; ++i) *(u32x4*)(ob + (size_t)(t0 + i) * ldo + cc) = (u32x4){outw[i][0], outw[i][1], outw[i][2], outw[i][3]};
        } else {
            const int chunk = t0 >> 7, s0 = t0 & 127, head = c0 >> 6, p0 = c0 & 63;
            bf16* xb = out0 + ((size_t)(chunk * 64 + head) * 64 + p0) * 128 + s0;
#pragma unroll
            for (int j = 0; j < 8; ++j) {
                unsigned e[8];
#pragma unroll
                for (int q = 0; q < 8; ++q) { const unsigned a = outw[2 * q][j >> 1], b = outw[2 * q + 1][j >> 1];
                    e[q] = (j & 1) ? ((a >> 16) | (b & 0xffff0000u)) : ((a & 0xffffu) | (b << 16)); }
                *(u32x4*)(xb + (size_t)j * 128) = (u32x4){e[0], e[1], e[2], e[3]}; *(u32x4*)(xb + (size_t)j * 128 + 8) = (u32x4){e[4], e[5], e[6], e[7]};
            }
        }
    }
}

__device__ __forceinline__ void p_rg_scan_a(const Frame& F0, const bf16* LA, const bf16* INP, float* HEND, float* PROD) {
    const Frame F = phase_frame(F0);
    for (int it = F.gw; it < 128 * 2 * 4; it += F.ngw) {
        const int cb = it & 3, d = (it >> 2) & 1, ck = it >> 3, c0 = cb * 512 + F.lane * 8;
        const bf16* la = LA + (size_t)d * TG * D + (size_t)ck * 64 * D + c0; const bf16* ip = INP + (size_t)d * TG * D + (size_t)ck * 64 * D + c0;
        float h[8], ls[8];
#pragma unroll
        for (int j = 0; j < 8; ++j) { h[j] = 0.f; ls[j] = 0.f; }
#pragma unroll 8
        for (int i = 0; i < 64; ++i) { const int t = d ? 63 - i : i;
            const u32x4 lw = *(const u32x4*)(la + (size_t)t * D), iw = *(const u32x4*)(ip + (size_t)t * D);
            const float l[8] = {bflo(lw.x), bfhi(lw.x), bflo(lw.y), bfhi(lw.y), bflo(lw.z), bfhi(lw.z), bflo(lw.w), bfhi(lw.w)};
            const float x[8] = {bflo(iw.x), bfhi(iw.x), bflo(iw.y), bfhi(iw.y), bflo(iw.z), bfhi(iw.z), bflo(iw.w), bfhi(iw.w)};
#pragma unroll
            for (int j = 0; j < 8; ++j) { h[j] = __expf(l[j]) * h[j] + x[j]; ls[j] += l[j]; } }
        float* he = HEND + ((size_t)ck * 2 + d) * D + c0; float* pr = PROD + ((size_t)ck * 2 + d) * D + c0;
        *(f32x4*)he = (f32x4){h[0], h[1], h[2], h[3]}; *(f32x4*)(he + 4) = (f32x4){h[4], h[5], h[6], h[7]};
        *(f32x4*)pr = (f32x4){__expf(ls[0]), __expf(ls[1]), __expf(ls[2]), __expf(ls[3])}; *(f32x4*)(pr + 4) = (f32x4){__expf(ls[4]), __expf(ls[5]), __expf(ls[6]), __expf(ls[7])};
    }
}
__device__ __forceinline__ void p_rg_scan_b(const Frame& F0, const float* __restrict__ HEND, const float* __restrict__ PROD, float* __restrict__ HIN, int L) {
    const Frame F = phase_frame(F0);
    const int nck = L / 64, nseq = TG / L, total = nseq * 2 * D;
    for (int e = F.gw * 64 + F.lane; e < total; e += F.ngw * 64) {
        const int c = e % D, d = (e / D) & 1, sq = e / (2 * D);
        float h = 0.f;
        for (int k0 = 0; k0 < nck; k0 += 16) {
            float p[16], he[16];
#pragma unroll
            for (int j = 0; j < 16; ++j) { const int k = k0 + j, ck = sq * nck + (d ? nck - 1 - k : k); const size_t o = ((size_t)ck * 2 + d) * D + c; p[j] = PROD[o]; he[j] = HEND[o]; }
#pragma unroll
            for (int j = 0; j < 16; ++j) { const int k = k0 + j, ck = sq * nck + (d ? nck - 1 - k : k); const size_t o = ((size_t)ck * 2 + d) * D + c; HIN[o] = h; h = p[j] * h + he[j]; }
        }
    }
}
__device__ __forceinline__ void p_rg_scan_c(const Frame& F0, const bf16* LA, const bf16* INP, const float* HIN, const bf16* GATE, bf16* Y) {
    const Frame F = phase_frame(F0);
    for (int it = F.gw; it < 128 * 16; it += F.ngw) {
        const int cb = it & 15, ck = it >> 4, c0 = cb * 128 + F.lane * 2;
        const size_t base = (size_t)ck * 64 * D + c0;
        const unsigned* la0 = (const unsigned*)(LA + base); const unsigned* ip0 = (const unsigned*)(INP + base);
        const unsigned* la1 = (const unsigned*)(LA + (size_t)TG * D + base); const unsigned* ip1 = (const unsigned*)(INP + (size_t)TG * D + base);
        const unsigned* gt = (const unsigned*)(GATE + base); unsigned* yo = (unsigned*)(Y + base);
        f32x2 hf[64];
        { const f32x2 hi = *(const f32x2*)(HIN + ((size_t)ck * 2 + 0) * D + c0); float h0 = hi.x, h1 = hi.y;
#pragma unroll
          for (int t = 0; t < 64; ++t) { const unsigned lw = la0[(size_t)t * (D / 2)], iw = ip0[(size_t)t * (D / 2)];
              h0 = __expf(bflo(lw)) * h0 + bflo(iw); h1 = __expf(bfhi(lw)) * h1 + bfhi(iw); hf[t] = (f32x2){h0, h1}; } }
        { const f32x2 hi = *(const f32x2*)(HIN + ((size_t)ck * 2 + 1) * D + c0); float h0 = hi.x, h1 = hi.y;
#pragma unroll
          for (int i = 0; i < 64; ++i) { const int t = 63 - i; const unsigned lw = la1[(size_t)t * (D / 2)], iw = ip1[(size_t)t * (D / 2)], gw = gt[(size_t)t * (D / 2)];
              h0 = __expf(bflo(lw)) * h0 + bflo(iw); h1 = __expf(bfhi(lw)) * h1 + bfhi(iw);
              yo[(size_t)t * (D / 2)] = pk2((hf[t].x + h0) * bflo(gw), (hf[t].y + h1) * bfhi(gw)); } }
    }
}

constexpr int PB = 272;
__device__ __forceinline__ s16x4 tr_read(const LAS unsigned char* p) { return __builtin_bit_cast(s16x4, __builtin_amdgcn_ds_read_tr16_b64_v4i16((LAS v4i16_t*)p)); }
__device__ __forceinline__ bf16x8 cat8(s16x4 lo, s16x4 hi) { return __builtin_shufflevector(lo, hi, 0, 1, 2, 3, 4, 5, 6, 7); }
__device__ __forceinline__ bf16x8 scale8(bf16x8 v, const float* w) {
    const u32x4 u = __builtin_bit_cast(u32x4, v); u32x4 o;
    o.x = pk2(bflo(u.x) * w[0], bfhi(u.x) * w[1]); o.y = pk2(bflo(u.y) * w[2], bfhi(u.y) * w[3]); o.z = pk2(bflo(u.z) * w[4], bfhi(u.z) * w[5]); o.w = pk2(bflo(u.w) * w[6], bfhi(u.w) * w[7]);
    return __builtin_bit_cast(bf16x8, o);
}
__device__ __forceinline__ bf16x8 scale8s(bf16x8 v, float w) {
    const u32x4 u = __builtin_bit_cast(u32x4, v); u32x4 o;
    o.x = pk2(bflo(u.x) * w, bfhi(u.x) * w); o.y = pk2(bflo(u.y) * w, bfhi(u.y) * w); o.z = pk2(bflo(u.z) * w, bfhi(u.z) * w); o.w = pk2(bflo(u.w) * w, bfhi(u.w) * w);
    return __builtin_bit_cast(bf16x8, o);
}
__device__ __forceinline__ void stage_img(const Frame& F, const bf16* src, int ld, LAS unsigned char* img) {
#pragma unroll
    for (int i = 0; i < 4; ++i) { const int idx = F.tid + 512 * i, r = idx >> 4, ch = idx & 15; *(LAS u32x4*)(img + r * PB + ch * 16) = *(const u32x4*)(src + (size_t)r * ld + ch * 8); }
}
__device__ __forceinline__ void ssd_tables(const Frame& F, const float* DT, int t0, int head, float A0, float A1, LAS float* tab) {
    const int L = F.lane; const float* dp = DT + (size_t)(t0 + 2 * L) * 128 + head;
    const float a0 = dp[0], a1 = dp[128], b0 = dp[64], b1 = dp[128 + 64];
    float sa = a0 + a1, sb = b0 + b1, ia = sa, ib = sb;
#pragma unroll
    for (int o = 1; o < 64; o <<= 1) { const float xa = shfl_lane(ia, (L - o) & 63), xb = shfl_lane(ib, (L - o) & 63); if (L >= o) { ia += xa; ib += xb; } }
    const float totb = shfl_lane(ib, 63);
    const float ea = ia - sa, eb = ib - sb;
    tab[2 * L] = A0 * (ea + a0); tab[2 * L + 1] = A0 * (ea + a0 + a1);
    tab[128 + 2 * L] = A1 * (totb - eb); tab[128 + 2 * L + 1] = A1 * (totb - eb - b0);
    tab[256 + 2 * L] = a0; tab[256 + 2 * L + 1] = a1; tab[384 + 2 * L] = b0; tab[384 + 2 * L + 1] = b1;
}
__device__ __forceinline__ void p_ssd_states(const Frame& F0, const bf16* XT, const bf16* BMt, const float* DT, const float* alog, bf16* ST, float* DEC) {
    const Frame F = phase_frame(F0);
    LAS unsigned char* img = F.lds; LAS float* tab = (LAS float*)(F.lds + 36864 + F.wave * 2048);
    const int L = F.lane, h = L >> 5, l31 = L & 31, q = (L & 15) >> 2, p4 = L & 3, blk = (L >> 4) & 1;
    for (int it = blockIdx.x; it < 64 * 8; it += F.G) {
        const int c = it >> 3, g = it & 7, head = g * 8 + F.wave, t0 = c * 128;
        stage_img(F, BMt + (size_t)t0 * 1024 + g * 128, 1024, img);
        const float A0 = -__expf(alog[head]), A1 = -__expf(alog[64 + head]);
        ssd_tables(F, DT, t0, head, A0, A1, tab);
        __syncthreads();
        const float afe = tab[127], ab0 = tab[128];
        if (L == 0) { DEC[(c * 2 + 0) * 64 + head] = __expf(afe); DEC[(c * 2 + 1) * 64 + head] = __expf(ab0); }
        const bf16* xt = XT + (size_t)(c * 64 + head) * 64 * 128;
#pragma unroll 1
        for (int dir = 0; dir < 2; ++dir) {
            f32x16 acc[4][2];
#pragma unroll
            for (int a = 0; a < 4; ++a)
#pragma unroll
                for (int b = 0; b < 2; ++b)
#pragma unroll
                    for (int r = 0; r < 16; ++r) acc[a][b][r] = 0.f;
            const float eref = dir ? ab0 : afe;
#pragma unroll 2
            for (int ks = 0; ks < 8; ++ks) {
                const int s0 = 16 * ks + 8 * h;
                float w[8];
#pragma unroll
                for (int j = 0; j < 8; ++j) w[j] = __expf(eref - tab[dir * 128 + s0 + j]) * tab[256 + dir * 128 + s0 + j];
                bf16x8 bfr[2];
#pragma unroll
                for (int pt = 0; pt < 2; ++pt) bfr[pt] = scale8(*(const bf16x8*)(xt + (size_t)(32 * pt + l31) * 128 + s0), w);
#pragma unroll
                for (int nt = 0; nt < 4; ++nt) {
                    const LAS unsigned char* ad = img + (16 * ks + 8 * h + q) * PB + (32 * nt + 16 * blk + 4 * p4) * 2;
                    const bf16x8 afr = cat8(tr_read(ad), tr_read(ad + 4 * PB));
#pragma unroll
                    for (int pt = 0; pt < 2; ++pt) acc[nt][pt] = __builtin_amdgcn_mfma_f32_32x32x16_bf16(afr, bfr[pt], acc[nt][pt], 0, 0, 0);
                }
            }
            bf16* st = ST + ((size_t)(c * 2 + dir) * 64 + head) * 8192;
#pragma unroll
            for (int nt = 0; nt < 4; ++nt)
#pragma unroll
                for (int pt = 0; pt < 2; ++pt)
#pragma unroll
                    for (int qd = 0; qd < 4; ++qd) { u32x2 w2; w2.x = pk2(acc[nt][pt][4 * qd], acc[nt][pt][4 * qd + 1]); w2.y = pk2(acc[nt][pt][4 * qd + 2], acc[nt][pt][4 * qd + 3]);
                        *(u32x2*)(st + (size_t)(32 * pt + l31) * 128 + 32 * nt + 8 * qd + 4 * h) = w2; }
        }
        __syncthreads();
    }
}
__device__ __forceinline__ void p_ssd_rec(const Frame& F0, bf16* ST, const float* __restrict__ DEC, int L) {
    const Frame F = phase_frame(F0);
    const int nck = L / 128, nseq = TG / L, total = nseq * 131072;
    for (int e = F.gw * 64 + F.lane; e < total; e += F.ngw * 64) {
        const int oct = e & 1023, head = (e >> 10) & 63, dir = (e >> 16) & 1, sq = e >> 17;
        float hst[8];
#pragma unroll
        for (int j = 0; j < 8; ++j) hst[j] = 0.f;
        for (int k0 = 0; k0 < nck; k0 += 8) {
            u32x4 v[8]; float dec[8];
#pragma unroll
            for (int j = 0; j < 8; ++j) { const int k = k0 + j, c = sq * nck + (dir ? nck - 1 - k : k);
                v[j] = *(const u32x4*)(ST + ((size_t)(c * 2 + dir) * 64 + head) * 8192 + oct * 8); dec[j] = DEC[(c * 2 + dir) * 64 + head]; }
#pragma unroll
            for (int j = 0; j < 8; ++j) { const int k = k0 + j, c = sq * nck + (dir ? nck - 1 - k : k);
                u32x4 o; o.x = pk2(hst[0], hst[1]); o.y = pk2(hst[2], hst[3]); o.z = pk2(hst[4], hst[5]); o.w = pk2(hst[6], hst[7]);
                *(u32x4*)(ST + ((size_t)(c * 2 + dir) * 64 + head) * 8192 + oct * 8) = o;
                const float dc = dec[j]; const u32x4 x = v[j];
                hst[0] = hst[0] * dc + bflo(x.x); hst[1] = hst[1] * dc + bfhi(x.x); hst[2] = hst[2] * dc + bflo(x.y); hst[3] = hst[3] * dc + bfhi(x.y);
                hst[4] = hst[4] * dc + bflo(x.z); hst[5] = hst[5] * dc + bfhi(x.z); hst[6] = hst[6] * dc + bflo(x.w); hst[7] = hst[7] * dc + bfhi(x.w); }
        }
    }
}
__device__ __forceinline__ void p_ssd_out(const Frame& F0, const bf16* XT, const bf16* BMt, const bf16* CMt, const float* DT, const float* alog, const float* dskip, const bf16* ST,
                                          const bf16* ZS, const float* ng, bf16* Y) {
    const Frame F = phase_frame(F0);
    LAS unsigned char* imgB = F.lds; LAS unsigned char* imgC = F.lds + 34816; LAS float* tab = (LAS float*)(F.lds + 69632 + F.wave * 2048); LAS float* part = (LAS float*)(F.lds + 69632 + 16384);
    const int L0 = F.lane;
    for (int it = blockIdx.x; it < 64 * 8; it += F.G) {
        const int c = it >> 3, g = it & 7, head = g * 8 + F.wave, t0 = c * 128;
        stage_img(F, BMt + (size_t)t0 * 1024 + g * 128, 1024, imgB);
        stage_img(F, CMt + (size_t)t0 * 1024 + g * 128, 1024, imgC);
        const float A0 = -__expf(alog[head]), A1 = -__expf(alog[64 + head]), dsk = dskip[head];
        ssd_tables(F, DT, t0, head, A0, A1, tab);
        __syncthreads();
        const bf16* xt = XT + (size_t)(c * 64 + head) * 64 * 128;
#pragma unroll 1
        for (int half = 0; half < 2; ++half) {
            f32x16 acc[2][2];
#pragma unroll
            for (int a = 0; a < 2; ++a)
#pragma unroll
                for (int b = 0; b < 2; ++b)
#pragma unroll
                    for (int r = 0; r < 16; ++r) acc[a][b][r] = 0.f;
            { int L = L0; asm volatile("" : "+v"(L)); const int h = L >> 5, l31 = L & 31;
#pragma unroll 1
            for (int st = 0; st < 4; ++st) {
                bf16x8 xa[2][2];
#pragma unroll
                for (int ks = 0; ks < 2; ++ks)
#pragma unroll
                    for (int pt = 0; pt < 2; ++pt) { const bf16* xp = xt + (size_t)(32 * pt + l31) * 128 + 32 * st + 16 * ks + 4 * h;
                        const s16x4 lo = *(const s16x4*)xp, hi = *(const s16x4*)(xp + 8); xa[ks][pt] = cat8(lo, hi); }
#pragma unroll
                for (int tt = 0; tt < 2; ++tt) {
                    const int tg = 2 * half + tt;
                    f32x16 dg;
#pragma unroll
                    for (int r = 0; r < 16; ++r) dg[r] = 0.f;
#pragma unroll 2
                    for (int kn = 0; kn < 8; ++kn) { const bf16x8 a = *(const LAS bf16x8*)(imgB + (32 * st + l31) * PB + (16 * kn + 8 * h) * 2), b = *(const LAS bf16x8*)(imgC + (32 * tg + l31) * PB + (16 * kn + 8 * h) * 2);
                        dg = __builtin_amdgcn_mfma_f32_32x32x16_bf16(a, b, dg, 0, 0, 0); }
                    const int t = 32 * tg + l31; const float aft = tab[t], abt = tab[128 + t];
                    float v[16];
#pragma unroll
                    for (int qd = 0; qd < 4; ++qd) { const int sb = 32 * st + 8 * qd + 4 * h;
                        const f32x4 afs = *(const LAS f32x4*)(tab + sb), abs_ = *(const LAS f32x4*)(tab + 128 + sb), d0 = *(const LAS f32x4*)(tab + 256 + sb), d1 = *(const LAS f32x4*)(tab + 384 + sb);
#pragma unroll
                        for (int e = 0; e < 4; ++e) { const int s = sb + e; float m = 0.f;
                            if (s <= t) m += __expf(aft - afs[e]) * d0[e];
                            if (s >= t) m += __expf(abt - abs_[e]) * d1[e];
                            float x = dg[4 * qd + e] * m; if (s == t) x += dsk; v[4 * qd + e] = x; } }
                    bf16x8 gf[2];
#pragma unroll
                    for (int ks = 0; ks < 2; ++ks) { u32x4 o; o.x = pk2(v[8 * ks], v[8 * ks + 1]); o.y = pk2(v[8 * ks + 2], v[8 * ks + 3]); o.z = pk2(v[8 * ks + 4], v[8 * ks + 5]); o.w = pk2(v[8 * ks + 6], v[8 * ks + 7]); gf[ks] = __builtin_bit_cast(bf16x8, o); }
#pragma unroll
                    for (int pt = 0; pt < 2; ++pt)
#pragma unroll
                        for (int ks = 0; ks < 2; ++ks) acc[tt][pt] = __builtin_amdgcn_mfma_f32_32x32x16_bf16(xa[ks][pt], gf[ks], acc[tt][pt], 0, 0, 0);
                }
            }
            }
            { int L = L0; asm volatile("" : "+v"(L)); const int h = L >> 5, l31 = L & 31;
#pragma unroll 1
            for (int dir = 0; dir < 2; ++dir) {
                const bf16* hs = ST + ((size_t)(c * 2 + dir) * 64 + head) * 8192;
                float et[2];
#pragma unroll
                for (int tt = 0; tt < 2; ++tt) et[tt] = __expf(tab[dir * 128 + 32 * (2 * half + tt) + l31]);
#pragma unroll 2
                for (int kn = 0; kn < 8; ++kn) {
                    bf16x8 ha[2];
#pragma unroll
                    for (int pt = 0; pt < 2; ++pt) ha[pt] = *(const bf16x8*)(hs + (size_t)(32 * pt + l31) * 128 + 16 * kn + 8 * h);
#pragma unroll
                    for (int tt = 0; tt < 2; ++tt) { const bf16x8 cb = scale8s(*(const LAS bf16x8*)(imgC + (32 * (2 * half + tt) + l31) * PB + (16 * kn + 8 * h) * 2), et[tt]);
#pragma unroll
                        for (int pt = 0; pt < 2; ++pt) acc[tt][pt] = __builtin_amdgcn_mfma_f32_32x32x16_bf16(ha[pt], cb, acc[tt][pt], 0, 0, 0); }
                }
            }
            }
            { int L = L0; asm volatile("" : "+v"(L)); const int h = L >> 5, l31 = L & 31;
#pragma unroll
            for (int tt = 0; tt < 2; ++tt) { const size_t row = (size_t)(t0 + 32 * (2 * half + tt) + l31); float ssq = 0.f;
#pragma unroll
                for (int pt = 0; pt < 2; ++pt)
#pragma unroll
                    for (int qd = 0; qd < 4; ++qd) { const u32x2 z = *(const u32x2*)(ZS + row * SSD_DI + head * 64 + 32 * pt + 8 * qd + 4 * h);
                        const float y0 = acc[tt][pt][4 * qd] * bflo(z.x), y1 = acc[tt][pt][4 * qd + 1] * bfhi(z.x), y2 = acc[tt][pt][4 * qd + 2] * bflo(z.y), y3 = acc[tt][pt][4 * qd + 3] * bfhi(z.y);
                        acc[tt][pt][4 * qd] = y0; acc[tt][pt][4 * qd + 1] = y1; acc[tt][pt][4 * qd + 2] = y2; acc[tt][pt][4 * qd + 3] = y3; ssq += (y0 * y0 + y1 * y1) + (y2 * y2 + y3 * y3); }
                ssq += shfl_lane(ssq, L ^ 32);
                if (h == 0) part[F.wave * 64 + 32 * tt + l31] = ssq; }
            __syncthreads();
#pragma unroll
            for (int tt = 0; tt < 2; ++tt) { const int tl = 32 * tt + l31; const size_t row = (size_t)(t0 + 64 * half + tl); float tot = 0.f;
#pragma unroll
                for (int w = 0; w < 8; ++w) tot += part[w * 64 + tl];
                const float rstd = rsqrtf(tot * (1.0f / 512.0f) + LN_EPS);
#pragma unroll
                for (int pt = 0; pt < 2; ++pt)
#pragma unroll
                    for (int qd = 0; qd < 4; ++qd) { const int cc = head * 64 + 32 * pt + 8 * qd + 4 * h; const f32x4 gg = *(const f32x4*)(ng + cc);
                        u32x2 o; o.x = pk2(acc[tt][pt][4 * qd] * rstd * gg.x, acc[tt][pt][4 * qd + 1] * rstd * gg.y); o.y = pk2(acc[tt][pt][4 * qd + 2] * rstd * gg.z, acc[tt][pt][4 * qd + 3] * rstd * gg.w);
                        *(u32x2*)(Y + row * SSD_DI + cc) = o; } }
            }
            __syncthreads();
        }
    }
}

__device__ __forceinline__ void p_natt(const Frame& F0, const bf16* Q, const bf16* Kb, const bf16* V, const float* rpb, bf16* O, int L) {
    const Frame F = phase_frame(F0);
    LAS unsigned char* vimg = F.lds;
    LAS float* rp = (LAS float*)(F.lds + 4 * 64 * PB);
    const int Ln = F.lane, g = Ln >> 4, l15 = Ln & 15, q4 = l15 >> 2, p4 = Ln & 3;
    const int rps = L / 64, hh = F.wave >> 2, j = F.wave & 3;
    const int kstart = (j == 0) ? 0 : (j == 1 ? 8 : (j == 2 ? 24 : 32));
    for (int it = blockIdx.x; it < 128 * 8; it += F.G) {
        const int hp = it & 7, grow = it >> 3, sq = grow / rps, r = grow % rps;
        int rs = r - 4; rs = rs < 0 ? 0 : (rs > rps - 8 ? rps - 8 : rs);
        const int head = 2 * hp + hh;
        const size_t rowbase = (size_t)sq * rps * 64;
        for (int i = F.tid; i < 2 * 465; i += NTHR) { const int a = i / 465, b = i % 465; rp[a * 480 + b] = rpb[(size_t)(2 * hp + a) * 465 + b]; }
        u32x4 vreg[4];
#pragma unroll
        for (int i = 0; i < 4; ++i) { const int idx = F.tid + 512 * i, a = idx >> 10, key = (idx >> 4) & 63, ch = idx & 15;
            vreg[i] = *(const u32x4*)(V + (rowbase + (size_t)(rs + 0) * 64 + key) * D + (2 * hp + a) * 128 + ch * 8); }
#pragma unroll
        for (int i = 0; i < 4; ++i) { const int idx = F.tid + 512 * i, a = idx >> 10, key = (idx >> 4) & 63, ch = idx & 15; *(LAS u32x4*)(vimg + ((0 * 2 + a) * 64 + key) * PB + ch * 16) = vreg[i]; }
        const int qcol = 16 * j + l15;
        bf16x8 qf[4];
#pragma unroll
        for (int kd = 0; kd < 4; ++kd) qf[kd] = *(const bf16x8*)(Q + (rowbase + (size_t)r * 64 + qcol) * D + head * 128 + 32 * kd + 8 * g);
        __syncthreads();
        int wst = qcol - 8; wst = wst < 0 ? 0 : (wst > 48 ? 48 : wst);
        float sc[16][4]; float mx = -3.0e38f;
#pragma unroll
        for (int kt = 0; kt < 16; ++kt) { const int kr = kt >> 1, kc0 = kstart + 16 * (kt & 1);
            f32x4 a4 = {0.f, 0.f, 0.f, 0.f};
            const bf16* kp = Kb + (rowbase + (size_t)(rs + kr) * 64 + kc0 + l15) * D + head * 128 + 8 * g;
#pragma unroll
            for (int kd = 0; kd < 4; ++kd) { const bf16x8 kf = *(const bf16x8*)(kp + 32 * kd); a4 = __builtin_amdgcn_mfma_f32_16x16x32_bf16(kf, qf[kd], a4, 0, 0, 0); }
            const int dy = rs + kr - r + 7;
#pragma unroll
            for (int e = 0; e < 4; ++e) { const int kcol = kc0 + 4 * g + e; const bool ok = (kcol >= wst) && (kcol < wst + 16);
                int dx = kcol - qcol + 15; dx = dx < 0 ? 0 : (dx > 30 ? 30 : dx);
                const float s = ok ? a4[e] + rp[hh * 480 + dy * 31 + dx] : -3.0e38f; sc[kt][e] = s; mx = fmaxf(mx, s); } }
        mx = fmaxf(mx, shfl_lane(mx, Ln ^ 16)); mx = fmaxf(mx, shfl_lane(mx, Ln ^ 32));
        float lsum = 0.f;
#pragma unroll
        for (int kt = 0; kt < 16; ++kt)
#pragma unroll
            for (int e = 0; e < 4; ++e) { const float p = __expf(sc[kt][e] - mx); sc[kt][e] = p; lsum += p; }
        lsum += shfl_lane(lsum, Ln ^ 16); lsum += shfl_lane(lsum, Ln ^ 32);
        const float inv = 1.0f / lsum;
        f32x4 oacc[8];
#pragma unroll
        for (int dt = 0; dt < 8; ++dt) oacc[dt] = (f32x4){0.f, 0.f, 0.f, 0.f};
#pragma unroll
        for (int kk = 0; kk < 8; ++kk) {
            if (kk + 1 < 8) {
#pragma unroll
                for (int i = 0; i < 4; ++i) { const int idx = F.tid + 512 * i, a = idx >> 10, key = (idx >> 4) & 63, ch = idx & 15;
                    vreg[i] = *(const u32x4*)(V + (rowbase + (size_t)(rs + kk + 1) * 64 + key) * D + (2 * hp + a) * 128 + ch * 8); } }
            u32x4 pw; pw.x = pk2(sc[2 * kk][0], sc[2 * kk][1]); pw.y = pk2(sc[2 * kk][2], sc[2 * kk][3]); pw.z = pk2(sc[2 * kk + 1][0], sc[2 * kk + 1][1]); pw.w = pk2(sc[2 * kk + 1][2], sc[2 * kk + 1][3]);
            const bf16x8 pf = __builtin_bit_cast(bf16x8, pw);
            const LAS unsigned char* vb = vimg + (((kk & 1) * 2 + hh) * 64) * PB;
#pragma unroll
            for (int dt = 0; dt < 8; ++dt) { const LAS unsigned char* ad = vb + (kstart + 4 * g + q4) * PB + (16 * dt + 4 * p4) * 2;
                const bf16x8 vf = cat8(tr_read(ad), tr_read(ad + 16 * PB));
                oacc[dt] = __builtin_amdgcn_mfma_f32_16x16x32_bf16(vf, pf, oacc[dt], 0, 0, 0); }
            if (kk + 1 < 8) {
#pragma unroll
                for (int i = 0; i < 4; ++i) { const int idx = F.tid + 512 * i, a = idx >> 10, key = (idx >> 4) & 63, ch = idx & 15; *(LAS u32x4*)(vimg + ((((kk + 1) & 1) * 2 + a) * 64 + key) * PB + ch * 16) = vreg[i]; }
            }
            __syncthreads();
        }
        bf16* op = O + (rowbase + (size_t)r * 64 + qcol) * D + head * 128 + 4 * g;
#pragma unroll
        for (int dt = 0; dt < 8; ++dt) { u32x2 o; o.x = pk2(oacc[dt][0] * inv, oacc[dt][1] * inv); o.y = pk2(oacc[dt][2] * inv, oacc[dt][3] * inv); *(u32x2*)(op + 16 * dt) = o; }
    }
}

struct Args { const float* in[29]; float* out; unsigned char* ws; int g_lo, g_hi, l_lo, l_hi, ph, pad; };

__global__ void __launch_bounds__(NTHR, 2) enc_fwd(Args args) {
    extern __shared__ __attribute__((aligned(16))) unsigned char lds[];
    Frame F;
    F.lds = (LAS unsigned char*)lds;
    F.tid = threadIdx.x; F.lane = F.tid & 63; F.wave = __builtin_amdgcn_readfirstlane(F.tid >> 6);
    F.G = gridDim.x; F.gw = blockIdx.x * NWAVES + F.wave; F.ngw = F.G * NWAVES;
    unsigned char* ws = args.ws;
    gu32* ctl = (gu32*)(ws + WS_CTL);
    for (int u = F.tid; u < (LDS_BYTES - LDSCTL_OFF) / 4; u += NTHR) ((LAS unsigned*)(F.lds + LDSCTL_OFF))[u] = 0u;
    __syncthreads();
    const int ph = args.ph;
    XcdBarrier bar; bar.bar = (unsigned*)(ctl + CW_BAR); bar.x = 0; bar.st = nullptr;
    if (ph < 0) bar = xcd_barrier_post((unsigned*)(ctl + CW_BAR), (volatile LAS unsigned*)(F.lds + MISC_OFF) + 8);
#define RUN(k) (ph < 0 || ph == (k))
#ifndef PROBE_MASK
#define PROBE_MASK 0
#endif
#define NREP(bit) (((PROBE_MASK >> (bit)) & 1) ? 2 : 1)
#define REPEAT(bit) _Pragma("unroll 1") for (int rep = 0; rep < NREP(bit); ++rep)
    float* XDUM = (float*)(ws + WS_SCR + S_DUM); bf16* XBDUM = (bf16*)(ws + WS_SCR + S_DUM + 64 * MiB);
#define GRID_BAR() do { if (ph < 0) xcd_barrier(bar); } while (0)

    bf16* Wb = (bf16*)(ws + WS_W);
    unsigned char* scr = ws + WS_SCR;
    bf16* XB = (bf16*)(scr + S_XB); bf16* YB = (bf16*)(scr + S_YB); bf16* HB = (bf16*)(scr + S_HID);
    LAS unsigned char* ring = F.lds;

    if (RUN(0) && args.g_lo == 0 && args.l_lo == 0) { p_prologue(F, args.in, Wb, (float*)(ws + WS_SPT), (bf16*)(scr + S_XB0)); GRID_BAR(); }

    for (int grp = args.g_lo; grp < args.g_hi; ++grp) {
        float* X = args.out + (size_t)grp * TG * D;
        const int L = grp < 2 ? 2048 : 8192;
        const float* Xin0 = grp < 2 ? args.in[0] + (size_t)grp * TG * D : args.in[1] + (size_t)(grp - 2) * TG * D;
        const bf16* XB0g = (const bf16*)(scr + S_XB0) + (size_t)grp * TG * D;
        for (int layer = args.l_lo; layer < args.l_hi; ++layer) {
            const int kind = layer % 3, jl = layer / 3;
            int Kout = 2048; const bf16* Wout; const bf16* XA = layer == 0 ? XB0g : XB;
            if (kind == 0) {
                bf16* GATE = (bf16*)(scr + S_RG_GATE); bf16* URAW = (bf16*)(scr + S_RG_URAW); bf16* U = (bf16*)(scr + S_RG_U); bf16* LA = (bf16*)(scr + S_RG_LA); bf16* INP = (bf16*)(scr + S_RG_INP);
                float* HEND = (float*)(scr + S_RG_HEND); float* PROD = (float*)(scr + S_RG_PROD); float* HIN = (float*)(scr + S_RG_HIN);
                if (RUN(10)) REPEAT(1) { pg8::Gemm g{XA, Wb + W_RGIN + (size_t)jl * 4096 * 2048, 2048, 2048, 2048, 0}; pg8::StaticOrder S; S.init(TG, 4096, F.G, (int)blockIdx.x);
                    pg8::EpiRgIn E{GATE, URAW}; pg8::gemm_phase<pg8::EpiRgIn>(ring, g, S, E); GRID_BAR(); }
                if (RUN(11)) REPEAT(3) { p_conv<0>(F, URAW, 2048, L, args.in[3] + (size_t)jl * 4 * 2048, args.in[4] + (size_t)jl * 2048, U, nullptr, nullptr); GRID_BAR(); }
                if (RUN(12)) REPEAT(1) { pg8::Gemm g{U, Wb + W_RGGATE + (size_t)jl * 32 * 65536, 2048, 256, 256, 1}; pg8::StaticOrder S; S.init(TG, 32 * 256, F.G, (int)blockIdx.x);
                    pg8::EpiRgGates E{U, LA, INP, args.in[6] + (size_t)jl * 2 * 2048, args.in[8] + (size_t)jl * 2 * 2048, (const float*)(ws + WS_SPT) + (size_t)jl * 2 * 2048};
                    pg8::gemm_phase<pg8::EpiRgGates>(ring, g, S, E); GRID_BAR(); }
                if (RUN(13)) REPEAT(3) { p_rg_scan_a(F, LA, INP, HEND, PROD); GRID_BAR(); }
                if (RUN(14)) REPEAT(3) { p_rg_scan_b(F, HEND, PROD, HIN, L); GRID_BAR(); }
                if (RUN(15)) REPEAT(3) { p_rg_scan_c(F, LA, INP, HIN, GATE, YB); GRID_BAR(); }
                Wout = Wb + W_RGOUT + (size_t)jl * 2048 * 2048;
            } else if (kind == 1) {
                bf16* ZS = (bf16*)(scr + S_SSD_ZS); bf16* XBCR = (bf16*)(scr + S_SSD_XBCR); bf16* XT = (bf16*)(scr + S_SSD_XT); bf16* BMt = (bf16*)(scr + S_SSD_BM); bf16* CMt = (bf16*)(scr + S_SSD_CM);
                float* DT = (float*)(scr + S_SSD_DT); float* DEC = (float*)(scr + S_SSD_DEC); bf16* ST = (bf16*)(scr + S_SSD_ST);
                if (RUN(20)) REPEAT(1) { pg8::Gemm g{XA, Wb + W_SSDIN, 2048, 2048, 2048, 0}; pg8::StaticOrder S; S.init(TG, SSD_NIN_PAD, F.G, (int)blockIdx.x);
                    pg8::EpiSsdIn E{ZS, XBCR, DT, args.in[14]}; pg8::gemm_phase<pg8::EpiSsdIn>(ring, g, S, E); GRID_BAR(); }
                if (RUN(21)) REPEAT(4) { p_conv<1>(F, XBCR, SSD_XBC, L, args.in[12], args.in[13], XT, BMt, CMt); GRID_BAR(); }
                if (RUN(22)) REPEAT(4) { p_ssd_states(F, XT, BMt, DT, args.in[15], ST, DEC); GRID_BAR(); }
                if (RUN(23)) { p_ssd_rec(F, ST, DEC, L); GRID_BAR(); }
                if (RUN(24)) REPEAT(4) { p_ssd_out(F, XT, BMt, CMt, DT, args.in[15], args.in[16], ST, ZS, args.in[17], YB); GRID_BAR(); }
                Wout = Wb + W_SSDOUT; Kout = 4096;
            } else {
                bf16* Qb = (bf16*)(scr + S_NA_Q); bf16* Kb = (bf16*)(scr + S_NA_K); bf16* Vb = (bf16*)(scr + S_NA_V);
                if (RUN(30)) REPEAT(1) { pg8::Gemm g{XA, Wb + W_NAQKV, 2048, 2048, 2048, 0}; pg8::StaticOrder S; S.init(TG, 6144, F.G, (int)blockIdx.x);
                    pg8::EpiQkv E{Qb, args.in[20]}; pg8::gemm_phase<pg8::EpiQkv>(ring, g, S, E); GRID_BAR(); }
                if (RUN(31)) REPEAT(5) { p_natt(F, Qb, Kb, Vb, args.in[21], YB, L); GRID_BAR(); }
                Wout = Wb + W_NAOUT;
            }
            unsigned long long* xslot = (unsigned long long*)(ws + WS_XSLOT); unsigned* pcnt = (unsigned*)(ctl + CW_SEAM); unsigned* ptmo = (unsigned*)(ctl + CW_TMO);
            const unsigned ep = (unsigned)((grp * DEPTH + layer) * 2);
            if (RUN(40)) { pg8::Gemm g{YB, Wout, Kout, Kout, Kout, 0}; pg8::StaticOrder S; S.init(TG, D, F.G, (int)blockIdx.x);
                pg8::EpiResidLn E{layer == 0 ? Xin0 : X, X, XB, args.in[25] + (size_t)layer * D, args.in[26] + (size_t)layer * D, ALPHA, xslot, pcnt, 64u * (ep + 1u), ptmo};
                pg8::gemm_phase<pg8::EpiResidLn>(ring, g, S, E); GRID_BAR(); }
            if (RUN(42)) REPEAT(6) { pg8::Gemm g{XB, Wb + W_UP + (size_t)layer * 8192 * 2048, 2048, 2048, 2048, 0}; pg8::StaticOrder S; S.init(TG, HID, F.G, (int)blockIdx.x);
                pg8::EpiRelu2 E{HB, HID}; pg8::gemm_phase<pg8::EpiRelu2>(ring, g, S, E); GRID_BAR(); }
            if (RUN(43)) { pg8::Gemm g{HB, Wb + W_DOWN + (size_t)layer * 2048 * 8192, 8192, 8192, 8192, 0}; pg8::StaticOrder S; S.init(TG, D, F.G, (int)blockIdx.x);
                pg8::EpiResidLn E{X, X, XB, args.in[27] + (size_t)layer * D, args.in[28] + (size_t)layer * D, ALPHA, xslot, pcnt, 64u * (ep + 2u), ptmo};
                pg8::gemm_phase<pg8::EpiResidLn>(ring, g, S, E); GRID_BAR(); }
        }
    }
#undef RUN
#undef GRID_BAR
}

extern "C" void kernel_launch(void* const* d_in, const int* in_sizes, int n_in, void* d_out, int out_size, void* d_ws, size_t ws_size, hipStream_t stream) {
    static int grid = 0;
    if (grid == 0) {
        if (n_in != 29 || out_size != NGROUP * TG * D || ws_size < WS_NEED) { fprintf(stderr, "kernel_launch: unexpected problem (n_in %d, out %d, ws %zu, need %zu)\n", n_in, out_size, ws_size, (size_t)WS_NEED); grid = -1; return; }
        int dev = 0, cus = 0, per_cu = 0;
        if (hipGetDevice(&dev) != hipSuccess || hipDeviceGetAttribute(&cus, hipDeviceAttributeMultiprocessorCount, dev) != hipSuccess) { grid = -1; return; }
        if (hipFuncSetAttribute((const void*)enc_fwd, hipFuncAttributeMaxDynamicSharedMemorySize, LDS_BYTES) != hipSuccess) { fprintf(stderr, "kernel_launch: hipFuncSetAttribute failed\n"); grid = -1; return; }
        if (hipOccupancyMaxActiveBlocksPerMultiprocessor(&per_cu, (const void*)enc_fwd, NTHR, LDS_BYTES) != hipSuccess || per_cu < 1) { fprintf(stderr, "kernel_launch: occupancy query says %d\n", per_cu); }
        (void)hipGetLastError();
        grid = cus;
        if (grid != 256) { fprintf(stderr, "kernel_launch: built for 256 CUs (one 256x256 tile per workgroup in the fused LayerNorm phases), got %d\n", cus); grid = -1; return; }
    }
    if (grid < 0) return;
    (void)hipMemsetAsync((char*)d_ws + WS_CTL, 0, CTL_ZERO_BYTES, stream);
    Args a{};
    for (int i = 0; i < 29; ++i) a.in[i] = (const float*)d_in[i];
    a.out = (float*)d_out; a.ws = (unsigned char*)d_ws; a.pad = 0;
#if MK_N_LAUNCHES == 1
    a.g_lo = 0; a.g_hi = NGROUP; a.l_lo = 0; a.l_hi = DEPTH; a.ph = -1;
    hipLaunchKernelGGL(enc_fwd, dim3(grid), dim3(NTHR), LDS_BYTES, stream, a);
#else
    auto launch = [&](int g, int l, int ph) { a.g_lo = g; a.g_hi = g + 1; a.l_lo = l; a.l_hi = l + 1; a.ph = ph; hipLaunchKernelGGL(enc_fwd, dim3(grid), dim3(NTHR), LDS_BYTES, stream, a); };
    launch(0, 0, 0);
    for (int g = 0; g < NGROUP; ++g) {
        for (int l = 0; l < DEPTH; ++l) {
            const int kind = l % 3;
            if (kind == 0) for (int p = 10; p <= 15; ++p) launch(g, l, p);
            else if (kind == 1) for (int p = 20; p <= 24; ++p) launch(g, l, p);
            else for (int p = 30; p <= 31; ++p) launch(g, l, p);
            launch(g, l, 40); launch(g, l, 42); launch(g, l, 43);
        }
    }
#endif
}
```

```cpp
#include <hip/hip_runtime.h>
#include <cstdio>
#include <cstdint>

#ifndef MK_N_LAUNCHES
#define MK_N_LAUNCHES 1
#endif
#ifndef MK_CHECK
#define MK_CHECK 0
#endif

#define LAS __attribute__((address_space(3)))
#define GAS __attribute__((address_space(1)))
typedef unsigned short bf16;
typedef short bf16x8 __attribute__((ext_vector_type(8)));
typedef short s16x4 __attribute__((ext_vector_type(4)));
typedef float f32x2 __attribute__((ext_vector_type(2)));
typedef float f32x4 __attribute__((ext_vector_type(4)));
typedef float f32x16 __attribute__((ext_vector_type(16)));
typedef unsigned u32x2 __attribute__((ext_vector_type(2)));
typedef unsigned u32x4 __attribute__((ext_vector_type(4)));
typedef __bf16 bf16x2_t __attribute__((ext_vector_type(2)));
typedef short v4i16_t __attribute__((ext_vector_type(4)));
typedef GAS unsigned gu32;

constexpr int D = 2048, TG = 8192, NGROUP = 6, DEPTH = 4, NWAVES = 8, NTHR = 512;
constexpr int HID = 8192;
constexpr int SSD_DI = 4096, SSD_NH = 64, SSD_NG = 8, SSD_NS = 128, SSD_CH = 128, SSD_XBC = 6144, SSD_NIN = 10368, SSD_NIN_PAD = 10496;
constexpr int NA_H = 16, NA_HD = 128;
constexpr float ALPHA = 1.681792830507429f, LN_EPS = 1e-5f;

constexpr size_t MiB = 1u << 20;
constexpr size_t WS_CTL = 0, CTL_ZERO_BYTES = 256 * 1024;
constexpr size_t WS_XSLOT = 1 * MiB;
constexpr size_t WS_W = 2 * MiB;
constexpr size_t W_RGIN = 0;
constexpr size_t W_RGGATE = W_RGIN + 2ull * 4096 * 2048;
constexpr size_t W_RGOUT = W_RGGATE + 2ull * 32 * 256 * 256;
constexpr size_t W_SSDIN = W_RGOUT + 2ull * 2048 * 2048;
constexpr size_t W_SSDOUT = W_SSDIN + (size_t)SSD_NIN_PAD * 2048;
constexpr size_t W_NAQKV = W_SSDOUT + 2048ull * 4096;
constexpr size_t W_NAOUT = W_NAQKV + 6144ull * 2048;
constexpr size_t W_UP = W_NAOUT + 2048ull * 2048;
constexpr size_t W_DOWN = W_UP + 4ull * 8192 * 2048;
constexpr size_t W_END = W_DOWN + 4ull * 8192 * 2048;
constexpr size_t WS_SCR = ((WS_W + W_END * 2 + MiB - 1) / MiB) * MiB;
constexpr size_t S_XB = 0;
constexpr size_t S_YB = 32 * MiB;
constexpr size_t S_MIX = 96 * MiB;
constexpr size_t S_HID = S_MIX;
constexpr size_t S_RG_GATE = S_MIX, S_RG_URAW = S_MIX + 32 * MiB, S_RG_U = S_MIX + 64 * MiB, S_RG_LA = S_MIX + 96 * MiB  , S_RG_INP = S_MIX + 160 * MiB  ;
constexpr size_t S_RG_HEND = S_MIX + 224 * MiB, S_RG_PROD = S_MIX + 226 * MiB, S_RG_HIN = S_MIX + 228 * MiB;
constexpr size_t S_SSD_ZS = S_MIX, S_SSD_XBCR = S_MIX + 64 * MiB, S_SSD_XT = S_MIX + 160 * MiB, S_SSD_BM = S_MIX + 224 * MiB, S_SSD_CM = S_MIX + 240 * MiB;
constexpr size_t S_SSD_DT = S_MIX + 256 * MiB, S_SSD_DEC = S_MIX + 260 * MiB, S_SSD_ST = S_MIX + 261 * MiB;
constexpr size_t S_NA_Q = S_MIX, S_NA_K = S_MIX + 32 * MiB, S_NA_V = S_MIX + 64 * MiB;
constexpr size_t S_END = S_MIX + 389 * MiB;
constexpr size_t S_XB0 = S_END;
constexpr size_t S_DUM = S_XB0 + 192 * MiB;
#ifndef PROBE_MASK
#define PROBE_MASK 0
#endif
constexpr size_t WS_NEED = WS_SCR + S_DUM + (PROBE_MASK ? 96 * MiB : 0);

constexpr int CW_BAR = 4096;
constexpr int CW_SEAM = 16384;
constexpr int CW_TMO = 0;
constexpr int CW_CHK = 1024;
constexpr size_t WS_SPT = 512 * 1024;

constexpr int RING_BYTES = 131072;
constexpr int LDSCTL_OFF = RING_BYTES, MISC_OFF = LDSCTL_OFF + 320;
constexpr int LDS_BYTES = 147456;

#define RLX_AGENT __ATOMIC_RELAXED, __HIP_MEMORY_SCOPE_AGENT
#define LDS_WAIT() asm volatile("s_waitcnt lgkmcnt(0)" ::: "memory")
#define VM_WAIT() asm volatile("s_waitcnt vmcnt(0)" ::: "memory")
__device__ __forceinline__ unsigned pk2(float lo, float hi) { f32x2 v = {lo, hi}; bf16x2_t b = __builtin_convertvector(v, bf16x2_t); return __builtin_bit_cast(unsigned, b); }
__device__ __forceinline__ float bflo(unsigned w) { return __uint_as_float(w << 16); }
__device__ __forceinline__ float bfhi(unsigned w) { return __uint_as_float(w & 0xffff0000u); }
__device__ __forceinline__ float bf2f(bf16 b) { return __uint_as_float(((unsigned)b) << 16); }
__device__ __forceinline__ float frcp_(float x) { return __builtin_amdgcn_rcpf(x); }
__device__ __forceinline__ float fsqrt_(float x) { return __builtin_amdgcn_sqrtf(x); }
__device__ __forceinline__ float sigmoidf_(float x) { return frcp_(1.0f + __expf(-x)); }
__device__ __forceinline__ float siluf_(float x) { return x * frcp_(1.0f + __expf(-x)); }
__device__ __forceinline__ float gelu_tanh_(float v) { const float u = 1.5957691216057308f * (v + 0.044715f * v * v * v); return v * frcp_(1.0f + __expf(-u)); }
__device__ __forceinline__ float softplusf_(float v) { return v > 20.f ? v : log1pf(__expf(v)); }
__device__ __forceinline__ float shfl_lane(float v, int srclane) { return __int_as_float(__builtin_amdgcn_ds_bpermute(srclane << 2, __float_as_int(v))); }
__device__ __forceinline__ float wave_sum(float v, int lane) {
#pragma unroll
    for (int o = 1; o < 64; o <<= 1) v += shfl_lane(v, lane ^ o);
    return v;
}

#define XB_TMO      128
#define XB_XCNT(j)  (256  + 64 * (j))
#define XB_XSUB(j)  (1280 + 64 * (j))
#define XB_XGEN(j)  (2304 + 64 * (j))
#define XB_TOP      3328
#define XB_TOPGEN   3392
#define XCD_BAR_WORDS 3456
#define XB_SPIN_CAP (1u << 22)

__device__ __forceinline__ unsigned xb_ld(unsigned* p)              { return __hip_atomic_load(p, __ATOMIC_RELAXED, __HIP_MEMORY_SCOPE_AGENT); }
__device__ __forceinline__ unsigned xb_add(unsigned* p, unsigned v) { return __hip_atomic_fetch_add(p, v, __ATOMIC_RELAXED, __HIP_MEMORY_SCOPE_AGENT); }
__device__ __forceinline__ unsigned xb_xcc_id() { return (unsigned)__builtin_amdgcn_s_getreg((3 << 11) | 20) & 0xFu; }
#define XB_SPIN(cond, bar) do { unsigned _sp = 0; while (cond) { __builtin_amdgcn_s_sleep(1); \
    if ((++_sp & 255u) == 0u) { if (xb_ld(&(bar)[XB_TMO])) break; if (_sp > XB_SPIN_CAP) { atomicAdd(&(bar)[XB_TMO], 1u); break; } } } } while (0)

struct XcdBarrier { unsigned* bar; unsigned x; volatile LAS unsigned* st; };

__device__ __forceinline__ XcdBarrier xcd_barrier_post(unsigned* bar, volatile LAS unsigned* st) {
    XcdBarrier b; b.bar = bar; b.x = xb_xcc_id(); b.st = st;
    if (threadIdx.x == 0) (void)xb_add(&bar[XB_XCNT(b.x)], 1u);
    return b;
}
__device__ __forceinline__ void xcd_barrier_complete(unsigned* bar, unsigned x, unsigned& nloc, unsigned& nx) {
    const unsigned G = gridDim.x * gridDim.y * gridDim.z;
    unsigned sum, cnt, mine, sp = 0u;
    for (;;) {
        sum = 0u; cnt = 0u; mine = 0u;
#pragma unroll
        for (unsigned j = 0; j < 16; ++j) { const unsigned c = xb_ld(&bar[XB_XCNT(j)]); sum += c; cnt += (c > 0u) ? 1u : 0u; mine = (j == x) ? c : mine; }
        if (sum == G) break;
        __builtin_amdgcn_s_sleep(1);
        if ((++sp & 255u) == 0u) { if (xb_ld(&bar[XB_TMO])) break; if (sp > XB_SPIN_CAP) { atomicAdd(&bar[XB_TMO], 1u); break; } }
    }
    nloc = mine > 0u ? mine : 1u; nx = cnt > 0u ? cnt : 1u;
}
__device__ __forceinline__ void xcd_barrier(const XcdBarrier& b) {
    asm volatile("s_waitcnt vmcnt(0)" ::: "memory");
    __syncthreads();
    if (threadIdx.x == 0) {
        unsigned* bar = b.bar;
        __builtin_amdgcn_s_waitcnt(0);
        unsigned nloc = b.st[0], nx = b.st[1];
        if (nloc == 0u) { xcd_barrier_complete(bar, b.x, nloc, nx); b.st[0] = nloc; b.st[1] = nx; }
        const unsigned old = xb_add(&bar[XB_XSUB(b.x)], 1u);
        const unsigned gen = old / nloc;
        if (old + 1u == (gen + 1u) * nloc) {
            __builtin_amdgcn_fence(__ATOMIC_RELEASE, "agent");
            asm volatile("s_waitcnt vmcnt(0)" ::: "memory");
            const unsigned og = xb_add(&bar[XB_TOP], 1u);
            const unsigned tg = og / nx;
            if (og + 1u == (tg + 1u) * nx) xb_add(&bar[XB_TOPGEN], 1u);
            else XB_SPIN(xb_ld(&bar[XB_TOPGEN]) == tg, bar);
            __builtin_amdgcn_fence(__ATOMIC_ACQUIRE, "agent");
            xb_add(&bar[XB_XGEN(b.x)], 1u);
            asm volatile("s_waitcnt vmcnt(0)" ::: "memory");
        } else {
            XB_SPIN(xb_ld(&bar[XB_XGEN(b.x)]) == gen, bar);
            __builtin_amdgcn_fence(__ATOMIC_ACQUIRE, "agent");
            asm volatile("s_waitcnt vmcnt(0)" ::: "memory");
        }
    }
    __syncthreads();
}

namespace pg8 {
constexpr int BM = 256, BK = 64, HALF = 128, HTB = HALF * BK * 2, STAGE_BYTES = 8 * HTB, NXCD = 8, WGM = 8;
__host__ __device__ __forceinline__ int lds_byte(int r, int c) { const int st = (r >> 4) * 2 + (c >> 5), rr = r & 15, cc = c & 31, ob = rr * 64 + cc * 2; return st * 1024 + (ob ^ (((ob >> 9) & 1) << 5)); }
__host__ __device__ __forceinline__ void stage_rc(int b, int& R, int& C) { const int st = b / 1024, sb = b % 1024, swz = sb ^ (((sb >> 9) & 1) << 5); R = (st >> 1) * 16 + swz / 64; C = (st & 1) * 32 + (swz % 64) / 2; }
__host__ __device__ __forceinline__ int perm32(int rho) { const int n = rho >> 4, i = rho & 15; return 8 * (i >> 2) + 4 * n + (i & 3); }

struct Unit { int pm, pn; };
struct Gemm { const bf16* A; const bf16* Bt; int lda, ldb, K, mode; };
__device__ __forceinline__ const char* a_base(const Gemm& g, const Unit& u) { return (const char*)(g.A + (size_t)u.pm * BM * g.lda + (g.mode == 1 ? ((u.pn >> 1) & 7) * 256 : 0)); }
__device__ __forceinline__ const char* b_base(const Gemm& g, const Unit& u) { return (const char*)(g.Bt + (size_t)u.pn * BM * g.ldb); }

struct StaticOrder {
    int nM, nN, nwg, G, c;
    __host__ __device__ void init(int M, int N, int G_, int c_) { nM = M / BM; nN = N / BM; nwg = nM * nN; G = G_; c = c_; }
    __host__ __device__ bool next(int i, Unit& u) const {
        const long L = (long)i * G + c; if (L >= nwg) return false;
        int wgid = (int)L; { const int q = nwg / NXCD, r = nwg % NXCD, xcd = wgid % NXCD, off = wgid / NXCD; wgid = (xcd < r ? xcd * (q + 1) : r * (q + 1) + (xcd - r) * q) + off; }
        const int nig = WGM * nN, gid = wgid / nig, fm = gid * WGM, gsz = (nM - fm) < WGM ? (nM - fm) : WGM;
        u.pm = fm + ((wgid % nig) % gsz); u.pn = (wgid % nig) / gsz; return true;
    }
};

template <class Epi, bool ALIGN_EPI = true, bool SP2 = true>
__device__ __forceinline__ void gemm_phase(LAS unsigned char* lds, const Gemm g, const StaticOrder& S, const Epi& E) {
    int tid_o = threadIdx.x; asm volatile("" : "+v"(tid_o));
    const int tid = tid_o, wid = __builtin_amdgcn_readfirstlane(tid >> 6), lane = tid & 63, wr = wid >> 2, wc = wid & 3, fr = lane & 15, fq = lane >> 4;
    const int K = g.K, nt = K / BK;
    unsigned voffA[2], voffB[2];
#pragma unroll
    for (int i = 0; i < 2; ++i) { int R, C; stage_rc(tid * 16 + i * 8192, R, C); const int Rb = Epi::PERM ? ((R & ~31) + perm32(R & 31)) : R;
        voffA[i] = (unsigned)(R * g.lda + C) * 2u; voffB[i] = (unsigned)(Rb * g.ldb + C) * 2u; }
    const size_t kstep = (size_t)(BK * 2);
    const size_t hstepA = (size_t)HALF * g.lda * 2, hstepB = (size_t)HALF * g.ldb * 2;
    const unsigned ldsw = (unsigned)wid * 1024u;
    const int aoff = lds_byte(wr * 64 + fr, fq * 8), boff = lds_byte(wc * 32 + fr, fq * 8);
#define PG8_SA(b, h) (((b) * 2 + (h)) * HTB)
#define PG8_SB(b, h) ((4 + (b) * 2 + (h)) * HTB)
#define PG8_STAGE(bufoff, gbase, voff) do { _Pragma("unroll") for (int _i = 0; _i < 2; ++_i) \
        __builtin_amdgcn_global_load_lds((const unsigned*)((const char*)(gbase) + (voff)[_i]), (LAS unsigned*)(lds + (bufoff) + ldsw + _i * 8192), 16, 0, 0); } while (0)
#define PG8_LDA(dst, b, h) do { _Pragma("unroll") for (int m = 0; m < 4; ++m) _Pragma("unroll") for (int k = 0; k < 2; ++k) dst[m][k] = *(const LAS bf16x8*)(lds + PG8_SA(b, h) + aoff + m * 2048 + k * 1024); } while (0)
#define PG8_LDB(dst, b, h) do { _Pragma("unroll") for (int n = 0; n < 2; ++n) _Pragma("unroll") for (int k = 0; k < 2; ++k) dst[n][k] = *(const LAS bf16x8*)(lds + PG8_SB(b, h) + boff + n * 2048 + k * 1024); } while (0)
#define PG8_MMA(ai, bj, At, Bt) do { __builtin_amdgcn_s_setprio(1); _Pragma("unroll") for (int m = 0; m < 4; ++m) _Pragma("unroll") for (int n = 0; n < 2; ++n) _Pragma("unroll") for (int k = 0; k < 2; ++k) \
        acc[ai][bj][m][n] = __builtin_amdgcn_mfma_f32_16x16x32_bf16(Bt[n][k], At[m][k], acc[ai][bj][m][n], 0, 0, 0); __builtin_amdgcn_s_setprio(0); } while (0)
#define PG8_WAIT_V(n) asm volatile("s_waitcnt vmcnt(" #n ")" ::: "memory")
#define PG8_WAIT_L(n) asm volatile("s_waitcnt lgkmcnt(" #n ")" ::: "memory")
#define PG8_BAR __builtin_amdgcn_s_barrier()
#define PG8_SCHED __builtin_amdgcn_sched_barrier(0)
    Unit cur, nxt; int ui = 0;
    if (!S.next(0, cur)) return;
    f32x4 acc[2][2][4][2];
#pragma unroll
    for (int a = 0; a < 2; ++a)
#pragma unroll
        for (int b = 0; b < 2; ++b)
#pragma unroll
            for (int m = 0; m < 4; ++m)
#pragma unroll
                for (int n = 0; n < 2; ++n) acc[a][b][m][n] = (f32x4){0.f, 0.f, 0.f, 0.f};
    bf16x8 At[4][2], B0[2][2], B1[2][2];
    const char* cA = a_base(g, cur); const char* cB = b_base(g, cur);
    if constexpr (SP2) {
        PG8_STAGE(PG8_SB(0, 0), cB, voffB); PG8_STAGE(PG8_SB(0, 1), cB + hstepB, voffB); PG8_STAGE(PG8_SA(0, 0), cA, voffA); PG8_STAGE(PG8_SA(0, 1), cA + hstepA, voffA);
        if (wr == 1) PG8_BAR;
        PG8_WAIT_V(2); PG8_BAR;
        PG8_STAGE(PG8_SB(1, 0), cB + kstep, voffB); PG8_STAGE(PG8_SA(1, 0), cA + kstep, voffA); PG8_STAGE(PG8_SB(1, 1), cB + hstepB + kstep, voffB);
        PG8_WAIT_V(6); PG8_BAR;
    } else {
        PG8_STAGE(PG8_SB(0, 0), cB, voffB); PG8_STAGE(PG8_SA(0, 0), cA, voffA); PG8_STAGE(PG8_SB(0, 1), cB + hstepB, voffB); PG8_STAGE(PG8_SA(0, 1), cA + hstepA, voffA);
        if (wr == 1) PG8_BAR;
        PG8_WAIT_V(4); PG8_BAR;
        PG8_STAGE(PG8_SB(1, 0), cB + kstep, voffB); PG8_STAGE(PG8_SA(1, 0), cA + kstep, voffA); PG8_STAGE(PG8_SB(1, 1), cB + hstepB + kstep, voffB);
        PG8_WAIT_V(6); PG8_BAR;
    }
    for (;;) {
        const bool has_next = S.next(ui + 1, nxt);
        const char* nA = has_next ? a_base(g, nxt) : cA; const char* nB = has_next ? b_base(g, nxt) : cB;
#pragma unroll 1
        for (int t = 0; t < nt; t += 2) {
            const bool last = (t == nt - 2);
            const char* a1 = cA + (size_t)(t + 1) * kstep;
            const char* a2 = last ? nA : cA + (size_t)(t + 2) * kstep; const char* b2 = last ? nB : cB + (size_t)(t + 2) * kstep;
            const char* a3 = a2 + kstep; const char* b3 = b2 + kstep;
            if constexpr (SP2) {
            PG8_LDB(B0, 0, 0); PG8_LDB(B1, 0, 1); PG8_SCHED; PG8_LDA(At, 0, 0); PG8_STAGE(PG8_SA(1, 1), a1 + hstepA, voffA);
            PG8_WAIT_V(8); PG8_WAIT_L(0); PG8_BAR; PG8_MMA(0, 0, At, B0); PG8_MMA(0, 1, At, B1); PG8_BAR; PG8_SCHED;
            PG8_LDA(At, 0, 1); PG8_STAGE(PG8_SB(0, 0), b2, voffB); PG8_STAGE(PG8_SB(0, 1), b2 + hstepB, voffB); PG8_STAGE(PG8_SA(0, 0), a2, voffA);
            PG8_WAIT_V(8); PG8_WAIT_L(0); PG8_BAR; PG8_MMA(1, 0, At, B0); PG8_MMA(1, 1, At, B1); PG8_BAR; PG8_SCHED;
            PG8_LDB(B0, 1, 0); PG8_LDB(B1, 1, 1); PG8_SCHED; PG8_LDA(At, 1, 0); PG8_STAGE(PG8_SA(0, 1), a2 + hstepA, voffA);
            PG8_WAIT_V(8); PG8_WAIT_L(0); PG8_BAR; PG8_MMA(0, 0, At, B0); PG8_MMA(0, 1, At, B1); PG8_BAR; PG8_SCHED;
            PG8_LDA(At, 1, 1); PG8_STAGE(PG8_SB(1, 0), b3, voffB); PG8_STAGE(PG8_SB(1, 1), b3 + hstepB, voffB); PG8_STAGE(PG8_SA(1, 0), a3, voffA);
            PG8_WAIT_V(8); PG8_WAIT_L(0); PG8_BAR; PG8_MMA(1, 0, At, B0); PG8_MMA(1, 1, At, B1); PG8_BAR; PG8_SCHED;
            } else {
            PG8_LDB(B0, 0, 0); PG8_SCHED; PG8_LDA(At, 0, 0); PG8_STAGE(PG8_SA(1, 1), a1 + hstepA, voffA);
            PG8_WAIT_L(8); PG8_BAR; PG8_WAIT_L(0); PG8_MMA(0, 0, At, B0); PG8_BAR; PG8_SCHED;
            PG8_LDB(B1, 0, 1); PG8_STAGE(PG8_SB(0, 0), b2, voffB);
            PG8_BAR; PG8_WAIT_L(0); PG8_MMA(0, 1, At, B1); PG8_BAR;
            PG8_LDA(At, 0, 1); PG8_STAGE(PG8_SA(0, 0), a2, voffA);
            PG8_BAR; PG8_WAIT_L(0); PG8_MMA(1, 0, At, B0); PG8_BAR; PG8_SCHED;
            PG8_STAGE(PG8_SB(0, 1), b2 + hstepB, voffB);
            PG8_WAIT_V(6); PG8_BAR; PG8_MMA(1, 1, At, B1); PG8_BAR;
            PG8_LDB(B0, 1, 0); PG8_SCHED; PG8_LDA(At, 1, 0); PG8_STAGE(PG8_SA(0, 1), a2 + hstepA, voffA);
            PG8_WAIT_L(8); PG8_BAR; PG8_WAIT_L(0); PG8_MMA(0, 0, At, B0); PG8_BAR; PG8_SCHED;
            PG8_LDB(B1, 1, 1); PG8_STAGE(PG8_SB(1, 0), b3, voffB);
            PG8_BAR; PG8_WAIT_L(0); PG8_MMA(0, 1, At, B1); PG8_BAR;
            PG8_LDA(At, 1, 1); PG8_STAGE(PG8_SA(1, 0), a3, voffA);
            PG8_BAR; PG8_WAIT_L(0); PG8_MMA(1, 0, At, B0); PG8_BAR; PG8_SCHED;
            PG8_STAGE(PG8_SB(1, 1), b3 + hstepB, voffB);
            PG8_WAIT_V(6); PG8_BAR; PG8_MMA(1, 1, At, B1); PG8_BAR;
            }
        }
        if constexpr (ALIGN_EPI) { if (wr == 0) PG8_BAR; }
        if constexpr (!Epi::AFTER_DRAIN) E(acc, cur, wr, wc, fr, fq);
        if (!has_next) break;
#pragma unroll
        for (int a = 0; a < 2; ++a)
#pragma unroll
            for (int b = 0; b < 2; ++b)
#pragma unroll
                for (int m = 0; m < 4; ++m)
#pragma unroll
                    for (int n = 0; n < 2; ++n) acc[a][b][m][n] = (f32x4){0.f, 0.f, 0.f, 0.f};
        cur = nxt; cA = nA; cB = nB; ++ui;
        if constexpr (ALIGN_EPI) { if (wr == 1) PG8_BAR; }
    }
    PG8_WAIT_V(0);
    if constexpr (!ALIGN_EPI) { if (wr == 0) PG8_BAR; }
    PG8_BAR;
    if constexpr (Epi::AFTER_DRAIN) E.fused(acc, cur, wr, wc, fr, fq, lds, wid, lane);
#undef PG8_SA
#undef PG8_SB
#undef PG8_STAGE
#undef PG8_LDA
#undef PG8_LDB
#undef PG8_MMA
#undef PG8_WAIT_V
#undef PG8_WAIT_L
#undef PG8_BAR
#undef PG8_SCHED
}

typedef f32x4 AccT[2][2][4][2];
struct EpiResid {
    static constexpr bool PERM = false, AFTER_DRAIN = false;
    float* X; int ldc; float alpha;
    __device__ __forceinline__ void operator()(const AccT& acc, const Unit& u, int wr, int wc, int fr_in, int fq_in) const {
        int fr = fr_in, fq = fq_in; asm volatile("" : "+v"(fr), "+v"(fq));
        const int row0 = u.pm * BM + wr * 64 + fr, col0 = u.pn * BM + wc * 32 + 4 * fq;
#pragma unroll
        for (int ai = 0; ai < 2; ++ai)
#pragma unroll
            for (int m = 0; m < 4; ++m) { float* rowp = X + (size_t)(row0 + ai * HALF + m * 16) * ldc + col0;
                f32x4 xv[2][2];
#pragma unroll
                for (int bj = 0; bj < 2; ++bj)
#pragma unroll
                    for (int n = 0; n < 2; ++n) xv[bj][n] = *(const f32x4*)(rowp + bj * HALF + n * 16);
#pragma unroll
                for (int bj = 0; bj < 2; ++bj)
#pragma unroll
                    for (int n = 0; n < 2; ++n) *(f32x4*)(rowp + bj * HALF + n * 16) = xv[bj][n] * alpha + acc[ai][bj][m][n]; }
    }
};
struct EpiResidLn {
    static constexpr bool PERM = false, AFTER_DRAIN = true;
    const float* Xin; float* Xout; bf16* XBout; const float* g; const float* b; float alpha;
    unsigned long long* xbuf; unsigned* cnt; unsigned want; unsigned* tmo;
    __device__ __forceinline__ void operator()(const AccT&, const Unit&, int, int, int, int) const {}
    __device__ __forceinline__ void fused(AccT& acc, const Unit& u, int wr, int wc, int fr_in, int fq_in, LAS unsigned char* lds, int wid, int lane_in) const {
        int fr = fr_in, fq = fq_in, lane = lane_in; asm volatile("" : "+v"(fr), "+v"(fq), "+v"(lane));
        LAS f32x2* P = (LAS f32x2*)lds;
        LAS f32x2* S = (LAS f32x2*)(lds + 8192);
        const int col0 = u.pn * BM + wc * 32 + 4 * fq;
#pragma unroll
        for (int ai = 0; ai < 2; ++ai)
#pragma unroll
            for (int m = 0; m < 4; ++m) { const float* rowp = Xin + (size_t)(u.pm * BM + ai * HALF + wr * 64 + m * 16 + fr) * D + col0;
#pragma unroll
                for (int bj = 0; bj < 2; ++bj) {
#pragma unroll
                    for (int n = 0; n < 2; ++n) acc[ai][bj][m][n] += *(const f32x4*)(rowp + bj * HALF + n * 16) * alpha;
                    asm volatile("" : "+v"(acc[ai][bj][m][0]), "+v"(acc[ai][bj][m][1]) :: "memory"); } }
#pragma unroll
        for (int ai = 0; ai < 2; ++ai)
#pragma unroll
            for (int m = 0; m < 4; ++m) {
                float s = 0.f;
#pragma unroll
                for (int bj = 0; bj < 2; ++bj)
#pragma unroll
                    for (int n = 0; n < 2; ++n) { const f32x4 x = acc[ai][bj][m][n]; s += (x[0] + x[1]) + (x[2] + x[3]); }
                s += shfl_lane(s, lane ^ 16); s += shfl_lane(s, lane ^ 32);
                const float mw = s * (1.0f / 64.0f); float q = 0.f;
#pragma unroll
                for (int bj = 0; bj < 2; ++bj)
#pragma unroll
                    for (int n = 0; n < 2; ++n) { const f32x4 d = acc[ai][bj][m][n] - mw; q += (d[0] * d[0] + d[1] * d[1]) + (d[2] * d[2] + d[3] * d[3]); }
                q += shfl_lane(q, lane ^ 16); q += shfl_lane(q, lane ^ 32);
                if (fq == 0) P[(ai * HALF + wr * 64 + m * 16 + fr) * 4 + wc] = (f32x2){mw, q};
            }
        asm volatile("s_waitcnt lgkmcnt(0)" ::: "memory"); __builtin_amdgcn_s_barrier(); asm volatile("" ::: "memory");
        const int row = wid * 32 + (lane & 31);
        if (lane < 32) {
            const f32x2 a = P[row * 4 + 0], bb = P[row * 4 + 1], c = P[row * 4 + 2], d = P[row * 4 + 3];
            const float mt = (a.x + bb.x + c.x + d.x) * 0.25f;
            const float da = a.x - mt, db = bb.x - mt, dc = c.x - mt, dd = d.x - mt;
            const float m2 = (a.y + bb.y) + (c.y + d.y) + 64.0f * ((da * da + db * db) + (dc * dc + dd * dd));
            unsigned long long* slot = xbuf + ((size_t)(u.pm * BM + row) * 8 + u.pn);
            __hip_atomic_store(slot, ((unsigned long long)__float_as_uint(m2) << 32) | __float_as_uint(mt), __ATOMIC_RELAXED, __HIP_MEMORY_SCOPE_AGENT);
        }
        asm volatile("s_waitcnt vmcnt(0)" ::: "memory");
        if (lane == 0) __hip_atomic_fetch_add(cnt + 64 * u.pm, 1u, __ATOMIC_RELAXED, __HIP_MEMORY_SCOPE_AGENT);
        if (wid == 0) {
            unsigned sp = 0;
            while ((unsigned)__builtin_amdgcn_readfirstlane(__hip_atomic_load(cnt + 64 * u.pm, __ATOMIC_RELAXED, __HIP_MEMORY_SCOPE_AGENT)) < want) {
                __builtin_amdgcn_s_sleep(1);
                if ((++sp & 1023u) == 0u) { if (__builtin_amdgcn_readfirstlane(__hip_atomic_load(tmo, __ATOMIC_RELAXED, __HIP_MEMORY_SCOPE_AGENT)) != 0u) break;
                    if (sp > (1u << 22)) { if (lane == 0) __hip_atomic_store(tmo, 1u, __ATOMIC_RELAXED, __HIP_MEMORY_SCOPE_AGENT); break; } } }
            __builtin_amdgcn_fence(__ATOMIC_ACQUIRE, "agent");
        }
        asm volatile("s_waitcnt vmcnt(0) lgkmcnt(0)" ::: "memory"); __builtin_amdgcn_s_barrier(); asm volatile("" ::: "memory");
        if (lane < 32) {
            const unsigned long long* slot = xbuf + (size_t)(u.pm * BM + row) * 8; float mt[8], m2[8]; float ms = 0.f;
#pragma unroll
            for (int t = 0; t < 8; ++t) { const unsigned long long w = __hip_atomic_load(slot + t, __ATOMIC_RELAXED, __HIP_MEMORY_SCOPE_AGENT); mt[t] = __uint_as_float((unsigned)w); m2[t] = __uint_as_float((unsigned)(w >> 32)); ms += mt[t]; }
            const float mean = ms * 0.125f; float q = 0.f;
#pragma unroll
            for (int t = 0; t < 8; ++t) { const float dm = mt[t] - mean; q += m2[t] + 256.0f * dm * dm; }
            S[row] = (f32x2){mean, rsqrtf(q * (1.0f / 2048.0f) + LN_EPS)};
        }
        asm volatile("s_waitcnt lgkmcnt(0)" ::: "memory"); __builtin_amdgcn_s_barrier(); asm volatile("" ::: "memory");
        asm volatile("" : "+v"(fr), "+v"(fq));
        const int col5 = u.pn * BM + wc * 32 + 4 * fq;
#pragma unroll
        for (int bj = 0; bj < 2; ++bj)
#pragma unroll
            for (int n = 0; n < 2; ++n) { const int cc = col5 + bj * HALF + n * 16; const f32x4 gg = *(const f32x4*)(g + cc), bv = *(const f32x4*)(b + cc);
#pragma unroll
                for (int ai = 0; ai < 2; ++ai)
#pragma unroll
                    for (int m = 0; m < 4; ++m) { const int r = ai * HALF + wr * 64 + m * 16 + fr; const f32x2 sr = S[r]; const size_t off = (size_t)(u.pm * BM + r) * D + cc;
                        const f32x4 o = (acc[ai][bj][m][n] - sr.x) * sr.y * gg + bv; *(f32x4*)(Xout + off) = o;
                        u32x2 w; w.x = pk2(o[0], o[1]); w.y = pk2(o[2], o[3]); *(u32x2*)(XBout + off) = w; }
                asm volatile("" ::: "memory"); }
    }
};
struct EpiRelu2 {
    static constexpr bool PERM = true, AFTER_DRAIN = false;
    bf16* O; int ldc;
    __device__ __forceinline__ void operator()(const AccT& acc, const Unit& u, int wr, int wc, int fr_in, int fq_in) const {
        int fr = fr_in, fq = fq_in; asm volatile("" : "+v"(fr), "+v"(fq));
        const int row0 = u.pm * BM + wr * 64 + fr, col0 = u.pn * BM + wc * 32 + 8 * fq;
#pragma unroll
        for (int ai = 0; ai < 2; ++ai)
#pragma unroll
            for (int m = 0; m < 4; ++m) { bf16* rowp = O + (size_t)(row0 + ai * HALF + m * 16) * ldc + col0;
#pragma unroll
                for (int bj = 0; bj < 2; ++bj) { f32x4 v0 = acc[ai][bj][m][0], v1 = acc[ai][bj][m][1];
#pragma unroll
                    for (int j = 0; j < 4; ++j) { const float a = fmaxf(v0[j], 0.f), b = fmaxf(v1[j], 0.f); v0[j] = a * a; v1[j] = b * b; }
                    u32x4 w; w.x = pk2(v0[0], v0[1]); w.y = pk2(v0[2], v0[3]); w.z = pk2(v1[0], v1[1]); w.w = pk2(v1[2], v1[3]);
                    *(u32x4*)(rowp + bj * HALF) = w; } }
    }
};
struct EpiRgIn {
    static constexpr bool PERM = true, AFTER_DRAIN = false;
    bf16* GATE; bf16* URAW;
    __device__ __forceinline__ void operator()(const AccT& acc, const Unit& u, int wr, int wc, int fr_in, int fq_in) const {
        int fr = fr_in, fq = fq_in; asm volatile("" : "+v"(fr), "+v"(fq));
        const bool isg = u.pn < 8; bf16* base = isg ? GATE : URAW;
        const int row0 = u.pm * BM + wr * 64 + fr, col0 = (u.pn & 7) * BM + wc * 32 + 8 * fq;
#pragma unroll
        for (int ai = 0; ai < 2; ++ai)
#pragma unroll
            for (int m = 0; m < 4; ++m) { bf16* rowp = base + (size_t)(row0 + ai * HALF + m * 16) * D + col0;
#pragma unroll
                for (int bj = 0; bj < 2; ++bj) { f32x4 v0 = acc[ai][bj][m][0], v1 = acc[ai][bj][m][1];
                    if (isg) {
#pragma unroll
                        for (int j = 0; j < 4; ++j) { v0[j] = gelu_tanh_(v0[j]); v1[j] = gelu_tanh_(v1[j]); } }
                    u32x4 w; w.x = pk2(v0[0], v0[1]); w.y = pk2(v0[2], v0[3]); w.z = pk2(v1[0], v1[1]); w.w = pk2(v1[2], v1[3]);
                    *(u32x4*)(rowp + bj * HALF) = w; } }
    }
};
struct EpiRgGates {
    static constexpr bool PERM = true, AFTER_DRAIN = false;
    const bf16* U; bf16* LA; bf16* INP; const float* ba; const float* bx; const float* spt;
    __device__ __forceinline__ void operator()(const AccT& acc, const Unit& u, int wr, int wc, int fr_in, int fq_in) const {
        int fr = fr_in, fq = fq_in; asm volatile("" : "+v"(fr), "+v"(fq));
        const int d = u.pn >> 4, nb = (u.pn >> 1) & 7, half = u.pn & 1;
        const int c0 = nb * 256 + half * 128 + wc * 32 + 8 * fq;
        const int row0 = u.pm * BM + wr * 64 + fr;
        bf16* la = LA + (size_t)d * TG * D; bf16* inp = INP + (size_t)d * TG * D;
#pragma unroll
        for (int n = 0; n < 2; ++n) {
            const f32x4 pba = *(const f32x4*)(ba + d * D + c0 + 4 * n), pbx = *(const f32x4*)(bx + d * D + c0 + 4 * n), psp = *(const f32x4*)(spt + d * D + c0 + 4 * n);
#pragma unroll
            for (int ai = 0; ai < 2; ++ai)
#pragma unroll
                for (int m = 0; m < 4; ++m) { const size_t off = (size_t)(row0 + ai * HALF + m * 16) * D + c0 + 4 * n;
                    const u32x2 uw = *(const u32x2*)(U + off);
                    const float uv[4] = {bflo(uw.x), bfhi(uw.x), bflo(uw.y), bfhi(uw.y)};
                    float lv[4], iv[4];
#pragma unroll
                    for (int j = 0; j < 4; ++j) { const float r = sigmoidf_(acc[ai][0][m][n][j] + pba[j]); const float ig = sigmoidf_(acc[ai][1][m][n][j] + pbx[j]);
                        const float l = r * psp[j]; const float a2 = __expf(2.0f * l); lv[j] = l; iv[j] = fsqrt_(fmaxf(1.0f - a2, 0.f)) * ig * uv[j]; }
                    u32x2 w; w.x = pk2(lv[0], lv[1]); w.y = pk2(lv[2], lv[3]); *(u32x2*)(la + off) = w;
                    u32x2 v; v.x = pk2(iv[0], iv[1]); v.y = pk2(iv[2], iv[3]); *(u32x2*)(inp + off) = v; }
            asm volatile("" ::: "memory");
        }
    }
};
struct EpiSsdIn {
    static constexpr bool PERM = true, AFTER_DRAIN = false;
    bf16* ZS; bf16* XBCR; float* DT; const float* dtb;
    __device__ __forceinline__ void operator()(const AccT& acc, const Unit& u, int wr, int wc, int fr_in, int fq_in) const {
        int fr = fr_in, fq = fq_in; asm volatile("" : "+v"(fr), "+v"(fq));
        const int row0 = u.pm * BM + wr * 64 + fr, cw = wc * 32 + 8 * fq;
        if (u.pn < 40) {
            const bool isz = u.pn < 16; bf16* base = isz ? ZS + (size_t)u.pn * BM : XBCR + (size_t)(u.pn - 16) * BM; const int ldc = isz ? SSD_DI : SSD_XBC;
#pragma unroll
            for (int ai = 0; ai < 2; ++ai)
#pragma unroll
                for (int m = 0; m < 4; ++m) { bf16* rowp = base + (size_t)(row0 + ai * HALF + m * 16) * ldc + cw;
#pragma unroll
                    for (int bj = 0; bj < 2; ++bj) { f32x4 v0 = acc[ai][bj][m][0], v1 = acc[ai][bj][m][1];
                        if (isz) {
#pragma unroll
                            for (int j = 0; j < 4; ++j) { v0[j] = siluf_(v0[j]); v1[j] = siluf_(v1[j]); } }
                        u32x4 w; w.x = pk2(v0[0], v0[1]); w.y = pk2(v0[2], v0[3]); w.z = pk2(v1[0], v1[1]); w.w = pk2(v1[2], v1[3]);
                        *(u32x4*)(rowp + bj * HALF) = w; } }
        } else {
            f32x4 b0 = *(const f32x4*)(dtb + cw), b1 = *(const f32x4*)(dtb + cw + 4);
#pragma unroll
            for (int ai = 0; ai < 2; ++ai)
#pragma unroll
                for (int m = 0; m < 4; ++m) { float* rowp = DT + (size_t)(row0 + ai * HALF + m * 16) * 128 + cw;
                    f32x4 v0 = acc[ai][0][m][0] + b0, v1 = acc[ai][0][m][1] + b1;
#pragma unroll
                    for (int j = 0; j < 4; ++j) { v0[j] = softplusf_(v0[j]); v1[j] = softplusf_(v1[j]); }
                    *(f32x4*)(rowp) = v0; *(f32x4*)(rowp + 4) = v1; }
        }
    }
};
struct EpiQkv {
    static constexpr bool PERM = true, AFTER_DRAIN = false;
    bf16* Q; const float* bias;
    __device__ __forceinline__ void operator()(const AccT& acc, const Unit& u, int wr, int wc, int fr_in, int fq_in) const {
        int fr = fr_in, fq = fq_in; asm volatile("" : "+v"(fr), "+v"(fq));
        const int t = u.pn >> 3; bf16* base = Q + (size_t)t * TG * D; const float sc = t == 0 ? 0.08838834764831845f : 1.0f;
        const int row0 = u.pm * BM + wr * 64 + fr, col0 = (u.pn & 7) * BM + wc * 32 + 8 * fq, bcol0 = u.pn * BM + wc * 32 + 8 * fq;
#pragma unroll
        for (int bj = 0; bj < 2; ++bj) {
            const f32x4 bv0 = *(const f32x4*)(bias + bcol0 + bj * HALF), bv1 = *(const f32x4*)(bias + bcol0 + bj * HALF + 4);
#pragma unroll
            for (int ai = 0; ai < 2; ++ai)
#pragma unroll
                for (int m = 0; m < 4; ++m) { bf16* rowp = base + (size_t)(row0 + ai * HALF + m * 16) * D + col0;
                    const f32x4 v0 = (acc[ai][bj][m][0] + bv0) * sc, v1 = (acc[ai][bj][m][1] + bv1) * sc;
                    u32x4 w; w.x = pk2(v0[0], v0[1]); w.y = pk2(v0[2], v0[3]); w.z = pk2(v1[0], v1[1]); w.w = pk2(v1[2], v1[3]);
                    *(u32x4*)(rowp + bj * HALF) = w; }
            asm volatile("" ::: "memory");
        }
    }
};
}

struct Frame {
    LAS unsigned char* lds;
    int tid, lane, wave, G, gw, ngw;
};

__device__ __forceinline__ Frame phase_frame(const Frame& F0) {
    Frame F = F0; int t = threadIdx.x; asm volatile("" : "+v"(t));
    F.tid = t; F.lane = t & 63; F.wave = __builtin_amdgcn_readfirstlane(t >> 6); F.gw = blockIdx.x * NWAVES + F.wave; return F;
}
__device__ __forceinline__ void transpose_item(const float* W, int ldw, bf16* WT, int ldt, int k0, int n0, int drow0, LAS float* scr, int lane) {
#pragma unroll 8
    for (int i = 0; i < 32; ++i) { const int kk = 2 * i + (lane >> 5); scr[kk * 33 + (lane & 31)] = W[(size_t)(k0 + kk) * ldw + n0 + (lane & 31)]; }
    LDS_WAIT(); asm volatile("" ::: "memory");
    const int c = lane & 7;
#pragma unroll
    for (int j = 0; j < 4; ++j) { const int n = (lane >> 3) + 8 * j; const LAS float* s = scr + (8 * c) * 33 + n;
        u32x4 o; o.x = pk2(s[0 * 33], s[1 * 33]); o.y = pk2(s[2 * 33], s[3 * 33]); o.z = pk2(s[4 * 33], s[5 * 33]); o.w = pk2(s[6 * 33], s[7 * 33]);
        *(GAS u32x4*)(WT + (size_t)(drow0 + n) * ldt + k0 + 8 * c) = o; }
    LDS_WAIT(); asm volatile("" ::: "memory");
}
__device__ __forceinline__ void conv_matrix(const Frame& F, const float* W, int K, int N, bf16* WT, LAS float* scr) {
    const int nblk = N / 32, nitems = (K / 64) * nblk;
    for (int it = F.gw; it < nitems; it += F.ngw) { const int kb = it / nblk, nb = it % nblk; transpose_item(W, N, WT, K, 64 * kb, 32 * nb, 32 * nb, scr, F.lane); }
}
__device__ __forceinline__ void p_prologue(const Frame& F0, const float* const* in, bf16* Wb, float* spt, bf16* XB0) {
    const Frame F = phase_frame(F0);
    { const int n4 = NGROUP * TG * D / 4, n4p = 2 * TG * D / 4;
      for (int i = F.gw * 64 + F.lane; i < n4; i += F.ngw * 64) { const f32x4 v = i < n4p ? ((const f32x4*)in[0])[i] : ((const f32x4*)in[1])[i - n4p]; u32x2 w; w.x = pk2(v.x, v.y); w.y = pk2(v.z, v.w); ((u32x2*)XB0)[i] = w; } }
    LAS float* scr = (LAS float*)(F.lds + F.wave * 16384);
    for (int l = 0; l < 2; ++l) {
        conv_matrix(F, in[2] + (size_t)l * 2048 * 4096, 2048, 4096, Wb + W_RGIN + (size_t)l * 4096 * 2048, scr);
        conv_matrix(F, in[10] + (size_t)l * 2048 * 2048, 2048, 2048, Wb + W_RGOUT + (size_t)l * 2048 * 2048, scr);
    }
    for (int it = F.gw; it < 2 * 2 * 16 * 32; it += F.ngw) {
        const int sub = it & 31, mat = it >> 5;
        const int dn = mat & 15, ax = (mat >> 4) & 1, l = mat >> 5;
        const int kb = sub >> 3, nb = sub & 7, j0 = 32 * nb;
        const float* W = in[ax ? 7 : 5] + ((size_t)(l * 16 + dn)) * 65536;
        bf16* WT = Wb + W_RGGATE + (size_t)l * 32 * 65536 + (size_t)(dn * 2 + (j0 >> 7)) * 65536;
        transpose_item(W, 256, WT, 256, 64 * kb, j0, (j0 & 127) + 128 * ax, scr, F.lane);
    }
    for (int i = F.gw * 64 + F.lane; i < 2 * 2 * 2048; i += F.ngw * 64) spt[i] = -8.0f * softplusf_(-in[9][i]);
    conv_matrix(F, in[11], 2048, SSD_NIN, Wb + W_SSDIN, scr);
    { u32x4* z = (u32x4*)(Wb + W_SSDIN + (size_t)SSD_NIN * 2048); const int n16 = (SSD_NIN_PAD - SSD_NIN) * 2048 / 8;
      for (int i = F.gw * 64 + F.lane; i < n16; i += F.ngw * 64) z[i] = (u32x4){0u, 0u, 0u, 0u}; }
    conv_matrix(F, in[18], 4096, 2048, Wb + W_SSDOUT, scr);
    conv_matrix(F, in[19], 2048, 6144, Wb + W_NAQKV, scr);
    conv_matrix(F, in[22], 2048, 2048, Wb + W_NAOUT, scr);
    for (int l = 0; l < 4; ++l) {
        conv_matrix(F, in[23] + (size_t)l * 2048 * 8192, 2048, 8192, Wb + W_UP + (size_t)l * 8192 * 2048, scr);
        conv_matrix(F, in[24] + (size_t)l * 8192 * 2048, 8192, 2048, Wb + W_DOWN + (size_t)l * 2048 * 8192, scr);
    }
}

__device__ __forceinline__ void p_copy(const Frame& F0, const float* src, float* X, bf16* XB) {
    const Frame F = phase_frame(F0);
    const int n4 = TG * D / 4;
    for (int i = F.gw * 64 + F.lane; i < n4; i += F.ngw * 64) { const f32x4 v = ((const f32x4*)src)[i]; ((f32x4*)X)[i] = v; u32x2 w; w.x = pk2(v.x, v.y); w.y = pk2(v.z, v.w); ((u32x2*)XB)[i] = w; }
}
__device__ __forceinline__ void p_ln(const Frame& F0, const float* Xi, float* X, bf16* XB, const float* g, const float* b) {
    const Frame F = phase_frame(F0);
    for (int m = F.gw; m < TG; m += F.ngw) {
        f32x4* xr = (f32x4*)(X + (size_t)m * D) + F.lane; const f32x4* xi = (const f32x4*)(Xi + (size_t)m * D) + F.lane;
        f32x4 v[8]; float s = 0.f;
#pragma unroll
        for (int j = 0; j < 8; ++j) { v[j] = xi[64 * j]; s += (v[j].x + v[j].y) + (v[j].z + v[j].w); }
        const float mean = wave_sum(s, F.lane) * (1.f / D); float s2 = 0.f;
#pragma unroll
        for (int j = 0; j < 8; ++j) { v[j] = v[j] - mean; s2 += (v[j].x * v[j].x + v[j].y * v[j].y) + (v[j].z * v[j].z + v[j].w * v[j].w); }
        const float rstd = rsqrtf(wave_sum(s2, F.lane) * (1.f / D) + LN_EPS);
        u32x2* o8 = (u32x2*)(XB + (size_t)m * D) + F.lane;
#pragma unroll
        for (int j = 0; j < 8; ++j) { const f32x4 gg = ((const f32x4*)g)[F.lane + 64 * j], bb = ((const f32x4*)b)[F.lane + 64 * j];
            const f32x4 y = v[j] * rstd * gg + bb; xr[64 * j] = y; u32x2 w; w.x = pk2(y.x, y.y); w.y = pk2(y.z, y.w); o8[64 * j] = w; }
    }
}

template <int MODE>
__device__ __forceinline__ void p_conv(const Frame& F0, const bf16* in, int C, int L, const float* cw, const float* cb, bf16* out0, bf16* out1, bf16* out2) {
    const Frame F = phase_frame(F0);
    const int ncb = C / 512, nitems = (TG / 16) * ncb;
    for (int it = F.gw; it < nitems; it += F.ngw) {
        const int cbk = it % ncb, run = it / ncb, t0 = run * 16, c0 = cbk * 512 + F.lane * 8;
        const int tl = t0 % L;
        float w[4][8], bias[8];
#pragma unroll
        for (int k = 0; k < 4; ++k) { const f32x4 a = *(const f32x4*)(cw + (size_t)k * C + c0), b = *(const f32x4*)(cw + (size_t)k * C + c0 + 4);
            w[k][0] = a.x; w[k][1] = a.y; w[k][2] = a.z; w[k][3] = a.w; w[k][4] = b.x; w[k][5] = b.y; w[k][6] = b.z; w[k][7] = b.w; }
        { const f32x4 a = *(const f32x4*)(cb + c0), b = *(const f32x4*)(cb + c0 + 4); bias[0] = a.x; bias[1] = a.y; bias[2] = a.z; bias[3] = a.w; bias[4] = b.x; bias[5] = b.y; bias[6] = b.z; bias[7] = b.w; }
        u32x4 rows[19];
#pragma unroll
        for (int i = 0; i < 19; ++i) { const int tt = tl - 1 + i; const bool ok = (tt >= 0) && (tt < L);
            rows[i] = ok ? *(const u32x4*)(in + (size_t)(t0 - 1 + i) * C + c0) : (u32x4){0u, 0u, 0u, 0u}; }
        unsigned outw[16][4];
#pragma unroll
        for (int i = 0; i < 16; ++i) {
            float y[8];
#pragma unroll
            for (int j = 0; j < 8; ++j) y[j] = bias[j];
#pragma unroll
            for (int k = 0; k < 4; ++k) { const u32x4 r = rows[i + k];
                y[0] += w[k][0] * bflo(r.x); y[1] += w[k][1] * bfhi(r.x); y[2] += w[k][2] * bflo(r.y); y[3] += w[k][3] * bfhi(r.y);
                y[4] += w[k][4] * bflo(r.z); y[5] += w[k][5] * bfhi(r.z); y[6] += w[k][6] * bflo(r.w); y[7] += w[k][7] * bfhi(r.w); }
            if (MODE == 1) {
#pragma unroll
                for (int j = 0; j < 8; ++j) y[j] = siluf_(y[j]); }
            outw[i][0] = pk2(y[0], y[1]); outw[i][1] = pk2(y[2], y[3]); outw[i][2] = pk2(y[4], y[5]); outw[i][3] = pk2(y[6], y[7]);
        }
        if (MODE == 0 || c0 >= 4096) {
            bf16* ob; int ldo, cc;
            if (MODE == 0) { ob = out0; ldo = C; cc = c0; } else if (c0 < 5120) { ob = out1; ldo = 1024; cc = c0 - 4096; } else { ob = out2; ldo = 1024; cc = c0 - 5120; }
#pragma unroll
            for (int i = 0; i < 16; ++i) *(u32x4*)(ob + (size_t)(t0 + i) * ldo + cc) = (u32x4){outw[i][0], outw[i][1], outw[i][2], outw[i][3]};
        } else {
            const int chunk = t0 >> 7, s0 = t0 & 127, head = c0 >> 6, p0 = c0 & 63;
            bf16* xb = out0 + ((size_t)(chunk * 64 + head) * 64 + p0) * 128 + s0;
#pragma unroll
            for (int j = 0; j < 8; ++j) {
                unsigned e[8];
#pragma unroll
                for (int q = 0; q < 8; ++q) { const unsigned a = outw[2 * q][j >> 1], b = outw[2 * q + 1][j >> 1];
                    e[q] = (j & 1) ? ((a >> 16) | (b & 0xffff0000u)) : ((a & 0xffffu) | (b << 16)); }
                *(u32x4*)(xb + (size_t)j * 128) = (u32x4){e[0], e[1], e[2], e[3]}; *(u32x4*)(xb + (size_t)j * 128 + 8) = (u32x4){e[4], e[5], e[6], e[7]};
            }
        }
    }
}

__device__ __forceinline__ void p_rg_scan_a(const Frame& F0, const bf16* LA, const bf16* INP, float* HEND, float* PROD) {
    const Frame F = phase_frame(F0);
    for (int it = F.gw; it < 128 * 2 * 4; it += F.ngw) {
        const int cb = it & 3, d = (it >> 2) & 1, ck = it >> 3, c0 = cb * 512 + F.lane * 8;
        const bf16* la = LA + (size_t)d * TG * D + (size_t)ck * 64 * D + c0; const bf16* ip = INP + (size_t)d * TG * D + (size_t)ck * 64 * D + c0;
        float h[8], ls[8];
#pragma unroll
        for (int j = 0; j < 8; ++j) { h[j] = 0.f; ls[j] = 0.f; }
#pragma unroll 8
        for (int i = 0; i < 64; ++i) { const int t = d ? 63 - i : i;
            const u32x4 lw = *(const u32x4*)(la + (size_t)t * D), iw = *(const u32x4*)(ip + (size_t)t * D);
            const float l[8] = {bflo(lw.x), bfhi(lw.x), bflo(lw.y), bfhi(lw.y), bflo(lw.z), bfhi(lw.z), bflo(lw.w), bfhi(lw.w)};
            const float x[8] = {bflo(iw.x), bfhi(iw.x), bflo(iw.y), bfhi(iw.y), bflo(iw.z), bfhi(iw.z), bflo(iw.w), bfhi(iw.w)};
#pragma unroll
            for (int j = 0; j < 8; ++j) { h[j] = __expf(l[j]) * h[j] + x[j]; ls[j] += l[j]; } }
        float* he = HEND + ((size_t)ck * 2 + d) * D + c0; float* pr = PROD + ((size_t)ck * 2 + d) * D + c0;
        *(f32x4*)he = (f32x4){h[0], h[1], h[2], h[3]}; *(f32x4*)(he + 4) = (f32x4){h[4], h[5], h[6], h[7]};
        *(f32x4*)pr = (f32x4){__expf(ls[0]), __expf(ls[1]), __expf(ls[2]), __expf(ls[3])}; *(f32x4*)(pr + 4) = (f32x4){__expf(ls[4]), __expf(ls[5]), __expf(ls[6]), __expf(ls[7])};
    }
}
__device__ __forceinline__ void p_rg_scan_b(const Frame& F0, const float* __restrict__ HEND, const float* __restrict__ PROD, float* __restrict__ HIN, int L) {
    const Frame F = phase_frame(F0);
    const int nck = L / 64, nseq = TG / L, total = nseq * 2 * D;
    for (int e = F.gw * 64 + F.lane; e < total; e += F.ngw * 64) {
        const int c = e % D, d = (e / D) & 1, sq = e / (2 * D);
        float h = 0.f;
        for (int k0 = 0; k0 < nck; k0 += 16) {
            float p[16], he[16];
#pragma unroll
            for (int j = 0; j < 16; ++j) { const int k = k0 + j, ck = sq * nck + (d ? nck - 1 - k : k); const size_t o = ((size_t)ck * 2 + d) * D + c; p[j] = PROD[o]; he[j] = HEND[o]; }
#pragma unroll
            for (int j = 0; j < 16; ++j) { const int k = k0 + j, ck = sq * nck + (d ? nck - 1 - k : k); const size_t o = ((size_t)ck * 2 + d) * D + c; HIN[o] = h; h = p[j] * h + he[j]; }
        }
    }
}
__device__ __forceinline__ void p_rg_scan_c(const Frame& F0, const bf16* LA, const bf16* INP, const float* HIN, const bf16* GATE, bf16* Y) {
    const Frame F = phase_frame(F0);
    for (int it = F.gw; it < 128 * 16; it += F.ngw) {
        const int cb = it & 15, ck = it >> 4, c0 = cb * 128 + F.lane * 2;
        const size_t base = (size_t)ck * 64 * D + c0;
        const unsigned* la0 = (const unsigned*)(LA + base); const unsigned* ip0 = (const unsigned*)(INP + base);
        const unsigned* la1 = (const unsigned*)(LA + (size_t)TG * D + base); const unsigned* ip1 = (const unsigned*)(INP + (size_t)TG * D + base);
        const unsigned* gt = (const unsigned*)(GATE + base); unsigned* yo = (unsigned*)(Y + base);
        f32x2 hf[64];
        { const f32x2 hi = *(const f32x2*)(HIN + ((size_t)ck * 2 + 0) * D + c0); float h0 = hi.x, h1 = hi.y;
#pragma unroll
          for (int t = 0; t < 64; ++t) { const unsigned lw = la0[(size_t)t * (D / 2)], iw = ip0[(size_t)t * (D / 2)];
              h0 = __expf(bflo(lw)) * h0 + bflo(iw); h1 = __expf(bfhi(lw)) * h1 + bfhi(iw); hf[t] = (f32x2){h0, h1}; } }
        { const f32x2 hi = *(const f32x2*)(HIN + ((size_t)ck * 2 + 1) * D + c0); float h0 = hi.x, h1 = hi.y;
#pragma unroll
          for (int i = 0; i < 64; ++i) { const int t = 63 - i; const unsigned lw = la1[(size_t)t * (D / 2)], iw = ip1[(size_t)t * (D / 2)], gw = gt[(size_t)t * (D / 2)];
              h0 = __expf(bflo(lw)) * h0 + bflo(iw); h1 = __expf(bfhi(lw)) * h1 + bfhi(iw);
              yo[(size_t)t * (D / 2)] = pk2((hf[t].x + h0) * bflo(gw), (hf[t].y + h1) * bfhi(gw)); } }
    }
}

constexpr int PB = 272;
__device__ __forceinline__ s16x4 tr_read(const LAS unsigned char* p) { return __builtin_bit_cast(s16x4, __builtin_amdgcn_ds_read_tr16_b64_v4i16((LAS v4i16_t*)p)); }
__device__ __forceinline__ bf16x8 cat8(s16x4 lo, s16x4 hi) { return __builtin_shufflevector(lo, hi, 0, 1, 2, 3, 4, 5, 6, 7); }
__device__ __forceinline__ bf16x8 scale8(bf16x8 v, const float* w) {
    const u32x4 u = __builtin_bit_cast(u32x4, v); u32x4 o;
    o.x = pk2(bflo(u.x) * w[0], bfhi(u.x) * w[1]); o.y = pk2(bflo(u.y) * w[2], bfhi(u.y) * w[3]); o.z = pk2(bflo(u.z) * w[4], bfhi(u.z) * w[5]); o.w = pk2(bflo(u.w) * w[6], bfhi(u.w) * w[7]);
    return __builtin_bit_cast(bf16x8, o);
}
__device__ __forceinline__ bf16x8 scale8s(bf16x8 v, float w) {
    const u32x4 u = __builtin_bit_cast(u32x4, v); u32x4 o;
    o.x = pk2(bflo(u.x) * w, bfhi(u.x) * w); o.y = pk2(bflo(u.y) * w, bfhi(u.y) * w); o.z = pk2(bflo(u.z) * w, bfhi(u.z) * w); o.w = pk2(bflo(u.w) * w, bfhi(u.w) * w);
    return __builtin_bit_cast(bf16x8, o);
}
__device__ __forceinline__ void stage_img(const Frame& F, const bf16* src, int ld, LAS unsigned char* img) {
#pragma unroll
    for (int i = 0; i < 4; ++i) { const int idx = F.tid + 512 * i, r = idx >> 4, ch = idx & 15; *(LAS u32x4*)(img + r * PB + ch * 16) = *(const u32x4*)(src + (size_t)r * ld + ch * 8); }
}
__device__ __forceinline__ void ssd_tables(const Frame& F, const float* DT, int t0, int head, float A0, float A1, LAS float* tab) {
    const int L = F.lane; const float* dp = DT + (size_t)(t0 + 2 * L) * 128 + head;
    const float a0 = dp[0], a1 = dp[128], b0 = dp[64], b1 = dp[128 + 64];
    float sa = a0 + a1, sb = b0 + b1, ia = sa, ib = sb;
#pragma unroll
    for (int o = 1; o < 64; o <<= 1) { const float xa = shfl_lane(ia, (L - o) & 63), xb = shfl_lane(ib, (L - o) & 63); if (L >= o) { ia += xa; ib += xb; } }
    const float totb = shfl_lane(ib, 63);
    const float ea = ia - sa, eb = ib - sb;
    tab[2 * L] = A0 * (ea + a0); tab[2 * L + 1] = A0 * (ea + a0 + a1);
    tab[128 + 2 * L] = A1 * (totb - eb); tab[128 + 2 * L + 1] = A1 * (totb - eb - b0);
    tab[256 + 2 * L] = a0; tab[256 + 2 * L + 1] = a1; tab[384 + 2 * L] = b0; tab[384 + 2 * L + 1] = b1;
}
__device__ __forceinline__ void p_ssd_states(const Frame& F0, const bf16* XT, const bf16* BMt, const float* DT, const float* alog, bf16* ST, float* DEC) {
    const Frame F = phase_frame(F0);
    LAS unsigned char* img = F.lds; LAS float* tab = (LAS float*)(F.lds + 36864 + F.wave * 2048);
    const int L = F.lane, h = L >> 5, l31 = L & 31, q = (L & 15) >> 2, p4 = L & 3, blk = (L >> 4) & 1;
    for (int it = blockIdx.x; it < 64 * 8; it += F.G) {
        const int c = it >> 3, g = it & 7, head = g * 8 + F.wave, t0 = c * 128;
        stage_img(F, BMt + (size_t)t0 * 1024 + g * 128, 1024, img);
        const float A0 = -__expf(alog[head]), A1 = -__expf(alog[64 + head]);
        ssd_tables(F, DT, t0, head, A0, A1, tab);
        __syncthreads();
        const float afe = tab[127], ab0 = tab[128];
        if (L == 0) { DEC[(c * 2 + 0) * 64 + head] = __expf(afe); DEC[(c * 2 + 1) * 64 + head] = __expf(ab0); }
        const bf16* xt = XT + (size_t)(c * 64 + head) * 64 * 128;
#pragma unroll 1
        for (int dir = 0; dir < 2; ++dir) {
            f32x16 acc[4][2];
#pragma unroll
            for (int a = 0; a < 4; ++a)
#pragma unroll
                for (int b = 0; b < 2; ++b)
#pragma unroll
                    for (int r = 0; r < 16; ++r) acc[a][b][r] = 0.f;
            const float eref = dir ? ab0 : afe;
#pragma unroll 2
            for (int ks = 0; ks < 8; ++ks) {
                const int s0 = 16 * ks + 8 * h;
                float w[8];
#pragma unroll
                for (int j = 0; j < 8; ++j) w[j] = __expf(eref - tab[dir * 128 + s0 + j]) * tab[256 + dir * 128 + s0 + j];
                bf16x8 bfr[2];
#pragma unroll
                for (int pt = 0; pt < 2; ++pt) bfr[pt] = scale8(*(const bf16x8*)(xt + (size_t)(32 * pt + l31) * 128 + s0), w);
#pragma unroll
                for (int nt = 0; nt < 4; ++nt) {
                    const LAS unsigned char* ad = img + (16 * ks + 8 * h + q) * PB + (32 * nt + 16 * blk + 4 * p4) * 2;
                    const bf16x8 afr = cat8(tr_read(ad), tr_read(ad + 4 * PB));
#pragma unroll
                    for (int pt = 0; pt < 2; ++pt) acc[nt][pt] = __builtin_amdgcn_mfma_f32_32x32x16_bf16(afr, bfr[pt], acc[nt][pt], 0, 0, 0);
                }
            }
            bf16* st = ST + ((size_t)(c * 2 + dir) * 64 + head) * 8192;
#pragma unroll
            for (int nt = 0; nt < 4; ++nt)
#pragma unroll
                for (int pt = 0; pt < 2; ++pt)
#pragma unroll
                    for (int qd = 0; qd < 4; ++qd) { u32x2 w2; w2.x = pk2(acc[nt][pt][4 * qd], acc[nt][pt][4 * qd + 1]); w2.y = pk2(acc[nt][pt][4 * qd + 2], acc[nt][pt][4 * qd + 3]);
                        *(u32x2*)(st + (size_t)(32 * pt + l31) * 128 + 32 * nt + 8 * qd + 4 * h) = w2; }
        }
        __syncthreads();
    }
}
__device__ __forceinline__ void p_ssd_rec(const Frame& F0, bf16* ST, const float* __restrict__ DEC, int L) {
    const Frame F = phase_frame(F0);
    const int nck = L / 128, nseq = TG / L, total = nseq * 131072;
    for (int e = F.gw * 64 + F.lane; e < total; e += F.ngw * 64) {
        const int oct = e & 1023, head = (e >> 10) & 63, dir = (e >> 16) & 1, sq = e >> 17;
        float hst[8];
#pragma unroll
        for (int j = 0; j < 8; ++j) hst[j] = 0.f;
        for (int k0 = 0; k0 < nck; k0 += 8) {
            u32x4 v[8]; float dec[8];
#pragma unroll
            for (int j = 0; j < 8; ++j) { const int k = k0 + j, c = sq * nck + (dir ? nck - 1 - k : k);
                v[j] = *(const u32x4*)(ST + ((size_t)(c * 2 + dir) * 64 + head) * 8192 + oct * 8); dec[j] = DEC[(c * 2 + dir) * 64 + head]; }
#pragma unroll
            for (int j = 0; j < 8; ++j) { const int k = k0 + j, c = sq * nck + (dir ? nck - 1 - k : k);
                u32x4 o; o.x = pk2(hst[0], hst[1]); o.y = pk2(hst[2], hst[3]); o.z = pk2(hst[4], hst[5]); o.w = pk2(hst[6], hst[7]);
                *(u32x4*)(ST + ((size_t)(c * 2 + dir) * 64 + head) * 8192 + oct * 8) = o;
                const float dc = dec[j]; const u32x4 x = v[j];
                hst[0] = hst[0] * dc + bflo(x.x); hst[1] = hst[1] * dc + bfhi(x.x); hst[2] = hst[2] * dc + bflo(x.y); hst[3] = hst[3] * dc + bfhi(x.y);
                hst[4] = hst[4] * dc + bflo(x.z); hst[5] = hst[5] * dc + bfhi(x.z); hst[6] = hst[6] * dc + bflo(x.w); hst[7] = hst[7] * dc + bfhi(x.w); }
        }
    }
}
__device__ __forceinline__ void p_ssd_out(const Frame& F0, const bf16* XT, const bf16* BMt, const bf16* CMt, const float* DT, const float* alog, const float* dskip, const bf16* ST,
                                          const bf16* ZS, const float* ng, bf16* Y) {
    const Frame F = phase_frame(F0);
    LAS unsigned char* imgB = F.lds; LAS unsigned char* imgC = F.lds + 34816; LAS float* tab = (LAS float*)(F.lds + 69632 + F.wave * 2048); LAS float* part = (LAS float*)(F.lds + 69632 + 16384);
    const int L0 = F.lane;
    for (int it = blockIdx.x; it < 64 * 8; it += F.G) {
        const int c = it >> 3, g = it & 7, head = g * 8 + F.wave, t0 = c * 128;
        stage_img(F, BMt + (size_t)t0 * 1024 + g * 128, 1024, imgB);
        stage_img(F, CMt + (size_t)t0 * 1024 + g * 128, 1024, imgC);
        const float A0 = -__expf(alog[head]), A1 = -__expf(alog[64 + head]), dsk = dskip[head];
        ssd_tables(F, DT, t0, head, A0, A1, tab);
        __syncthreads();
        const bf16* xt = XT + (size_t)(c * 64 + head) * 64 * 128;
#pragma unroll 1
        for (int half = 0; half < 2; ++half) {
            f32x16 acc[2][2];
#pragma unroll
            for (int a = 0; a < 2; ++a)
#pragma unroll
                for (int b = 0; b < 2; ++b)
#pragma unroll
                    for (int r = 0; r < 16; ++r) acc[a][b][r] = 0.f;
            { int L = L0; asm volatile("" : "+v"(L)); const int h = L >> 5, l31 = L & 31;
#pragma unroll 1
            for (int st = 0; st < 4; ++st) {
                bf16x8 xa[2][2];
#pragma unroll
                for (int ks = 0; ks < 2; ++ks)
#pragma unroll
                    for (int pt = 0; pt < 2; ++pt) { const bf16* xp = xt + (size_t)(32 * pt + l31) * 128 + 32 * st + 16 * ks + 4 * h;
                        const s16x4 lo = *(const s16x4*)xp, hi = *(const s16x4*)(xp + 8); xa[ks][pt] = cat8(lo, hi); }
#pragma unroll
                for (int tt = 0; tt < 2; ++tt) {
                    const int tg = 2 * half + tt;
                    f32x16 dg;
#pragma unroll
                    for (int r = 0; r < 16; ++r) dg[r] = 0.f;
#pragma unroll 2
                    for (int kn = 0; kn < 8; ++kn) { const bf16x8 a = *(const LAS bf16x8*)(imgB + (32 * st + l31) * PB + (16 * kn + 8 * h) * 2), b = *(const LAS bf16x8*)(imgC + (32 * tg + l31) * PB + (16 * kn + 8 * h) * 2);
                        dg = __builtin_amdgcn_mfma_f32_32x32x16_bf16(a, b, dg, 0, 0, 0); }
                    const int t = 32 * tg + l31; const float aft = tab[t], abt = tab[128 + t];
                    float v[16];
#pragma unroll
                    for (int qd = 0; qd < 4; ++qd) { const int sb = 32 * st + 8 * qd + 4 * h;
                        const f32x4 afs = *(const LAS f32x4*)(tab + sb), abs_ = *(const LAS f32x4*)(tab + 128 + sb), d0 = *(const LAS f32x4*)(tab + 256 + sb), d1 = *(const LAS f32x4*)(tab + 384 + sb);
#pragma unroll
                        for (int e = 0; e < 4; ++e) { const int s = sb + e; float m = 0.f;
                            if (s <= t) m += __expf(aft - afs[e]) * d0[e];
                            if (s >= t) m += __expf(abt - abs_[e]) * d1[e];
                            float x = dg[4 * qd + e] * m; if (s == t) x += dsk; v[4 * qd + e] = x; } }
                    bf16x8 gf[2];
#pragma unroll
                    for (int ks = 0; ks < 2; ++ks) { u32x4 o; o.x = pk2(v[8 * ks], v[8 * ks + 1]); o.y = pk2(v[8 * ks + 2], v[8 * ks + 3]); o.z = pk2(v[8 * ks + 4], v[8 * ks + 5]); o.w = pk2(v[8 * ks + 6], v[8 * ks + 7]); gf[ks] = __builtin_bit_cast(bf16x8, o); }
#pragma unroll
                    for (int pt = 0; pt < 2; ++pt)
#pragma unroll
                        for (int ks = 0; ks < 2; ++ks) acc[tt][pt] = __builtin_amdgcn_mfma_f32_32x32x16_bf16(xa[ks][pt], gf[ks], acc[tt][pt], 0, 0, 0);
                }
            }
            }
            { int L = L0; asm volatile("" : "+v"(L)); const int h = L >> 5, l31 = L & 31;
#pragma unroll 1
            for (int dir = 0; dir < 2; ++dir) {
                const bf16* hs = ST + ((size_t)(c * 2 + dir) * 64 + head) * 8192;
                float et[2];
#pragma unroll
                for (int tt = 0; tt < 2; ++tt) et[tt] = __expf(tab[dir * 128 + 32 * (2 * half + tt) + l31]);
#pragma unroll 2
                for (int kn = 0; kn < 8; ++kn) {
                    bf16x8 ha[2];
#pragma unroll
                    for (int pt = 0; pt < 2; ++pt) ha[pt] = *(const bf16x8*)(hs + (size_t)(32 * pt + l31) * 128 + 16 * kn + 8 * h);
#pragma unroll
                    for (int tt = 0; tt < 2; ++tt) { const bf16x8 cb = scale8s(*(const LAS bf16x8*)(imgC + (32 * (2 * half + tt) + l31) * PB + (16 * kn + 8 * h) * 2), et[tt]);
#pragma unroll
                        for (int pt = 0; pt < 2; ++pt) acc[tt][pt] = __builtin_amdgcn_mfma_f32_32x32x16_bf16(ha[pt], cb, acc[tt][pt], 0, 0, 0); }
                }
            }
            }
            { int L = L0; asm volatile("" : "+v"(L)); const int h = L >> 5, l31 = L & 31;
#pragma unroll
            for (int tt = 0; tt < 2; ++tt) { const size_t row = (size_t)(t0 + 32 * (2 * half + tt) + l31); float ssq = 0.f;
#pragma unroll
                for (int pt = 0; pt < 2; ++pt)
#pragma unroll
                    for (int qd = 0; qd < 4; ++qd) { const u32x2 z = *(const u32x2*)(ZS + row * SSD_DI + head * 64 + 32 * pt + 8 * qd + 4 * h);
                        const float y0 = acc[tt][pt][4 * qd] * bflo(z.x), y1 = acc[tt][pt][4 * qd + 1] * bfhi(z.x), y2 = acc[tt][pt][4 * qd + 2] * bflo(z.y), y3 = acc[tt][pt][4 * qd + 3] * bfhi(z.y);
                        acc[tt][pt][4 * qd] = y0; acc[tt][pt][4 * qd + 1] = y1; acc[tt][pt][4 * qd + 2] = y2; acc[tt][pt][4 * qd + 3] = y3; ssq += (y0 * y0 + y1 * y1) + (y2 * y2 + y3 * y3); }
                ssq += shfl_lane(ssq, L ^ 32);
                if (h == 0) part[F.wave * 64 + 32 * tt + l31] = ssq; }
            __syncthreads();
#pragma unroll
            for (int tt = 0; tt < 2; ++tt) { const int tl = 32 * tt + l31; const size_t row = (size_t)(t0 + 64 * half + tl); float tot = 0.f;
#pragma unroll
                for (int w = 0; w < 8; ++w) tot += part[w * 64 + tl];
                const float rstd = rsqrtf(tot * (1.0f / 512.0f) + LN_EPS);
#pragma unroll
                for (int pt = 0; pt < 2; ++pt)
#pragma unroll
                    for (int qd = 0; qd < 4; ++qd) { const int cc = head * 64 + 32 * pt + 8 * qd + 4 * h; const f32x4 gg = *(const f32x4*)(ng + cc);
                        u32x2 o; o.x = pk2(acc[tt][pt][4 * qd] * rstd * gg.x, acc[tt][pt][4 * qd + 1] * rstd * gg.y); o.y = pk2(acc[tt][pt][4 * qd + 2] * rstd * gg.z, acc[tt][pt][4 * qd + 3] * rstd * gg.w);
                        *(u32x2*)(Y + row * SSD_DI + cc) = o; } }
            }
            __syncthreads();
        }
    }
}

constexpr int NA_STG = 2 * 64 * PB;
__device__ __forceinline__ void p_natt(const Frame& F0, const bf16* Q, const bf16* Kb, const bf16* V, const float* rpb, bf16* O, int L) {
    const Frame F = phase_frame(F0);
    LAS unsigned char* ringb = F.lds;
    LAS float* rp = (LAS float*)(F.lds + 3 * NA_STG);
    const int Ln = F.lane, g = Ln >> 4, l15 = Ln & 15, q4 = l15 >> 2, p4 = Ln & 3;
    const int rps = L / 64, nrb = 128 / 4;
    const int wrow = F.wave >> 1, chf = F.wave & 1;
    for (int it = blockIdx.x; it < nrb * 16; it += F.G) {
        const int head = it & 15, rb = it >> 4, grow0 = rb * 4, sq = grow0 / rps, r0 = grow0 % rps;
        const size_t rowbase = (size_t)sq * rps * 64;
        int klo = r0 - 4; klo = klo < 0 ? 0 : (klo > rps - 8 ? rps - 8 : klo);
        int khi = r0 + 3 - 4; khi = khi < 0 ? 0 : (khi > rps - 8 ? rps - 8 : khi); khi += 7;
        const int nst = khi - klo + 1;
        const int r = r0 + wrow; int rs = r - 4; rs = rs < 0 ? 0 : (rs > rps - 8 ? rps - 8 : rs);
        for (int i = F.tid; i < 465; i += NTHR) rp[i] = rpb[(size_t)head * 465 + i];
        u32x4 st0[4], st1[4];
        auto gload = [&](u32x4 (&d)[4], int s) {
#pragma unroll
            for (int i = 0; i < 2; ++i) { const int idx = F.tid + 512 * i, key = idx >> 4, ch = idx & 15; const size_t off = (rowbase + (size_t)(klo + s) * 64 + key) * D + head * 128 + ch * 8;
                d[i] = *(const u32x4*)(Kb + off); d[2 + i] = *(const u32x4*)(V + off); } };
        auto lstore = [&](const u32x4 (&d)[4], int s) { LAS unsigned char* b = ringb + (s % 3) * NA_STG;
#pragma unroll
            for (int i = 0; i < 2; ++i) { const int idx = F.tid + 512 * i, key = idx >> 4, ch = idx & 15; *(LAS u32x4*)(b + key * PB + ch * 16) = d[i]; *(LAS u32x4*)(b + 64 * PB + key * PB + ch * 16) = d[2 + i]; } };
        gload(st0, 0); gload(st1, 1);
        bf16x8 qf[2][4];
#pragma unroll
        for (int jt = 0; jt < 2; ++jt)
#pragma unroll
            for (int kd = 0; kd < 4; ++kd) qf[jt][kd] = *(const bf16x8*)(Q + (rowbase + (size_t)r * 64 + 16 * (2 * chf + jt) + l15) * D + head * 128 + 32 * kd + 8 * g);
        lstore(st0, 0); lstore(st1, 1);
        gload(st0, 2); if (nst > 3) gload(st1, 3);
        float mrun[2] = {-3.0e38f, -3.0e38f}, lrun[2] = {0.f, 0.f};
        f32x4 oacc[2][8];
#pragma unroll
        for (int jt = 0; jt < 2; ++jt)
#pragma unroll
            for (int dt = 0; dt < 8; ++dt) oacc[jt][dt] = (f32x4){0.f, 0.f, 0.f, 0.f};
        __syncthreads();
#pragma unroll 1
        for (int s = 0; s < nst; ++s) {
            const int kr = klo + s;
            const LAS unsigned char* kb = ringb + (s % 3) * NA_STG; const LAS unsigned char* vb = kb + 64 * PB;
            if (kr >= rs && kr <= rs + 7) {
                const int dy = kr - r + 7;
                int Lq = Ln; asm volatile("" : "+v"(Lq));
                const int g = Lq >> 4, l15 = Lq & 15, q4 = l15 >> 2, p4 = Lq & 3;
#pragma unroll
                for (int jt = 0; jt < 2; ++jt) {
                    const int j = 2 * chf + jt, kstart = (j == 0) ? 0 : (j == 1 ? 8 : (j == 2 ? 24 : 32)), qcol = 16 * j + l15;
                    int wst = qcol - 8; wst = wst < 0 ? 0 : (wst > 48 ? 48 : wst);
                    f32x4 sA = {0.f, 0.f, 0.f, 0.f}, sB = {0.f, 0.f, 0.f, 0.f};
                    const LAS unsigned char* ka = kb + (kstart + 8 * q4 + p4) * PB + 16 * g;
#pragma unroll
                    for (int kd = 0; kd < 4; ++kd) { const bf16x8 fa = *(const LAS bf16x8*)(ka + 64 * kd), fb = *(const LAS bf16x8*)(ka + 4 * PB + 64 * kd);
                        sA = __builtin_amdgcn_mfma_f32_16x16x32_bf16(fa, qf[jt][kd], sA, 0, 0, 0); sB = __builtin_amdgcn_mfma_f32_16x16x32_bf16(fb, qf[jt][kd], sB, 0, 0, 0); }
                    float sv[8]; float mx = mrun[jt];
#pragma unroll
                    for (int e = 0; e < 8; ++e) { const int kcol = kstart + 8 * g + e; const bool ok = (kcol >= wst) && (kcol < wst + 16);
                        int dx = kcol - qcol + 15; dx = dx < 0 ? 0 : (dx > 30 ? 30 : dx);
                        const float x = (e < 4 ? sA[e] : sB[e - 4]) + rp[dy * 31 + dx]; sv[e] = ok ? x : -3.0e38f; mx = fmaxf(mx, sv[e]); }
                    mx = fmaxf(mx, shfl_lane(mx, Lq ^ 16)); mx = fmaxf(mx, shfl_lane(mx, Lq ^ 32));
                    const float alpha = __expf(mrun[jt] - mx); mrun[jt] = mx;
                    float ps = 0.f;
#pragma unroll
                    for (int e = 0; e < 8; ++e) { sv[e] = __expf(sv[e] - mx); ps += sv[e]; }
                    ps += shfl_lane(ps, Lq ^ 16); ps += shfl_lane(ps, Lq ^ 32);
                    lrun[jt] = lrun[jt] * alpha + ps;
                    u32x4 pw; pw.x = pk2(sv[0], sv[1]); pw.y = pk2(sv[2], sv[3]); pw.z = pk2(sv[4], sv[5]); pw.w = pk2(sv[6], sv[7]);
                    const bf16x8 pf = __builtin_bit_cast(bf16x8, pw);
                    const LAS unsigned char* va = vb + (kstart + 8 * g + q4) * PB + 8 * p4;
#pragma unroll
                    for (int dt = 0; dt < 8; ++dt) { const bf16x8 vf = cat8(tr_read(va + 32 * dt), tr_read(va + 4 * PB + 32 * dt));
                        oacc[jt][dt] = oacc[jt][dt] * alpha; oacc[jt][dt] = __builtin_amdgcn_mfma_f32_16x16x32_bf16(vf, pf, oacc[jt][dt], 0, 0, 0); }
                }
            }
            if (s + 2 < nst) { if (s & 1) lstore(st1, s + 2); else lstore(st0, s + 2); }
            if (s + 4 < nst) { if (s & 1) gload(st1, s + 4); else gload(st0, s + 4); }
            __syncthreads();
        }
#pragma unroll
        for (int jt = 0; jt < 2; ++jt) { const float inv = frcp_(lrun[jt]); bf16* op = O + (rowbase + (size_t)r * 64 + 16 * (2 * chf + jt) + l15) * D + head * 128 + 4 * g;
#pragma unroll
            for (int dt = 0; dt < 8; ++dt) { u32x2 o; o.x = pk2(oacc[jt][dt][0] * inv, oacc[jt][dt][1] * inv); o.y = pk2(oacc[jt][dt][2] * inv, oacc[jt][dt][3] * inv); *(u32x2*)(op + 16 * dt) = o; } }
    }
}

struct Args { const float* in[29]; float* out; unsigned char* ws; int g_lo, g_hi, l_lo, l_hi, ph, pad; };

__global__ void __launch_bounds__(NTHR, 2) enc_fwd(Args args) {
    extern __shared__ __attribute__((aligned(16))) unsigned char lds[];
    Frame F;
    F.lds = (LAS unsigned char*)lds;
    F.tid = threadIdx.x; F.lane = F.tid & 63; F.wave = __builtin_amdgcn_readfirstlane(F.tid >> 6);
    F.G = gridDim.x; F.gw = blockIdx.x * NWAVES + F.wave; F.ngw = F.G * NWAVES;
    unsigned char* ws = args.ws;
    gu32* ctl = (gu32*)(ws + WS_CTL);
    for (int u = F.tid; u < (LDS_BYTES - LDSCTL_OFF) / 4; u += NTHR) ((LAS unsigned*)(F.lds + LDSCTL_OFF))[u] = 0u;
    __syncthreads();
    const int ph = args.ph;
    XcdBarrier bar; bar.bar = (unsigned*)(ctl + CW_BAR); bar.x = 0; bar.st = nullptr;
    if (ph < 0) bar = xcd_barrier_post((unsigned*)(ctl + CW_BAR), (volatile LAS unsigned*)(F.lds + MISC_OFF) + 8);
#define RUN(k) (ph < 0 || ph == (k))
#ifndef PROBE_MASK
#define PROBE_MASK 0
#endif
#define NREP(bit) (((PROBE_MASK >> (bit)) & 1) ? 2 : 1)
#define REPEAT(bit) _Pragma("unroll 1") for (int rep = 0; rep < NREP(bit); ++rep)
    float* XDUM = (float*)(ws + WS_SCR + S_DUM); bf16* XBDUM = (bf16*)(ws + WS_SCR + S_DUM + 64 * MiB);
#define GRID_BAR() do { if (ph < 0) xcd_barrier(bar); } while (0)

    bf16* Wb = (bf16*)(ws + WS_W);
    unsigned char* scr = ws + WS_SCR;
    bf16* XB = (bf16*)(scr + S_XB); bf16* YB = (bf16*)(scr + S_YB); bf16* HB = (bf16*)(scr + S_HID);
    LAS unsigned char* ring = F.lds;

    if (RUN(0) && args.g_lo == 0 && args.l_lo == 0) { p_prologue(F, args.in, Wb, (float*)(ws + WS_SPT), (bf16*)(scr + S_XB0)); GRID_BAR(); }

    for (int grp = args.g_lo; grp < args.g_hi; ++grp) {
        float* X = args.out + (size_t)grp * TG * D;
        const int L = grp < 2 ? 2048 : 8192;
        const float* Xin0 = grp < 2 ? args.in[0] + (size_t)grp * TG * D : args.in[1] + (size_t)(grp - 2) * TG * D;
        const bf16* XB0g = (const bf16*)(scr + S_XB0) + (size_t)grp * TG * D;
        for (int layer = args.l_lo; layer < args.l_hi; ++layer) {
            const int kind = layer % 3, jl = layer / 3;
            int Kout = 2048; const bf16* Wout; const bf16* XA = layer == 0 ? XB0g : XB;
            if (kind == 0) {
                bf16* GATE = (bf16*)(scr + S_RG_GATE); bf16* URAW = (bf16*)(scr + S_RG_URAW); bf16* U = (bf16*)(scr + S_RG_U); bf16* LA = (bf16*)(scr + S_RG_LA); bf16* INP = (bf16*)(scr + S_RG_INP);
                float* HEND = (float*)(scr + S_RG_HEND); float* PROD = (float*)(scr + S_RG_PROD); float* HIN = (float*)(scr + S_RG_HIN);
                if (RUN(10)) REPEAT(1) { pg8::Gemm g{XA, Wb + W_RGIN + (size_t)jl * 4096 * 2048, 2048, 2048, 2048, 0}; pg8::StaticOrder S; S.init(TG, 4096, F.G, (int)blockIdx.x);
                    pg8::EpiRgIn E{GATE, URAW}; pg8::gemm_phase<pg8::EpiRgIn>(ring, g, S, E); GRID_BAR(); }
                if (RUN(11)) REPEAT(3) { p_conv<0>(F, URAW, 2048, L, args.in[3] + (size_t)jl * 4 * 2048, args.in[4] + (size_t)jl * 2048, U, nullptr, nullptr); GRID_BAR(); }
                if (RUN(12)) REPEAT(1) { pg8::Gemm g{U, Wb + W_RGGATE + (size_t)jl * 32 * 65536, 2048, 256, 256, 1}; pg8::StaticOrder S; S.init(TG, 32 * 256, F.G, (int)blockIdx.x);
                    pg8::EpiRgGates E{U, LA, INP, args.in[6] + (size_t)jl * 2 * 2048, args.in[8] + (size_t)jl * 2 * 2048, (const float*)(ws + WS_SPT) + (size_t)jl * 2 * 2048};
                    pg8::gemm_phase<pg8::EpiRgGates>(ring, g, S, E); GRID_BAR(); }
                if (RUN(13)) REPEAT(3) { p_rg_scan_a(F, LA, INP, HEND, PROD); GRID_BAR(); }
                if (RUN(14)) REPEAT(3) { p_rg_scan_b(F, HEND, PROD, HIN, L); GRID_BAR(); }
                if (RUN(15)) REPEAT(3) { p_rg_scan_c(F, LA, INP, HIN, GATE, YB); GRID_BAR(); }
                Wout = Wb + W_RGOUT + (size_t)jl * 2048 * 2048;
            } else if (kind == 1) {
                bf16* ZS = (bf16*)(scr + S_SSD_ZS); bf16* XBCR = (bf16*)(scr + S_SSD_XBCR); bf16* XT = (bf16*)(scr + S_SSD_XT); bf16* BMt = (bf16*)(scr + S_SSD_BM); bf16* CMt = (bf16*)(scr + S_SSD_CM);
                float* DT = (float*)(scr + S_SSD_DT); float* DEC = (float*)(scr + S_SSD_DEC); bf16* ST = (bf16*)(scr + S_SSD_ST);
                if (RUN(20)) REPEAT(1) { pg8::Gemm g{XA, Wb + W_SSDIN, 2048, 2048, 2048, 0}; pg8::StaticOrder S; S.init(TG, SSD_NIN_PAD, F.G, (int)blockIdx.x);
                    pg8::EpiSsdIn E{ZS, XBCR, DT, args.in[14]}; pg8::gemm_phase<pg8::EpiSsdIn>(ring, g, S, E); GRID_BAR(); }
                if (RUN(21)) REPEAT(4) { p_conv<1>(F, XBCR, SSD_XBC, L, args.in[12], args.in[13], XT, BMt, CMt); GRID_BAR(); }
                if (RUN(22)) REPEAT(4) { p_ssd_states(F, XT, BMt, DT, args.in[15], ST, DEC); GRID_BAR(); }
                if (RUN(23)) { p_ssd_rec(F, ST, DEC, L); GRID_BAR(); }
                if (RUN(24)) REPEAT(4) { p_ssd_out(F, XT, BMt, CMt, DT, args.in[15], args.in[16], ST, ZS, args.in[17], YB); GRID_BAR(); }
                Wout = Wb + W_SSDOUT; Kout = 4096;
            } else {
                bf16* Qb = (bf16*)(scr + S_NA_Q); bf16* Kb = (bf16*)(scr + S_NA_K); bf16* Vb = (bf16*)(scr + S_NA_V);
                if (RUN(30)) REPEAT(1) { pg8::Gemm g{XA, Wb + W_NAQKV, 2048, 2048, 2048, 0}; pg8::StaticOrder S; S.init(TG, 6144, F.G, (int)blockIdx.x);
                    pg8::EpiQkv E{Qb, args.in[20]}; pg8::gemm_phase<pg8::EpiQkv>(ring, g, S, E); GRID_BAR(); }
                if (RUN(31)) REPEAT(5) { p_natt(F, Qb, Kb, Vb, args.in[21], YB, L); GRID_BAR(); }
                Wout = Wb + W_NAOUT;
            }
            unsigned long long* xslot = (unsigned long long*)(ws + WS_XSLOT); unsigned* pcnt = (unsigned*)(ctl + CW_SEAM); unsigned* ptmo = (unsigned*)(ctl + CW_TMO);
            const unsigned ep = (unsigned)((grp * DEPTH + layer) * 2);
            if (RUN(40)) { pg8::Gemm g{YB, Wout, Kout, Kout, Kout, 0}; pg8::StaticOrder S; S.init(TG, D, F.G, (int)blockIdx.x);
                pg8::EpiResidLn E{layer == 0 ? Xin0 : X, X, XB, args.in[25] + (size_t)layer * D, args.in[26] + (size_t)layer * D, ALPHA, xslot, pcnt, 64u * (ep + 1u), ptmo};
                pg8::gemm_phase<pg8::EpiResidLn>(ring, g, S, E); GRID_BAR(); }
            if (RUN(42)) REPEAT(6) { pg8::Gemm g{XB, Wb + W_UP + (size_t)layer * 8192 * 2048, 2048, 2048, 2048, 0}; pg8::StaticOrder S; S.init(TG, HID, F.G, (int)blockIdx.x);
                pg8::EpiRelu2 E{HB, HID}; pg8::gemm_phase<pg8::EpiRelu2>(ring, g, S, E); GRID_BAR(); }
            if (RUN(43)) { pg8::Gemm g{HB, Wb + W_DOWN + (size_t)layer * 2048 * 8192, 8192, 8192, 8192, 0}; pg8::StaticOrder S; S.init(TG, D, F.G, (int)blockIdx.x);
                pg8::EpiResidLn E{X, X, XB, args.in[27] + (size_t)layer * D, args.in[28] + (size_t)layer * D, ALPHA, xslot, pcnt, 64u * (ep + 2u), ptmo};
                pg8::gemm_phase<pg8::EpiResidLn>(ring, g, S, E); GRID_BAR(); }
        }
    }
#undef RUN
#undef GRID_BAR
}

extern "C" void kernel_launch(void* const* d_in, const int* in_sizes, int n_in, void* d_out, int out_size, void* d_ws, size_t ws_size, hipStream_t stream) {
    static int grid = 0;
    if (grid == 0) {
        if (n_in != 29 || out_size != NGROUP * TG * D || ws_size < WS_NEED) { fprintf(stderr, "kernel_launch: unexpected problem (n_in %d, out %d, ws %zu, need %zu)\n", n_in, out_size, ws_size, (size_t)WS_NEED); grid = -1; return; }
        int dev = 0, cus = 0, per_cu = 0;
        if (hipGetDevice(&dev) != hipSuccess || hipDeviceGetAttribute(&cus, hipDeviceAttributeMultiprocessorCount, dev) != hipSuccess) { grid = -1; return; }
        if (hipFuncSetAttribute((const void*)enc_fwd, hipFuncAttributeMaxDynamicSharedMemorySize, LDS_BYTES) != hipSuccess) { fprintf(stderr, "kernel_launch: hipFuncSetAttribute failed\n"); grid = -1; return; }
        if (hipOccupancyMaxActiveBlocksPerMultiprocessor(&per_cu, (const void*)enc_fwd, NTHR, LDS_BYTES) != hipSuccess || per_cu < 1) { fprintf(stderr, "kernel_launch: occupancy query says %d\n", per_cu); }
        (void)hipGetLastError();
        grid = cus;
        if (grid != 256) { fprintf(stderr, "kernel_launch: built for 256 CUs (one 256x256 tile per workgroup in the fused LayerNorm phases), got %d\n", cus); grid = -1; return; }
    }
    if (grid < 0) return;
    (void)hipMemsetAsync((char*)d_ws + WS_CTL, 0, CTL_ZERO_BYTES, stream);
    Args a{};
    for (int i = 0; i < 29; ++i) a.in[i] = (const float*)d_in[i];
    a.out = (float*)d_out; a.ws = (unsigned char*)d_ws; a.pad = 0;
#if MK_N_LAUNCHES == 1
    a.g_lo = 0; a.g_hi = NGROUP; a.l_lo = 0; a.l_hi = DEPTH; a.ph = -1;
    hipLaunchKernelGGL(enc_fwd, dim3(grid), dim3(NTHR), LDS_BYTES, stream, a);
#else
    auto launch = [&](int g, int l, int ph) { a.g_lo = g; a.g_hi = g + 1; a.l_lo = l; a.l_hi = l + 1; a.ph = ph; hipLaunchKernelGGL(enc_fwd, dim3(grid), dim3(NTHR), LDS_BYTES, stream, a); };
    launch(0, 0, 0);
    for (int g = 0; g < NGROUP; ++g) {
        for (int l = 0; l < DEPTH; ++l) {
            const int kind = l % 3;
            if (kind == 0) for (int p = 10; p <= 15; ++p) launch(g, l, p);
            else if (kind == 1) for (int p = 20; p <= 24; ++p) launch(g, l, p);
            else for (int p = 30; p <= 31; ++p) launch(g, l, p);
            launch(g, l, 40); launch(g, l, 42); launch(g, l, 43);
        }
    }
#endif
}
```

```cpp
#include <hip/hip_runtime.h>
#include <cstdio>
#include <cstdint>

#ifndef WGM_UP
#define WGM_UP 8
#endif
#ifndef WGM_DOWN
#define WGM_DOWN 8
#endif

#define LAS __attribute__((address_space(3)))
#define GAS __attribute__((address_space(1)))
typedef unsigned short bf16;
typedef short bf16x8 __attribute__((ext_vector_type(8)));
typedef short s16x4 __attribute__((ext_vector_type(4)));
typedef float f32x2 __attribute__((ext_vector_type(2)));
typedef float f32x4 __attribute__((ext_vector_type(4)));
typedef float f32x16 __attribute__((ext_vector_type(16)));
typedef unsigned u32x2 __attribute__((ext_vector_type(2)));
typedef unsigned u32x4 __attribute__((ext_vector_type(4)));
typedef __bf16 bf16x2_t __attribute__((ext_vector_type(2)));
typedef short v4i16_t __attribute__((ext_vector_type(4)));
typedef GAS unsigned gu32;

constexpr int D = 2048, TG = 8192, NGROUP = 6, DEPTH = 4, NWAVES = 8, NTHR = 512;
constexpr int HID = 8192;
constexpr int SSD_DI = 4096, SSD_NH = 64, SSD_NG = 8, SSD_NS = 128, SSD_CH = 128, SSD_XBC = 6144, SSD_NIN = 10368, SSD_NIN_PAD = 10496;
constexpr int NA_H = 16, NA_HD = 128;
constexpr float ALPHA = 1.681792830507429f, LN_EPS = 1e-5f;

constexpr size_t MiB = 1u << 20;
constexpr size_t WS_CTL = 0, CTL_ZERO_BYTES = 256 * 1024;
constexpr size_t WS_XSLOT = 1 * MiB;
constexpr size_t WS_W = 2 * MiB;
constexpr size_t W_RGIN = 0;
constexpr size_t W_RGGATE = W_RGIN + 2ull * 4096 * 2048;
constexpr size_t W_RGOUT = W_RGGATE + 2ull * 32 * 256 * 256;
constexpr size_t W_SSDIN = W_RGOUT + 2ull * 2048 * 2048;
constexpr size_t W_SSDOUT = W_SSDIN + (size_t)SSD_NIN_PAD * 2048;
constexpr size_t W_NAQKV = W_SSDOUT + 2048ull * 4096;
constexpr size_t W_NAOUT = W_NAQKV + 6144ull * 2048;
constexpr size_t W_UP = W_NAOUT + 2048ull * 2048;
constexpr size_t W_DOWN = W_UP + 4ull * 8192 * 2048;
constexpr size_t W_END = W_DOWN + 4ull * 8192 * 2048;
constexpr size_t WS_SCR = ((WS_W + W_END * 2 + MiB - 1) / MiB) * MiB;
constexpr size_t S_XB = 0;
constexpr size_t S_YB = 32 * MiB;
constexpr size_t S_MIX = 96 * MiB;
constexpr size_t S_HID = S_MIX;
constexpr size_t S_RG_GATE = S_MIX, S_RG_URAW = S_MIX + 32 * MiB, S_RG_LA = S_MIX + 96 * MiB  , S_RG_INP = S_MIX + 160 * MiB  ;
constexpr size_t S_RG_HEND = S_MIX + 224 * MiB, S_RG_PROD = S_MIX + 226 * MiB, S_RG_HIN = S_MIX + 228 * MiB;
constexpr size_t S_SSD_ZS = S_MIX, S_SSD_XBCR = S_MIX + 64 * MiB, S_SSD_XT = S_MIX + 160 * MiB, S_SSD_BM = S_MIX + 224 * MiB, S_SSD_CM = S_MIX + 240 * MiB;
constexpr size_t S_SSD_DT = S_MIX + 256 * MiB, S_SSD_DEC = S_MIX + 260 * MiB, S_SSD_ST = S_MIX + 261 * MiB;
constexpr size_t S_NA_Q = S_MIX, S_NA_K = S_MIX + 32 * MiB, S_NA_V = S_MIX + 64 * MiB;
constexpr size_t S_END = S_MIX + 389 * MiB;
constexpr size_t S_XB0 = S_END;
constexpr size_t S_DUM = S_XB0 + 192 * MiB;
#ifndef PROBE_MASK
#define PROBE_MASK 0
#endif
constexpr size_t WS_NEED = WS_SCR + S_DUM + (PROBE_MASK ? 96 * MiB : 0);

constexpr int CW_BAR = 4096;
constexpr int CW_SEAM = 16384;
constexpr int CW_TMO = 0;
constexpr int CW_CHK = 1024;
constexpr size_t WS_SPT = 512 * 1024;

constexpr int RING_BYTES = 131072;
constexpr int LDSCTL_OFF = RING_BYTES, MISC_OFF = LDSCTL_OFF + 320;
constexpr int LDS_BYTES = 147456;

#define RLX_AGENT __ATOMIC_RELAXED, __HIP_MEMORY_SCOPE_AGENT
#define LDS_WAIT() asm volatile("s_waitcnt lgkmcnt(0)" ::: "memory")
#define VM_WAIT() asm volatile("s_waitcnt vmcnt(0)" ::: "memory")
__device__ __forceinline__ unsigned pk2(float lo, float hi) { f32x2 v = {lo, hi}; bf16x2_t b = __builtin_convertvector(v, bf16x2_t); return __builtin_bit_cast(unsigned, b); }
__device__ __forceinline__ float bflo(unsigned w) { return __uint_as_float(w << 16); }
__device__ __forceinline__ float bfhi(unsigned w) { return __uint_as_float(w & 0xffff0000u); }
__device__ __forceinline__ float bf2f(bf16 b) { return __uint_as_float(((unsigned)b) << 16); }
__device__ __forceinline__ float frcp_(float x) { return __builtin_amdgcn_rcpf(x); }
__device__ __forceinline__ float fsqrt_(float x) { return __builtin_amdgcn_sqrtf(x); }
__device__ __forceinline__ float sigmoidf_(float x) { return frcp_(1.0f + __expf(-x)); }
__device__ __forceinline__ float siluf_(float x) { return x * frcp_(1.0f + __expf(-x)); }
__device__ __forceinline__ float gelu_tanh_(float v) { const float u = 1.5957691216057308f * (v + 0.044715f * v * v * v); return v * frcp_(1.0f + __expf(-u)); }
__device__ __forceinline__ float softplusf_(float v) { return v > 20.f ? v : log1pf(__expf(v)); }
__device__ __forceinline__ float shfl_lane(float v, int srclane) { return __int_as_float(__builtin_amdgcn_ds_bpermute(srclane << 2, __float_as_int(v))); }
__device__ __forceinline__ float wave_sum(float v, int lane) {
#pragma unroll
    for (int o = 1; o < 64; o <<= 1) v += shfl_lane(v, lane ^ o);
    return v;
}

#define XB_TMO      128
#define XB_XCNT(j)  (256  + 64 * (j))
#define XB_XSUB(j)  (1280 + 64 * (j))
#define XB_XGEN(j)  (2304 + 64 * (j))
#define XB_TOP      3328
#define XB_TOPGEN   3392
#define XCD_BAR_WORDS 3456
#define XB_SPIN_CAP (1u << 22)

__device__ __forceinline__ unsigned xb_ld(unsigned* p)              { return __hip_atomic_load(p, __ATOMIC_RELAXED, __HIP_MEMORY_SCOPE_AGENT); }
__device__ __forceinline__ unsigned xb_add(unsigned* p, unsigned v) { return __hip_atomic_fetch_add(p, v, __ATOMIC_RELAXED, __HIP_MEMORY_SCOPE_AGENT); }
__device__ __forceinline__ unsigned xb_xcc_id() { return (unsigned)__builtin_amdgcn_s_getreg((3 << 11) | 20) & 0xFu; }
#define XB_SPIN(cond, bar) do { unsigned _sp = 0; while (cond) { __builtin_amdgcn_s_sleep(1); \
    if ((++_sp & 255u) == 0u) { if (xb_ld(&(bar)[XB_TMO])) break; if (_sp > XB_SPIN_CAP) { atomicAdd(&(bar)[XB_TMO], 1u); break; } } } } while (0)

struct XcdBarrier { unsigned* bar; unsigned x; volatile LAS unsigned* st; };

__device__ __forceinline__ XcdBarrier xcd_barrier_post(unsigned* bar, volatile LAS unsigned* st) {
    XcdBarrier b; b.bar = bar; b.x = xb_xcc_id(); b.st = st;
    if (threadIdx.x == 0) (void)xb_add(&bar[XB_XCNT(b.x)], 1u);
    return b;
}
__device__ __forceinline__ void xcd_barrier_complete(unsigned* bar, unsigned x, unsigned& nloc, unsigned& nx) {
    const unsigned G = gridDim.x * gridDim.y * gridDim.z;
    unsigned sum, cnt, mine, sp = 0u;
    for (;;) {
        sum = 0u; cnt = 0u; mine = 0u;
#pragma unroll
        for (unsigned j = 0; j < 16; ++j) { const unsigned c = xb_ld(&bar[XB_XCNT(j)]); sum += c; cnt += (c > 0u) ? 1u : 0u; mine = (j == x) ? c : mine; }
        if (sum == G) break;
        __builtin_amdgcn_s_sleep(1);
        if ((++sp & 255u) == 0u) { if (xb_ld(&bar[XB_TMO])) break; if (sp > XB_SPIN_CAP) { atomicAdd(&bar[XB_TMO], 1u); break; } }
    }
    nloc = mine > 0u ? mine : 1u; nx = cnt > 0u ? cnt : 1u;
}
__device__ __forceinline__ void xcd_barrier(const XcdBarrier& b) {
    asm volatile("s_waitcnt vmcnt(0)" ::: "memory");
    __syncthreads();
    if (threadIdx.x == 0) {
        unsigned* bar = b.bar;
        __builtin_amdgcn_s_waitcnt(0);
        unsigned nloc = b.st[0], nx = b.st[1];
        if (nloc == 0u) { xcd_barrier_complete(bar, b.x, nloc, nx); b.st[0] = nloc; b.st[1] = nx; }
        const unsigned old = xb_add(&bar[XB_XSUB(b.x)], 1u);
        const unsigned gen = old / nloc;
        if (old + 1u == (gen + 1u) * nloc) {
            __builtin_amdgcn_fence(__ATOMIC_RELEASE, "agent");
            asm volatile("s_waitcnt vmcnt(0)" ::: "memory");
            const unsigned og = xb_add(&bar[XB_TOP], 1u);
            const unsigned tg = og / nx;
            if (og + 1u == (tg + 1u) * nx) xb_add(&bar[XB_TOPGEN], 1u);
            else XB_SPIN(xb_ld(&bar[XB_TOPGEN]) == tg, bar);
            __builtin_amdgcn_fence(__ATOMIC_ACQUIRE, "agent");
            xb_add(&bar[XB_XGEN(b.x)], 1u);
            asm volatile("s_waitcnt vmcnt(0)" ::: "memory");
        } else {
            XB_SPIN(xb_ld(&bar[XB_XGEN(b.x)]) == gen, bar);
            __builtin_amdgcn_fence(__ATOMIC_ACQUIRE, "agent");
            asm volatile("s_waitcnt vmcnt(0)" ::: "memory");
        }
    }
    __syncthreads();
}

namespace pg8 {
constexpr int BM = 256, BK = 64, HALF = 128, HTB = HALF * BK * 2, STAGE_BYTES = 8 * HTB, NXCD = 8, WGM = 8;
__host__ __device__ __forceinline__ int lds_byte(int r, int c) { const int st = (r >> 4) * 2 + (c >> 5), rr = r & 15, cc = c & 31, ob = rr * 64 + cc * 2; return st * 1024 + (ob ^ (((ob >> 9) & 1) << 5)); }
__host__ __device__ __forceinline__ void stage_rc(int b, int& R, int& C) { const int st = b / 1024, sb = b % 1024, swz = sb ^ (((sb >> 9) & 1) << 5); R = (st >> 1) * 16 + swz / 64; C = (st & 1) * 32 + (swz % 64) / 2; }
__host__ __device__ __forceinline__ int perm32(int rho) { const int n = rho >> 4, i = rho & 15; return 8 * (i >> 2) + 4 * n + (i & 3); }

struct Unit { int pm, pn; };
struct Gemm { const bf16* A; const bf16* Bt; int lda, K, blkA; };
constexpr int BLK = 16384;
__host__ __device__ __forceinline__ int perm32inv(int x) { return 16 * ((x >> 2) & 1) + 4 * (x >> 3) + (x & 3); }
__host__ __device__ __forceinline__ size_t blk_off(int row, int k, int K, bool perm) {
    const int r = row & 127, slot = perm ? ((r & ~31) + perm32inv(r & 31)) : r; return ((size_t)(row >> 7) * (K >> 6) + (k >> 6)) * BLK + lds_byte(slot, k & 63); }
__device__ __forceinline__ const char* a_base(const Gemm& g, const Unit& u) { return g.blkA ? (const char*)g.A + (size_t)u.pm * 2 * (g.K >> 6) * BLK : (const char*)(g.A + (size_t)u.pm * BM * g.lda); }
__device__ __forceinline__ const char* b_base(const Gemm& g, const Unit& u) { return (const char*)g.Bt + (size_t)u.pn * 2 * (g.K >> 6) * BLK; }

struct StaticOrder {
    int nM, nN, nwg, G, c, wgm;
    __host__ __device__ void init(int M, int N, int G_, int c_, int wgm_ = 8) { nM = M / BM; nN = N / BM; nwg = nM * nN; G = G_; c = c_; wgm = wgm_; }
    __host__ __device__ bool next(int i, Unit& u) const {
        const long L = (long)i * G + c; if (L >= nwg) return false;
        int wgid = (int)L; { const int q = nwg / NXCD, r = nwg % NXCD, xcd = wgid % NXCD, off = wgid / NXCD; wgid = (xcd < r ? xcd * (q + 1) : r * (q + 1) + (xcd - r) * q) + off; }
        const int nig = wgm * nN, gid = wgid / nig, fm = gid * wgm, gsz = (nM - fm) < wgm ? (nM - fm) : wgm;
        u.pm = fm + ((wgid % nig) % gsz); u.pn = (wgid % nig) / gsz; return true;
    }
};

template <class Epi, bool ALIGN_EPI = true, bool SP2 = true>
__device__ __forceinline__ void gemm_phase(LAS unsigned char* lds, const Gemm g, const StaticOrder& S, const Epi& E, unsigned long long& tacc, const int tmode) {
    int tid_o = threadIdx.x; asm volatile("" : "+v"(tid_o));
    const int tid = tid_o, wid = __builtin_amdgcn_readfirstlane(tid >> 6), lane = tid & 63, wr = wid >> 2, wc = wid & 3, fr = lane & 15, fq = lane >> 4;
    const int K = g.K, nt = K / BK;
    unsigned voffA[2], voffB[2];
    static_assert(Epi::PERM, "the blocked weight layout bakes in the PERM row order");
#pragma unroll
    for (int i = 0; i < 2; ++i) { int R, C; stage_rc(tid * 16 + i * 8192, R, C);
        voffA[i] = g.blkA ? (unsigned)(tid * 16 + i * 8192) : (unsigned)(R * g.lda + C) * 2u; voffB[i] = (unsigned)(tid * 16 + i * 8192); }
    const size_t kstepA = g.blkA ? (size_t)BLK : (size_t)(BK * 2), kstepB = (size_t)BLK;
    const size_t hstepA = g.blkA ? (size_t)(K >> 6) * BLK : (size_t)HALF * g.lda * 2, hstepB = (size_t)(K >> 6) * BLK;
    const unsigned ldsw = (unsigned)wid * 1024u;
    const int aoff = lds_byte(wr * 64 + fr, fq * 8), boff = lds_byte(wc * 32 + fr, fq * 8);
#define PG8_SA(b, h) (((b) * 2 + (h)) * HTB)
#define PG8_SB(b, h) ((4 + (b) * 2 + (h)) * HTB)
#define PG8_STAGE(bufoff, gbase, voff) do { _Pragma("unroll") for (int _i = 0; _i < 2; ++_i) \
        __builtin_amdgcn_global_load_lds((const unsigned*)((const char*)(gbase) + (voff)[_i]), (LAS unsigned*)(lds + (bufoff) + ldsw + _i * 8192), 16, 0, 0); } while (0)
#define PG8_LDA(dst, b, h) do { _Pragma("unroll") for (int m = 0; m < 4; ++m) _Pragma("unroll") for (int k = 0; k < 2; ++k) dst[m][k] = *(const LAS bf16x8*)(lds + PG8_SA(b, h) + aoff + m * 2048 + k * 1024); } while (0)
#define PG8_LDB(dst, b, h) do { _Pragma("unroll") for (int n = 0; n < 2; ++n) _Pragma("unroll") for (int k = 0; k < 2; ++k) dst[n][k] = *(const LAS bf16x8*)(lds + PG8_SB(b, h) + boff + n * 2048 + k * 1024); } while (0)
#define PG8_MMA(ai, bj, At, Bt) do { __builtin_amdgcn_s_setprio(1); _Pragma("unroll") for (int m = 0; m < 4; ++m) _Pragma("unroll") for (int n = 0; n < 2; ++n) _Pragma("unroll") for (int k = 0; k < 2; ++k) \
        acc[ai][bj][m][n] = __builtin_amdgcn_mfma_f32_16x16x32_bf16(Bt[n][k], At[m][k], acc[ai][bj][m][n], 0, 0, 0); __builtin_amdgcn_s_setprio(0); } while (0)
#define PG8_WAIT_V(n) asm volatile("s_waitcnt vmcnt(" #n ")" ::: "memory")
#define PG8_WAIT_L(n) asm volatile("s_waitcnt lgkmcnt(" #n ")" ::: "memory")
#define PG8_BAR __builtin_amdgcn_s_barrier()
#define PG8_SCHED __builtin_amdgcn_sched_barrier(0)
    Unit cur, nxt; int ui = 0;
    if (!S.next(0, cur)) return;
    f32x4 acc[2][2][4][2];
#pragma unroll
    for (int a = 0; a < 2; ++a)
#pragma unroll
        for (int b = 0; b < 2; ++b)
#pragma unroll
            for (int m = 0; m < 4; ++m)
#pragma unroll
                for (int n = 0; n < 2; ++n) acc[a][b][m][n] = (f32x4){0.f, 0.f, 0.f, 0.f};
    bf16x8 At[4][2], B0[2][2], B1[2][2];
    const char* cA = a_base(g, cur); const char* cB = b_base(g, cur);
    if constexpr (SP2) {
        PG8_STAGE(PG8_SB(0, 0), cB, voffB); PG8_STAGE(PG8_SB(0, 1), cB + hstepB, voffB); PG8_STAGE(PG8_SA(0, 0), cA, voffA); PG8_STAGE(PG8_SA(0, 1), cA + hstepA, voffA);
        if (wr == 1) PG8_BAR;
        PG8_WAIT_V(2); PG8_BAR;
        PG8_STAGE(PG8_SB(1, 0), cB + kstepB, voffB); PG8_STAGE(PG8_SA(1, 0), cA + kstepA, voffA); PG8_STAGE(PG8_SB(1, 1), cB + hstepB + kstepB, voffB);
        PG8_WAIT_V(6); PG8_BAR;
    } else {
        PG8_STAGE(PG8_SB(0, 0), cB, voffB); PG8_STAGE(PG8_SA(0, 0), cA, voffA); PG8_STAGE(PG8_SB(0, 1), cB + hstepB, voffB); PG8_STAGE(PG8_SA(0, 1), cA + hstepA, voffA);
        if (wr == 1) PG8_BAR;
        PG8_WAIT_V(4); PG8_BAR;
        PG8_STAGE(PG8_SB(1, 0), cB + kstepB, voffB); PG8_STAGE(PG8_SA(1, 0), cA + kstepA, voffA); PG8_STAGE(PG8_SB(1, 1), cB + hstepB + kstepB, voffB);
        PG8_WAIT_V(6); PG8_BAR;
    }
    for (;;) {
        const bool has_next = S.next(ui + 1, nxt);
        const char* nA = has_next ? a_base(g, nxt) : cA; const char* nB = has_next ? b_base(g, nxt) : cB;
        unsigned long long tk0 = 0ull; if (tmode == 1) tk0 = __builtin_amdgcn_s_memrealtime(); if (tmode == 3) tk0 = (unsigned long long)clock64();
#pragma unroll 1
        for (int t = 0; t < nt; t += 2) {
            const bool last = (t == nt - 2);
            const char* a1 = cA + (size_t)(t + 1) * kstepA;
            const char* a2 = last ? nA : cA + (size_t)(t + 2) * kstepA; const char* b2 = last ? nB : cB + (size_t)(t + 2) * kstepB;
            const char* a3 = a2 + kstepA; const char* b3 = b2 + kstepB;
            if constexpr (SP2) {
            PG8_LDB(B0, 0, 0); PG8_LDB(B1, 0, 1); PG8_SCHED; PG8_LDA(At, 0, 0); PG8_STAGE(PG8_SA(1, 1), a1 + hstepA, voffA);
            PG8_WAIT_V(8); PG8_WAIT_L(0); PG8_BAR; PG8_MMA(0, 0, At, B0); PG8_MMA(0, 1, At, B1); PG8_BAR; PG8_SCHED;
            PG8_LDA(At, 0, 1); PG8_STAGE(PG8_SB(0, 0), b2, voffB); PG8_STAGE(PG8_SB(0, 1), b2 + hstepB, voffB); PG8_STAGE(PG8_SA(0, 0), a2, voffA);
            PG8_WAIT_V(8); PG8_WAIT_L(0); PG8_BAR; PG8_MMA(1, 0, At, B0); PG8_MMA(1, 1, At, B1); PG8_BAR; PG8_SCHED;
            PG8_LDB(B0, 1, 0); PG8_LDB(B1, 1, 1); PG8_SCHED; PG8_LDA(At, 1, 0); PG8_STAGE(PG8_SA(0, 1), a2 + hstepA, voffA);
            PG8_WAIT_V(8); PG8_WAIT_L(0); PG8_BAR; PG8_MMA(0, 0, At, B0); PG8_MMA(0, 1, At, B1); PG8_BAR; PG8_SCHED;
            PG8_LDA(At, 1, 1); PG8_STAGE(PG8_SB(1, 0), b3, voffB); PG8_STAGE(PG8_SB(1, 1), b3 + hstepB, voffB); PG8_STAGE(PG8_SA(1, 0), a3, voffA);
            PG8_WAIT_V(8); PG8_WAIT_L(0); PG8_BAR; PG8_MMA(1, 0, At, B0); PG8_MMA(1, 1, At, B1); PG8_BAR; PG8_SCHED;
            } else {
            PG8_LDB(B0, 0, 0); PG8_SCHED; PG8_LDA(At, 0, 0); PG8_STAGE(PG8_SA(1, 1), a1 + hstepA, voffA);
            PG8_WAIT_L(8); PG8_BAR; PG8_WAIT_L(0); PG8_MMA(0, 0, At, B0); PG8_BAR; PG8_SCHED;
            PG8_LDB(B1, 0, 1); PG8_STAGE(PG8_SB(0, 0), b2, voffB);
            PG8_BAR; PG8_WAIT_L(0); PG8_MMA(0, 1, At, B1); PG8_BAR;
            PG8_LDA(At, 0, 1); PG8_STAGE(PG8_SA(0, 0), a2, voffA);
            PG8_BAR; PG8_WAIT_L(0); PG8_MMA(1, 0, At, B0); PG8_BAR; PG8_SCHED;
            PG8_STAGE(PG8_SB(0, 1), b2 + hstepB, voffB);
            PG8_WAIT_V(6); PG8_BAR; PG8_MMA(1, 1, At, B1); PG8_BAR;
            PG8_LDB(B0, 1, 0); PG8_SCHED; PG8_LDA(At, 1, 0); PG8_STAGE(PG8_SA(0, 1), a2 + hstepA, voffA);
            PG8_WAIT_L(8); PG8_BAR; PG8_WAIT_L(0); PG8_MMA(0, 0, At, B0); PG8_BAR; PG8_SCHED;
            PG8_LDB(B1, 1, 1); PG8_STAGE(PG8_SB(1, 0), b3, voffB);
            PG8_BAR; PG8_WAIT_L(0); PG8_MMA(0, 1, At, B1); PG8_BAR;
            PG8_LDA(At, 1, 1); PG8_STAGE(PG8_SA(1, 0), a3, voffA);
            PG8_BAR; PG8_WAIT_L(0); PG8_MMA(1, 0, At, B0); PG8_BAR; PG8_SCHED;
            PG8_STAGE(PG8_SB(1, 1), b3 + hstepB, voffB);
            PG8_WAIT_V(6); PG8_BAR; PG8_MMA(1, 1, At, B1); PG8_BAR;
            }
        }
        if (tmode == 1) tacc += __builtin_amdgcn_s_memrealtime() - tk0;
        if (tmode == 3) tacc += ((unsigned long long)clock64() - tk0) / 24ull;
        if (tmode == 2) tk0 = __builtin_amdgcn_s_memrealtime();
        if constexpr (ALIGN_EPI) { if (wr == 0) PG8_BAR; }
        if constexpr (!Epi::AFTER_DRAIN) E(acc, cur, wr, wc, fr, fq);
        if (!has_next) { if (tmode == 2) tacc += __builtin_amdgcn_s_memrealtime() - tk0; break; }
#pragma unroll
        for (int a = 0; a < 2; ++a)
#pragma unroll
            for (int b = 0; b < 2; ++b)
#pragma unroll
                for (int m = 0; m < 4; ++m)
#pragma unroll
                    for (int n = 0; n < 2; ++n) acc[a][b][m][n] = (f32x4){0.f, 0.f, 0.f, 0.f};
        cur = nxt; cA = nA; cB = nB; ++ui;
        if constexpr (ALIGN_EPI) { if (wr == 1) PG8_BAR; }
        if (tmode == 2) tacc += __builtin_amdgcn_s_memrealtime() - tk0;
    }
    PG8_WAIT_V(0);
    if constexpr (!ALIGN_EPI) { if (wr == 0) PG8_BAR; }
    PG8_BAR;
    if constexpr (Epi::AFTER_DRAIN) E.fused(acc, cur, wr, wc, fr, fq, lds, wid, lane);
#undef PG8_SA
#undef PG8_SB
#undef PG8_STAGE
#undef PG8_LDA
#undef PG8_LDB
#undef PG8_MMA
#undef PG8_WAIT_V
#undef PG8_WAIT_L
#undef PG8_BAR
#undef PG8_SCHED
}

typedef f32x4 AccT[2][2][4][2];
template <bool F32OUT> struct EpiResidLn {
    static constexpr bool PERM = true, AFTER_DRAIN = true;
    const bf16* XinB; float* XoutF; bf16* XBout; const float* g; const float* b; float alpha;
    unsigned long long* xbuf; unsigned* cnt; unsigned want; unsigned* tmo;
    __device__ __forceinline__ void operator()(const AccT&, const Unit&, int, int, int, int) const {}
    __device__ __forceinline__ void fused(AccT& acc, const Unit& u, int wr, int wc, int fr_in, int fq_in, LAS unsigned char* lds, int wid, int lane_in) const {
        int fr = fr_in, fq = fq_in, lane = lane_in; asm volatile("" : "+v"(fr), "+v"(fq), "+v"(lane));
        LAS f32x2* P = (LAS f32x2*)lds;
        LAS f32x2* S = (LAS f32x2*)(lds + 8192);
        const int col0 = u.pn * BM + wc * 32 + 8 * fq;
        {
            u32x4 xr[2][4][2];
#pragma unroll
            for (int ai = 0; ai < 2; ++ai)
#pragma unroll
                for (int m = 0; m < 4; ++m) { const int rowi = u.pm * BM + ai * HALF + wr * 64 + m * 16 + fr;
#pragma unroll
                    for (int bj = 0; bj < 2; ++bj) xr[ai][m][bj] = *(const u32x4*)((const char*)XinB + blk_off(rowi, col0 + bj * HALF, D, false)); }
#pragma unroll
            for (int ai = 0; ai < 2; ++ai)
#pragma unroll
                for (int m = 0; m < 4; ++m)
#pragma unroll
                    for (int bj = 0; bj < 2; ++bj) { const u32x4 w = xr[ai][m][bj];
                        acc[ai][bj][m][0] += (f32x4){bflo(w.x), bfhi(w.x), bflo(w.y), bfhi(w.y)} * alpha; acc[ai][bj][m][1] += (f32x4){bflo(w.z), bfhi(w.z), bflo(w.w), bfhi(w.w)} * alpha;
                        asm volatile("" : "+v"(acc[ai][bj][m][0]), "+v"(acc[ai][bj][m][1])); }
            asm volatile("" ::: "memory");
        }
#pragma unroll
        for (int ai = 0; ai < 2; ++ai)
#pragma unroll
            for (int m = 0; m < 4; ++m) {
                float s = 0.f;
#pragma unroll
                for (int bj = 0; bj < 2; ++bj)
#pragma unroll
                    for (int n = 0; n < 2; ++n) { const f32x4 x = acc[ai][bj][m][n]; s += (x[0] + x[1]) + (x[2] + x[3]); }
                s += shfl_lane(s, lane ^ 16); s += shfl_lane(s, lane ^ 32);
                const float mw = s * (1.0f / 64.0f); float q = 0.f;
#pragma unroll
                for (int bj = 0; bj < 2; ++bj)
#pragma unroll
                    for (int n = 0; n < 2; ++n) { const f32x4 d = acc[ai][bj][m][n] - mw; q += (d[0] * d[0] + d[1] * d[1]) + (d[2] * d[2] + d[3] * d[3]); }
                q += shfl_lane(q, lane ^ 16); q += shfl_lane(q, lane ^ 32);
                if (fq == 0) P[(ai * HALF + wr * 64 + m * 16 + fr) * 4 + wc] = (f32x2){mw, q};
            }
        const int col5 = u.pn * BM + wc * 32 + 8 * fq;
        f32x4 gg[2][2], bv[2][2];
#pragma unroll
        for (int bj = 0; bj < 2; ++bj)
#pragma unroll
            for (int n = 0; n < 2; ++n) { gg[bj][n] = *(const f32x4*)(g + col5 + bj * HALF + n * 4); bv[bj][n] = *(const f32x4*)(b + col5 + bj * HALF + n * 4); }
        asm volatile("s_waitcnt lgkmcnt(0)" ::: "memory"); __builtin_amdgcn_s_barrier(); asm volatile("" ::: "memory");
        const int row = wid * 32 + (lane & 31);
        if (lane < 32) {
            const f32x2 a = P[row * 4 + 0], bb = P[row * 4 + 1], c = P[row * 4 + 2], d = P[row * 4 + 3];
            const float mt = (a.x + bb.x + c.x + d.x) * 0.25f;
            const float da = a.x - mt, db = bb.x - mt, dc = c.x - mt, dd = d.x - mt;
            const float m2 = (a.y + bb.y) + (c.y + d.y) + 64.0f * ((da * da + db * db) + (dc * dc + dd * dd));
            unsigned long long* slot = xbuf + ((size_t)(u.pm * BM + row) * 8 + u.pn);
            __hip_atomic_store(slot, ((unsigned long long)__float_as_uint(m2) << 32) | __float_as_uint(mt), __ATOMIC_RELAXED, __HIP_MEMORY_SCOPE_AGENT);
        }
        asm volatile("s_waitcnt vmcnt(0)" ::: "memory");
        if (lane == 0) __hip_atomic_fetch_add(cnt + 64 * u.pm, 1u, __ATOMIC_RELAXED, __HIP_MEMORY_SCOPE_AGENT);
        if (wid == 0) {
            unsigned sp = 0;
            while ((unsigned)__builtin_amdgcn_readfirstlane(__hip_atomic_load(cnt + 64 * u.pm, __ATOMIC_RELAXED, __HIP_MEMORY_SCOPE_AGENT)) < want) {
                __builtin_amdgcn_s_sleep(1);
                if ((++sp & 1023u) == 0u) { if (__builtin_amdgcn_readfirstlane(__hip_atomic_load(tmo, __ATOMIC_RELAXED, __HIP_MEMORY_SCOPE_AGENT)) != 0u) break;
                    if (sp > (1u << 22)) { if (lane == 0) __hip_atomic_store(tmo, 1u, __ATOMIC_RELAXED, __HIP_MEMORY_SCOPE_AGENT); break; } } }
            __builtin_amdgcn_fence(__ATOMIC_ACQUIRE, "agent");
        }
        asm volatile("s_waitcnt vmcnt(0) lgkmcnt(0)" ::: "memory"); __builtin_amdgcn_s_barrier(); asm volatile("" ::: "memory");
        if (lane < 32) {
            const unsigned long long* slot = xbuf + (size_t)(u.pm * BM + row) * 8; float mt[8], m2[8]; float ms = 0.f;
#pragma unroll
            for (int t = 0; t < 8; ++t) { const unsigned long long w = __hip_atomic_load(slot + t, __ATOMIC_RELAXED, __HIP_MEMORY_SCOPE_AGENT); mt[t] = __uint_as_float((unsigned)w); m2[t] = __uint_as_float((unsigned)(w >> 32)); ms += mt[t]; }
            const float mean = ms * 0.125f; float q = 0.f;
#pragma unroll
            for (int t = 0; t < 8; ++t) { const float dm = mt[t] - mean; q += m2[t] + 256.0f * dm * dm; }
            S[row] = (f32x2){mean, rsqrtf(q * (1.0f / 2048.0f) + LN_EPS)};
        }
        asm volatile("s_waitcnt lgkmcnt(0)" ::: "memory"); __builtin_amdgcn_s_barrier(); asm volatile("" ::: "memory");
#pragma unroll
        for (int ai = 0; ai < 2; ++ai)
#pragma unroll
            for (int m = 0; m < 4; ++m) { const int r = ai * HALF + wr * 64 + m * 16 + fr; const f32x2 sr = S[r]; const size_t off = (size_t)(u.pm * BM + r) * D + col5;
#pragma unroll
                for (int bj = 0; bj < 2; ++bj) { const f32x4 o0 = (acc[ai][bj][m][0] - sr.x) * sr.y * gg[bj][0] + bv[bj][0], o1 = (acc[ai][bj][m][1] - sr.x) * sr.y * gg[bj][1] + bv[bj][1];
                    if constexpr (F32OUT) { *(f32x4*)(XoutF + off + bj * HALF) = o0; *(f32x4*)(XoutF + off + bj * HALF + 4) = o1; }
                    else { u32x4 w; w.x = pk2(o0[0], o0[1]); w.y = pk2(o0[2], o0[3]); w.z = pk2(o1[0], o1[1]); w.w = pk2(o1[2], o1[3]); *(u32x4*)((char*)XBout + blk_off(u.pm * BM + r, col5 + bj * HALF, D, false)) = w; } }
                asm volatile("" ::: "memory"); }
    }
};
struct EpiRelu2 {
    static constexpr bool PERM = true, AFTER_DRAIN = false;
    bf16* O; int Kd;
    __device__ __forceinline__ void operator()(const AccT& acc, const Unit& u, int wr, int wc, int fr_in, int fq_in) const {
        int fr = fr_in, fq = fq_in; asm volatile("" : "+v"(fr), "+v"(fq));
        const int row0 = u.pm * BM + wr * 64 + fr, col0 = u.pn * BM + wc * 32 + 8 * fq;
#pragma unroll
        for (int ai = 0; ai < 2; ++ai)
#pragma unroll
            for (int m = 0; m < 4; ++m) { const int row = row0 + ai * HALF + m * 16;
#pragma unroll
                for (int bj = 0; bj < 2; ++bj) { f32x4 v0 = acc[ai][bj][m][0], v1 = acc[ai][bj][m][1];
#pragma unroll
                    for (int j = 0; j < 4; ++j) { const float a = fmaxf(v0[j], 0.f), b = fmaxf(v1[j], 0.f); v0[j] = a * a; v1[j] = b * b; }
                    u32x4 w; w.x = pk2(v0[0], v0[1]); w.y = pk2(v0[2], v0[3]); w.z = pk2(v1[0], v1[1]); w.w = pk2(v1[2], v1[3]);
                    *(u32x4*)((char*)O + blk_off(row, col0 + bj * HALF, Kd, false)) = w; } }
    }
};
struct EpiRgIn {
    static constexpr bool PERM = true, AFTER_DRAIN = false;
    bf16* GATE; bf16* URAW;
    __device__ __forceinline__ void operator()(const AccT& acc, const Unit& u, int wr, int wc, int fr_in, int fq_in) const {
        int fr = fr_in, fq = fq_in; asm volatile("" : "+v"(fr), "+v"(fq));
        const bool isg = u.pn < 8; bf16* base = isg ? GATE : URAW;
        const int row0 = u.pm * BM + wr * 64 + fr, col0 = (u.pn & 7) * BM + wc * 32 + 8 * fq;
#pragma unroll
        for (int ai = 0; ai < 2; ++ai)
#pragma unroll
            for (int m = 0; m < 4; ++m) { bf16* rowp = base + (size_t)(row0 + ai * HALF + m * 16) * D + col0;
#pragma unroll
                for (int bj = 0; bj < 2; ++bj) { f32x4 v0 = acc[ai][bj][m][0], v1 = acc[ai][bj][m][1];
                    if (isg) {
#pragma unroll
                        for (int j = 0; j < 4; ++j) { v0[j] = gelu_tanh_(v0[j]); v1[j] = gelu_tanh_(v1[j]); } }
                    u32x4 w; w.x = pk2(v0[0], v0[1]); w.y = pk2(v0[2], v0[3]); w.z = pk2(v1[0], v1[1]); w.w = pk2(v1[2], v1[3]);
                    *(u32x4*)(rowp + bj * HALF) = w; } }
    }
};
struct EpiSsdIn {
    static constexpr bool PERM = true, AFTER_DRAIN = false;
    bf16* ZS; bf16* XBCR;
    __device__ __forceinline__ void operator()(const AccT& acc, const Unit& u, int wr, int wc, int fr_in, int fq_in) const {
        int fr = fr_in, fq = fq_in; asm volatile("" : "+v"(fr), "+v"(fq));
        const int row0 = u.pm * BM + wr * 64 + fr, cw = wc * 32 + 8 * fq;
        const bool isz = u.pn < 16; bf16* base = isz ? ZS + (size_t)u.pn * BM : XBCR + (size_t)(u.pn - 16) * BM; const int ldc = isz ? SSD_DI : SSD_XBC;
#pragma unroll
        for (int ai = 0; ai < 2; ++ai)
#pragma unroll
            for (int m = 0; m < 4; ++m) { bf16* rowp = base + (size_t)(row0 + ai * HALF + m * 16) * ldc + cw;
#pragma unroll
                for (int bj = 0; bj < 2; ++bj) { f32x4 v0 = acc[ai][bj][m][0], v1 = acc[ai][bj][m][1];
                    if (isz) {
#pragma unroll
                        for (int j = 0; j < 4; ++j) { v0[j] = siluf_(v0[j]); v1[j] = siluf_(v1[j]); } }
                    u32x4 w; w.x = pk2(v0[0], v0[1]); w.y = pk2(v0[2], v0[3]); w.z = pk2(v1[0], v1[1]); w.w = pk2(v1[2], v1[3]);
                    *(u32x4*)(rowp + bj * HALF) = w; } }
    }
};
struct EpiQkv {
    static constexpr bool PERM = true, AFTER_DRAIN = false;
    bf16* Q; const float* bias;
    __device__ __forceinline__ void operator()(const AccT& acc, const Unit& u, int wr, int wc, int fr_in, int fq_in) const {
        int fr = fr_in, fq = fq_in; asm volatile("" : "+v"(fr), "+v"(fq));
        const int t = u.pn >> 3; bf16* base = Q + (size_t)t * TG * D; const float sc = t == 0 ? 0.08838834764831845f : 1.0f;
        const int row0 = u.pm * BM + wr * 64 + fr, col0 = (u.pn & 7) * BM + wc * 32 + 8 * fq, bcol0 = u.pn * BM + wc * 32 + 8 * fq;
#pragma unroll
        for (int bj = 0; bj < 2; ++bj) {
            const f32x4 bv0 = *(const f32x4*)(bias + bcol0 + bj * HALF), bv1 = *(const f32x4*)(bias + bcol0 + bj * HALF + 4);
#pragma unroll
            for (int ai = 0; ai < 2; ++ai)
#pragma unroll
                for (int m = 0; m < 4; ++m) { bf16* rowp = base + (size_t)(row0 + ai * HALF + m * 16) * D + col0;
                    const f32x4 v0 = (acc[ai][bj][m][0] + bv0) * sc, v1 = (acc[ai][bj][m][1] + bv1) * sc;
                    u32x4 w; w.x = pk2(v0[0], v0[1]); w.y = pk2(v0[2], v0[3]); w.z = pk2(v1[0], v1[1]); w.w = pk2(v1[2], v1[3]);
                    *(u32x4*)(rowp + bj * HALF) = w; }
            asm volatile("" ::: "memory");
        }
    }
};
}

struct Frame {
    LAS unsigned char* lds;
    int tid, lane, wave, G, gw, ngw;
};

__device__ __forceinline__ Frame phase_frame(const Frame& F0) {
    Frame F = F0; int t = threadIdx.x; asm volatile("" : "+v"(t));
    F.tid = t; F.lane = t & 63; F.wave = __builtin_amdgcn_readfirstlane(t >> 6); F.gw = F.wave * F0.G + (int)blockIdx.x; return F;
}
template <int FRAG16 = 0>
__device__ __forceinline__ void transpose_item(const float* W, int ldw, bf16* WT, int ldt, int k0, int n0, int drow0, LAS float* scr, int lane) {
#pragma unroll
    for (int i = 0; i < 16; ++i) { const int kk = 4 * i + (lane >> 4), c2 = 2 * (lane & 15); const f32x2 v = *(const f32x2*)(W + (size_t)(k0 + kk) * ldw + n0 + c2); scr[kk * 33 + c2] = v.x; scr[kk * 33 + c2 + 1] = v.y; }
    LDS_WAIT(); asm volatile("" ::: "memory");
    const int c = lane & 7;
#pragma unroll
    for (int j = 0; j < 4; ++j) { const int n = (lane >> 3) + 8 * j; const LAS float* s = scr + (8 * c) * 33 + n;
        u32x4 o; o.x = pk2(s[0 * 33], s[1 * 33]); o.y = pk2(s[2 * 33], s[3 * 33]); o.z = pk2(s[4 * 33], s[5 * 33]); o.w = pk2(s[6 * 33], s[7 * 33]);
        if constexpr (FRAG16 == 2) { *(GAS u32x4*)((GAS char*)WT + pg8::blk_off(drow0 + n, k0 + 8 * c, ldt, true)) = o; }
        else if constexpr (FRAG16 == 1) { const int r = drow0 + n, k = k0 + 8 * c;
            *(GAS u32x4*)(WT + (((r >> 4) * 8 + (k >> 5)) * 64 + (r & 15) + 16 * ((k >> 3) & 3)) * 8) = o; }
        else *(GAS u32x4*)(WT + (size_t)(drow0 + n) * ldt + k0 + 8 * c) = o; }
    LDS_WAIT(); asm volatile("" ::: "memory");
}
__device__ __forceinline__ void conv_matrix(const Frame& F, const float* W, int K, int N, bf16* WT, LAS float* scr, int nblocked = 1 << 30) {
    const int nblk = N / 32, nitems = (K / 64) * nblk;
    for (int it = F.gw; it < nitems; it += F.ngw) { const int kb = it / nblk, nb = it % nblk;
        if (32 * nb < nblocked) transpose_item<2>(W, N, WT, K, 64 * kb, 32 * nb, 32 * nb, scr, F.lane); else transpose_item<0>(W, N, WT, K, 64 * kb, 32 * nb, 32 * nb, scr, F.lane); }
}
__device__ __forceinline__ void p_prologue(const Frame& F0, const float* const* in, bf16* Wb, float* spt, bf16* XB0) {
    const Frame F = phase_frame(F0);
    { const int n4 = NGROUP * TG * D / 4, n4p = 2 * TG * D / 4;
      for (int i = F.gw * 64 + F.lane; i < n4; i += F.ngw * 64) { const f32x4 v = i < n4p ? ((const f32x4*)in[0])[i] : ((const f32x4*)in[1])[i - n4p]; u32x2 w; w.x = pk2(v.x, v.y); w.y = pk2(v.z, v.w);
          const int row = i >> 9, col = (i & 511) * 4, grp = row >> 13;
          *(u32x2*)((char*)(XB0 + (size_t)grp * TG * D) + pg8::blk_off(row & (TG - 1), col, D, false)) = w; } }
    LAS float* scr = (LAS float*)(F.lds + F.wave * 16384);
    for (int l = 0; l < 2; ++l) {
        conv_matrix(F, in[2] + (size_t)l * 2048 * 4096, 2048, 4096, Wb + W_RGIN + (size_t)l * 4096 * 2048, scr);
        conv_matrix(F, in[10] + (size_t)l * 2048 * 2048, 2048, 2048, Wb + W_RGOUT + (size_t)l * 2048 * 2048, scr);
    }
    for (int it = F.gw; it < 2 * 2 * 16 * 32; it += F.ngw) {
        const int sub = it & 31, mat = it >> 5;
        const int dn = mat & 15, ax = (mat >> 4) & 1, l = mat >> 5;
        const int kb = sub >> 3, nb = sub & 7, j0 = 32 * nb;
        const float* W = in[ax ? 7 : 5] + ((size_t)(l * 16 + dn)) * 65536;
        bf16* WT = Wb + W_RGGATE + (size_t)l * 32 * 65536 + (size_t)(dn * 2 + (j0 >> 7)) * 65536;
        transpose_item<1>(W, 256, WT, 256, 64 * kb, j0, (j0 & 127) + 128 * ax, scr, F.lane);
    }
    for (int i = F.gw * 64 + F.lane; i < 2 * 2 * 2048; i += F.ngw * 64) spt[i] = -8.0f * softplusf_(-in[9][i]);
    conv_matrix(F, in[11], 2048, SSD_NIN, Wb + W_SSDIN, scr, 10240);
    { u32x4* z = (u32x4*)(Wb + W_SSDIN + (size_t)SSD_NIN * 2048); const int n16 = (SSD_NIN_PAD - SSD_NIN) * 2048 / 8;
      for (int i = F.gw * 64 + F.lane; i < n16; i += F.ngw * 64) z[i] = (u32x4){0u, 0u, 0u, 0u}; }
    conv_matrix(F, in[18], 4096, 2048, Wb + W_SSDOUT, scr);
    conv_matrix(F, in[19], 2048, 6144, Wb + W_NAQKV, scr);
    conv_matrix(F, in[22], 2048, 2048, Wb + W_NAOUT, scr);
    for (int l = 0; l < 4; ++l) {
        conv_matrix(F, in[23] + (size_t)l * 2048 * 8192, 2048, 8192, Wb + W_UP + (size_t)l * 8192 * 2048, scr);
        conv_matrix(F, in[24] + (size_t)l * 8192 * 2048, 8192, 2048, Wb + W_DOWN + (size_t)l * 2048 * 8192, scr);
    }
}

__device__ __forceinline__ void p_conv_ssd(const Frame& F0, const bf16* in, int L, const float* cw, const float* cb, bf16* XT, bf16* BMo, bf16* CMo) {
    const Frame F = phase_frame(F0);
    constexpr int C = SSD_XBC, NCB = C / 512, TP = 144;
    LAS unsigned char* tile = F.lds;
    const int co = F.tid & 63, tr = F.tid >> 6;
    for (int it = blockIdx.x; it < NCB * (TG / 64); it += F.G) {
        const int cbk = it % NCB, tb = it / NCB, t0 = tb * 64, c0 = cbk * 512 + co * 8, r0 = t0 + 8 * tr, rl = r0 % L;
        float w[4][8], bias[8];
#pragma unroll
        for (int k = 0; k < 4; ++k) { const f32x4 a = *(const f32x4*)(cw + (size_t)k * C + c0), b = *(const f32x4*)(cw + (size_t)k * C + c0 + 4);
            w[k][0] = a.x; w[k][1] = a.y; w[k][2] = a.z; w[k][3] = a.w; w[k][4] = b.x; w[k][5] = b.y; w[k][6] = b.z; w[k][7] = b.w; }
        { const f32x4 a = *(const f32x4*)(cb + c0), b = *(const f32x4*)(cb + c0 + 4); bias[0] = a.x; bias[1] = a.y; bias[2] = a.z; bias[3] = a.w; bias[4] = b.x; bias[5] = b.y; bias[6] = b.z; bias[7] = b.w; }
        u32x4 rows[11];
#pragma unroll
        for (int i = 0; i < 11; ++i) { const int tt = rl - 1 + i; const bool ok = (tt >= 0) && (tt < L);
            rows[i] = ok ? *(const u32x4*)(in + (size_t)(r0 - 1 + i) * C + c0) : (u32x4){0u, 0u, 0u, 0u}; }
        unsigned outw[8][4];
#pragma unroll
        for (int i = 0; i < 8; ++i) {
            float y[8];
#pragma unroll
            for (int j = 0; j < 8; ++j) y[j] = bias[j];
#pragma unroll
            for (int k = 0; k < 4; ++k) { const u32x4 r = rows[i + k];
                y[0] += w[k][0] * bflo(r.x); y[1] += w[k][1] * bfhi(r.x); y[2] += w[k][2] * bflo(r.y); y[3] += w[k][3] * bfhi(r.y);
                y[4] += w[k][4] * bflo(r.z); y[5] += w[k][5] * bfhi(r.z); y[6] += w[k][6] * bflo(r.w); y[7] += w[k][7] * bfhi(r.w); }
#pragma unroll
            for (int j = 0; j < 8; ++j) y[j] = siluf_(y[j]);
            outw[i][0] = pk2(y[0], y[1]); outw[i][1] = pk2(y[2], y[3]); outw[i][2] = pk2(y[4], y[5]); outw[i][3] = pk2(y[6], y[7]);
        }
        if (cbk >= 8) {
            bf16* ob = cbk < 10 ? BMo : CMo; const int cc = cbk < 10 ? c0 - 4096 : c0 - 5120;
#pragma unroll
            for (int i = 0; i < 8; ++i) *(u32x4*)(ob + (size_t)(r0 + i) * 1024 + cc) = (u32x4){outw[i][0], outw[i][1], outw[i][2], outw[i][3]};
        } else {
#pragma unroll
            for (int j = 0; j < 8; ++j) {
                unsigned e[4];
#pragma unroll
                for (int q = 0; q < 4; ++q) { const unsigned a = outw[2 * q][j >> 1], b = outw[2 * q + 1][j >> 1];
                    e[q] = (j & 1) ? ((a >> 16) | (b & 0xffff0000u)) : ((a & 0xffffu) | (b << 16)); }
                *(LAS u32x4*)(tile + (co * 8 + j) * TP + tr * 16) = (u32x4){e[0], e[1], e[2], e[3]};
            }
            __syncthreads();
            const int chunk = t0 >> 7, s0 = t0 & 127;
#pragma unroll
            for (int i = 0; i < 8; ++i) { const int idx = F.tid + 512 * i, piece = idx >> 9, row = idx & 511, c = cbk * 512 + row, p = c & 63, s = s0 + 8 * piece;
                *(u32x4*)(XT + (size_t)(chunk * 64 + (c >> 6)) * 8192 + (((s >> 4) * 2 + (p >> 5)) * 64 + (p & 31) + 32 * ((s >> 3) & 1)) * 8) = *(const LAS u32x4*)(tile + row * TP + piece * 16); }
            __syncthreads();
        }
    }
}

constexpr int RGF_PITCH = 528;
__device__ __forceinline__ void p_rg_fused(const Frame& F0, const bf16* URAW, int L, const float* cw, const float* cbias, const bf16* Wg, const float* ba, const float* bx, const float* spt,
                                           bf16* LA, bf16* INP, float* HEND, float* PROD) {
    const Frame F = phase_frame(F0);
    LAS unsigned char* ut = F.lds;
    for (int it = blockIdx.x; it < 64 * 8; it += F.G) {
        const int nb = it & 7, run = it >> 3, t0 = run * 128;
        { const int co = F.tid & 31, tq = F.tid >> 5, c0 = nb * 256 + co * 8, tb = t0 + 8 * tq, tl = tb % L;
          float w[4][8], bias[8];
#pragma unroll
          for (int k = 0; k < 4; ++k) { const f32x4 a = *(const f32x4*)(cw + (size_t)k * D + c0), b = *(const f32x4*)(cw + (size_t)k * D + c0 + 4);
              w[k][0] = a.x; w[k][1] = a.y; w[k][2] = a.z; w[k][3] = a.w; w[k][4] = b.x; w[k][5] = b.y; w[k][6] = b.z; w[k][7] = b.w; }
          { const f32x4 a = *(const f32x4*)(cbias + c0), b = *(const f32x4*)(cbias + c0 + 4); bias[0] = a.x; bias[1] = a.y; bias[2] = a.z; bias[3] = a.w; bias[4] = b.x; bias[5] = b.y; bias[6] = b.z; bias[7] = b.w; }
          u32x4 rows[11];
#pragma unroll
          for (int i = 0; i < 11; ++i) { const int tt = tl - 1 + i; const bool ok = (tt >= 0) && (tt < L);
              rows[i] = ok ? *(const u32x4*)(URAW + (size_t)(tb - 1 + i) * D + c0) : (u32x4){0u, 0u, 0u, 0u}; }
#pragma unroll
          for (int i = 0; i < 8; ++i) {
              float y[8];
#pragma unroll
              for (int j = 0; j < 8; ++j) y[j] = bias[j];
#pragma unroll
              for (int k = 0; k < 4; ++k) { const u32x4 r = rows[i + k];
                  y[0] += w[k][0] * bflo(r.x); y[1] += w[k][1] * bfhi(r.x); y[2] += w[k][2] * bflo(r.y); y[3] += w[k][3] * bfhi(r.y);
                  y[4] += w[k][4] * bflo(r.z); y[5] += w[k][5] * bfhi(r.z); y[6] += w[k][6] * bflo(r.w); y[7] += w[k][7] * bfhi(r.w); }
              *(LAS u32x4*)(ut + (8 * tq + i) * RGF_PITCH + co * 16) = (u32x4){pk2(y[0], y[1]), pk2(y[2], y[3]), pk2(y[4], y[5]), pk2(y[6], y[7])};
          } }
        __syncthreads();
#pragma unroll 1
        for (int d = 0; d < 2; ++d) {
            int Lq = F.lane; asm volatile("" : "+v"(Lq));
            const int g = Lq >> 4, l15 = Lq & 15, w8 = F.wave;
            f32x4 acc[8][4];
#pragma unroll
            for (int m = 0; m < 8; ++m)
#pragma unroll
                for (int n = 0; n < 4; ++n) acc[m][n] = (f32x4){0.f, 0.f, 0.f, 0.f};
            const bf16* wtile = Wg + (size_t)((d * 8 + nb) * 2 + (w8 >> 2)) * 65536 + Lq * 8;
            bf16x8 bq[3][4];
#pragma unroll
            for (int q = 0; q < 3; ++q)
#pragma unroll
                for (int n = 0; n < 4; ++n) bq[q][n] = *(const bf16x8*)(wtile + ((((w8 & 3) * 2 + (n & 1) + (n >> 1) * 8) * 8 + q) * 512));
#pragma unroll 1
            for (int ks = 0; ks < 8; ++ks) {
                bf16x8 bn[4];
#pragma unroll
                for (int n = 0; n < 4; ++n) bn[n] = *(const bf16x8*)(wtile + ((((w8 & 3) * 2 + (n & 1) + (n >> 1) * 8) * 8 + ((ks + 3) & 7)) * 512));
#pragma unroll
                for (int m = 0; m < 8; ++m) { const bf16x8 a = *(const LAS bf16x8*)(ut + (16 * m + l15) * RGF_PITCH + (32 * ks + 8 * g) * 2);
#pragma unroll
                    for (int n = 0; n < 4; ++n) acc[m][n] = __builtin_amdgcn_mfma_f32_16x16x32_bf16(a, bq[0][n], acc[m][n], 0, 0, 0); }
#pragma unroll
                for (int n = 0; n < 4; ++n) { bq[0][n] = bq[1][n]; bq[1][n] = bq[2][n]; bq[2][n] = bn[n]; }
            }
            bf16* la = LA + (size_t)d * TG * D + (size_t)t0 * D + nb * 256; bf16* in = INP + (size_t)d * TG * D + (size_t)t0 * D + nb * 256;
#pragma unroll
            for (int np = 0; np < 2; ++np) {
                const int cl = 32 * w8 + 16 * np + l15, c = nb * 256 + cl;
                const float pba = ba[d * D + c], pbx = bx[d * D + c], psp = spt[d * D + c];
                float Lm[8], Hm[8];
#pragma unroll
                for (int m = 0; m < 8; ++m) {
                    float lr[4], xr[4], ea[4]; unsigned lwv[4], xwv[4];
                    int gq = g; asm volatile("" : "+v"(gq));
#pragma unroll
                    for (int e = 0; e < 4; ++e) { const int tok = 16 * m + 4 * gq + e;
                        const float u = bf2f(*(const LAS bf16*)(ut + tok * RGF_PITCH + cl * 2));
                        const float e1 = __expf(fminf(-(acc[m][np][e] + pba), 80.f)), e2 = __expf(fminf(-(acc[m][2 + np][e] + pbx), 80.f));
                        const float d1 = 1.0f + e1, d2 = 1.0f + e2, rc = frcp_(d1 * d2);
                        const float r = d2 * rc, ig = d1 * rc;
                        const unsigned lw = pk2(r * psp, 0.f); lr[e] = bflo(lw);
                        ea[e] = __expf(lr[e]);
                        const float x = fsqrt_(fmaxf(1.0f - ea[e] * ea[e], 0.f)) * ig * u;
                        const unsigned xw = pk2(x, 0.f); xr[e] = bflo(xw);
                        lwv[e] = lw & 0xffffu; xwv[e] = xw & 0xffffu; }
#pragma unroll
                    for (int ep = 0; ep < 2; ++ep) { const bool odd = (Lq & 1) != 0; const int tok = 16 * m + 4 * gq + 2 * ep + (odd ? 1 : 0);
                        const unsigned sl = odd ? lwv[2 * ep] : lwv[2 * ep + 1], sx = odd ? xwv[2 * ep] : xwv[2 * ep + 1];
                        const unsigned rl = (unsigned)__builtin_amdgcn_update_dpp(0, (int)sl, 0xB1, 0xf, 0xf, true), rx = (unsigned)__builtin_amdgcn_update_dpp(0, (int)sx, 0xB1, 0xf, 0xf, true);
                        const unsigned wl = odd ? (rl | (lwv[2 * ep + 1] << 16)) : (lwv[2 * ep] | (rl << 16)), wx = odd ? (rx | (xwv[2 * ep + 1] << 16)) : (xwv[2 * ep] | (rx << 16));
                        const int c2 = cl & ~1;
                        *(unsigned*)(la + (size_t)tok * D + c2) = wl; *(unsigned*)(in + (size_t)tok * D + c2) = wx; }
                    const float Hf = ((xr[0] * ea[1] + xr[1]) * ea[2] + xr[2]) * ea[3] + xr[3], Hb = ((xr[3] * ea[2] + xr[2]) * ea[1] + xr[1]) * ea[0] + xr[0];
                    float Ls = (lr[0] + lr[1]) + (lr[2] + lr[3]), Hs = d ? Hb : Hf;
#pragma unroll
                    for (int st = 0; st < 2; ++st) { const int bit = st ? 2 : 1; const int pl = Lq ^ (st ? 32 : 16);
                        const float Lp = shfl_lane(Ls, pl), Hp = shfl_lane(Hs, pl);
                        const bool mine_first = (((g & bit) == 0) != (d != 0));
                        Hs = mine_first ? Hs * __expf(Lp) + Hp : Hp * __expf(Ls) + Hs; Ls += Lp; }
                    Lm[m] = Ls; Hm[m] = Hs;
                }
                float Lc[2], Hc[2];
#pragma unroll
                for (int ch = 0; ch < 2; ++ch) {
                    if (d == 0) { float H = Hm[4 * ch]; H = H * __expf(Lm[4 * ch + 1]) + Hm[4 * ch + 1]; H = H * __expf(Lm[4 * ch + 2]) + Hm[4 * ch + 2]; H = H * __expf(Lm[4 * ch + 3]) + Hm[4 * ch + 3]; Hc[ch] = H; }
                    else        { float H = Hm[4 * ch + 3]; H = H * __expf(Lm[4 * ch + 2]) + Hm[4 * ch + 2]; H = H * __expf(Lm[4 * ch + 1]) + Hm[4 * ch + 1]; H = H * __expf(Lm[4 * ch]) + Hm[4 * ch]; Hc[ch] = H; }
                    Lc[ch] = (Lm[4 * ch] + Lm[4 * ch + 1]) + (Lm[4 * ch + 2] + Lm[4 * ch + 3]);
                }
                if (g == 0) {
#pragma unroll
                    for (int ch = 0; ch < 2; ++ch) { const size_t o = ((size_t)(run * 2 + ch) * 2 + d) * D + c; HEND[o] = Hc[ch]; PROD[o] = __expf(Lc[ch]); } }
            }
        }
        __syncthreads();
    }
}
__device__ __forceinline__ void p_rg_scan_b(const Frame& F0, const float* __restrict__ HEND, const float* __restrict__ PROD, float* __restrict__ HIN, int L) {
    const Frame F = phase_frame(F0);
    const int nck = L / 64, nseq = TG / L, total = nseq * 2 * D;
    for (int e = F.gw * 64 + F.lane; e < total; e += F.ngw * 64) {
        const int c = e % D, d = (e / D) & 1, sq = e / (2 * D);
        float h = 0.f;
        for (int k0 = 0; k0 < nck; k0 += 16) {
            float p[16], he[16];
#pragma unroll
            for (int j = 0; j < 16; ++j) { const int k = k0 + j, ck = sq * nck + (d ? nck - 1 - k : k); const size_t o = ((size_t)ck * 2 + d) * D + c; p[j] = PROD[o]; he[j] = HEND[o]; }
#pragma unroll
            for (int j = 0; j < 16; ++j) { const int k = k0 + j, ck = sq * nck + (d ? nck - 1 - k : k); const size_t o = ((size_t)ck * 2 + d) * D + c; HIN[o] = h; h = p[j] * h + he[j]; }
        }
    }
}
__device__ __forceinline__ void p_rg_scan_c(const Frame& F0, const bf16* LA, const bf16* INP, const float* HIN, const bf16* GATE, bf16* Y) {
    const Frame F = phase_frame(F0);
    for (int it = F.gw; it < 128 * 16; it += F.ngw) {
        const int cb = it & 15, ck = it >> 4, c0 = cb * 128 + F.lane * 2;
        const size_t base = (size_t)ck * 64 * D + c0;
        const unsigned* la0 = (const unsigned*)(LA + base); const unsigned* ip0 = (const unsigned*)(INP + base);
        const unsigned* la1 = (const unsigned*)(LA + (size_t)TG * D + base); const unsigned* ip1 = (const unsigned*)(INP + (size_t)TG * D + base);
        const unsigned* gt = (const unsigned*)(GATE + base); unsigned* yo = (unsigned*)(Y + base);
        constexpr int RS = D / 2;
        f32x2 hf[64];
        { const f32x2 hi = *(const f32x2*)(HIN + ((size_t)ck * 2 + 0) * D + c0); float h0 = hi.x, h1 = hi.y;
          unsigned cl[8], cx[8];
#pragma unroll
          for (int j = 0; j < 8; ++j) { cl[j] = la0[(size_t)j * RS]; cx[j] = ip0[(size_t)j * RS]; }
#pragma unroll
          for (int blk = 0; blk < 8; ++blk) {
              unsigned nl[8], nx[8];
              if (blk < 7) {
#pragma unroll
                  for (int j = 0; j < 8; ++j) { const int t = 8 * (blk + 1) + j; nl[j] = la0[(size_t)t * RS]; nx[j] = ip0[(size_t)t * RS]; } }
#pragma unroll
              for (int j = 0; j < 8; ++j) { const unsigned lw = cl[j], iw = cx[j]; h0 = __expf(bflo(lw)) * h0 + bflo(iw); h1 = __expf(bfhi(lw)) * h1 + bfhi(iw); hf[8 * blk + j] = (f32x2){h0, h1}; }
#pragma unroll
              for (int j = 0; j < 8; ++j) { cl[j] = nl[j]; cx[j] = nx[j]; }
          } }
        { const f32x2 hi = *(const f32x2*)(HIN + ((size_t)ck * 2 + 1) * D + c0); float h0 = hi.x, h1 = hi.y;
          unsigned cl[8], cx[8], cg[8];
#pragma unroll
          for (int j = 0; j < 8; ++j) { const int t = 63 - j; cl[j] = la1[(size_t)t * RS]; cx[j] = ip1[(size_t)t * RS]; cg[j] = gt[(size_t)t * RS]; }
#pragma unroll
          for (int blk = 0; blk < 8; ++blk) {
              unsigned nl[8], nx[8], ng[8];
              if (blk < 7) {
#pragma unroll
                  for (int j = 0; j < 8; ++j) { const int t = 63 - (8 * (blk + 1) + j); nl[j] = la1[(size_t)t * RS]; nx[j] = ip1[(size_t)t * RS]; ng[j] = gt[(size_t)t * RS]; } }
#pragma unroll
              for (int j = 0; j < 8; ++j) { const int t = 63 - (8 * blk + j); const unsigned lw = cl[j], iw = cx[j], gw = cg[j];
                  h0 = __expf(bflo(lw)) * h0 + bflo(iw); h1 = __expf(bfhi(lw)) * h1 + bfhi(iw);
                  yo[(size_t)t * RS] = pk2((hf[t].x + h0) * bflo(gw), (hf[t].y + h1) * bfhi(gw)); }
#pragma unroll
              for (int j = 0; j < 8; ++j) { cl[j] = nl[j]; cx[j] = nx[j]; cg[j] = ng[j]; }
          } }
    }
}

constexpr int PB = 272;
__device__ __forceinline__ s16x4 tr_read(const LAS unsigned char* p) { return __builtin_bit_cast(s16x4, __builtin_amdgcn_ds_read_tr16_b64_v4i16((LAS v4i16_t*)p)); }
__device__ __forceinline__ bf16x8 cat8(s16x4 lo, s16x4 hi) { return __builtin_shufflevector(lo, hi, 0, 1, 2, 3, 4, 5, 6, 7); }
__device__ __forceinline__ bf16x8 scale8(bf16x8 v, const float* w) {
    const u32x4 u = __builtin_bit_cast(u32x4, v); u32x4 o;
    o.x = pk2(bflo(u.x) * w[0], bfhi(u.x) * w[1]); o.y = pk2(bflo(u.y) * w[2], bfhi(u.y) * w[3]); o.z = pk2(bflo(u.z) * w[4], bfhi(u.z) * w[5]); o.w = pk2(bflo(u.w) * w[6], bfhi(u.w) * w[7]);
    return __builtin_bit_cast(bf16x8, o);
}
__device__ __forceinline__ bf16x8 scale8s(bf16x8 v, float w) {
    const u32x4 u = __builtin_bit_cast(u32x4, v); u32x4 o;
    o.x = pk2(bflo(u.x) * w, bfhi(u.x) * w); o.y = pk2(bflo(u.y) * w, bfhi(u.y) * w); o.z = pk2(bflo(u.z) * w, bfhi(u.z) * w); o.w = pk2(bflo(u.w) * w, bfhi(u.w) * w);
    return __builtin_bit_cast(bf16x8, o);
}
__device__ __forceinline__ void stage_img(const Frame& F, const bf16* src, int ld, LAS unsigned char* img) {
#pragma unroll
    for (int i = 0; i < 4; ++i) { const int idx = F.tid + 512 * i, r = idx >> 4, ch = idx & 15; *(LAS u32x4*)(img + r * PB + ch * 16) = *(const u32x4*)(src + (size_t)r * ld + ch * 8); }
}
__device__ __forceinline__ void ssd_tables(const Frame& F, const float* DT, int t0, int head, float A0, float A1, LAS float* tab) {
    const int L = F.lane; const float* dp = DT + (size_t)(t0 + 2 * L) * 128 + head;
    const float a0 = dp[0], a1 = dp[128], b0 = dp[64], b1 = dp[128 + 64];
    float sa = a0 + a1, sb = b0 + b1, ia = sa, ib = sb;
#pragma unroll
    for (int o = 1; o < 64; o <<= 1) { const float xa = shfl_lane(ia, (L - o) & 63), xb = shfl_lane(ib, (L - o) & 63); if (L >= o) { ia += xa; ib += xb; } }
    const float totb = shfl_lane(ib, 63);
    const float ea = ia - sa, eb = ib - sb;
    tab[2 * L] = A0 * (ea + a0); tab[2 * L + 1] = A0 * (ea + a0 + a1);
    tab[128 + 2 * L] = A1 * (totb - eb); tab[128 + 2 * L + 1] = A1 * (totb - eb - b0);
    tab[256 + 2 * L] = a0; tab[256 + 2 * L + 1] = a1; tab[384 + 2 * L] = b0; tab[384 + 2 * L + 1] = b1;
}
__device__ __forceinline__ void p_ssd_dt(const Frame& F0, const bf16* XA, const bf16* Wdt  , const float* dtb, float* DT) {
    const Frame F = phase_frame(F0);
    LAS float* part = (LAS float*)F.lds;
    const int L = F.lane, g = L >> 4, l15 = L & 15;
    for (int rb = blockIdx.x; rb < TG / 32; rb += F.G) {
        const int r0 = rb * 32, kb = F.wave * 256;
        f32x4 acc[2][8];
#pragma unroll
        for (int m = 0; m < 2; ++m)
#pragma unroll
            for (int n = 0; n < 8; ++n) acc[m][n] = (f32x4){0.f, 0.f, 0.f, 0.f};
#pragma unroll 2
        for (int ks = 0; ks < 8; ++ks) {
            bf16x8 a[2], b[8];
#pragma unroll
            for (int m = 0; m < 2; ++m) a[m] = *(const bf16x8*)((const char*)XA + pg8::blk_off(r0 + 16 * m + l15, kb + 32 * ks + 8 * g, D, false));
#pragma unroll
            for (int n = 0; n < 8; ++n) b[n] = *(const bf16x8*)(Wdt + (size_t)(16 * n + l15) * D + kb + 32 * ks + 8 * g);
#pragma unroll
            for (int m = 0; m < 2; ++m)
#pragma unroll
                for (int n = 0; n < 8; ++n) acc[m][n] = __builtin_amdgcn_mfma_f32_16x16x32_bf16(a[m], b[n], acc[m][n], 0, 0, 0);
        }
#pragma unroll
        for (int m = 0; m < 2; ++m)
#pragma unroll
            for (int n = 0; n < 8; ++n)
#pragma unroll
                for (int e = 0; e < 4; ++e) part[(F.wave * 32 + 16 * m + 4 * g + e) * 128 + 16 * n + l15] = acc[m][n][e];
        __syncthreads();
        { const int row = F.tid >> 4, cb = (F.tid & 15) * 8;
          f32x4 s0 = *(const f32x4*)(dtb + cb), s1 = *(const f32x4*)(dtb + cb + 4);
#pragma unroll
          for (int w = 0; w < 8; ++w) { s0 += *(const LAS f32x4*)(part + (w * 32 + row) * 128 + cb); s1 += *(const LAS f32x4*)(part + (w * 32 + row) * 128 + cb + 4); }
#pragma unroll
          for (int j = 0; j < 4; ++j) { s0[j] = softplusf_(s0[j]); s1[j] = softplusf_(s1[j]); }
          float* o = DT + (size_t)(r0 + row) * 128 + cb; *(f32x4*)o = s0; *(f32x4*)(o + 4) = s1; }
        __syncthreads();
    }
}
__device__ __forceinline__ void p_ssd_states(const Frame& F0, const bf16* XT, const bf16* BMt, const float* DT, const float* alog, bf16* ST, float* DEC) {
    const Frame F = phase_frame(F0);
    LAS unsigned char* img = F.lds; LAS float* tab = (LAS float*)(F.lds + 36864 + F.wave * 2048);
    const int L = F.lane, h = L >> 5, l31 = L & 31, q = (L & 15) >> 2, p4 = L & 3, blk = (L >> 4) & 1;
    for (int it = blockIdx.x; it < 64 * 8; it += F.G) {
        const int c = it >> 3, g = it & 7, head = g * 8 + F.wave, t0 = c * 128;
        const bf16* xt = XT + (size_t)(c * 64 + head) * 64 * 128;
        bf16x8 xc[2][2];
#pragma unroll
        for (int k2 = 0; k2 < 2; ++k2)
#pragma unroll
            for (int pt = 0; pt < 2; ++pt) xc[k2][pt] = *(const bf16x8*)(xt + ((k2 * 2 + pt) * 64 + L) * 8);
        stage_img(F, BMt + (size_t)t0 * 1024 + g * 128, 1024, img);
        const float A0 = -__expf(alog[head]), A1 = -__expf(alog[64 + head]);
        ssd_tables(F, DT, t0, head, A0, A1, tab);
        __syncthreads();
        const float afe = tab[127], ab0 = tab[128];
        if (L == 0) { DEC[(c * 2 + 0) * 64 + head] = __expf(afe); DEC[(c * 2 + 1) * 64 + head] = __expf(ab0); }
#pragma unroll 1
        for (int dir = 0; dir < 2; ++dir) {
            f32x16 acc[4][2];
#pragma unroll
            for (int a = 0; a < 4; ++a)
#pragma unroll
                for (int b = 0; b < 2; ++b)
#pragma unroll
                    for (int r = 0; r < 16; ++r) acc[a][b][r] = 0.f;
            const float eref = dir ? ab0 : afe;
#pragma unroll 1
            for (int kp = 0; kp < 4; ++kp) {
                bf16x8 xn[2][2];
                { const int kn0 = (kp < 3) ? 2 * (kp + 1) : 0;
#pragma unroll
                  for (int k2 = 0; k2 < 2; ++k2)
#pragma unroll
                      for (int pt = 0; pt < 2; ++pt) xn[k2][pt] = *(const bf16x8*)(xt + (((kn0 + k2) * 2 + pt) * 64 + L) * 8); }
#pragma unroll
                for (int k2 = 0; k2 < 2; ++k2) {
                    const int ks = 2 * kp + k2, s0 = 16 * ks + 8 * h;
                    float w[8];
#pragma unroll
                    for (int j = 0; j < 8; ++j) w[j] = __expf(eref - tab[dir * 128 + s0 + j]) * tab[256 + dir * 128 + s0 + j];
                    bf16x8 bfr[2];
#pragma unroll
                    for (int pt = 0; pt < 2; ++pt) bfr[pt] = scale8(xc[k2][pt], w);
#pragma unroll
                    for (int nt = 0; nt < 4; ++nt) {
                        const LAS unsigned char* ad = img + (16 * ks + 8 * h + q) * PB + (32 * nt + 16 * blk + 4 * p4) * 2;
                        const bf16x8 afr = cat8(tr_read(ad), tr_read(ad + 4 * PB));
#pragma unroll
                        for (int pt = 0; pt < 2; ++pt) acc[nt][pt] = __builtin_amdgcn_mfma_f32_32x32x16_bf16(afr, bfr[pt], acc[nt][pt], 0, 0, 0);
                    }
                }
#pragma unroll
                for (int k2 = 0; k2 < 2; ++k2)
#pragma unroll
                    for (int pt = 0; pt < 2; ++pt) xc[k2][pt] = xn[k2][pt];
            }
            bf16* st = ST + ((size_t)(c * 2 + dir) * 64 + head) * 8192;
#pragma unroll
            for (int nt = 0; nt < 4; ++nt)
#pragma unroll
                for (int pt = 0; pt < 2; ++pt)
#pragma unroll
                    for (int qd = 0; qd < 4; ++qd) { u32x2 w2; w2.x = pk2(acc[nt][pt][4 * qd], acc[nt][pt][4 * qd + 1]); w2.y = pk2(acc[nt][pt][4 * qd + 2], acc[nt][pt][4 * qd + 3]);
                        *(u32x2*)(st + (((2 * nt + (qd >> 1)) * 2 + pt) * 64 + l31 + 32 * (qd & 1)) * 8 + 4 * h) = w2; }
        }
        __syncthreads();
    }
}
__device__ __forceinline__ void p_ssd_rec(const Frame& F0, bf16* ST, const float* __restrict__ DEC, int L) {
    const Frame F = phase_frame(F0);
    const int nck = L / 128, nseq = TG / L, total = nseq * 131072;
    for (int e = F.gw * 64 + F.lane; e < total; e += F.ngw * 64) {
        const int oct = e & 1023, head = (e >> 10) & 63, dir = (e >> 16) & 1, sq = e >> 17;
        float hst[8];
#pragma unroll
        for (int j = 0; j < 8; ++j) hst[j] = 0.f;
        for (int k0 = 0; k0 < nck; k0 += 8) {
            u32x4 v[8]; float dec[8];
#pragma unroll
            for (int j = 0; j < 8; ++j) { const int k = k0 + j, c = sq * nck + (dir ? nck - 1 - k : k);
                v[j] = *(const u32x4*)(ST + ((size_t)(c * 2 + dir) * 64 + head) * 8192 + oct * 8); dec[j] = DEC[(c * 2 + dir) * 64 + head]; }
#pragma unroll
            for (int j = 0; j < 8; ++j) { const int k = k0 + j, c = sq * nck + (dir ? nck - 1 - k : k);
                u32x4 o; o.x = pk2(hst[0], hst[1]); o.y = pk2(hst[2], hst[3]); o.z = pk2(hst[4], hst[5]); o.w = pk2(hst[6], hst[7]);
                *(u32x4*)(ST + ((size_t)(c * 2 + dir) * 64 + head) * 8192 + oct * 8) = o;
                const float dc = dec[j]; const u32x4 x = v[j];
                hst[0] = hst[0] * dc + bflo(x.x); hst[1] = hst[1] * dc + bfhi(x.x); hst[2] = hst[2] * dc + bflo(x.y); hst[3] = hst[3] * dc + bfhi(x.y);
                hst[4] = hst[4] * dc + bflo(x.z); hst[5] = hst[5] * dc + bfhi(x.z); hst[6] = hst[6] * dc + bflo(x.w); hst[7] = hst[7] * dc + bfhi(x.w); }
        }
    }
}
__device__ __forceinline__ void p_ssd_out(const Frame& F0, const bf16* XT, const bf16* BMt, const bf16* CMt, const float* DT, const float* alog, const float* dskip, const bf16* ST,
                                          const bf16* ZS, const float* ng, bf16* Y) {
    const Frame F = phase_frame(F0);
    LAS unsigned char* imgB = F.lds; LAS unsigned char* imgC = F.lds + 34816; LAS float* tab = (LAS float*)(F.lds + 69632 + F.wave * 2048); LAS float* part = (LAS float*)(F.lds + 69632 + 16384);
    const int L0 = F.lane;
    for (int it = blockIdx.x; it < 64 * 8; it += F.G) {
        const int c = it >> 3, g = it & 7, head = g * 8 + F.wave, t0 = c * 128;
        stage_img(F, BMt + (size_t)t0 * 1024 + g * 128, 1024, imgB);
        stage_img(F, CMt + (size_t)t0 * 1024 + g * 128, 1024, imgC);
        const float A0 = -__expf(alog[head]), A1 = -__expf(alog[64 + head]), dsk = dskip[head];
        ssd_tables(F, DT, t0, head, A0, A1, tab);
        __syncthreads();
        const bf16* xt = XT + (size_t)(c * 64 + head) * 64 * 128;
#pragma unroll 1
        for (int half = 0; half < 2; ++half) {
            f32x16 acc[2][2];
#pragma unroll
            for (int a = 0; a < 2; ++a)
#pragma unroll
                for (int b = 0; b < 2; ++b)
#pragma unroll
                    for (int r = 0; r < 16; ++r) acc[a][b][r] = 0.f;
            { int L = L0; asm volatile("" : "+v"(L)); const int h = L >> 5, l31 = L & 31;
#pragma unroll 1
            for (int st = 0; st < 4; ++st) {
                bf16x8 xa[2][2];
#pragma unroll
                for (int ks = 0; ks < 2; ++ks)
#pragma unroll
                    for (int pt = 0; pt < 2; ++pt) { const bf16* xp = xt + (((2 * st + ks) * 2 + pt) * 64 + l31) * 8 + 4 * h;
                        const s16x4 lo = *(const s16x4*)xp, hi = *(const s16x4*)(xp + 32 * 8); xa[ks][pt] = cat8(lo, hi); }
#pragma unroll
                for (int tt = 0; tt < 2; ++tt) {
                    const int tg = 2 * half + tt;
                    f32x16 dg;
#pragma unroll
                    for (int r = 0; r < 16; ++r) dg[r] = 0.f;
#pragma unroll 2
                    for (int kn = 0; kn < 8; ++kn) { const bf16x8 a = *(const LAS bf16x8*)(imgB + (32 * st + l31) * PB + (16 * kn + 8 * h) * 2), b = *(const LAS bf16x8*)(imgC + (32 * tg + l31) * PB + (16 * kn + 8 * h) * 2);
                        dg = __builtin_amdgcn_mfma_f32_32x32x16_bf16(a, b, dg, 0, 0, 0); }
                    const int t = 32 * tg + l31; const float aft = tab[t], abt = tab[128 + t];
                    float v[16];
#pragma unroll
                    for (int qd = 0; qd < 4; ++qd) { const int sb = 32 * st + 8 * qd + 4 * h;
                        const f32x4 afs = *(const LAS f32x4*)(tab + sb), abs_ = *(const LAS f32x4*)(tab + 128 + sb), d0 = *(const LAS f32x4*)(tab + 256 + sb), d1 = *(const LAS f32x4*)(tab + 384 + sb);
                        if (st < tg) {
#pragma unroll
                            for (int e = 0; e < 4; ++e) v[4 * qd + e] = dg[4 * qd + e] * (__expf(aft - afs[e]) * d0[e]);
                        } else if (st > tg) {
#pragma unroll
                            for (int e = 0; e < 4; ++e) v[4 * qd + e] = dg[4 * qd + e] * (__expf(abt - abs_[e]) * d1[e]);
                        } else {
#pragma unroll
                            for (int e = 0; e < 4; ++e) { const int s = sb + e; float m = 0.f;
                                if (s <= t) m += __expf(aft - afs[e]) * d0[e];
                                if (s >= t) m += __expf(abt - abs_[e]) * d1[e];
                                float x = dg[4 * qd + e] * m; if (s == t) x += dsk; v[4 * qd + e] = x; } } }
                    bf16x8 gf[2];
#pragma unroll
                    for (int ks = 0; ks < 2; ++ks) { u32x4 o; o.x = pk2(v[8 * ks], v[8 * ks + 1]); o.y = pk2(v[8 * ks + 2], v[8 * ks + 3]); o.z = pk2(v[8 * ks + 4], v[8 * ks + 5]); o.w = pk2(v[8 * ks + 6], v[8 * ks + 7]); gf[ks] = __builtin_bit_cast(bf16x8, o); }
#pragma unroll
                    for (int pt = 0; pt < 2; ++pt)
#pragma unroll
                        for (int ks = 0; ks < 2; ++ks) acc[tt][pt] = __builtin_amdgcn_mfma_f32_32x32x16_bf16(xa[ks][pt], gf[ks], acc[tt][pt], 0, 0, 0);
                }
            }
            }
            { int L = L0; asm volatile("" : "+v"(L)); const int h = L >> 5, l31 = L & 31;
            const bf16* hs0 = ST + ((size_t)(c * 2) * 64 + head) * 8192;
            bf16x8 hc[4][2];
#pragma unroll
            for (int k4 = 0; k4 < 4; ++k4)
#pragma unroll
                for (int pt = 0; pt < 2; ++pt) hc[k4][pt] = *(const bf16x8*)(hs0 + ((k4 * 2 + pt) * 64 + L) * 8);
#pragma unroll 1
            for (int bt = 0; bt < 4; ++bt) {
                const int dir = bt >> 1, kh = bt & 1;
                bf16x8 hn[4][2];
                { const int nb2 = (bt + 1) & 3; const bf16* hsn = hs0 + (size_t)(nb2 >> 1) * 64 * 8192;
#pragma unroll
                  for (int k4 = 0; k4 < 4; ++k4)
#pragma unroll
                      for (int pt = 0; pt < 2; ++pt) hn[k4][pt] = *(const bf16x8*)(hsn + (((4 * (nb2 & 1) + k4) * 2 + pt) * 64 + L) * 8); }
                float et[2];
#pragma unroll
                for (int tt = 0; tt < 2; ++tt) et[tt] = __expf(tab[dir * 128 + 32 * (2 * half + tt) + l31]);
#pragma unroll
                for (int k4 = 0; k4 < 4; ++k4) { const int kn = 4 * kh + k4;
#pragma unroll
                    for (int tt = 0; tt < 2; ++tt) { const bf16x8 cb = scale8s(*(const LAS bf16x8*)(imgC + (32 * (2 * half + tt) + l31) * PB + (16 * kn + 8 * h) * 2), et[tt]);
#pragma unroll
                        for (int pt = 0; pt < 2; ++pt) acc[tt][pt] = __builtin_amdgcn_mfma_f32_32x32x16_bf16(hc[k4][pt], cb, acc[tt][pt], 0, 0, 0); }
                }
#pragma unroll
                for (int k4 = 0; k4 < 4; ++k4)
#pragma unroll
                    for (int pt = 0; pt < 2; ++pt) hc[k4][pt] = hn[k4][pt];
            }
            }
            { int L = L0; asm volatile("" : "+v"(L)); const int h = L >> 5, l31 = L & 31, lr8 = L >> 3, lp8 = L & 7;
              LAS unsigned char* wt = F.lds + 88064 + F.wave * 4608;
#pragma unroll
            for (int tt = 0; tt < 2; ++tt) { const size_t rowb = (size_t)(t0 + 32 * (2 * half + tt)); float ssq = 0.f;
                u32x4 zl[4];
#pragma unroll
                for (int i = 0; i < 4; ++i) zl[i] = *(const u32x4*)(ZS + (rowb + lr8 + 8 * i) * SSD_DI + head * 64 + lp8 * 8);
#pragma unroll
                for (int i = 0; i < 4; ++i) *(LAS u32x4*)(wt + (lr8 + 8 * i) * 144 + lp8 * 16) = zl[i];
                asm volatile("s_waitcnt lgkmcnt(0)" ::: "memory");
#pragma unroll
                for (int pt = 0; pt < 2; ++pt)
#pragma unroll
                    for (int qd = 0; qd < 4; ++qd) { const u32x2 z = *(const LAS u32x2*)(wt + l31 * 144 + (32 * pt + 8 * qd + 4 * h) * 2);
                        const float y0 = acc[tt][pt][4 * qd] * bflo(z.x), y1 = acc[tt][pt][4 * qd + 1] * bfhi(z.x), y2 = acc[tt][pt][4 * qd + 2] * bflo(z.y), y3 = acc[tt][pt][4 * qd + 3] * bfhi(z.y);
                        acc[tt][pt][4 * qd] = y0; acc[tt][pt][4 * qd + 1] = y1; acc[tt][pt][4 * qd + 2] = y2; acc[tt][pt][4 * qd + 3] = y3; ssq += (y0 * y0 + y1 * y1) + (y2 * y2 + y3 * y3); }
                asm volatile("s_waitcnt lgkmcnt(0)" ::: "memory");
                ssq += shfl_lane(ssq, L ^ 32);
                if (h == 0) part[F.wave * 64 + 32 * tt + l31] = ssq; }
            __syncthreads();
#pragma unroll
            for (int tt = 0; tt < 2; ++tt) { const int tl = 32 * tt + l31; const size_t rowb = (size_t)(t0 + 64 * half + 32 * tt); float tot = 0.f;
#pragma unroll
                for (int w = 0; w < 8; ++w) tot += part[w * 64 + tl];
                const float rstd = rsqrtf(tot * (1.0f / 512.0f) + LN_EPS);
#pragma unroll
                for (int pt = 0; pt < 2; ++pt)
#pragma unroll
                    for (int qd = 0; qd < 4; ++qd) { const int cc = head * 64 + 32 * pt + 8 * qd + 4 * h; const f32x4 gg = *(const f32x4*)(ng + cc);
                        u32x2 o; o.x = pk2(acc[tt][pt][4 * qd] * rstd * gg.x, acc[tt][pt][4 * qd + 1] * rstd * gg.y); o.y = pk2(acc[tt][pt][4 * qd + 2] * rstd * gg.z, acc[tt][pt][4 * qd + 3] * rstd * gg.w);
                        *(LAS u32x2*)(wt + l31 * 144 + (32 * pt + 8 * qd + 4 * h) * 2) = o; }
                asm volatile("s_waitcnt lgkmcnt(0)" ::: "memory");
#pragma unroll
                for (int i = 0; i < 4; ++i) *(u32x4*)(Y + (rowb + lr8 + 8 * i) * SSD_DI + head * 64 + lp8 * 8) = *(const LAS u32x4*)(wt + (lr8 + 8 * i) * 144 + lp8 * 16);
                asm volatile("s_waitcnt lgkmcnt(0)" ::: "memory"); }
            }
            __syncthreads();
        }
    }
}

constexpr int NA_STG = 2 * 64 * PB;
__device__ __forceinline__ void p_natt(const Frame& F0, const bf16* Q, const bf16* Kb, const bf16* V, const float* rpb, bf16* O, int L) {
    const Frame F = phase_frame(F0);
    LAS unsigned char* ringb = F.lds;
    LAS float* rp = (LAS float*)(F.lds + 3 * NA_STG);
    const int Ln = F.lane, g = Ln >> 4, l15 = Ln & 15, q4 = l15 >> 2, p4 = Ln & 3;
    const int rps = L / 64, nrb = 128 / 4;
    const int wrow = F.wave >> 1, chf = F.wave & 1;
    for (int it = blockIdx.x; it < nrb * 16; it += F.G) {
        const int head = it & 15, rb = it >> 4, grow0 = rb * 4, sq = grow0 / rps, r0 = grow0 % rps;
        const size_t rowbase = (size_t)sq * rps * 64;
        int klo = r0 - 4; klo = klo < 0 ? 0 : (klo > rps - 8 ? rps - 8 : klo);
        int khi = r0 + 3 - 4; khi = khi < 0 ? 0 : (khi > rps - 8 ? rps - 8 : khi); khi += 7;
        const int nst = khi - klo + 1;
        const int r = r0 + wrow; int rs = r - 4; rs = rs < 0 ? 0 : (rs > rps - 8 ? rps - 8 : rs);
        for (int i = F.tid; i < 465; i += NTHR) rp[i] = rpb[(size_t)head * 465 + i];
        u32x4 st0[4], st1[4];
        auto gload = [&](u32x4 (&d)[4], int s) {
#pragma unroll
            for (int i = 0; i < 2; ++i) { const int idx = F.tid + 512 * i, key = idx >> 4, ch = idx & 15; const size_t off = (rowbase + (size_t)(klo + s) * 64 + key) * D + head * 128 + ch * 8;
                d[i] = *(const u32x4*)(Kb + off); d[2 + i] = *(const u32x4*)(V + off); } };
        auto lstore = [&](const u32x4 (&d)[4], int s) { LAS unsigned char* b = ringb + (s % 3) * NA_STG;
#pragma unroll
            for (int i = 0; i < 2; ++i) { const int idx = F.tid + 512 * i, key = idx >> 4, ch = idx & 15; *(LAS u32x4*)(b + key * PB + ch * 16) = d[i]; *(LAS u32x4*)(b + 64 * PB + key * PB + ch * 16) = d[2 + i]; } };
        gload(st0, 0); gload(st1, 1);
        bf16x8 qf[2][4];
#pragma unroll
        for (int jt = 0; jt < 2; ++jt)
#pragma unroll
            for (int kd = 0; kd < 4; ++kd) qf[jt][kd] = *(const bf16x8*)(Q + (rowbase + (size_t)r * 64 + 16 * (2 * chf + jt) + l15) * D + head * 128 + 32 * kd + 8 * g);
        lstore(st0, 0); lstore(st1, 1);
        gload(st0, 2); if (nst > 3) gload(st1, 3);
        float mrun[2] = {-3.0e38f, -3.0e38f}, lrun[2] = {0.f, 0.f};
        f32x4 oacc[2][8];
#pragma unroll
        for (int jt = 0; jt < 2; ++jt)
#pragma unroll
            for (int dt = 0; dt < 8; ++dt) oacc[jt][dt] = (f32x4){0.f, 0.f, 0.f, 0.f};
        __syncthreads();
#pragma unroll 1
        for (int s = 0; s < nst; ++s) {
            const int kr = klo + s;
            const LAS unsigned char* kb = ringb + (s % 3) * NA_STG; const LAS unsigned char* vb = kb + 64 * PB;
            if (kr >= rs && kr <= rs + 7) {
                const int dy = kr - r + 7;
                int Lq = Ln; asm volatile("" : "+v"(Lq));
                const int g = Lq >> 4, l15 = Lq & 15, q4 = l15 >> 2, p4 = Lq & 3;
#pragma unroll
                for (int jt = 0; jt < 2; ++jt) {
                    const int j = 2 * chf + jt, kstart = (j == 0) ? 0 : (j == 1 ? 8 : (j == 2 ? 24 : 32)), qcol = 16 * j + l15;
                    int wst = qcol - 8; wst = wst < 0 ? 0 : (wst > 48 ? 48 : wst);
                    f32x4 sA = {0.f, 0.f, 0.f, 0.f}, sB = {0.f, 0.f, 0.f, 0.f};
                    const LAS unsigned char* ka = kb + (kstart + 8 * q4 + p4) * PB + 16 * g;
#pragma unroll
                    for (int kd = 0; kd < 4; ++kd) { const bf16x8 fa = *(const LAS bf16x8*)(ka + 64 * kd), fb = *(const LAS bf16x8*)(ka + 4 * PB + 64 * kd);
                        sA = __builtin_amdgcn_mfma_f32_16x16x32_bf16(fa, qf[jt][kd], sA, 0, 0, 0); sB = __builtin_amdgcn_mfma_f32_16x16x32_bf16(fb, qf[jt][kd], sB, 0, 0, 0); }
                    float sv[8]; float mx = mrun[jt];
#pragma unroll
                    for (int e = 0; e < 8; ++e) { const int kcol = kstart + 8 * g + e; const bool ok = (kcol >= wst) && (kcol < wst + 16);
                        int dx = kcol - qcol + 15; dx = dx < 0 ? 0 : (dx > 30 ? 30 : dx);
                        const float x = (e < 4 ? sA[e] : sB[e - 4]) + rp[dy * 31 + dx]; sv[e] = ok ? x : -3.0e38f; mx = fmaxf(mx, sv[e]); }
                    mx = fmaxf(mx, shfl_lane(mx, Lq ^ 16)); mx = fmaxf(mx, shfl_lane(mx, Lq ^ 32));
                    const float alpha = __expf(mrun[jt] - mx); mrun[jt] = mx;
                    float ps = 0.f;
#pragma unroll
                    for (int e = 0; e < 8; ++e) { sv[e] = __expf(sv[e] - mx); ps += sv[e]; }
                    ps += shfl_lane(ps, Lq ^ 16); ps += shfl_lane(ps, Lq ^ 32);
                    lrun[jt] = lrun[jt] * alpha + ps;
                    u32x4 pw; pw.x = pk2(sv[0], sv[1]); pw.y = pk2(sv[2], sv[3]); pw.z = pk2(sv[4], sv[5]); pw.w = pk2(sv[6], sv[7]);
                    const bf16x8 pf = __builtin_bit_cast(bf16x8, pw);
                    const LAS unsigned char* va = vb + (kstart + 8 * g + q4) * PB + 8 * p4;
#pragma unroll
                    for (int dt = 0; dt < 8; ++dt) { const bf16x8 vf = cat8(tr_read(va + 32 * dt), tr_read(va + 4 * PB + 32 * dt));
                        oacc[jt][dt] = oacc[jt][dt] * alpha; oacc[jt][dt] = __builtin_amdgcn_mfma_f32_16x16x32_bf16(vf, pf, oacc[jt][dt], 0, 0, 0); }
                }
            }
            if (s + 2 < nst) { if (s & 1) lstore(st1, s + 2); else lstore(st0, s + 2); }
            if (s + 4 < nst) { if (s & 1) gload(st1, s + 4); else gload(st0, s + 4); }
            __syncthreads();
        }
#pragma unroll
        for (int jt = 0; jt < 2; ++jt) { const float inv = frcp_(lrun[jt]); bf16* op = O + (rowbase + (size_t)r * 64 + 16 * (2 * chf + jt) + l15) * D + head * 128 + 4 * g;
#pragma unroll
            for (int dt = 0; dt < 8; ++dt) { u32x2 o; o.x = pk2(oacc[jt][dt][0] * inv, oacc[jt][dt][1] * inv); o.y = pk2(oacc[jt][dt][2] * inv, oacc[jt][dt][3] * inv); *(u32x2*)(op + 16 * dt) = o; } }
    }
}

struct Args { const float* in[29]; float* out; unsigned char* ws; int g_lo, g_hi, l_lo, l_hi, ph, pad; };

__global__ void __launch_bounds__(NTHR, 2) enc_fwd(Args args) {
    extern __shared__ __attribute__((aligned(16))) unsigned char lds[];
    Frame F;
    F.lds = (LAS unsigned char*)lds;
    F.tid = threadIdx.x; F.lane = F.tid & 63; F.wave = __builtin_amdgcn_readfirstlane(F.tid >> 6);
    F.G = gridDim.x; F.gw = F.wave * F.G + (int)blockIdx.x; F.ngw = F.G * NWAVES;
    unsigned char* ws = args.ws;
    gu32* ctl = (gu32*)(ws + WS_CTL);
    for (int u = F.tid; u < (LDS_BYTES - LDSCTL_OFF) / 4; u += NTHR) ((LAS unsigned*)(F.lds + LDSCTL_OFF))[u] = 0u;
    __syncthreads();
    const int ph = args.ph;
    XcdBarrier bar; bar.bar = (unsigned*)(ctl + CW_BAR); bar.x = 0; bar.st = nullptr;
    if (ph < 0) bar = xcd_barrier_post((unsigned*)(ctl + CW_BAR), (volatile LAS unsigned*)(F.lds + MISC_OFF) + 8);
#ifndef PROBE_TMASK
#define PROBE_TMASK 0ull
#endif
    unsigned long long tp0 = 0ull, tpacc = 0ull; int tph = 0;
#define RUN(k) ((ph < 0 || ph == (k)) && (tph = (k), tp0 = (PROBE_TMASK ? __builtin_amdgcn_s_memrealtime() : 0ull), true))
#ifndef PROBE_MASK
#define PROBE_MASK 0
#endif
#define NREP(bit) (((PROBE_MASK >> (bit)) & 1) ? 2 : 1)
#define REPEAT(bit) _Pragma("unroll 1") for (int rep = 0; rep < NREP(bit); ++rep)
    float* XDUM = (float*)(ws + WS_SCR + S_DUM); bf16* XBDUM = (bf16*)(ws + WS_SCR + S_DUM + 64 * MiB);
#ifndef PROBE_GPART
#define PROBE_GPART 0
#endif
#define TMODE() ((PROBE_GPART && (((unsigned long long)PROBE_TMASK >> tph) & 1ull)) ? PROBE_GPART : 0)
#define GRID_BAR() do { if (ph < 0) xcd_barrier(bar); if (PROBE_TMASK && !PROBE_GPART && (((unsigned long long)PROBE_TMASK >> tph) & 1ull)) tpacc += __builtin_amdgcn_s_memrealtime() - tp0; } while (0)

    bf16* Wb = (bf16*)(ws + WS_W);
    unsigned char* scr = ws + WS_SCR;
    bf16* XB = (bf16*)(scr + S_XB); bf16* YB = (bf16*)(scr + S_YB); bf16* HB = (bf16*)(scr + S_HID);
    LAS unsigned char* ring = F.lds;

    if (RUN(0) && args.g_lo == 0 && args.l_lo == 0) { p_prologue(F, args.in, Wb, (float*)(ws + WS_SPT), (bf16*)(scr + S_XB0)); GRID_BAR(); }

    for (int grp = args.g_lo; grp < args.g_hi; ++grp) {
        float* X = args.out + (size_t)grp * TG * D;
        const int L = grp < 2 ? 2048 : 8192;
        const float* Xin0 = grp < 2 ? args.in[0] + (size_t)grp * TG * D : args.in[1] + (size_t)(grp - 2) * TG * D;
        const bf16* XB0g = (const bf16*)(scr + S_XB0) + (size_t)grp * TG * D;
        for (int layer = args.l_lo; layer < args.l_hi; ++layer) {
            const int kind = layer % 3, jl = layer / 3;
            int Kout = 2048; const bf16* Wout; const bf16* XA = layer == 0 ? XB0g : XB;
            if (kind == 0) {
                bf16* GATE = (bf16*)(scr + S_RG_GATE); bf16* URAW = (bf16*)(scr + S_RG_URAW); bf16* LA = (bf16*)(scr + S_RG_LA); bf16* INP = (bf16*)(scr + S_RG_INP);
                float* HEND = (float*)(scr + S_RG_HEND); float* PROD = (float*)(scr + S_RG_PROD); float* HIN = (float*)(scr + S_RG_HIN);
                if (RUN(10)) REPEAT(1) { pg8::Gemm g{XA, Wb + W_RGIN + (size_t)jl * 4096 * 2048, 2048, 2048, 1}; pg8::StaticOrder S; S.init(TG, 4096, F.G, (int)blockIdx.x);
                    pg8::EpiRgIn E{GATE, URAW}; pg8::gemm_phase<pg8::EpiRgIn>(ring, g, S, E, tpacc, TMODE()); GRID_BAR(); }
                if (RUN(11)) { p_rg_fused(F, URAW, L, args.in[3] + (size_t)jl * 4 * 2048, args.in[4] + (size_t)jl * 2048, Wb + W_RGGATE + (size_t)jl * 32 * 65536,
                                          args.in[6] + (size_t)jl * 2 * 2048, args.in[8] + (size_t)jl * 2 * 2048, (const float*)(ws + WS_SPT) + (size_t)jl * 2 * 2048, LA, INP, HEND, PROD); GRID_BAR(); }
                if (RUN(14)) REPEAT(3) { p_rg_scan_b(F, HEND, PROD, HIN, L); GRID_BAR(); }
                if (RUN(15)) REPEAT(3) { p_rg_scan_c(F, LA, INP, HIN, GATE, YB); GRID_BAR(); }
                Wout = Wb + W_RGOUT + (size_t)jl * 2048 * 2048;
            } else if (kind == 1) {
                bf16* ZS = (bf16*)(scr + S_SSD_ZS); bf16* XBCR = (bf16*)(scr + S_SSD_XBCR); bf16* XT = (bf16*)(scr + S_SSD_XT); bf16* BMt = (bf16*)(scr + S_SSD_BM); bf16* CMt = (bf16*)(scr + S_SSD_CM);
                float* DT = (float*)(scr + S_SSD_DT); float* DEC = (float*)(scr + S_SSD_DEC); bf16* ST = (bf16*)(scr + S_SSD_ST);
                if (RUN(20)) REPEAT(1) { pg8::Gemm g{XA, Wb + W_SSDIN, 2048, 2048, 1}; pg8::StaticOrder S; S.init(TG, 40 * 256, F.G, (int)blockIdx.x);
                    pg8::EpiSsdIn E{ZS, XBCR}; pg8::gemm_phase<pg8::EpiSsdIn>(ring, g, S, E, tpacc, TMODE()); GRID_BAR(); }
                if (RUN(21)) REPEAT(4) { p_ssd_dt(F, XA, Wb + W_SSDIN + (size_t)10240 * 2048, args.in[14], DT); p_conv_ssd(F, XBCR, L, args.in[12], args.in[13], XT, BMt, CMt); GRID_BAR(); }
                if (RUN(22)) REPEAT(4) { p_ssd_states(F, XT, BMt, DT, args.in[15], ST, DEC); GRID_BAR(); }
                if (RUN(23)) { p_ssd_rec(F, ST, DEC, L); GRID_BAR(); }
                if (RUN(24)) REPEAT(4) { p_ssd_out(F, XT, BMt, CMt, DT, args.in[15], args.in[16], ST, ZS, args.in[17], YB); GRID_BAR(); }
                Wout = Wb + W_SSDOUT; Kout = 4096;
            } else {
                bf16* Qb = (bf16*)(scr + S_NA_Q); bf16* Kb = (bf16*)(scr + S_NA_K); bf16* Vb = (bf16*)(scr + S_NA_V);
                if (RUN(30)) REPEAT(1) { pg8::Gemm g{XA, Wb + W_NAQKV, 2048, 2048, 1}; pg8::StaticOrder S; S.init(TG, 6144, F.G, (int)blockIdx.x);
                    pg8::EpiQkv E{Qb, args.in[20]}; pg8::gemm_phase<pg8::EpiQkv>(ring, g, S, E, tpacc, TMODE()); GRID_BAR(); }
                if (RUN(31)) REPEAT(5) { p_natt(F, Qb, Kb, Vb, args.in[21], YB, L); GRID_BAR(); }
                Wout = Wb + W_NAOUT;
            }
            unsigned long long* xslot = (unsigned long long*)(ws + WS_XSLOT); unsigned* pcnt = (unsigned*)(ctl + CW_SEAM); unsigned* ptmo = (unsigned*)(ctl + CW_TMO);
            const unsigned ep = (unsigned)((grp * DEPTH + layer) * 2);
            if (RUN(40)) { pg8::Gemm g{YB, Wout, Kout, Kout, 0}; pg8::StaticOrder S; S.init(TG, D, F.G, (int)blockIdx.x);
                pg8::EpiResidLn<false> E{XA, nullptr, XB, args.in[25] + (size_t)layer * D, args.in[26] + (size_t)layer * D, ALPHA, xslot, pcnt, 64u * (ep + 1u), ptmo};
                pg8::gemm_phase<pg8::EpiResidLn<false>>(ring, g, S, E, tpacc, TMODE()); GRID_BAR(); }
            if (RUN(42)) REPEAT(6) { pg8::Gemm g{XB, Wb + W_UP + (size_t)layer * 8192 * 2048, 2048, 2048, 1}; pg8::StaticOrder S; S.init(TG, HID, F.G, (int)blockIdx.x, WGM_UP);
                pg8::EpiRelu2 E{HB, HID}; pg8::gemm_phase<pg8::EpiRelu2>(ring, g, S, E, tpacc, TMODE()); GRID_BAR(); }
            if (RUN(43)) { pg8::Gemm g{HB, Wb + W_DOWN + (size_t)layer * 2048 * 8192, 8192, 8192, 1}; pg8::StaticOrder S; S.init(TG, D, F.G, (int)blockIdx.x, WGM_DOWN);
                if (layer == DEPTH - 1) { pg8::EpiResidLn<true> E{XB, X, nullptr, args.in[27] + (size_t)layer * D, args.in[28] + (size_t)layer * D, ALPHA, xslot, pcnt, 64u * (ep + 2u), ptmo};
                    pg8::gemm_phase<pg8::EpiResidLn<true>>(ring, g, S, E, tpacc, TMODE()); }
                else { pg8::EpiResidLn<false> E{XB, nullptr, XB, args.in[27] + (size_t)layer * D, args.in[28] + (size_t)layer * D, ALPHA, xslot, pcnt, 64u * (ep + 2u), ptmo};
                    pg8::gemm_phase<pg8::EpiResidLn<false>>(ring, g, S, E, tpacc, TMODE()); }
                GRID_BAR(); }
        }
    }
    if (PROBE_TMASK && blockIdx.x == 0) { const unsigned long long te = __builtin_amdgcn_s_memrealtime(); while (__builtin_amdgcn_s_memrealtime() - te < tpacc) __builtin_amdgcn_s_sleep(8); }
#undef RUN
#undef GRID_BAR
}

extern "C" void kernel_launch(void* const* d_in, const int* in_sizes, int n_in, void* d_out, int out_size, void* d_ws, size_t ws_size, hipStream_t stream) {
    static int grid = 0;
    if (grid == 0) {
        if (n_in != 29 || out_size != NGROUP * TG * D || ws_size < WS_NEED) { fprintf(stderr, "kernel_launch: unexpected problem (n_in %d, out %d, ws %zu, need %zu)\n", n_in, out_size, ws_size, (size_t)WS_NEED); grid = -1; return; }
        int dev = 0, cus = 0, per_cu = 0;
        if (hipGetDevice(&dev) != hipSuccess || hipDeviceGetAttribute(&cus, hipDeviceAttributeMultiprocessorCount, dev) != hipSuccess) { grid = -1; return; }
        if (hipFuncSetAttribute((const void*)enc_fwd, hipFuncAttributeMaxDynamicSharedMemorySize, LDS_BYTES) != hipSuccess) { fprintf(stderr, "kernel_launch: hipFuncSetAttribute failed\n"); grid = -1; return; }
        if (hipOccupancyMaxActiveBlocksPerMultiprocessor(&per_cu, (const void*)enc_fwd, NTHR, LDS_BYTES) != hipSuccess || per_cu < 1) { fprintf(stderr, "kernel_launch: occupancy query says %d\n", per_cu); }
        (void)hipGetLastError();
        grid = cus;
        if (grid != 256) { fprintf(stderr, "kernel_launch: built for 256 CUs (one 256x256 tile per workgroup in the fused LayerNorm phases), got %d\n", cus); grid = -1; return; }
    }
    if (grid < 0) return;
    (void)hipMemsetAsync((char*)d_ws + WS_CTL, 0, CTL_ZERO_BYTES, stream);
    Args a{};
    for (int i = 0; i < 29; ++i) a.in[i] = (const float*)d_in[i];
    a.out = (float*)d_out; a.ws = (unsigned char*)d_ws; a.pad = 0;
    a.g_lo = 0; a.g_hi = NGROUP; a.l_lo = 0; a.l_hi = DEPTH; a.ph = -1;
    hipLaunchKernelGGL(enc_fwd, dim3(grid), dim3(NTHR), LDS_BYTES, stream, a);
}
```

```cpp
#include <hip/hip_runtime.h>
#include <cstdio>
#include <cstdint>

#ifndef WGM_UP
#define WGM_UP 4
#endif
#ifndef WGM_DOWN
#define WGM_DOWN 4
#endif

#define LAS __attribute__((address_space(3)))
#define GAS __attribute__((address_space(1)))
typedef unsigned short bf16;
typedef short bf16x8 __attribute__((ext_vector_type(8)));
typedef short s16x4 __attribute__((ext_vector_type(4)));
typedef float f32x2 __attribute__((ext_vector_type(2)));
typedef float f32x4 __attribute__((ext_vector_type(4)));
typedef float f32x16 __attribute__((ext_vector_type(16)));
typedef unsigned u32x2 __attribute__((ext_vector_type(2)));
typedef unsigned u32x4 __attribute__((ext_vector_type(4)));
typedef __bf16 bf16x2_t __attribute__((ext_vector_type(2)));
typedef short v4i16_t __attribute__((ext_vector_type(4)));
typedef GAS unsigned gu32;

constexpr int D = 2048, TG = 8192, NGROUP = 6, DEPTH = 4, NWAVES = 8, NTHR = 512;
constexpr int HID = 8192;
constexpr int SSD_DI = 4096, SSD_NH = 64, SSD_NG = 8, SSD_NS = 128, SSD_CH = 128, SSD_XBC = 6144, SSD_NIN = 10368, SSD_NIN_PAD = 10496;
constexpr int NA_H = 16, NA_HD = 128;
constexpr float ALPHA = 1.681792830507429f, LN_EPS = 1e-5f;

constexpr size_t MiB = 1u << 20;
constexpr size_t WS_CTL = 0, CTL_ZERO_BYTES = 256 * 1024;
constexpr size_t WS_XSLOT = 1 * MiB;
constexpr size_t WS_W = 2 * MiB;
constexpr size_t W_RGIN = 0;
constexpr size_t W_RGGATE = W_RGIN + 2ull * 4096 * 2048;
constexpr size_t W_RGOUT = W_RGGATE + 2ull * 32 * 256 * 256;
constexpr size_t W_SSDIN = W_RGOUT + 2ull * 2048 * 2048;
constexpr size_t W_SSDOUT = W_SSDIN + (size_t)SSD_NIN_PAD * 2048;
constexpr size_t W_NAQKV = W_SSDOUT + 2048ull * 4096;
constexpr size_t W_NAOUT = W_NAQKV + 6144ull * 2048;
constexpr size_t W_UP = W_NAOUT + 2048ull * 2048;
constexpr size_t W_DOWN = W_UP + 4ull * 8192 * 2048;
constexpr size_t W_END = W_DOWN + 4ull * 8192 * 2048;
constexpr size_t WS_SCR = ((WS_W + W_END * 2 + MiB - 1) / MiB) * MiB;
constexpr size_t S_XB = 0;
constexpr size_t S_YB = 32 * MiB;
constexpr size_t S_MIX = 96 * MiB;
constexpr size_t S_HID = S_MIX;
constexpr size_t S_RG_GATE = S_MIX, S_RG_URAW = S_MIX + 32 * MiB, S_RG_LA = S_MIX + 96 * MiB  , S_RG_INP = S_MIX + 160 * MiB  ;
constexpr size_t S_RG_HEND = S_MIX + 224 * MiB, S_RG_PROD = S_MIX + 226 * MiB, S_RG_HIN = S_MIX + 228 * MiB;
constexpr size_t S_SSD_ZS = S_MIX, S_SSD_XBCR = S_MIX + 64 * MiB, S_SSD_XT = S_MIX + 160 * MiB, S_SSD_BM = S_MIX + 224 * MiB, S_SSD_CM = S_MIX + 240 * MiB;
constexpr size_t S_SSD_DT = S_MIX + 256 * MiB, S_SSD_DEC = S_MIX + 260 * MiB, S_SSD_ST = S_MIX + 261 * MiB;
constexpr size_t S_NA_Q = S_MIX, S_NA_K = S_MIX + 32 * MiB, S_NA_V = S_MIX + 64 * MiB;
constexpr size_t S_END = S_MIX + 389 * MiB;
constexpr size_t S_XB0 = S_END;
constexpr size_t S_DUM = S_XB0 + 192 * MiB;
#ifndef PROBE_MASK
#define PROBE_MASK 0
#endif
constexpr size_t WS_NEED = WS_SCR + S_DUM + (PROBE_MASK ? 96 * MiB : 0);

constexpr int CW_BAR = 4096;
constexpr int CW_SEAM = 16384;
constexpr int CW_TMO = 0;
constexpr int CW_CHK = 1024;
constexpr size_t WS_SPT = 512 * 1024;

constexpr int RING_BYTES = 131072;
constexpr int LDSCTL_OFF = RING_BYTES, MISC_OFF = LDSCTL_OFF + 320;
constexpr int LDS_BYTES = 147456;

#define RLX_AGENT __ATOMIC_RELAXED, __HIP_MEMORY_SCOPE_AGENT
#define LDS_WAIT() asm volatile("s_waitcnt lgkmcnt(0)" ::: "memory")
#define VM_WAIT() asm volatile("s_waitcnt vmcnt(0)" ::: "memory")
__device__ __forceinline__ unsigned pk2(float lo, float hi) { f32x2 v = {lo, hi}; bf16x2_t b = __builtin_convertvector(v, bf16x2_t); return __builtin_bit_cast(unsigned, b); }
__device__ __forceinline__ float bflo(unsigned w) { return __uint_as_float(w << 16); }
__device__ __forceinline__ float bfhi(unsigned w) { return __uint_as_float(w & 0xffff0000u); }
__device__ __forceinline__ float bf2f(bf16 b) { return __uint_as_float(((unsigned)b) << 16); }
__device__ __forceinline__ float frcp_(float x) { return __builtin_amdgcn_rcpf(x); }
__device__ __forceinline__ float fsqrt_(float x) { return __builtin_amdgcn_sqrtf(x); }
__device__ __forceinline__ float sigmoidf_(float x) { return frcp_(1.0f + __expf(-x)); }
__device__ __forceinline__ float siluf_(float x) { return x * frcp_(1.0f + __expf(-x)); }
__device__ __forceinline__ float gelu_tanh_(float v) { const float u = 1.5957691216057308f * (v + 0.044715f * v * v * v); return v * frcp_(1.0f + __expf(-u)); }
__device__ __forceinline__ float softplusf_(float v) { return v > 20.f ? v : log1pf(__expf(v)); }
__device__ __forceinline__ float shfl_lane(float v, int srclane) { return __int_as_float(__builtin_amdgcn_ds_bpermute(srclane << 2, __float_as_int(v))); }
__device__ __forceinline__ float wave_sum(float v, int lane) {
#pragma unroll
    for (int o = 1; o < 64; o <<= 1) v += shfl_lane(v, lane ^ o);
    return v;
}

#define XB_TMO      128
#define XB_XCNT(j)  (256  + 64 * (j))
#define XB_XSUB(j)  (1280 + 64 * (j))
#define XB_XGEN(j)  (2304 + 64 * (j))
#define XB_TOP      3328
#define XB_TOPGEN   3392
#define XCD_BAR_WORDS 3456
#define XB_SPIN_CAP (1u << 22)

__device__ __forceinline__ unsigned xb_ld(unsigned* p)              { return __hip_atomic_load(p, __ATOMIC_RELAXED, __HIP_MEMORY_SCOPE_AGENT); }
__device__ __forceinline__ unsigned xb_add(unsigned* p, unsigned v) { return __hip_atomic_fetch_add(p, v, __ATOMIC_RELAXED, __HIP_MEMORY_SCOPE_AGENT); }
__device__ __forceinline__ unsigned xb_xcc_id() { return (unsigned)__builtin_amdgcn_s_getreg((3 << 11) | 20) & 0xFu; }
#define XB_SPIN(cond, bar) do { unsigned _sp = 0; while (cond) { __builtin_amdgcn_s_sleep(1); \
    if ((++_sp & 255u) == 0u) { if (xb_ld(&(bar)[XB_TMO])) break; if (_sp > XB_SPIN_CAP) { atomicAdd(&(bar)[XB_TMO], 1u); break; } } } } while (0)

struct XcdBarrier { unsigned* bar; unsigned x; volatile LAS unsigned* st; };

__device__ __forceinline__ XcdBarrier xcd_barrier_post(unsigned* bar, volatile LAS unsigned* st) {
    XcdBarrier b; b.bar = bar; b.x = xb_xcc_id(); b.st = st;
    if (threadIdx.x == 0) (void)xb_add(&bar[XB_XCNT(b.x)], 1u);
    return b;
}
__device__ __forceinline__ void xcd_barrier_complete(unsigned* bar, unsigned x, unsigned& nloc, unsigned& nx) {
    const unsigned G = gridDim.x * gridDim.y * gridDim.z;
    unsigned sum, cnt, mine, sp = 0u;
    for (;;) {
        sum = 0u; cnt = 0u; mine = 0u;
#pragma unroll
        for (unsigned j = 0; j < 16; ++j) { const unsigned c = xb_ld(&bar[XB_XCNT(j)]); sum += c; cnt += (c > 0u) ? 1u : 0u; mine = (j == x) ? c : mine; }
        if (sum == G) break;
        __builtin_amdgcn_s_sleep(1);
        if ((++sp & 255u) == 0u) { if (xb_ld(&bar[XB_TMO])) break; if (sp > XB_SPIN_CAP) { atomicAdd(&bar[XB_TMO], 1u); break; } }
    }
    nloc = mine > 0u ? mine : 1u; nx = cnt > 0u ? cnt : 1u;
}
__device__ __forceinline__ void xcd_barrier(const XcdBarrier& b) {
    asm volatile("s_waitcnt vmcnt(0)" ::: "memory");
    __syncthreads();
    if (threadIdx.x == 0) {
        unsigned* bar = b.bar;
        __builtin_amdgcn_s_waitcnt(0);
        unsigned nloc = b.st[0], nx = b.st[1];
        if (nloc == 0u) { xcd_barrier_complete(bar, b.x, nloc, nx); b.st[0] = nloc; b.st[1] = nx; }
        const unsigned old = xb_add(&bar[XB_XSUB(b.x)], 1u);
        const unsigned gen = old / nloc;
        if (old + 1u == (gen + 1u) * nloc) {
            __builtin_amdgcn_fence(__ATOMIC_RELEASE, "agent");
            asm volatile("s_waitcnt vmcnt(0)" ::: "memory");
            const unsigned og = xb_add(&bar[XB_TOP], 1u);
            const unsigned tg = og / nx;
            if (og + 1u == (tg + 1u) * nx) xb_add(&bar[XB_TOPGEN], 1u);
            else XB_SPIN(xb_ld(&bar[XB_TOPGEN]) == tg, bar);
            __builtin_amdgcn_fence(__ATOMIC_ACQUIRE, "agent");
            xb_add(&bar[XB_XGEN(b.x)], 1u);
            asm volatile("s_waitcnt vmcnt(0)" ::: "memory");
        } else {
            XB_SPIN(xb_ld(&bar[XB_XGEN(b.x)]) == gen, bar);
            __builtin_amdgcn_fence(__ATOMIC_ACQUIRE, "agent");
            asm volatile("s_waitcnt vmcnt(0)" ::: "memory");
        }
    }
    __syncthreads();
}

namespace pg8 {
constexpr int BM = 256, BK = 64, HALF = 128, HTB = HALF * BK * 2, STAGE_BYTES = 8 * HTB, NXCD = 8, WGM = 8;
__host__ __device__ __forceinline__ int lds_byte(int r, int c) { const int st = (r >> 4) * 2 + (c >> 5), rr = r & 15, cc = c & 31, ob = rr * 64 + cc * 2; return st * 1024 + (ob ^ (((ob >> 9) & 1) << 5)); }
__host__ __device__ __forceinline__ void stage_rc(int b, int& R, int& C) { const int st = b / 1024, sb = b % 1024, swz = sb ^ (((sb >> 9) & 1) << 5); R = (st >> 1) * 16 + swz / 64; C = (st & 1) * 32 + (swz % 64) / 2; }
__host__ __device__ __forceinline__ int perm32(int rho) { const int n = rho >> 4, i = rho & 15; return 8 * (i >> 2) + 4 * n + (i & 3); }

struct Unit { int pm, pn; };
struct Gemm { const bf16* A; const bf16* Bt; int lda, K, blkA; };
constexpr int BLK = 16384;
__host__ __device__ __forceinline__ int perm32inv(int x) { return 16 * ((x >> 2) & 1) + 4 * (x >> 3) + (x & 3); }
__host__ __device__ __forceinline__ size_t blk_off(int row, int k, int K, bool perm) {
    const int r = row & 127, slot = perm ? ((r & ~31) + perm32inv(r & 31)) : r; return ((size_t)(row >> 7) * (K >> 6) + (k >> 6)) * BLK + lds_byte(slot, k & 63); }
__device__ __forceinline__ const char* a_base(const Gemm& g, const Unit& u) { return g.blkA ? (const char*)g.A + (size_t)u.pm * 2 * (g.K >> 6) * BLK : (const char*)(g.A + (size_t)u.pm * BM * g.lda); }
__device__ __forceinline__ const char* b_base(const Gemm& g, const Unit& u) { return (const char*)g.Bt + (size_t)u.pn * 2 * (g.K >> 6) * BLK; }

struct StaticOrder {
    int nM, nN, nwg, G, c, wgm;
    __host__ __device__ void init(int M, int N, int G_, int c_, int wgm_ = 4) { nM = M / BM; nN = N / BM; nwg = nM * nN; G = G_; c = c_; wgm = wgm_; }
    __host__ __device__ bool next(int i, Unit& u) const {
        const long L = (long)i * G + c; if (L >= nwg) return false;
        int wgid = (int)L; { const int q = nwg / NXCD, r = nwg % NXCD, xcd = wgid % NXCD, off = wgid / NXCD; wgid = (xcd < r ? xcd * (q + 1) : r * (q + 1) + (xcd - r) * q) + off; }
        const int nig = wgm * nN, gid = wgid / nig, fm = gid * wgm, gsz = (nM - fm) < wgm ? (nM - fm) : wgm;
        u.pm = fm + ((wgid % nig) % gsz); u.pn = (wgid % nig) / gsz; return true;
    }
};

template <class Epi, bool ALIGN_EPI = true, bool SP2 = true>
__device__ __forceinline__ void gemm_phase(LAS unsigned char* lds, const Gemm g, const StaticOrder& S, const Epi& E, unsigned long long& tacc, const int tmode) {
    int tid_o = threadIdx.x; asm volatile("" : "+v"(tid_o));
    const int tid = tid_o, wid = __builtin_amdgcn_readfirstlane(tid >> 6), lane = tid & 63, wr = wid >> 2, wc = wid & 3, fr = lane & 15, fq = lane >> 4;
    const int K = g.K, nt = K / BK;
    unsigned voffA[2], voffB[2];
    static_assert(Epi::PERM, "the blocked weight layout bakes in the PERM row order");
#pragma unroll
    for (int i = 0; i < 2; ++i) { int R, C; stage_rc(tid * 16 + i * 8192, R, C);
        voffA[i] = g.blkA ? (unsigned)(tid * 16 + i * 8192) : (unsigned)(R * g.lda + C) * 2u; voffB[i] = (unsigned)(tid * 16 + i * 8192); }
    const size_t kstepA = g.blkA ? (size_t)BLK : (size_t)(BK * 2), kstepB = (size_t)BLK;
    const size_t hstepA = g.blkA ? (size_t)(K >> 6) * BLK : (size_t)HALF * g.lda * 2, hstepB = (size_t)(K >> 6) * BLK;
    const unsigned ldsw = (unsigned)wid * 1024u;
    const int aoff = lds_byte(wr * 64 + fr, fq * 8), boff = lds_byte(wc * 32 + fr, fq * 8);
#define PG8_SA(b, h) (((b) * 2 + (h)) * HTB)
#define PG8_SB(b, h) ((4 + (b) * 2 + (h)) * HTB)
#define PG8_STAGE(bufoff, gbase, voff) do { _Pragma("unroll") for (int _i = 0; _i < 2; ++_i) \
        __builtin_amdgcn_global_load_lds((const unsigned*)((const char*)(gbase) + (voff)[_i]), (LAS unsigned*)(lds + (bufoff) + ldsw + _i * 8192), 16, 0, 0); } while (0)
#define PG8_LDA(dst, b, h) do { _Pragma("unroll") for (int m = 0; m < 4; ++m) _Pragma("unroll") for (int k = 0; k < 2; ++k) dst[m][k] = *(const LAS bf16x8*)(lds + PG8_SA(b, h) + aoff + m * 2048 + k * 1024); } while (0)
#define PG8_LDB(dst, b, h) do { _Pragma("unroll") for (int n = 0; n < 2; ++n) _Pragma("unroll") for (int k = 0; k < 2; ++k) dst[n][k] = *(const LAS bf16x8*)(lds + PG8_SB(b, h) + boff + n * 2048 + k * 1024); } while (0)
#define PG8_MMA(ai, bj, At, Bt) do { __builtin_amdgcn_s_setprio(1); _Pragma("unroll") for (int m = 0; m < 4; ++m) _Pragma("unroll") for (int n = 0; n < 2; ++n) _Pragma("unroll") for (int k = 0; k < 2; ++k) \
        acc[ai][bj][m][n] = __builtin_amdgcn_mfma_f32_16x16x32_bf16(Bt[n][k], At[m][k], acc[ai][bj][m][n], 0, 0, 0); __builtin_amdgcn_s_setprio(0); } while (0)
#define PG8_WAIT_V(n) asm volatile("s_waitcnt vmcnt(" #n ")" ::: "memory")
#define PG8_WAIT_L(n) asm volatile("s_waitcnt lgkmcnt(" #n ")" ::: "memory")
#define PG8_BAR __builtin_amdgcn_s_barrier()
#define PG8_SCHED __builtin_amdgcn_sched_barrier(0)
    Unit cur, nxt; int ui = 0;
    if (!S.next(0, cur)) return;
    f32x4 acc[2][2][4][2];
#pragma unroll
    for (int a = 0; a < 2; ++a)
#pragma unroll
        for (int b = 0; b < 2; ++b)
#pragma unroll
            for (int m = 0; m < 4; ++m)
#pragma unroll
                for (int n = 0; n < 2; ++n) acc[a][b][m][n] = (f32x4){0.f, 0.f, 0.f, 0.f};
    bf16x8 At[4][2], B0[2][2], B1[2][2];
    const char* cA = a_base(g, cur); const char* cB = b_base(g, cur);
    if constexpr (SP2) {
        PG8_STAGE(PG8_SB(0, 0), cB, voffB); PG8_STAGE(PG8_SB(0, 1), cB + hstepB, voffB); PG8_STAGE(PG8_SA(0, 0), cA, voffA); PG8_STAGE(PG8_SA(0, 1), cA + hstepA, voffA);
        if (wr == 1) PG8_BAR;
        PG8_WAIT_V(2); PG8_BAR;
        PG8_STAGE(PG8_SB(1, 0), cB + kstepB, voffB); PG8_STAGE(PG8_SA(1, 0), cA + kstepA, voffA); PG8_STAGE(PG8_SB(1, 1), cB + hstepB + kstepB, voffB);
        PG8_WAIT_V(6); PG8_BAR;
    } else {
        PG8_STAGE(PG8_SB(0, 0), cB, voffB); PG8_STAGE(PG8_SA(0, 0), cA, voffA); PG8_STAGE(PG8_SB(0, 1), cB + hstepB, voffB); PG8_STAGE(PG8_SA(0, 1), cA + hstepA, voffA);
        if (wr == 1) PG8_BAR;
        PG8_WAIT_V(4); PG8_BAR;
        PG8_STAGE(PG8_SB(1, 0), cB + kstepB, voffB); PG8_STAGE(PG8_SA(1, 0), cA + kstepA, voffA); PG8_STAGE(PG8_SB(1, 1), cB + hstepB + kstepB, voffB);
        PG8_WAIT_V(6); PG8_BAR;
    }
    for (;;) {
        const bool has_next = S.next(ui + 1, nxt);
        const char* nA = has_next ? a_base(g, nxt) : cA; const char* nB = has_next ? b_base(g, nxt) : cB;
        unsigned long long tk0 = 0ull; if (tmode == 1) tk0 = __builtin_amdgcn_s_memrealtime(); if (tmode == 3) tk0 = (unsigned long long)clock64();
#pragma unroll 1
        for (int t = 0; t < nt; t += 2) {
            const bool last = (t == nt - 2);
            const char* a1 = cA + (size_t)(t + 1) * kstepA;
            const char* a2 = last ? nA : cA + (size_t)(t + 2) * kstepA; const char* b2 = last ? nB : cB + (size_t)(t + 2) * kstepB;
            const char* a3 = a2 + kstepA; const char* b3 = b2 + kstepB;
            if constexpr (SP2) {
            PG8_LDB(B0, 0, 0); PG8_LDB(B1, 0, 1); PG8_SCHED; PG8_LDA(At, 0, 0); PG8_STAGE(PG8_SA(1, 1), a1 + hstepA, voffA);
            PG8_WAIT_V(8); PG8_WAIT_L(0); PG8_BAR; PG8_MMA(0, 0, At, B0); PG8_MMA(0, 1, At, B1); PG8_BAR; PG8_SCHED;
            PG8_LDA(At, 0, 1); PG8_STAGE(PG8_SB(0, 0), b2, voffB); PG8_STAGE(PG8_SB(0, 1), b2 + hstepB, voffB); PG8_STAGE(PG8_SA(0, 0), a2, voffA);
            PG8_WAIT_V(8); PG8_WAIT_L(0); PG8_BAR; PG8_MMA(1, 0, At, B0); PG8_MMA(1, 1, At, B1); PG8_BAR; PG8_SCHED;
            PG8_LDB(B0, 1, 0); PG8_LDB(B1, 1, 1); PG8_SCHED; PG8_LDA(At, 1, 0); PG8_STAGE(PG8_SA(0, 1), a2 + hstepA, voffA);
            PG8_WAIT_V(8); PG8_WAIT_L(0); PG8_BAR; PG8_MMA(0, 0, At, B0); PG8_MMA(0, 1, At, B1); PG8_BAR; PG8_SCHED;
            PG8_LDA(At, 1, 1); PG8_STAGE(PG8_SB(1, 0), b3, voffB); PG8_STAGE(PG8_SB(1, 1), b3 + hstepB, voffB); PG8_STAGE(PG8_SA(1, 0), a3, voffA);
            PG8_WAIT_V(8); PG8_WAIT_L(0); PG8_BAR; PG8_MMA(1, 0, At, B0); PG8_MMA(1, 1, At, B1); PG8_BAR; PG8_SCHED;
            } else {
            PG8_LDB(B0, 0, 0); PG8_SCHED; PG8_LDA(At, 0, 0); PG8_STAGE(PG8_SA(1, 1), a1 + hstepA, voffA);
            PG8_WAIT_L(8); PG8_BAR; PG8_WAIT_L(0); PG8_MMA(0, 0, At, B0); PG8_BAR; PG8_SCHED;
            PG8_LDB(B1, 0, 1); PG8_STAGE(PG8_SB(0, 0), b2, voffB);
            PG8_BAR; PG8_WAIT_L(0); PG8_MMA(0, 1, At, B1); PG8_BAR;
            PG8_LDA(At, 0, 1); PG8_STAGE(PG8_SA(0, 0), a2, voffA);
            PG8_BAR; PG8_WAIT_L(0); PG8_MMA(1, 0, At, B0); PG8_BAR; PG8_SCHED;
            PG8_STAGE(PG8_SB(0, 1), b2 + hstepB, voffB);
            PG8_WAIT_V(6); PG8_BAR; PG8_MMA(1, 1, At, B1); PG8_BAR;
            PG8_LDB(B0, 1, 0); PG8_SCHED; PG8_LDA(At, 1, 0); PG8_STAGE(PG8_SA(0, 1), a2 + hstepA, voffA);
            PG8_WAIT_L(8); PG8_BAR; PG8_WAIT_L(0); PG8_MMA(0, 0, At, B0); PG8_BAR; PG8_SCHED;
            PG8_LDB(B1, 1, 1); PG8_STAGE(PG8_SB(1, 0), b3, voffB);
            PG8_BAR; PG8_WAIT_L(0); PG8_MMA(0, 1, At, B1); PG8_BAR;
            PG8_LDA(At, 1, 1); PG8_STAGE(PG8_SA(1, 0), a3, voffA);
            PG8_BAR; PG8_WAIT_L(0); PG8_MMA(1, 0, At, B0); PG8_BAR; PG8_SCHED;
            PG8_STAGE(PG8_SB(1, 1), b3 + hstepB, voffB);
            PG8_WAIT_V(6); PG8_BAR; PG8_MMA(1, 1, At, B1); PG8_BAR;
            }
        }
        if (tmode == 1) tacc += __builtin_amdgcn_s_memrealtime() - tk0;
        if (tmode == 3) tacc += ((unsigned long long)clock64() - tk0) / 24ull;
        if (tmode == 2) tk0 = __builtin_amdgcn_s_memrealtime();
        if constexpr (ALIGN_EPI) { if (wr == 0) PG8_BAR; }
        if constexpr (!Epi::AFTER_DRAIN) E(acc, cur, wr, wc, fr, fq);
        if (!has_next) { if (tmode == 2) tacc += __builtin_amdgcn_s_memrealtime() - tk0; break; }
#pragma unroll
        for (int a = 0; a < 2; ++a)
#pragma unroll
            for (int b = 0; b < 2; ++b)
#pragma unroll
                for (int m = 0; m < 4; ++m)
#pragma unroll
                    for (int n = 0; n < 2; ++n) acc[a][b][m][n] = (f32x4){0.f, 0.f, 0.f, 0.f};
        cur = nxt; cA = nA; cB = nB; ++ui;
        if constexpr (ALIGN_EPI) { if (wr == 1) PG8_BAR; }
        if (tmode == 2) tacc += __builtin_amdgcn_s_memrealtime() - tk0;
    }
    PG8_WAIT_V(0);
    if constexpr (!ALIGN_EPI) { if (wr == 0) PG8_BAR; }
    PG8_BAR;
    if constexpr (Epi::AFTER_DRAIN) E.fused(acc, cur, wr, wc, fr, fq, lds, wid, lane);
#undef PG8_SA
#undef PG8_SB
#undef PG8_STAGE
#undef PG8_LDA
#undef PG8_LDB
#undef PG8_MMA
#undef PG8_WAIT_V
#undef PG8_WAIT_L
#undef PG8_BAR
#undef PG8_SCHED
}

typedef f32x4 AccT[2][2][4][2];
template <bool F32OUT> struct EpiResidLn {
    static constexpr bool PERM = true, AFTER_DRAIN = true;
    const bf16* XinB; float* XoutF; bf16* XBout; const float* g; const float* b; float alpha;
    unsigned long long* xbuf; unsigned* cnt; unsigned want; unsigned* tmo;
    __device__ __forceinline__ void operator()(const AccT&, const Unit&, int, int, int, int) const {}
    __device__ __forceinline__ void fused(AccT& acc, const Unit& u, int wr, int wc, int fr_in, int fq_in, LAS unsigned char* lds, int wid, int lane_in) const {
        int fr = fr_in, fq = fq_in, lane = lane_in; asm volatile("" : "+v"(fr), "+v"(fq), "+v"(lane));
        LAS f32x2* P = (LAS f32x2*)lds;
        LAS f32x2* S = (LAS f32x2*)(lds + 8192);
        const int col0 = u.pn * BM + wc * 32 + 8 * fq;
        {
            u32x4 xr[2][4][2];
#pragma unroll
            for (int ai = 0; ai < 2; ++ai)
#pragma unroll
                for (int m = 0; m < 4; ++m) { const int rowi = u.pm * BM + ai * HALF + wr * 64 + m * 16 + fr;
#pragma unroll
                    for (int bj = 0; bj < 2; ++bj) xr[ai][m][bj] = *(const u32x4*)((const char*)XinB + blk_off(rowi, col0 + bj * HALF, D, false)); }
#pragma unroll
            for (int ai = 0; ai < 2; ++ai)
#pragma unroll
                for (int m = 0; m < 4; ++m)
#pragma unroll
                    for (int bj = 0; bj < 2; ++bj) { const u32x4 w = xr[ai][m][bj];
                        acc[ai][bj][m][0] += (f32x4){bflo(w.x), bfhi(w.x), bflo(w.y), bfhi(w.y)} * alpha; acc[ai][bj][m][1] += (f32x4){bflo(w.z), bfhi(w.z), bflo(w.w), bfhi(w.w)} * alpha;
                        asm volatile("" : "+v"(acc[ai][bj][m][0]), "+v"(acc[ai][bj][m][1])); }
            asm volatile("" ::: "memory");
        }
#pragma unroll
        for (int ai = 0; ai < 2; ++ai)
#pragma unroll
            for (int m = 0; m < 4; ++m) {
                float s = 0.f;
#pragma unroll
                for (int bj = 0; bj < 2; ++bj)
#pragma unroll
                    for (int n = 0; n < 2; ++n) { const f32x4 x = acc[ai][bj][m][n]; s += (x[0] + x[1]) + (x[2] + x[3]); }
                s += shfl_lane(s, lane ^ 16); s += shfl_lane(s, lane ^ 32);
                const float mw = s * (1.0f / 64.0f); float q = 0.f;
#pragma unroll
                for (int bj = 0; bj < 2; ++bj)
#pragma unroll
                    for (int n = 0; n < 2; ++n) { const f32x4 d = acc[ai][bj][m][n] - mw; q += (d[0] * d[0] + d[1] * d[1]) + (d[2] * d[2] + d[3] * d[3]); }
                q += shfl_lane(q, lane ^ 16); q += shfl_lane(q, lane ^ 32);
                if (fq == 0) P[(ai * HALF + wr * 64 + m * 16 + fr) * 4 + wc] = (f32x2){mw, q};
            }
        const int col5 = u.pn * BM + wc * 32 + 8 * fq;
        f32x4 gg[2][2], bv[2][2];
#pragma unroll
        for (int bj = 0; bj < 2; ++bj)
#pragma unroll
            for (int n = 0; n < 2; ++n) { gg[bj][n] = *(const f32x4*)(g + col5 + bj * HALF + n * 4); bv[bj][n] = *(const f32x4*)(b + col5 + bj * HALF + n * 4); }
        asm volatile("s_waitcnt lgkmcnt(0)" ::: "memory"); __builtin_amdgcn_s_barrier(); asm volatile("" ::: "memory");
        const int row = wid * 32 + (lane & 31);
        if (lane < 32) {
            const f32x2 a = P[row * 4 + 0], bb = P[row * 4 + 1], c = P[row * 4 + 2], d = P[row * 4 + 3];
            const float mt = (a.x + bb.x + c.x + d.x) * 0.25f;
            const float da = a.x - mt, db = bb.x - mt, dc = c.x - mt, dd = d.x - mt;
            const float m2 = (a.y + bb.y) + (c.y + d.y) + 64.0f * ((da * da + db * db) + (dc * dc + dd * dd));
            unsigned long long* slot = xbuf + ((size_t)(u.pm * BM + row) * 8 + u.pn);
            __hip_atomic_store(slot, ((unsigned long long)__float_as_uint(m2) << 32) | __float_as_uint(mt), __ATOMIC_RELAXED, __HIP_MEMORY_SCOPE_AGENT);
        }
        asm volatile("s_waitcnt vmcnt(0)" ::: "memory");
        if (lane == 0) __hip_atomic_fetch_add(cnt + 64 * u.pm, 1u, __ATOMIC_RELAXED, __HIP_MEMORY_SCOPE_AGENT);
        if (wid == 0) {
            unsigned sp = 0;
            while ((unsigned)__builtin_amdgcn_readfirstlane(__hip_atomic_load(cnt + 64 * u.pm, __ATOMIC_RELAXED, __HIP_MEMORY_SCOPE_AGENT)) < want) {
                __builtin_amdgcn_s_sleep(1);
                if ((++sp & 1023u) == 0u) { if (__builtin_amdgcn_readfirstlane(__hip_atomic_load(tmo, __ATOMIC_RELAXED, __HIP_MEMORY_SCOPE_AGENT)) != 0u) break;
                    if (sp > (1u << 22)) { if (lane == 0) __hip_atomic_store(tmo, 1u, __ATOMIC_RELAXED, __HIP_MEMORY_SCOPE_AGENT); break; } } }
            __builtin_amdgcn_fence(__ATOMIC_ACQUIRE, "agent");
        }
        asm volatile("s_waitcnt vmcnt(0) lgkmcnt(0)" ::: "memory"); __builtin_amdgcn_s_barrier(); asm volatile("" ::: "memory");
        if (lane < 32) {
            const unsigned long long* slot = xbuf + (size_t)(u.pm * BM + row) * 8; float mt[8], m2[8]; float ms = 0.f;
#pragma unroll
            for (int t = 0; t < 8; ++t) { const unsigned long long w = __hip_atomic_load(slot + t, __ATOMIC_RELAXED, __HIP_MEMORY_SCOPE_AGENT); mt[t] = __uint_as_float((unsigned)w); m2[t] = __uint_as_float((unsigned)(w >> 32)); ms += mt[t]; }
            const float mean = ms * 0.125f; float q = 0.f;
#pragma unroll
            for (int t = 0; t < 8; ++t) { const float dm = mt[t] - mean; q += m2[t] + 256.0f * dm * dm; }
            S[row] = (f32x2){mean, rsqrtf(q * (1.0f / 2048.0f) + LN_EPS)};
        }
        asm volatile("s_waitcnt lgkmcnt(0)" ::: "memory"); __builtin_amdgcn_s_barrier(); asm volatile("" ::: "memory");
#pragma unroll
        for (int ai = 0; ai < 2; ++ai)
#pragma unroll
            for (int m = 0; m < 4; ++m) { const int r = ai * HALF + wr * 64 + m * 16 + fr; const f32x2 sr = S[r]; const size_t off = (size_t)(u.pm * BM + r) * D + col5;
#pragma unroll
                for (int bj = 0; bj < 2; ++bj) { const f32x4 o0 = (acc[ai][bj][m][0] - sr.x) * sr.y * gg[bj][0] + bv[bj][0], o1 = (acc[ai][bj][m][1] - sr.x) * sr.y * gg[bj][1] + bv[bj][1];
                    if constexpr (F32OUT) { *(f32x4*)(XoutF + off + bj * HALF) = o0; *(f32x4*)(XoutF + off + bj * HALF + 4) = o1; }
                    else { u32x4 w; w.x = pk2(o0[0], o0[1]); w.y = pk2(o0[2], o0[3]); w.z = pk2(o1[0], o1[1]); w.w = pk2(o1[2], o1[3]); *(u32x4*)((char*)XBout + blk_off(u.pm * BM + r, col5 + bj * HALF, D, false)) = w; } }
                asm volatile("" ::: "memory"); }
    }
};
struct EpiRelu2 {
    static constexpr bool PERM = true, AFTER_DRAIN = false;
    bf16* O; int Kd;
    __device__ __forceinline__ void operator()(const AccT& acc, const Unit& u, int wr, int wc, int fr_in, int fq_in) const {
        int fr = fr_in, fq = fq_in; asm volatile("" : "+v"(fr), "+v"(fq));
        const int row0 = u.pm * BM + wr * 64 + fr, col0 = u.pn * BM + wc * 32 + 8 * fq;
#pragma unroll
        for (int ai = 0; ai < 2; ++ai)
#pragma unroll
            for (int m = 0; m < 4; ++m) { const int row = row0 + ai * HALF + m * 16;
#pragma unroll
                for (int bj = 0; bj < 2; ++bj) { f32x4 v0 = acc[ai][bj][m][0], v1 = acc[ai][bj][m][1];
#pragma unroll
                    for (int j = 0; j < 4; ++j) { const float a = fmaxf(v0[j], 0.f), b = fmaxf(v1[j], 0.f); v0[j] = a * a; v1[j] = b * b; }
                    u32x4 w; w.x = pk2(v0[0], v0[1]); w.y = pk2(v0[2], v0[3]); w.z = pk2(v1[0], v1[1]); w.w = pk2(v1[2], v1[3]);
                    *(u32x4*)((char*)O + blk_off(row, col0 + bj * HALF, Kd, false)) = w; } }
    }
};
struct EpiRgIn {
    static constexpr bool PERM = true, AFTER_DRAIN = false;
    bf16* GATE; bf16* URAW;
    __device__ __forceinline__ void operator()(const AccT& acc, const Unit& u, int wr, int wc, int fr_in, int fq_in) const {
        int fr = fr_in, fq = fq_in; asm volatile("" : "+v"(fr), "+v"(fq));
        const bool isg = u.pn < 8; bf16* base = isg ? GATE : URAW;
        const int row0 = u.pm * BM + wr * 64 + fr, col0 = (u.pn & 7) * BM + wc * 32 + 8 * fq;
#pragma unroll
        for (int ai = 0; ai < 2; ++ai)
#pragma unroll
            for (int m = 0; m < 4; ++m) { bf16* rowp = base + (size_t)(row0 + ai * HALF + m * 16) * D + col0;
#pragma unroll
                for (int bj = 0; bj < 2; ++bj) { f32x4 v0 = acc[ai][bj][m][0], v1 = acc[ai][bj][m][1];
                    if (isg) {
#pragma unroll
                        for (int j = 0; j < 4; ++j) { v0[j] = gelu_tanh_(v0[j]); v1[j] = gelu_tanh_(v1[j]); } }
                    u32x4 w; w.x = pk2(v0[0], v0[1]); w.y = pk2(v0[2], v0[3]); w.z = pk2(v1[0], v1[1]); w.w = pk2(v1[2], v1[3]);
                    *(u32x4*)(rowp + bj * HALF) = w; } }
    }
};
struct EpiSsdIn {
    static constexpr bool PERM = true, AFTER_DRAIN = false;
    bf16* ZS; bf16* XBCR;
    __device__ __forceinline__ void operator()(const AccT& acc, const Unit& u, int wr, int wc, int fr_in, int fq_in) const {
        int fr = fr_in, fq = fq_in; asm volatile("" : "+v"(fr), "+v"(fq));
        const int row0 = u.pm * BM + wr * 64 + fr, cw = wc * 32 + 8 * fq;
        const bool isz = u.pn < 16; bf16* base = isz ? ZS + (size_t)u.pn * BM : XBCR + (size_t)(u.pn - 16) * BM; const int ldc = isz ? SSD_DI : SSD_XBC;
#pragma unroll
        for (int ai = 0; ai < 2; ++ai)
#pragma unroll
            for (int m = 0; m < 4; ++m) { bf16* rowp = base + (size_t)(row0 + ai * HALF + m * 16) * ldc + cw;
#pragma unroll
                for (int bj = 0; bj < 2; ++bj) { f32x4 v0 = acc[ai][bj][m][0], v1 = acc[ai][bj][m][1];
                    if (isz) {
#pragma unroll
                        for (int j = 0; j < 4; ++j) { v0[j] = siluf_(v0[j]); v1[j] = siluf_(v1[j]); } }
                    u32x4 w; w.x = pk2(v0[0], v0[1]); w.y = pk2(v0[2], v0[3]); w.z = pk2(v1[0], v1[1]); w.w = pk2(v1[2], v1[3]);
                    *(u32x4*)(rowp + bj * HALF) = w; } }
    }
};
struct EpiQkv {
    static constexpr bool PERM = true, AFTER_DRAIN = false;
    bf16* Q; const float* bias;
    __device__ __forceinline__ void operator()(const AccT& acc, const Unit& u, int wr, int wc, int fr_in, int fq_in) const {
        int fr = fr_in, fq = fq_in; asm volatile("" : "+v"(fr), "+v"(fq));
        const int t = u.pn >> 3; bf16* base = Q + (size_t)t * TG * D; const float sc = t == 0 ? 0.08838834764831845f : 1.0f;
        const int row0 = u.pm * BM + wr * 64 + fr, col0 = (u.pn & 7) * BM + wc * 32 + 8 * fq, bcol0 = u.pn * BM + wc * 32 + 8 * fq;
#pragma unroll
        for (int bj = 0; bj < 2; ++bj) {
            const f32x4 bv0 = *(const f32x4*)(bias + bcol0 + bj * HALF), bv1 = *(const f32x4*)(bias + bcol0 + bj * HALF + 4);
#pragma unroll
            for (int ai = 0; ai < 2; ++ai)
#pragma unroll
                for (int m = 0; m < 4; ++m) { bf16* rowp = base + (size_t)(row0 + ai * HALF + m * 16) * D + col0;
                    const f32x4 v0 = (acc[ai][bj][m][0] + bv0) * sc, v1 = (acc[ai][bj][m][1] + bv1) * sc;
                    u32x4 w; w.x = pk2(v0[0], v0[1]); w.y = pk2(v0[2], v0[3]); w.z = pk2(v1[0], v1[1]); w.w = pk2(v1[2], v1[3]);
                    *(u32x4*)(rowp + bj * HALF) = w; }
            asm volatile("" ::: "memory");
        }
    }
};
}

struct Frame {
    LAS unsigned char* lds;
    int tid, lane, wave, G, gw, ngw;
};

__device__ __forceinline__ Frame phase_frame(const Frame& F0) {
    Frame F = F0; int t = threadIdx.x; asm volatile("" : "+v"(t));
    F.tid = t; F.lane = t & 63; F.wave = __builtin_amdgcn_readfirstlane(t >> 6); F.gw = F.wave * F0.G + (int)blockIdx.x; return F;
}
template <int FRAG16 = 0>
__device__ __forceinline__ void transpose_item(const float* W, int ldw, bf16* WT, int ldt, int k0, int n0, int drow0, LAS float* scr, int lane) {
#pragma unroll
    for (int i = 0; i < 16; ++i) { const int kk = 4 * i + (lane >> 4), c2 = 2 * (lane & 15); const f32x2 v = *(const f32x2*)(W + (size_t)(k0 + kk) * ldw + n0 + c2); scr[kk * 33 + c2] = v.x; scr[kk * 33 + c2 + 1] = v.y; }
    LDS_WAIT(); asm volatile("" ::: "memory");
    const int c = lane & 7;
#pragma unroll
    for (int j = 0; j < 4; ++j) { const int n = (lane >> 3) + 8 * j; const LAS float* s = scr + (8 * c) * 33 + n;
        u32x4 o; o.x = pk2(s[0 * 33], s[1 * 33]); o.y = pk2(s[2 * 33], s[3 * 33]); o.z = pk2(s[4 * 33], s[5 * 33]); o.w = pk2(s[6 * 33], s[7 * 33]);
        if constexpr (FRAG16 == 2) { *(GAS u32x4*)((GAS char*)WT + pg8::blk_off(drow0 + n, k0 + 8 * c, ldt, true)) = o; }
        else if constexpr (FRAG16 == 1) { const int r = drow0 + n, k = k0 + 8 * c;
            *(GAS u32x4*)(WT + (((r >> 4) * 8 + (k >> 5)) * 64 + (r & 15) + 16 * ((k >> 3) & 3)) * 8) = o; }
        else *(GAS u32x4*)(WT + (size_t)(drow0 + n) * ldt + k0 + 8 * c) = o; }
    LDS_WAIT(); asm volatile("" ::: "memory");
}
__device__ __forceinline__ void conv_matrix(const Frame& F, const float* W, int K, int N, bf16* WT, LAS float* scr, int nblocked = 1 << 30) {
    const int nblk = N / 32, nitems = (K / 64) * nblk;
    for (int it = F.gw; it < nitems; it += F.ngw) { const int kb = it / nblk, nb = it % nblk;
        if (32 * nb < nblocked) transpose_item<2>(W, N, WT, K, 64 * kb, 32 * nb, 32 * nb, scr, F.lane); else transpose_item<0>(W, N, WT, K, 64 * kb, 32 * nb, 32 * nb, scr, F.lane); }
}
__device__ __forceinline__ void p_prologue(const Frame& F0, const float* const* in, bf16* Wb, float* spt, bf16* XB0) {
    const Frame F = phase_frame(F0);
    { const int n4 = NGROUP * TG * D / 4, n4p = 2 * TG * D / 4;
      for (int i = F.gw * 64 + F.lane; i < n4; i += F.ngw * 64) { const f32x4 v = i < n4p ? ((const f32x4*)in[0])[i] : ((const f32x4*)in[1])[i - n4p]; u32x2 w; w.x = pk2(v.x, v.y); w.y = pk2(v.z, v.w);
          const int row = i >> 9, col = (i & 511) * 4, grp = row >> 13;
          *(u32x2*)((char*)(XB0 + (size_t)grp * TG * D) + pg8::blk_off(row & (TG - 1), col, D, false)) = w; } }
    LAS float* scr = (LAS float*)(F.lds + F.wave * 16384);
    for (int l = 0; l < 2; ++l) {
        conv_matrix(F, in[2] + (size_t)l * 2048 * 4096, 2048, 4096, Wb + W_RGIN + (size_t)l * 4096 * 2048, scr);
        conv_matrix(F, in[10] + (size_t)l * 2048 * 2048, 2048, 2048, Wb + W_RGOUT + (size_t)l * 2048 * 2048, scr);
    }
    for (int it = F.gw; it < 2 * 2 * 16 * 32; it += F.ngw) {
        const int sub = it & 31, mat = it >> 5;
        const int dn = mat & 15, ax = (mat >> 4) & 1, l = mat >> 5;
        const int kb = sub >> 3, nb = sub & 7, j0 = 32 * nb;
        const float* W = in[ax ? 7 : 5] + ((size_t)(l * 16 + dn)) * 65536;
        bf16* WT = Wb + W_RGGATE + (size_t)l * 32 * 65536 + (size_t)(dn * 2 + (j0 >> 7)) * 65536;
        transpose_item<1>(W, 256, WT, 256, 64 * kb, j0, (j0 & 127) + 128 * ax, scr, F.lane);
    }
    for (int i = F.gw * 64 + F.lane; i < 2 * 2 * 2048; i += F.ngw * 64) spt[i] = -8.0f * softplusf_(-in[9][i]);
    conv_matrix(F, in[11], 2048, SSD_NIN, Wb + W_SSDIN, scr, 10240);
    { u32x4* z = (u32x4*)(Wb + W_SSDIN + (size_t)SSD_NIN * 2048); const int n16 = (SSD_NIN_PAD - SSD_NIN) * 2048 / 8;
      for (int i = F.gw * 64 + F.lane; i < n16; i += F.ngw * 64) z[i] = (u32x4){0u, 0u, 0u, 0u}; }
    conv_matrix(F, in[18], 4096, 2048, Wb + W_SSDOUT, scr);
    conv_matrix(F, in[19], 2048, 6144, Wb + W_NAQKV, scr);
    conv_matrix(F, in[22], 2048, 2048, Wb + W_NAOUT, scr);
    for (int l = 0; l < 4; ++l) {
        conv_matrix(F, in[23] + (size_t)l * 2048 * 8192, 2048, 8192, Wb + W_UP + (size_t)l * 8192 * 2048, scr);
        conv_matrix(F, in[24] + (size_t)l * 8192 * 2048, 8192, 2048, Wb + W_DOWN + (size_t)l * 2048 * 8192, scr);
    }
}

__device__ __forceinline__ void p_conv_ssd(const Frame& F0, const bf16* in, int L, const float* cw, const float* cb, bf16* XT, bf16* BMo, bf16* CMo) {
    const Frame F = phase_frame(F0);
    constexpr int C = SSD_XBC, NCB = C / 512, TP = 144;
    LAS unsigned char* tile = F.lds;
    const int co = F.tid & 63, tr = F.tid >> 6;
    for (int it = blockIdx.x; it < NCB * (TG / 64); it += F.G) {
        const int cbk = it % NCB, tb = it / NCB, t0 = tb * 64, c0 = cbk * 512 + co * 8, r0 = t0 + 8 * tr, rl = r0 % L;
        float w[4][8], bias[8];
#pragma unroll
        for (int k = 0; k < 4; ++k) { const f32x4 a = *(const f32x4*)(cw + (size_t)k * C + c0), b = *(const f32x4*)(cw + (size_t)k * C + c0 + 4);
            w[k][0] = a.x; w[k][1] = a.y; w[k][2] = a.z; w[k][3] = a.w; w[k][4] = b.x; w[k][5] = b.y; w[k][6] = b.z; w[k][7] = b.w; }
        { const f32x4 a = *(const f32x4*)(cb + c0), b = *(const f32x4*)(cb + c0 + 4); bias[0] = a.x; bias[1] = a.y; bias[2] = a.z; bias[3] = a.w; bias[4] = b.x; bias[5] = b.y; bias[6] = b.z; bias[7] = b.w; }
        u32x4 rows[11];
#pragma unroll
        for (int i = 0; i < 11; ++i) { const int tt = rl - 1 + i; const bool ok = (tt >= 0) && (tt < L);
            rows[i] = ok ? *(const u32x4*)(in + (size_t)(r0 - 1 + i) * C + c0) : (u32x4){0u, 0u, 0u, 0u}; }
        unsigned outw[8][4];
#pragma unroll
        for (int i = 0; i < 8; ++i) {
            float y[8];
#pragma unroll
            for (int j = 0; j < 8; ++j) y[j] = bias[j];
#pragma unroll
            for (int k = 0; k < 4; ++k) { const u32x4 r = rows[i + k];
                y[0] += w[k][0] * bflo(r.x); y[1] += w[k][1] * bfhi(r.x); y[2] += w[k][2] * bflo(r.y); y[3] += w[k][3] * bfhi(r.y);
                y[4] += w[k][4] * bflo(r.z); y[5] += w[k][5] * bfhi(r.z); y[6] += w[k][6] * bflo(r.w); y[7] += w[k][7] * bfhi(r.w); }
#pragma unroll
            for (int j = 0; j < 8; ++j) y[j] = siluf_(y[j]);
            outw[i][0] = pk2(y[0], y[1]); outw[i][1] = pk2(y[2], y[3]); outw[i][2] = pk2(y[4], y[5]); outw[i][3] = pk2(y[6], y[7]);
        }
        if (cbk >= 8) {
            bf16* ob = cbk < 10 ? BMo : CMo; const int cc = cbk < 10 ? c0 - 4096 : c0 - 5120;
#pragma unroll
            for (int i = 0; i < 8; ++i) *(u32x4*)(ob + (size_t)(r0 + i) * 1024 + cc) = (u32x4){outw[i][0], outw[i][1], outw[i][2], outw[i][3]};
        } else {
#pragma unroll
            for (int j = 0; j < 8; ++j) {
                unsigned e[4];
#pragma unroll
                for (int q = 0; q < 4; ++q) { const unsigned a = outw[2 * q][j >> 1], b = outw[2 * q + 1][j >> 1];
                    e[q] = (j & 1) ? ((a >> 16) | (b & 0xffff0000u)) : ((a & 0xffffu) | (b << 16)); }
                *(LAS u32x4*)(tile + (co * 8 + j) * TP + tr * 16) = (u32x4){e[0], e[1], e[2], e[3]};
            }
            __syncthreads();
            const int chunk = t0 >> 7, s0 = t0 & 127;
#pragma unroll
            for (int i = 0; i < 8; ++i) { const int idx = F.tid + 512 * i, piece = idx >> 9, row = idx & 511, c = cbk * 512 + row, p = c & 63, s = s0 + 8 * piece;
                *(u32x4*)(XT + (size_t)(chunk * 64 + (c >> 6)) * 8192 + (((s >> 4) * 2 + (p >> 5)) * 64 + (p & 31) + 32 * ((s >> 3) & 1)) * 8) = *(const LAS u32x4*)(tile + row * TP + piece * 16); }
            __syncthreads();
        }
    }
}

constexpr int RGF_PITCH = 528;
__device__ __forceinline__ void p_rg_fused(const Frame& F0, const bf16* URAW, int L, const float* cw, const float* cbias, const bf16* Wg, const float* ba, const float* bx, const float* spt,
                                           bf16* LA, bf16* INP, float* HEND, float* PROD) {
    const Frame F = phase_frame(F0);
    LAS unsigned char* ut = F.lds;
    for (int it = blockIdx.x; it < 64 * 8; it += F.G) {
        const int nb = it & 7, run = it >> 3, t0 = run * 128;
        { const int co = F.tid & 31, tq = F.tid >> 5, c0 = nb * 256 + co * 8, tb = t0 + 8 * tq, tl = tb % L;
          float w[4][8], bias[8];
#pragma unroll
          for (int k = 0; k < 4; ++k) { const f32x4 a = *(const f32x4*)(cw + (size_t)k * D + c0), b = *(const f32x4*)(cw + (size_t)k * D + c0 + 4);
              w[k][0] = a.x; w[k][1] = a.y; w[k][2] = a.z; w[k][3] = a.w; w[k][4] = b.x; w[k][5] = b.y; w[k][6] = b.z; w[k][7] = b.w; }
          { const f32x4 a = *(const f32x4*)(cbias + c0), b = *(const f32x4*)(cbias + c0 + 4); bias[0] = a.x; bias[1] = a.y; bias[2] = a.z; bias[3] = a.w; bias[4] = b.x; bias[5] = b.y; bias[6] = b.z; bias[7] = b.w; }
          u32x4 rows[11];
#pragma unroll
          for (int i = 0; i < 11; ++i) { const int tt = tl - 1 + i; const bool ok = (tt >= 0) && (tt < L);
              rows[i] = ok ? *(const u32x4*)(URAW + (size_t)(tb - 1 + i) * D + c0) : (u32x4){0u, 0u, 0u, 0u}; }
#pragma unroll
          for (int i = 0; i < 8; ++i) {
              float y[8];
#pragma unroll
              for (int j = 0; j < 8; ++j) y[j] = bias[j];
#pragma unroll
              for (int k = 0; k < 4; ++k) { const u32x4 r = rows[i + k];
                  y[0] += w[k][0] * bflo(r.x); y[1] += w[k][1] * bfhi(r.x); y[2] += w[k][2] * bflo(r.y); y[3] += w[k][3] * bfhi(r.y);
                  y[4] += w[k][4] * bflo(r.z); y[5] += w[k][5] * bfhi(r.z); y[6] += w[k][6] * bflo(r.w); y[7] += w[k][7] * bfhi(r.w); }
              *(LAS u32x4*)(ut + (8 * tq + i) * RGF_PITCH + co * 16) = (u32x4){pk2(y[0], y[1]), pk2(y[2], y[3]), pk2(y[4], y[5]), pk2(y[6], y[7])};
          } }
        __syncthreads();
#pragma unroll 1
        for (int d = 0; d < 2; ++d) {
            int Lq = F.lane; asm volatile("" : "+v"(Lq));
            const int g = Lq >> 4, l15 = Lq & 15, w8 = F.wave;
            f32x4 acc[8][4];
#pragma unroll
            for (int m = 0; m < 8; ++m)
#pragma unroll
                for (int n = 0; n < 4; ++n) acc[m][n] = (f32x4){0.f, 0.f, 0.f, 0.f};
            const bf16* wtile = Wg + (size_t)((d * 8 + nb) * 2 + (w8 >> 2)) * 65536 + Lq * 8;
            bf16x8 bq[3][4];
#pragma unroll
            for (int q = 0; q < 3; ++q)
#pragma unroll
                for (int n = 0; n < 4; ++n) bq[q][n] = *(const bf16x8*)(wtile + ((((w8 & 3) * 2 + (n & 1) + (n >> 1) * 8) * 8 + q) * 512));
#pragma unroll 1
            for (int ks = 0; ks < 8; ++ks) {
                bf16x8 bn[4];
#pragma unroll
                for (int n = 0; n < 4; ++n) bn[n] = *(const bf16x8*)(wtile + ((((w8 & 3) * 2 + (n & 1) + (n >> 1) * 8) * 8 + ((ks + 3) & 7)) * 512));
#pragma unroll
                for (int m = 0; m < 8; ++m) { const bf16x8 a = *(const LAS bf16x8*)(ut + (16 * m + l15) * RGF_PITCH + (32 * ks + 8 * g) * 2);
#pragma unroll
                    for (int n = 0; n < 4; ++n) acc[m][n] = __builtin_amdgcn_mfma_f32_16x16x32_bf16(a, bq[0][n], acc[m][n], 0, 0, 0); }
#pragma unroll
                for (int n = 0; n < 4; ++n) { bq[0][n] = bq[1][n]; bq[1][n] = bq[2][n]; bq[2][n] = bn[n]; }
            }
            bf16* la = LA + (size_t)d * TG * D + (size_t)t0 * D + nb * 256; bf16* in = INP + (size_t)d * TG * D + (size_t)t0 * D + nb * 256;
#pragma unroll
            for (int np = 0; np < 2; ++np) {
                const int cl = 32 * w8 + 16 * np + l15, c = nb * 256 + cl;
                const float pba = ba[d * D + c], pbx = bx[d * D + c], psp = spt[d * D + c];
                float Lm[8], Hm[8];
#pragma unroll
                for (int m = 0; m < 8; ++m) {
                    float lr[4], xr[4], ea[4]; unsigned lwv[4], xwv[4];
                    int gq = g; asm volatile("" : "+v"(gq));
                    {
                        f32x4 u4;
#pragma unroll
                        for (int e = 0; e < 4; ++e) u4[e] = bf2f(*(const LAS bf16*)(ut + (16 * m + 4 * gq + e) * RGF_PITCH + cl * 2));
                        const f32x4 na = -(acc[m][np] + pba), nb2 = -(acc[m][2 + np] + pbx); f32x4 e1, e2;
#pragma unroll
                        for (int e = 0; e < 4; ++e) { e1[e] = __expf(fminf(na[e], 80.f)); e2[e] = __expf(fminf(nb2[e], 80.f)); }
                        const f32x4 d1 = e1 + 1.0f, d2 = e2 + 1.0f, dp = d1 * d2; f32x4 rc;
#pragma unroll
                        for (int e = 0; e < 4; ++e) rc[e] = frcp_(dp[e]);
                        const f32x4 l4 = (d2 * rc) * psp, ig = d1 * rc;
                        const unsigned lw01 = pk2(l4[0], l4[1]), lw23 = pk2(l4[2], l4[3]);
                        lr[0] = bflo(lw01); lr[1] = bfhi(lw01); lr[2] = bflo(lw23); lr[3] = bfhi(lw23);
                        f32x4 ea4, sq;
#pragma unroll
                        for (int e = 0; e < 4; ++e) { ea4[e] = __expf(lr[e]); ea[e] = ea4[e]; }
                        const f32x4 om = 1.0f - ea4 * ea4;
#pragma unroll
                        for (int e = 0; e < 4; ++e) sq[e] = fsqrt_(fmaxf(om[e], 0.f));
                        const f32x4 x4 = sq * ig * u4;
                        const unsigned xw01 = pk2(x4[0], x4[1]), xw23 = pk2(x4[2], x4[3]);
                        xr[0] = bflo(xw01); xr[1] = bfhi(xw01); xr[2] = bflo(xw23); xr[3] = bfhi(xw23);
                        lwv[0] = lw01 & 0xffffu; lwv[1] = lw01 >> 16; lwv[2] = lw23 & 0xffffu; lwv[3] = lw23 >> 16;
                        xwv[0] = xw01 & 0xffffu; xwv[1] = xw01 >> 16; xwv[2] = xw23 & 0xffffu; xwv[3] = xw23 >> 16; }
#pragma unroll
                    for (int ep = 0; ep < 2; ++ep) { const bool odd = (Lq & 1) != 0; const int tok = 16 * m + 4 * gq + 2 * ep + (odd ? 1 : 0);
                        const unsigned sl = odd ? lwv[2 * ep] : lwv[2 * ep + 1], sx = odd ? xwv[2 * ep] : xwv[2 * ep + 1];
                        const unsigned rl = (unsigned)__builtin_amdgcn_update_dpp(0, (int)sl, 0xB1, 0xf, 0xf, true), rx = (unsigned)__builtin_amdgcn_update_dpp(0, (int)sx, 0xB1, 0xf, 0xf, true);
                        const unsigned wl = odd ? (rl | (lwv[2 * ep + 1] << 16)) : (lwv[2 * ep] | (rl << 16)), wx = odd ? (rx | (xwv[2 * ep + 1] << 16)) : (xwv[2 * ep] | (rx << 16));
                        const int c2 = cl & ~1;
                        *(unsigned*)(la + (size_t)tok * D + c2) = wl; *(unsigned*)(in + (size_t)tok * D + c2) = wx; }
                    const float Hf = ((xr[0] * ea[1] + xr[1]) * ea[2] + xr[2]) * ea[3] + xr[3], Hb = ((xr[3] * ea[2] + xr[2]) * ea[1] + xr[1]) * ea[0] + xr[0];
                    float Ls = (lr[0] + lr[1]) + (lr[2] + lr[3]), Hs = d ? Hb : Hf;
#pragma unroll
                    for (int st = 0; st < 2; ++st) { const int bit = st ? 2 : 1; const int pl = Lq ^ (st ? 32 : 16);
                        const float Lp = shfl_lane(Ls, pl), Hp = shfl_lane(Hs, pl);
                        const bool mine_first = (((g & bit) == 0) != (d != 0));
                        Hs = mine_first ? Hs * __expf(Lp) + Hp : Hp * __expf(Ls) + Hs; Ls += Lp; }
                    Lm[m] = Ls; Hm[m] = Hs;
                }
                float Lc[2], Hc[2];
#pragma unroll
                for (int ch = 0; ch < 2; ++ch) {
                    if (d == 0) { float H = Hm[4 * ch]; H = H * __expf(Lm[4 * ch + 1]) + Hm[4 * ch + 1]; H = H * __expf(Lm[4 * ch + 2]) + Hm[4 * ch + 2]; H = H * __expf(Lm[4 * ch + 3]) + Hm[4 * ch + 3]; Hc[ch] = H; }
                    else        { float H = Hm[4 * ch + 3]; H = H * __expf(Lm[4 * ch + 2]) + Hm[4 * ch + 2]; H = H * __expf(Lm[4 * ch + 1]) + Hm[4 * ch + 1]; H = H * __expf(Lm[4 * ch]) + Hm[4 * ch]; Hc[ch] = H; }
                    Lc[ch] = (Lm[4 * ch] + Lm[4 * ch + 1]) + (Lm[4 * ch + 2] + Lm[4 * ch + 3]);
                }
                if (g == 0) {
#pragma unroll
                    for (int ch = 0; ch < 2; ++ch) { const size_t o = ((size_t)(run * 2 + ch) * 2 + d) * D + c; HEND[o] = Hc[ch]; PROD[o] = __expf(Lc[ch]); } }
            }
        }
        __syncthreads();
    }
}
__device__ __forceinline__ void p_rg_scan_b(const Frame& F0, const float* __restrict__ HEND, const float* __restrict__ PROD, float* __restrict__ HIN, int L) {
    const Frame F = phase_frame(F0);
    const int nck = L / 64, nseq = TG / L, total = nseq * 2 * D;
    for (int e = F.gw * 64 + F.lane; e < total; e += F.ngw * 64) {
        const int c = e % D, d = (e / D) & 1, sq = e / (2 * D);
        float h = 0.f;
        for (int k0 = 0; k0 < nck; k0 += 16) {
            float p[16], he[16];
#pragma unroll
            for (int j = 0; j < 16; ++j) { const int k = k0 + j, ck = sq * nck + (d ? nck - 1 - k : k); const size_t o = ((size_t)ck * 2 + d) * D + c; p[j] = PROD[o]; he[j] = HEND[o]; }
#pragma unroll
            for (int j = 0; j < 16; ++j) { const int k = k0 + j, ck = sq * nck + (d ? nck - 1 - k : k); const size_t o = ((size_t)ck * 2 + d) * D + c; HIN[o] = h; h = p[j] * h + he[j]; }
        }
    }
}
__device__ __forceinline__ void p_rg_scan_c(const Frame& F0, const bf16* LA, const bf16* INP, const float* HIN, const bf16* GATE, bf16* Y) {
    const Frame F = phase_frame(F0);
    for (int it = F.gw; it < 128 * 16; it += F.ngw) {
        const int cb = it & 15, ck = it >> 4, c0 = cb * 128 + F.lane * 2;
        const size_t base = (size_t)ck * 64 * D + c0;
        const unsigned* la0 = (const unsigned*)(LA + base); const unsigned* ip0 = (const unsigned*)(INP + base);
        const unsigned* la1 = (const unsigned*)(LA + (size_t)TG * D + base); const unsigned* ip1 = (const unsigned*)(INP + (size_t)TG * D + base);
        const unsigned* gt = (const unsigned*)(GATE + base); unsigned* yo = (unsigned*)(Y + base);
        constexpr int RS = D / 2;
        f32x2 hf[64];
        { const f32x2 hi = *(const f32x2*)(HIN + ((size_t)ck * 2 + 0) * D + c0); float h0 = hi.x, h1 = hi.y;
          unsigned cl[8], cx[8];
#pragma unroll
          for (int j = 0; j < 8; ++j) { cl[j] = la0[(size_t)j * RS]; cx[j] = ip0[(size_t)j * RS]; }
#pragma unroll
          for (int blk = 0; blk < 8; ++blk) {
              unsigned nl[8], nx[8];
              if (blk < 7) {
#pragma unroll
                  for (int j = 0; j < 8; ++j) { const int t = 8 * (blk + 1) + j; nl[j] = la0[(size_t)t * RS]; nx[j] = ip0[(size_t)t * RS]; } }
#pragma unroll
              for (int j = 0; j < 8; ++j) { const unsigned lw = cl[j], iw = cx[j]; h0 = __expf(bflo(lw)) * h0 + bflo(iw); h1 = __expf(bfhi(lw)) * h1 + bfhi(iw); hf[8 * blk + j] = (f32x2){h0, h1}; }
#pragma unroll
              for (int j = 0; j < 8; ++j) { cl[j] = nl[j]; cx[j] = nx[j]; }
          } }
        { const f32x2 hi = *(const f32x2*)(HIN + ((size_t)ck * 2 + 1) * D + c0); float h0 = hi.x, h1 = hi.y;
          unsigned cl[8], cx[8], cg[8];
#pragma unroll
          for (int j = 0; j < 8; ++j) { const int t = 63 - j; cl[j] = la1[(size_t)t * RS]; cx[j] = ip1[(size_t)t * RS]; cg[j] = gt[(size_t)t * RS]; }
#pragma unroll
          for (int blk = 0; blk < 8; ++blk) {
              unsigned nl[8], nx[8], ng[8];
              if (blk < 7) {
#pragma unroll
                  for (int j = 0; j < 8; ++j) { const int t = 63 - (8 * (blk + 1) + j); nl[j] = la1[(size_t)t * RS]; nx[j] = ip1[(size_t)t * RS]; ng[j] = gt[(size_t)t * RS]; } }
#pragma unroll
              for (int j = 0; j < 8; ++j) { const int t = 63 - (8 * blk + j); const unsigned lw = cl[j], iw = cx[j], gw = cg[j];
                  h0 = __expf(bflo(lw)) * h0 + bflo(iw); h1 = __expf(bfhi(lw)) * h1 + bfhi(iw);
                  yo[(size_t)t * RS] = pk2((hf[t].x + h0) * bflo(gw), (hf[t].y + h1) * bfhi(gw)); }
#pragma unroll
              for (int j = 0; j < 8; ++j) { cl[j] = nl[j]; cx[j] = nx[j]; cg[j] = ng[j]; }
          } }
    }
}

constexpr int PB = 272;
__device__ __forceinline__ s16x4 tr_read(const LAS unsigned char* p) { return __builtin_bit_cast(s16x4, __builtin_amdgcn_ds_read_tr16_b64_v4i16((LAS v4i16_t*)p)); }
__device__ __forceinline__ bf16x8 cat8(s16x4 lo, s16x4 hi) { return __builtin_shufflevector(lo, hi, 0, 1, 2, 3, 4, 5, 6, 7); }
__device__ __forceinline__ bf16x8 scale8(bf16x8 v, const float* w) {
    const u32x4 u = __builtin_bit_cast(u32x4, v); u32x4 o;
    o.x = pk2(bflo(u.x) * w[0], bfhi(u.x) * w[1]); o.y = pk2(bflo(u.y) * w[2], bfhi(u.y) * w[3]); o.z = pk2(bflo(u.z) * w[4], bfhi(u.z) * w[5]); o.w = pk2(bflo(u.w) * w[6], bfhi(u.w) * w[7]);
    return __builtin_bit_cast(bf16x8, o);
}
__device__ __forceinline__ bf16x8 scale8s(bf16x8 v, float w) {
    const u32x4 u = __builtin_bit_cast(u32x4, v); u32x4 o;
    o.x = pk2(bflo(u.x) * w, bfhi(u.x) * w); o.y = pk2(bflo(u.y) * w, bfhi(u.y) * w); o.z = pk2(bflo(u.z) * w, bfhi(u.z) * w); o.w = pk2(bflo(u.w) * w, bfhi(u.w) * w);
    return __builtin_bit_cast(bf16x8, o);
}
__device__ __forceinline__ void stage_img(const Frame& F, const bf16* src, int ld, LAS unsigned char* img) {
#pragma unroll
    for (int i = 0; i < 4; ++i) { const int idx = F.tid + 512 * i, r = idx >> 4, ch = idx & 15; *(LAS u32x4*)(img + r * PB + ch * 16) = *(const u32x4*)(src + (size_t)r * ld + ch * 8); }
}
__device__ __forceinline__ void ssd_tables(const Frame& F, const float* DT, int t0, int head, float A0, float A1, LAS float* tab) {
    const int L = F.lane; const float* dp = DT + (size_t)(t0 + 2 * L) * 128 + head;
    const float a0 = dp[0], a1 = dp[128], b0 = dp[64], b1 = dp[128 + 64];
    float sa = a0 + a1, sb = b0 + b1, ia = sa, ib = sb;
#pragma unroll
    for (int o = 1; o < 64; o <<= 1) { const float xa = shfl_lane(ia, (L - o) & 63), xb = shfl_lane(ib, (L - o) & 63); if (L >= o) { ia += xa; ib += xb; } }
    const float totb = shfl_lane(ib, 63);
    const float ea = ia - sa, eb = ib - sb;
    tab[2 * L] = A0 * (ea + a0); tab[2 * L + 1] = A0 * (ea + a0 + a1);
    tab[128 + 2 * L] = A1 * (totb - eb); tab[128 + 2 * L + 1] = A1 * (totb - eb - b0);
    tab[256 + 2 * L] = a0; tab[256 + 2 * L + 1] = a1; tab[384 + 2 * L] = b0; tab[384 + 2 * L + 1] = b1;
}
__device__ __forceinline__ void p_ssd_dt(const Frame& F0, const bf16* XA, const bf16* Wdt  , const float* dtb, float* DT) {
    const Frame F = phase_frame(F0);
    LAS float* part = (LAS float*)F.lds;
    const int L = F.lane, g = L >> 4, l15 = L & 15;
    for (int rb = blockIdx.x; rb < TG / 32; rb += F.G) {
        const int r0 = rb * 32, kb = F.wave * 256;
        f32x4 acc[2][8];
#pragma unroll
        for (int m = 0; m < 2; ++m)
#pragma unroll
            for (int n = 0; n < 8; ++n) acc[m][n] = (f32x4){0.f, 0.f, 0.f, 0.f};
#pragma unroll 2
        for (int ks = 0; ks < 8; ++ks) {
            bf16x8 a[2], b[8];
#pragma unroll
            for (int m = 0; m < 2; ++m) a[m] = *(const bf16x8*)((const char*)XA + pg8::blk_off(r0 + 16 * m + l15, kb + 32 * ks + 8 * g, D, false));
#pragma unroll
            for (int n = 0; n < 8; ++n) b[n] = *(const bf16x8*)(Wdt + (size_t)(16 * n + l15) * D + kb + 32 * ks + 8 * g);
#pragma unroll
            for (int m = 0; m < 2; ++m)
#pragma unroll
                for (int n = 0; n < 8; ++n) acc[m][n] = __builtin_amdgcn_mfma_f32_16x16x32_bf16(a[m], b[n], acc[m][n], 0, 0, 0);
        }
#pragma unroll
        for (int m = 0; m < 2; ++m)
#pragma unroll
            for (int n = 0; n < 8; ++n)
#pragma unroll
                for (int e = 0; e < 4; ++e) part[(F.wave * 32 + 16 * m + 4 * g + e) * 128 + 16 * n + l15] = acc[m][n][e];
        __syncthreads();
        { const int row = F.tid >> 4, cb = (F.tid & 15) * 8;
          f32x4 s0 = *(const f32x4*)(dtb + cb), s1 = *(const f32x4*)(dtb + cb + 4);
#pragma unroll
          for (int w = 0; w < 8; ++w) { s0 += *(const LAS f32x4*)(part + (w * 32 + row) * 128 + cb); s1 += *(const LAS f32x4*)(part + (w * 32 + row) * 128 + cb + 4); }
#pragma unroll
          for (int j = 0; j < 4; ++j) { s0[j] = softplusf_(s0[j]); s1[j] = softplusf_(s1[j]); }
          float* o = DT + (size_t)(r0 + row) * 128 + cb; *(f32x4*)o = s0; *(f32x4*)(o + 4) = s1; }
        __syncthreads();
    }
}
__device__ __forceinline__ void p_ssd_states(const Frame& F0, const bf16* XT, const bf16* BMt, const float* DT, const float* alog, bf16* ST, float* DEC) {
    const Frame F = phase_frame(F0);
    LAS unsigned char* img = F.lds; LAS float* tab = (LAS float*)(F.lds + 36864 + F.wave * 2048);
    const int L = F.lane, h = L >> 5, l31 = L & 31, q = (L & 15) >> 2, p4 = L & 3, blk = (L >> 4) & 1;
    for (int it = blockIdx.x; it < 64 * 8; it += F.G) {
        const int c = it >> 3, g = it & 7, head = g * 8 + F.wave, t0 = c * 128;
        const bf16* xt = XT + (size_t)(c * 64 + head) * 64 * 128;
        bf16x8 xc[2][2];
#pragma unroll
        for (int k2 = 0; k2 < 2; ++k2)
#pragma unroll
            for (int pt = 0; pt < 2; ++pt) xc[k2][pt] = *(const bf16x8*)(xt + ((k2 * 2 + pt) * 64 + L) * 8);
        stage_img(F, BMt + (size_t)t0 * 1024 + g * 128, 1024, img);
        const float A0 = -__expf(alog[head]), A1 = -__expf(alog[64 + head]);
        ssd_tables(F, DT, t0, head, A0, A1, tab);
        __syncthreads();
        const float afe = tab[127], ab0 = tab[128];
        if (L == 0) { DEC[(c * 2 + 0) * 64 + head] = __expf(afe); DEC[(c * 2 + 1) * 64 + head] = __expf(ab0); }
#pragma unroll 1
        for (int dir = 0; dir < 2; ++dir) {
            f32x16 acc[4][2];
#pragma unroll
            for (int a = 0; a < 4; ++a)
#pragma unroll
                for (int b = 0; b < 2; ++b)
#pragma unroll
                    for (int r = 0; r < 16; ++r) acc[a][b][r] = 0.f;
            const float eref = dir ? ab0 : afe;
#pragma unroll 1
            for (int kp = 0; kp < 4; ++kp) {
                bf16x8 xn[2][2];
                { const int kn0 = (kp < 3) ? 2 * (kp + 1) : 0;
#pragma unroll
                  for (int k2 = 0; k2 < 2; ++k2)
#pragma unroll
                      for (int pt = 0; pt < 2; ++pt) xn[k2][pt] = *(const bf16x8*)(xt + (((kn0 + k2) * 2 + pt) * 64 + L) * 8); }
#pragma unroll
                for (int k2 = 0; k2 < 2; ++k2) {
                    const int ks = 2 * kp + k2, s0 = 16 * ks + 8 * h;
                    float w[8];
#pragma unroll
                    for (int j = 0; j < 8; ++j) w[j] = __expf(eref - tab[dir * 128 + s0 + j]) * tab[256 + dir * 128 + s0 + j];
                    bf16x8 bfr[2];
#pragma unroll
                    for (int pt = 0; pt < 2; ++pt) bfr[pt] = scale8(xc[k2][pt], w);
#pragma unroll
                    for (int nt = 0; nt < 4; ++nt) {
                        const LAS unsigned char* ad = img + (16 * ks + 8 * h + q) * PB + (32 * nt + 16 * blk + 4 * p4) * 2;
                        const bf16x8 afr = cat8(tr_read(ad), tr_read(ad + 4 * PB));
#pragma unroll
                        for (int pt = 0; pt < 2; ++pt) acc[nt][pt] = __builtin_amdgcn_mfma_f32_32x32x16_bf16(afr, bfr[pt], acc[nt][pt], 0, 0, 0);
                    }
                }
#pragma unroll
                for (int k2 = 0; k2 < 2; ++k2)
#pragma unroll
                    for (int pt = 0; pt < 2; ++pt) xc[k2][pt] = xn[k2][pt];
            }
            bf16* st = ST + ((size_t)(c * 2 + dir) * 64 + head) * 8192;
#pragma unroll
            for (int nt = 0; nt < 4; ++nt)
#pragma unroll
                for (int pt = 0; pt < 2; ++pt)
#pragma unroll
                    for (int qd = 0; qd < 4; ++qd) { u32x2 w2; w2.x = pk2(acc[nt][pt][4 * qd], acc[nt][pt][4 * qd + 1]); w2.y = pk2(acc[nt][pt][4 * qd + 2], acc[nt][pt][4 * qd + 3]);
                        *(u32x2*)(st + (((2 * nt + (qd >> 1)) * 2 + pt) * 64 + l31 + 32 * (qd & 1)) * 8 + 4 * h) = w2; }
        }
        __syncthreads();
    }
}
__device__ __forceinline__ void p_ssd_rec(const Frame& F0, bf16* ST, const float* __restrict__ DEC, int L) {
    const Frame F = phase_frame(F0);
    const int nck = L / 128, nseq = TG / L, total = nseq * 131072;
    for (int e = F.gw * 64 + F.lane; e < total; e += F.ngw * 64) {
        const int oct = e & 1023, head = (e >> 10) & 63, dir = (e >> 16) & 1, sq = e >> 17;
        float hst[8];
#pragma unroll
        for (int j = 0; j < 8; ++j) hst[j] = 0.f;
        for (int k0 = 0; k0 < nck; k0 += 8) {
            u32x4 v[8]; float dec[8];
#pragma unroll
            for (int j = 0; j < 8; ++j) { const int k = k0 + j, c = sq * nck + (dir ? nck - 1 - k : k);
                v[j] = *(const u32x4*)(ST + ((size_t)(c * 2 + dir) * 64 + head) * 8192 + oct * 8); dec[j] = DEC[(c * 2 + dir) * 64 + head]; }
#pragma unroll
            for (int j = 0; j < 8; ++j) { const int k = k0 + j, c = sq * nck + (dir ? nck - 1 - k : k);
                u32x4 o; o.x = pk2(hst[0], hst[1]); o.y = pk2(hst[2], hst[3]); o.z = pk2(hst[4], hst[5]); o.w = pk2(hst[6], hst[7]);
                *(u32x4*)(ST + ((size_t)(c * 2 + dir) * 64 + head) * 8192 + oct * 8) = o;
                const float dc = dec[j]; const u32x4 x = v[j];
                hst[0] = hst[0] * dc + bflo(x.x); hst[1] = hst[1] * dc + bfhi(x.x); hst[2] = hst[2] * dc + bflo(x.y); hst[3] = hst[3] * dc + bfhi(x.y);
                hst[4] = hst[4] * dc + bflo(x.z); hst[5] = hst[5] * dc + bfhi(x.z); hst[6] = hst[6] * dc + bflo(x.w); hst[7] = hst[7] * dc + bfhi(x.w); }
        }
    }
}
__device__ __forceinline__ void p_ssd_out(const Frame& F0, const bf16* XT, const bf16* BMt, const bf16* CMt, const float* DT, const float* alog, const float* dskip, const bf16* ST,
                                          const bf16* ZS, const float* ng, bf16* Y) {
    const Frame F = phase_frame(F0);
    LAS unsigned char* imgB = F.lds; LAS unsigned char* imgC = F.lds + 34816; LAS float* tab = (LAS float*)(F.lds + 69632 + F.wave * 2048); LAS float* part = (LAS float*)(F.lds + 69632 + 16384);
    const int L0 = F.lane;
    for (int it = blockIdx.x; it < 64 * 8; it += F.G) {
        const int c = it >> 3, g = it & 7, head = g * 8 + F.wave, t0 = c * 128;
        stage_img(F, BMt + (size_t)t0 * 1024 + g * 128, 1024, imgB);
        stage_img(F, CMt + (size_t)t0 * 1024 + g * 128, 1024, imgC);
        const float A0 = -__expf(alog[head]), A1 = -__expf(alog[64 + head]), dsk = dskip[head];
        ssd_tables(F, DT, t0, head, A0, A1, tab);
        __syncthreads();
        const bf16* xt = XT + (size_t)(c * 64 + head) * 64 * 128;
#pragma unroll 1
        for (int half = 0; half < 2; ++half) {
            f32x16 acc[2][2];
#pragma unroll
            for (int a = 0; a < 2; ++a)
#pragma unroll
                for (int b = 0; b < 2; ++b)
#pragma unroll
                    for (int r = 0; r < 16; ++r) acc[a][b][r] = 0.f;
            { int L = L0; asm volatile("" : "+v"(L)); const int h = L >> 5, l31 = L & 31;
#pragma unroll 1
            for (int st = 0; st < 4; ++st) {
                bf16x8 xa[2][2];
#pragma unroll
                for (int ks = 0; ks < 2; ++ks)
#pragma unroll
                    for (int pt = 0; pt < 2; ++pt) { const bf16* xp = xt + (((2 * st + ks) * 2 + pt) * 64 + l31) * 8 + 4 * h;
                        const s16x4 lo = *(const s16x4*)xp, hi = *(const s16x4*)(xp + 32 * 8); xa[ks][pt] = cat8(lo, hi); }
#pragma unroll
                for (int tt = 0; tt < 2; ++tt) {
                    const int tg = 2 * half + tt;
                    f32x16 dg;
#pragma unroll
                    for (int r = 0; r < 16; ++r) dg[r] = 0.f;
#pragma unroll 2
                    for (int kn = 0; kn < 8; ++kn) { const bf16x8 a = *(const LAS bf16x8*)(imgB + (32 * st + l31) * PB + (16 * kn + 8 * h) * 2), b = *(const LAS bf16x8*)(imgC + (32 * tg + l31) * PB + (16 * kn + 8 * h) * 2);
                        dg = __builtin_amdgcn_mfma_f32_32x32x16_bf16(a, b, dg, 0, 0, 0); }
                    const int t = 32 * tg + l31; const float aft = tab[t], abt = tab[128 + t];
                    float v[16];
#pragma unroll
                    for (int qd = 0; qd < 4; ++qd) { const int sb = 32 * st + 8 * qd + 4 * h;
                        const f32x4 afs = *(const LAS f32x4*)(tab + sb), abs_ = *(const LAS f32x4*)(tab + 128 + sb), d0 = *(const LAS f32x4*)(tab + 256 + sb), d1 = *(const LAS f32x4*)(tab + 384 + sb);
                        if (st < tg) {
#pragma unroll
                            for (int e = 0; e < 4; ++e) v[4 * qd + e] = dg[4 * qd + e] * (__expf(aft - afs[e]) * d0[e]);
                        } else if (st > tg) {
#pragma unroll
                            for (int e = 0; e < 4; ++e) v[4 * qd + e] = dg[4 * qd + e] * (__expf(abt - abs_[e]) * d1[e]);
                        } else {
#pragma unroll
                            for (int e = 0; e < 4; ++e) { const int s = sb + e; float m = 0.f;
                                if (s <= t) m += __expf(aft - afs[e]) * d0[e];
                                if (s >= t) m += __expf(abt - abs_[e]) * d1[e];
                                float x = dg[4 * qd + e] * m; if (s == t) x += dsk; v[4 * qd + e] = x; } } }
                    bf16x8 gf[2];
#pragma unroll
                    for (int ks = 0; ks < 2; ++ks) { u32x4 o; o.x = pk2(v[8 * ks], v[8 * ks + 1]); o.y = pk2(v[8 * ks + 2], v[8 * ks + 3]); o.z = pk2(v[8 * ks + 4], v[8 * ks + 5]); o.w = pk2(v[8 * ks + 6], v[8 * ks + 7]); gf[ks] = __builtin_bit_cast(bf16x8, o); }
#pragma unroll
                    for (int pt = 0; pt < 2; ++pt)
#pragma unroll
                        for (int ks = 0; ks < 2; ++ks) acc[tt][pt] = __builtin_amdgcn_mfma_f32_32x32x16_bf16(xa[ks][pt], gf[ks], acc[tt][pt], 0, 0, 0);
                }
            }
            }
            { int L = L0; asm volatile("" : "+v"(L)); const int h = L >> 5, l31 = L & 31;
            const bf16* hs0 = ST + ((size_t)(c * 2) * 64 + head) * 8192;
            bf16x8 hc[4][2];
#pragma unroll
            for (int k4 = 0; k4 < 4; ++k4)
#pragma unroll
                for (int pt = 0; pt < 2; ++pt) hc[k4][pt] = *(const bf16x8*)(hs0 + ((k4 * 2 + pt) * 64 + L) * 8);
#pragma unroll 1
            for (int bt = 0; bt < 4; ++bt) {
                const int dir = bt >> 1, kh = bt & 1;
                bf16x8 hn[4][2];
                { const int nb2 = (bt + 1) & 3; const bf16* hsn = hs0 + (size_t)(nb2 >> 1) * 64 * 8192;
#pragma unroll
                  for (int k4 = 0; k4 < 4; ++k4)
#pragma unroll
                      for (int pt = 0; pt < 2; ++pt) hn[k4][pt] = *(const bf16x8*)(hsn + (((4 * (nb2 & 1) + k4) * 2 + pt) * 64 + L) * 8); }
                float et[2];
#pragma unroll
                for (int tt = 0; tt < 2; ++tt) et[tt] = __expf(tab[dir * 128 + 32 * (2 * half + tt) + l31]);
#pragma unroll
                for (int k4 = 0; k4 < 4; ++k4) { const int kn = 4 * kh + k4;
#pragma unroll
                    for (int tt = 0; tt < 2; ++tt) { const bf16x8 cb = scale8s(*(const LAS bf16x8*)(imgC + (32 * (2 * half + tt) + l31) * PB + (16 * kn + 8 * h) * 2), et[tt]);
#pragma unroll
                        for (int pt = 0; pt < 2; ++pt) acc[tt][pt] = __builtin_amdgcn_mfma_f32_32x32x16_bf16(hc[k4][pt], cb, acc[tt][pt], 0, 0, 0); }
                }
#pragma unroll
                for (int k4 = 0; k4 < 4; ++k4)
#pragma unroll
                    for (int pt = 0; pt < 2; ++pt) hc[k4][pt] = hn[k4][pt];
            }
            }
            { int L = L0; asm volatile("" : "+v"(L)); const int h = L >> 5, l31 = L & 31, lr8 = L >> 3, lp8 = L & 7;
              LAS unsigned char* wt = F.lds + 88064 + F.wave * 4608;
#pragma unroll
            for (int tt = 0; tt < 2; ++tt) { const size_t rowb = (size_t)(t0 + 32 * (2 * half + tt)); float ssq = 0.f;
                u32x4 zl[4];
#pragma unroll
                for (int i = 0; i < 4; ++i) zl[i] = *(const u32x4*)(ZS + (rowb + lr8 + 8 * i) * SSD_DI + head * 64 + lp8 * 8);
#pragma unroll
                for (int i = 0; i < 4; ++i) *(LAS u32x4*)(wt + (lr8 + 8 * i) * 144 + lp8 * 16) = zl[i];
                asm volatile("s_waitcnt lgkmcnt(0)" ::: "memory");
#pragma unroll
                for (int pt = 0; pt < 2; ++pt)
#pragma unroll
                    for (int qd = 0; qd < 4; ++qd) { const u32x2 z = *(const LAS u32x2*)(wt + l31 * 144 + (32 * pt + 8 * qd + 4 * h) * 2);
                        const float y0 = acc[tt][pt][4 * qd] * bflo(z.x), y1 = acc[tt][pt][4 * qd + 1] * bfhi(z.x), y2 = acc[tt][pt][4 * qd + 2] * bflo(z.y), y3 = acc[tt][pt][4 * qd + 3] * bfhi(z.y);
                        acc[tt][pt][4 * qd] = y0; acc[tt][pt][4 * qd + 1] = y1; acc[tt][pt][4 * qd + 2] = y2; acc[tt][pt][4 * qd + 3] = y3; ssq += (y0 * y0 + y1 * y1) + (y2 * y2 + y3 * y3); }
                asm volatile("s_waitcnt lgkmcnt(0)" ::: "memory");
                ssq += shfl_lane(ssq, L ^ 32);
                if (h == 0) part[F.wave * 64 + 32 * tt + l31] = ssq; }
            __syncthreads();
#pragma unroll
            for (int tt = 0; tt < 2; ++tt) { const int tl = 32 * tt + l31; const size_t rowb = (size_t)(t0 + 64 * half + 32 * tt); float tot = 0.f;
#pragma unroll
                for (int w = 0; w < 8; ++w) tot += part[w * 64 + tl];
                const float rstd = rsqrtf(tot * (1.0f / 512.0f) + LN_EPS);
#pragma unroll
                for (int pt = 0; pt < 2; ++pt)
#pragma unroll
                    for (int qd = 0; qd < 4; ++qd) { const int cc = head * 64 + 32 * pt + 8 * qd + 4 * h; const f32x4 gg = *(const f32x4*)(ng + cc);
                        u32x2 o; o.x = pk2(acc[tt][pt][4 * qd] * rstd * gg.x, acc[tt][pt][4 * qd + 1] * rstd * gg.y); o.y = pk2(acc[tt][pt][4 * qd + 2] * rstd * gg.z, acc[tt][pt][4 * qd + 3] * rstd * gg.w);
                        *(LAS u32x2*)(wt + l31 * 144 + (32 * pt + 8 * qd + 4 * h) * 2) = o; }
                asm volatile("s_waitcnt lgkmcnt(0)" ::: "memory");
#pragma unroll
                for (int i = 0; i < 4; ++i) *(u32x4*)(Y + (rowb + lr8 + 8 * i) * SSD_DI + head * 64 + lp8 * 8) = *(const LAS u32x4*)(wt + (lr8 + 8 * i) * 144 + lp8 * 16);
                asm volatile("s_waitcnt lgkmcnt(0)" ::: "memory"); }
            }
            __syncthreads();
        }
    }
}

constexpr int NA_STG = 2 * 64 * PB;
__device__ __forceinline__ void p_natt(const Frame& F0, const bf16* Q, const bf16* Kb, const bf16* V, const float* rpb, bf16* O, int L) {
    const Frame F = phase_frame(F0);
    LAS unsigned char* ringb = F.lds;
    LAS float* rp = (LAS float*)(F.lds + 3 * NA_STG);
    const int Ln = F.lane, g = Ln >> 4, l15 = Ln & 15, q4 = l15 >> 2, p4 = Ln & 3;
    const int rps = L / 64, nrb = 128 / 4;
    const int wrow = F.wave >> 1, chf = F.wave & 1;
    for (int it = blockIdx.x; it < nrb * 16; it += F.G) {
        const int head = it & 15, rb = it >> 4, grow0 = rb * 4, sq = grow0 / rps, r0 = grow0 % rps;
        const size_t rowbase = (size_t)sq * rps * 64;
        int klo = r0 - 4; klo = klo < 0 ? 0 : (klo > rps - 8 ? rps - 8 : klo);
        int khi = r0 + 3 - 4; khi = khi < 0 ? 0 : (khi > rps - 8 ? rps - 8 : khi); khi += 7;
        const int nst = khi - klo + 1;
        const int r = r0 + wrow; int rs = r - 4; rs = rs < 0 ? 0 : (rs > rps - 8 ? rps - 8 : rs);
        for (int i = F.tid; i < 465; i += NTHR) rp[i] = rpb[(size_t)head * 465 + i];
        u32x4 st0[4], st1[4];
        auto gload = [&](u32x4 (&d)[4], int s) {
#pragma unroll
            for (int i = 0; i < 2; ++i) { const int idx = F.tid + 512 * i, key = idx >> 4, ch = idx & 15; const size_t off = (rowbase + (size_t)(klo + s) * 64 + key) * D + head * 128 + ch * 8;
                d[i] = *(const u32x4*)(Kb + off); d[2 + i] = *(const u32x4*)(V + off); } };
        auto lstore = [&](const u32x4 (&d)[4], int s) { LAS unsigned char* b = ringb + (s % 3) * NA_STG;
#pragma unroll
            for (int i = 0; i < 2; ++i) { const int idx = F.tid + 512 * i, key = idx >> 4, ch = idx & 15; *(LAS u32x4*)(b + key * PB + ch * 16) = d[i]; *(LAS u32x4*)(b + 64 * PB + key * PB + ch * 16) = d[2 + i]; } };
        gload(st0, 0); gload(st1, 1);
        bf16x8 qf[2][4];
#pragma unroll
        for (int jt = 0; jt < 2; ++jt)
#pragma unroll
            for (int kd = 0; kd < 4; ++kd) qf[jt][kd] = *(const bf16x8*)(Q + (rowbase + (size_t)r * 64 + 16 * (2 * chf + jt) + l15) * D + head * 128 + 32 * kd + 8 * g);
        lstore(st0, 0); lstore(st1, 1);
        gload(st0, 2); if (nst > 3) gload(st1, 3);
        float mrun[2] = {-3.0e38f, -3.0e38f}, lrun[2] = {0.f, 0.f};
        f32x4 oacc[2][8];
#pragma unroll
        for (int jt = 0; jt < 2; ++jt)
#pragma unroll
            for (int dt = 0; dt < 8; ++dt) oacc[jt][dt] = (f32x4){0.f, 0.f, 0.f, 0.f};
        __syncthreads();
#pragma unroll 1
        for (int s = 0; s < nst; ++s) {
            const int kr = klo + s;
            const LAS unsigned char* kb = ringb + (s % 3) * NA_STG; const LAS unsigned char* vb = kb + 64 * PB;
            if (kr >= rs && kr <= rs + 7) {
                const int dy = kr - r + 7;
                int Lq = Ln; asm volatile("" : "+v"(Lq));
                const int g = Lq >> 4, l15 = Lq & 15, q4 = l15 >> 2, p4 = Lq & 3;
#pragma unroll
                for (int jt = 0; jt < 2; ++jt) {
                    const int j = 2 * chf + jt, kstart = (j == 0) ? 0 : (j == 1 ? 8 : (j == 2 ? 24 : 32)), qcol = 16 * j + l15;
                    int wst = qcol - 8; wst = wst < 0 ? 0 : (wst > 48 ? 48 : wst);
                    f32x4 sA = {0.f, 0.f, 0.f, 0.f}, sB = {0.f, 0.f, 0.f, 0.f};
                    const LAS unsigned char* ka = kb + (kstart + 8 * q4 + p4) * PB + 16 * g;
#pragma unroll
                    for (int kd = 0; kd < 4; ++kd) { const bf16x8 fa = *(const LAS bf16x8*)(ka + 64 * kd), fb = *(const LAS bf16x8*)(ka + 4 * PB + 64 * kd);
                        sA = __builtin_amdgcn_mfma_f32_16x16x32_bf16(fa, qf[jt][kd], sA, 0, 0, 0); sB = __builtin_amdgcn_mfma_f32_16x16x32_bf16(fb, qf[jt][kd], sB, 0, 0, 0); }
                    float sv[8]; float mx = mrun[jt];
#pragma unroll
                    for (int e = 0; e < 8; ++e) { const int kcol = kstart + 8 * g + e; const bool ok = (kcol >= wst) && (kcol < wst + 16);
                        int dx = kcol - qcol + 15; dx = dx < 0 ? 0 : (dx > 30 ? 30 : dx);
                        const float x = (e < 4 ? sA[e] : sB[e - 4]) + rp[dy * 31 + dx]; sv[e] = ok ? x : -3.0e38f; mx = fmaxf(mx, sv[e]); }
                    mx = fmaxf(mx, shfl_lane(mx, Lq ^ 16)); mx = fmaxf(mx, shfl_lane(mx, Lq ^ 32));
                    const float alpha = __expf(mrun[jt] - mx); mrun[jt] = mx;
                    float ps = 0.f;
#pragma unroll
                    for (int e = 0; e < 8; ++e) { sv[e] = __expf(sv[e] - mx); ps += sv[e]; }
                    ps += shfl_lane(ps, Lq ^ 16); ps += shfl_lane(ps, Lq ^ 32);
                    lrun[jt] = lrun[jt] * alpha + ps;
                    u32x4 pw; pw.x = pk2(sv[0], sv[1]); pw.y = pk2(sv[2], sv[3]); pw.z = pk2(sv[4], sv[5]); pw.w = pk2(sv[6], sv[7]);
                    const bf16x8 pf = __builtin_bit_cast(bf16x8, pw);
                    const LAS unsigned char* va = vb + (kstart + 8 * g + q4) * PB + 8 * p4;
#pragma unroll
                    for (int dt = 0; dt < 8; ++dt) { const bf16x8 vf = cat8(tr_read(va + 32 * dt), tr_read(va + 4 * PB + 32 * dt));
                        oacc[jt][dt] = oacc[jt][dt] * alpha; oacc[jt][dt] = __builtin_amdgcn_mfma_f32_16x16x32_bf16(vf, pf, oacc[jt][dt], 0, 0, 0); }
                }
            }
            if (s + 2 < nst) { if (s & 1) lstore(st1, s + 2); else lstore(st0, s + 2); }
            if (s + 4 < nst) { if (s & 1) gload(st1, s + 4); else gload(st0, s + 4); }
            __syncthreads();
        }
#pragma unroll
        for (int jt = 0; jt < 2; ++jt) { const float inv = frcp_(lrun[jt]); bf16* op = O + (rowbase + (size_t)r * 64 + 16 * (2 * chf + jt) + l15) * D + head * 128 + 4 * g;
#pragma unroll
            for (int dt = 0; dt < 8; ++dt) { u32x2 o; o.x = pk2(oacc[jt][dt][0] * inv, oacc[jt][dt][1] * inv); o.y = pk2(oacc[jt][dt][2] * inv, oacc[jt][dt][3] * inv); *(u32x2*)(op + 16 * dt) = o; } }
    }
}

struct Args { const float* in[29]; float* out; unsigned char* ws; int g_lo, g_hi, l_lo, l_hi, ph, pad; };

__global__ void __launch_bounds__(NTHR, 2) enc_fwd(Args args) {
    extern __shared__ __attribute__((aligned(16))) unsigned char lds[];
    Frame F;
    F.lds = (LAS unsigned char*)lds;
    F.tid = threadIdx.x; F.lane = F.tid & 63; F.wave = __builtin_amdgcn_readfirstlane(F.tid >> 6);
    F.G = gridDim.x; F.gw = F.wave * F.G + (int)blockIdx.x; F.ngw = F.G * NWAVES;
    unsigned char* ws = args.ws;
    gu32* ctl = (gu32*)(ws + WS_CTL);
    for (int u = F.tid; u < (LDS_BYTES - LDSCTL_OFF) / 4; u += NTHR) ((LAS unsigned*)(F.lds + LDSCTL_OFF))[u] = 0u;
    __syncthreads();
    const int ph = args.ph;
    XcdBarrier bar; bar.bar = (unsigned*)(ctl + CW_BAR); bar.x = 0; bar.st = nullptr;
    if (ph < 0) bar = xcd_barrier_post((unsigned*)(ctl + CW_BAR), (volatile LAS unsigned*)(F.lds + MISC_OFF) + 8);
#ifndef PROBE_TMASK
#define PROBE_TMASK 0ull
#endif
    unsigned long long tp0 = 0ull, tpacc = 0ull; int tph = 0;
#define RUN(k) ((ph < 0 || ph == (k)) && (tph = (k), tp0 = (PROBE_TMASK ? __builtin_amdgcn_s_memrealtime() : 0ull), true))
#ifndef PROBE_MASK
#define PROBE_MASK 0
#endif
#define NREP(bit) (((PROBE_MASK >> (bit)) & 1) ? 2 : 1)
#define REPEAT(bit) _Pragma("unroll 1") for (int rep = 0; rep < NREP(bit); ++rep)
    float* XDUM = (float*)(ws + WS_SCR + S_DUM); bf16* XBDUM = (bf16*)(ws + WS_SCR + S_DUM + 64 * MiB);
#ifndef PROBE_GPART
#define PROBE_GPART 0
#endif
#define TMODE() ((PROBE_GPART && (((unsigned long long)PROBE_TMASK >> tph) & 1ull)) ? PROBE_GPART : 0)
#define GRID_BAR() do { if (ph < 0) xcd_barrier(bar); if (PROBE_TMASK && !PROBE_GPART && (((unsigned long long)PROBE_TMASK >> tph) & 1ull)) tpacc += __builtin_amdgcn_s_memrealtime() - tp0; } while (0)

    bf16* Wb = (bf16*)(ws + WS_W);
    unsigned char* scr = ws + WS_SCR;
    bf16* XB = (bf16*)(scr + S_XB); bf16* YB = (bf16*)(scr + S_YB); bf16* HB = (bf16*)(scr + S_HID);
    LAS unsigned char* ring = F.lds;

    if (RUN(0) && args.g_lo == 0 && args.l_lo == 0) { p_prologue(F, args.in, Wb, (float*)(ws + WS_SPT), (bf16*)(scr + S_XB0)); GRID_BAR(); }

    for (int grp = args.g_lo; grp < args.g_hi; ++grp) {
        float* X = args.out + (size_t)grp * TG * D;
        const int L = grp < 2 ? 2048 : 8192;
        const float* Xin0 = grp < 2 ? args.in[0] + (size_t)grp * TG * D : args.in[1] + (size_t)(grp - 2) * TG * D;
        const bf16* XB0g = (const bf16*)(scr + S_XB0) + (size_t)grp * TG * D;
        for (int layer = args.l_lo; layer < args.l_hi; ++layer) {
            const int kind = layer % 3, jl = layer / 3;
            int Kout = 2048; const bf16* Wout; const bf16* XA = layer == 0 ? XB0g : XB;
            if (kind == 0) {
                bf16* GATE = (bf16*)(scr + S_RG_GATE); bf16* URAW = (bf16*)(scr + S_RG_URAW); bf16* LA = (bf16*)(scr + S_RG_LA); bf16* INP = (bf16*)(scr + S_RG_INP);
                float* HEND = (float*)(scr + S_RG_HEND); float* PROD = (float*)(scr + S_RG_PROD); float* HIN = (float*)(scr + S_RG_HIN);
                if (RUN(10)) REPEAT(1) { pg8::Gemm g{XA, Wb + W_RGIN + (size_t)jl * 4096 * 2048, 2048, 2048, 1}; pg8::StaticOrder S; S.init(TG, 4096, F.G, (int)blockIdx.x);
                    pg8::EpiRgIn E{GATE, URAW}; pg8::gemm_phase<pg8::EpiRgIn>(ring, g, S, E, tpacc, TMODE()); GRID_BAR(); }
                if (RUN(11)) { p_rg_fused(F, URAW, L, args.in[3] + (size_t)jl * 4 * 2048, args.in[4] + (size_t)jl * 2048, Wb + W_RGGATE + (size_t)jl * 32 * 65536,
                                          args.in[6] + (size_t)jl * 2 * 2048, args.in[8] + (size_t)jl * 2 * 2048, (const float*)(ws + WS_SPT) + (size_t)jl * 2 * 2048, LA, INP, HEND, PROD); GRID_BAR(); }
                if (RUN(14)) REPEAT(3) { p_rg_scan_b(F, HEND, PROD, HIN, L); GRID_BAR(); }
                if (RUN(15)) REPEAT(3) { p_rg_scan_c(F, LA, INP, HIN, GATE, YB); GRID_BAR(); }
                Wout = Wb + W_RGOUT + (size_t)jl * 2048 * 2048;
            } else if (kind == 1) {
                bf16* ZS = (bf16*)(scr + S_SSD_ZS); bf16* XBCR = (bf16*)(scr + S_SSD_XBCR); bf16* XT = (bf16*)(scr + S_SSD_XT); bf16* BMt = (bf16*)(scr + S_SSD_BM); bf16* CMt = (bf16*)(scr + S_SSD_CM);
                float* DT = (float*)(scr + S_SSD_DT); float* DEC = (float*)(scr + S_SSD_DEC); bf16* ST = (bf16*)(scr + S_SSD_ST);
                if (RUN(20)) REPEAT(1) { pg8::Gemm g{XA, Wb + W_SSDIN, 2048, 2048, 1}; pg8::StaticOrder S; S.init(TG, 40 * 256, F.G, (int)blockIdx.x);
                    pg8::EpiSsdIn E{ZS, XBCR}; pg8::gemm_phase<pg8::EpiSsdIn>(ring, g, S, E, tpacc, TMODE()); GRID_BAR(); }
                if (RUN(21)) REPEAT(4) { p_ssd_dt(F, XA, Wb + W_SSDIN + (size_t)10240 * 2048, args.in[14], DT); p_conv_ssd(F, XBCR, L, args.in[12], args.in[13], XT, BMt, CMt); GRID_BAR(); }
                if (RUN(22)) REPEAT(4) { p_ssd_states(F, XT, BMt, DT, args.in[15], ST, DEC); GRID_BAR(); }
                if (RUN(23)) { p_ssd_rec(F, ST, DEC, L); GRID_BAR(); }
                if (RUN(24)) REPEAT(4) { p_ssd_out(F, XT, BMt, CMt, DT, args.in[15], args.in[16], ST, ZS, args.in[17], YB); GRID_BAR(); }
                Wout = Wb + W_SSDOUT; Kout = 4096;
            } else {
                bf16* Qb = (bf16*)(scr + S_NA_Q); bf16* Kb = (bf16*)(scr + S_NA_K); bf16* Vb = (bf16*)(scr + S_NA_V);
                if (RUN(30)) REPEAT(1) { pg8::Gemm g{XA, Wb + W_NAQKV, 2048, 2048, 1}; pg8::StaticOrder S; S.init(TG, 6144, F.G, (int)blockIdx.x);
                    pg8::EpiQkv E{Qb, args.in[20]}; pg8::gemm_phase<pg8::EpiQkv>(ring, g, S, E, tpacc, TMODE()); GRID_BAR(); }
                if (RUN(31)) REPEAT(5) { p_natt(F, Qb, Kb, Vb, args.in[21], YB, L); GRID_BAR(); }
                Wout = Wb + W_NAOUT;
            }
            unsigned long long* xslot = (unsigned long long*)(ws + WS_XSLOT); unsigned* pcnt = (unsigned*)(ctl + CW_SEAM); unsigned* ptmo = (unsigned*)(ctl + CW_TMO);
            const unsigned ep = (unsigned)((grp * DEPTH + layer) * 2);
            if (RUN(40)) { pg8::Gemm g{YB, Wout, Kout, Kout, 0}; pg8::StaticOrder S; S.init(TG, D, F.G, (int)blockIdx.x);
                pg8::EpiResidLn<false> E{XA, nullptr, XB, args.in[25] + (size_t)layer * D, args.in[26] + (size_t)layer * D, ALPHA, xslot, pcnt, 64u * (ep + 1u), ptmo};
                pg8::gemm_phase<pg8::EpiResidLn<false>>(ring, g, S, E, tpacc, TMODE()); GRID_BAR(); }
            if (RUN(42)) REPEAT(6) { pg8::Gemm g{XB, Wb + W_UP + (size_t)layer * 8192 * 2048, 2048, 2048, 1}; pg8::StaticOrder S; S.init(TG, HID, F.G, (int)blockIdx.x, WGM_UP);
                pg8::EpiRelu2 E{HB, HID}; pg8::gemm_phase<pg8::EpiRelu2>(ring, g, S, E, tpacc, TMODE()); GRID_BAR(); }
            if (RUN(43)) { pg8::Gemm g{HB, Wb + W_DOWN + (size_t)layer * 2048 * 8192, 8192, 8192, 1}; pg8::StaticOrder S; S.init(TG, D, F.G, (int)blockIdx.x, WGM_DOWN);
                if (layer == DEPTH - 1) { pg8::EpiResidLn<true> E{XB, X, nullptr, args.in[27] + (size_t)layer * D, args.in[28] + (size_t)layer * D, ALPHA, xslot, pcnt, 64u * (ep + 2u), ptmo};
                    pg8::gemm_phase<pg8::EpiResidLn<true>>(ring, g, S, E, tpacc, TMODE()); }
                else { pg8::EpiResidLn<false> E{XB, nullptr, XB, args.in[27] + (size_t)layer * D, args.in[28] + (size_t)layer * D, ALPHA, xslot, pcnt, 64u * (ep + 2u), ptmo};
                    pg8::gemm_phase<pg8::EpiResidLn<false>>(ring, g, S, E, tpacc, TMODE()); }
                GRID_BAR(); }
        }
    }
    if (PROBE_TMASK && blockIdx.x == 0) { const unsigned long long te = __builtin_amdgcn_s_memrealtime(); while (__builtin_amdgcn_s_memrealtime() - te < tpacc) __builtin_amdgcn_s_sleep(8); }
#undef RUN
#undef GRID_BAR
}

extern "C" void kernel_launch(void* const* d_in, const int* in_sizes, int n_in, void* d_out, int out_size, void* d_ws, size_t ws_size, hipStream_t stream) {
    static int grid = 0;
    if (grid == 0) {
        if (n_in != 29 || out_size != NGROUP * TG * D || ws_size < WS_NEED) { fprintf(stderr, "kernel_launch: unexpected problem (n_in %d, out %d, ws %zu, need %zu)\n", n_in, out_size, ws_size, (size_t)WS_NEED); grid = -1; return; }
        int dev = 0, cus = 0, per_cu = 0;
        if (hipGetDevice(&dev) != hipSuccess || hipDeviceGetAttribute(&cus, hipDeviceAttributeMultiprocessorCount, dev) != hipSuccess) { grid = -1; return; }
        if (hipFuncSetAttribute((const void*)enc_fwd, hipFuncAttributeMaxDynamicSharedMemorySize, LDS_BYTES) != hipSuccess) { fprintf(stderr, "kernel_launch: hipFuncSetAttribute failed\n"); grid = -1; return; }
        if (hipOccupancyMaxActiveBlocksPerMultiprocessor(&per_cu, (const void*)enc_fwd, NTHR, LDS_BYTES) != hipSuccess || per_cu < 1) { fprintf(stderr, "kernel_launch: occupancy query says %d\n", per_cu); }
        (void)hipGetLastError();
        grid = cus;
        if (grid != 256) { fprintf(stderr, "kernel_launch: built for 256 CUs (one 256x256 tile per workgroup in the fused LayerNorm phases), got %d\n", cus); grid = -1; return; }
    }
    if (grid < 0) return;
    (void)hipMemsetAsync((char*)d_ws + WS_CTL, 0, CTL_ZERO_BYTES, stream);
    Args a{};
    for (int i = 0; i < 29; ++i) a.in[i] = (const float*)d_in[i];
    a.out = (float*)d_out; a.ws = (unsigned char*)d_ws; a.pad = 0;
    a.g_lo = 0; a.g_hi = NGROUP; a.l_lo = 0; a.l_hi = DEPTH; a.ph = -1;
    hipLaunchKernelGGL(enc_fwd, dim3(grid), dim3(NTHR), LDS_BYTES, stream, a);
}
```

```cpp
#include <hip/hip_runtime.h>
#include <cstdio>
#include <cstdint>

#ifndef WGM_UP
#define WGM_UP 4
#endif
#ifndef WGM_DOWN
#define WGM_DOWN 4
#endif

#define LAS __attribute__((address_space(3)))
#define GAS __attribute__((address_space(1)))
typedef unsigned short bf16;
typedef short bf16x8 __attribute__((ext_vector_type(8)));
typedef short s16x4 __attribute__((ext_vector_type(4)));
typedef float f32x2 __attribute__((ext_vector_type(2)));
typedef float f32x4 __attribute__((ext_vector_type(4)));
typedef float f32x16 __attribute__((ext_vector_type(16)));
typedef unsigned u32x2 __attribute__((ext_vector_type(2)));
typedef unsigned u32x4 __attribute__((ext_vector_type(4)));
typedef __bf16 bf16x2_t __attribute__((ext_vector_type(2)));
typedef short v4i16_t __attribute__((ext_vector_type(4)));
typedef GAS unsigned gu32;

constexpr int D = 2048, TG = 8192, NGROUP = 6, DEPTH = 4, NWAVES = 8, NTHR = 512;
constexpr int HID = 8192;
constexpr int SSD_DI = 4096, SSD_NH = 64, SSD_NG = 8, SSD_NS = 128, SSD_CH = 128, SSD_XBC = 6144, SSD_NIN = 10368, SSD_NIN_PAD = 10496;
constexpr int NA_H = 16, NA_HD = 128;
constexpr float ALPHA = 1.681792830507429f, LN_EPS = 1e-5f;

constexpr size_t MiB = 1u << 20;
constexpr size_t WS_CTL = 0, CTL_ZERO_BYTES = 256 * 1024;
constexpr size_t WS_XSLOT = 1 * MiB;
constexpr size_t WS_W = 2 * MiB;
constexpr size_t W_RGIN = 0;
constexpr size_t W_RGGATE = W_RGIN + 2ull * 4096 * 2048;
constexpr size_t W_RGOUT = W_RGGATE + 2ull * 32 * 256 * 256;
constexpr size_t W_SSDIN = W_RGOUT + 2ull * 2048 * 2048;
constexpr size_t W_SSDOUT = W_SSDIN + (size_t)SSD_NIN_PAD * 2048;
constexpr size_t W_NAQKV = W_SSDOUT + 2048ull * 4096;
constexpr size_t W_NAOUT = W_NAQKV + 6144ull * 2048;
constexpr size_t W_UP = W_NAOUT + 2048ull * 2048;
constexpr size_t W_DOWN = W_UP + 4ull * 8192 * 2048;
constexpr size_t W_END = W_DOWN + 4ull * 8192 * 2048;
constexpr size_t WS_SCR = ((WS_W + W_END * 2 + MiB - 1) / MiB) * MiB;
constexpr size_t S_XB = 0;
constexpr size_t S_YB = 32 * MiB;
constexpr size_t S_MIX = 96 * MiB;
constexpr size_t S_HID = S_MIX;
constexpr size_t S_RG_GATE = S_MIX, S_RG_URAW = S_MIX + 32 * MiB, S_RG_LA = S_MIX + 96 * MiB  , S_RG_INP = S_MIX + 160 * MiB  ;
constexpr size_t S_RG_HEND = S_MIX + 224 * MiB, S_RG_PROD = S_MIX + 226 * MiB, S_RG_HIN = S_MIX + 228 * MiB;
constexpr size_t S_SSD_ZS = S_MIX, S_SSD_XBCR = S_MIX + 64 * MiB, S_SSD_XT = S_MIX + 160 * MiB, S_SSD_BM = S_MIX + 224 * MiB, S_SSD_CM = S_MIX + 240 * MiB;
constexpr size_t S_SSD_DT = S_MIX + 256 * MiB, S_SSD_DEC = S_MIX + 260 * MiB, S_SSD_ST = S_MIX + 261 * MiB;
constexpr size_t S_NA_Q = S_MIX, S_NA_K = S_MIX + 32 * MiB, S_NA_V = S_MIX + 64 * MiB;
constexpr size_t S_END = S_MIX + 389 * MiB;
constexpr size_t S_XB0 = S_END;
constexpr size_t S_DUM = S_XB0 + 192 * MiB;
#ifndef PROBE_MASK
#define PROBE_MASK 0
#endif
constexpr size_t WS_NEED = WS_SCR + S_DUM + (PROBE_MASK ? 96 * MiB : 0);

constexpr int CW_BAR = 4096;
constexpr int CW_SEAM = 16384;
constexpr int CW_TMO = 0;
constexpr int CW_CHK = 1024;
constexpr size_t WS_SPT = 512 * 1024;

constexpr int RING_BYTES = 131072;
constexpr int LDSCTL_OFF = RING_BYTES, MISC_OFF = LDSCTL_OFF + 320;
constexpr int LDS_BYTES = 147456;

#define RLX_AGENT __ATOMIC_RELAXED, __HIP_MEMORY_SCOPE_AGENT
#define LDS_WAIT() asm volatile("s_waitcnt lgkmcnt(0)" ::: "memory")
#define VM_WAIT() asm volatile("s_waitcnt vmcnt(0)" ::: "memory")
__device__ __forceinline__ unsigned pk2(float lo, float hi) { f32x2 v = {lo, hi}; bf16x2_t b = __builtin_convertvector(v, bf16x2_t); return __builtin_bit_cast(unsigned, b); }
__device__ __forceinline__ float bflo(unsigned w) { return __uint_as_float(w << 16); }
__device__ __forceinline__ float bfhi(unsigned w) { return __uint_as_float(w & 0xffff0000u); }
__device__ __forceinline__ float bf2f(bf16 b) { return __uint_as_float(((unsigned)b) << 16); }
__device__ __forceinline__ float frcp_(float x) { return __builtin_amdgcn_rcpf(x); }
__device__ __forceinline__ float fsqrt_(float x) { return __builtin_amdgcn_sqrtf(x); }
__device__ __forceinline__ float sigmoidf_(float x) { return frcp_(1.0f + __expf(-x)); }
__device__ __forceinline__ float siluf_(float x) { return x * frcp_(1.0f + __expf(-x)); }
__device__ __forceinline__ float gelu_tanh_(float v) { const float u = 1.5957691216057308f * (v + 0.044715f * v * v * v); return v * frcp_(1.0f + __expf(-u)); }
__device__ __forceinline__ float softplusf_(float v) { return v > 20.f ? v : log1pf(__expf(v)); }
__device__ __forceinline__ float shfl_lane(float v, int srclane) { return __int_as_float(__builtin_amdgcn_ds_bpermute(srclane << 2, __float_as_int(v))); }
__device__ __forceinline__ float wave_sum(float v, int lane) {
#pragma unroll
    for (int o = 1; o < 64; o <<= 1) v += shfl_lane(v, lane ^ o);
    return v;
}

#define XB_TMO      128
#define XB_XCNT(j)  (256  + 64 * (j))
#define XB_XSUB(j)  (1280 + 64 * (j))
#define XB_XGEN(j)  (2304 + 64 * (j))
#define XB_TOP      3328
#define XB_TOPGEN   3392
#define XCD_BAR_WORDS 3456
#define XB_SPIN_CAP (1u << 22)

__device__ __forceinline__ unsigned xb_ld(unsigned* p)              { return __hip_atomic_load(p, __ATOMIC_RELAXED, __HIP_MEMORY_SCOPE_AGENT); }
__device__ __forceinline__ unsigned xb_add(unsigned* p, unsigned v) { return __hip_atomic_fetch_add(p, v, __ATOMIC_RELAXED, __HIP_MEMORY_SCOPE_AGENT); }
__device__ __forceinline__ unsigned xb_xcc_id() { return (unsigned)__builtin_amdgcn_s_getreg((3 << 11) | 20) & 0xFu; }
#define XB_SPIN(cond, bar) do { unsigned _sp = 0; while (cond) { __builtin_amdgcn_s_sleep(1); \
    if ((++_sp & 255u) == 0u) { if (xb_ld(&(bar)[XB_TMO])) break; if (_sp > XB_SPIN_CAP) { atomicAdd(&(bar)[XB_TMO], 1u); break; } } } } while (0)

struct XcdBarrier { unsigned* bar; unsigned x; volatile LAS unsigned* st; };

__device__ __forceinline__ XcdBarrier xcd_barrier_post(unsigned* bar, volatile LAS unsigned* st) {
    XcdBarrier b; b.bar = bar; b.x = xb_xcc_id(); b.st = st;
    if (threadIdx.x == 0) (void)xb_add(&bar[XB_XCNT(b.x)], 1u);
    return b;
}
__device__ __forceinline__ void xcd_barrier_complete(unsigned* bar, unsigned x, unsigned& nloc, unsigned& nx) {
    const unsigned G = gridDim.x * gridDim.y * gridDim.z;
    unsigned sum, cnt, mine, sp = 0u;
    for (;;) {
        sum = 0u; cnt = 0u; mine = 0u;
#pragma unroll
        for (unsigned j = 0; j < 16; ++j) { const unsigned c = xb_ld(&bar[XB_XCNT(j)]); sum += c; cnt += (c > 0u) ? 1u : 0u; mine = (j == x) ? c : mine; }
        if (sum == G) break;
        __builtin_amdgcn_s_sleep(1);
        if ((++sp & 255u) == 0u) { if (xb_ld(&bar[XB_TMO])) break; if (sp > XB_SPIN_CAP) { atomicAdd(&bar[XB_TMO], 1u); break; } }
    }
    nloc = mine > 0u ? mine : 1u; nx = cnt > 0u ? cnt : 1u;
}
__device__ __forceinline__ void xcd_barrier(const XcdBarrier& b) {
    asm volatile("s_waitcnt vmcnt(0)" ::: "memory");
    __syncthreads();
    if (threadIdx.x == 0) {
        unsigned* bar = b.bar;
        __builtin_amdgcn_s_waitcnt(0);
        unsigned nloc = b.st[0], nx = b.st[1];
        if (nloc == 0u) { xcd_barrier_complete(bar, b.x, nloc, nx); b.st[0] = nloc; b.st[1] = nx; }
        const unsigned old = xb_add(&bar[XB_XSUB(b.x)], 1u);
        const unsigned gen = old / nloc;
        if (old + 1u == (gen + 1u) * nloc) {
            __builtin_amdgcn_fence(__ATOMIC_RELEASE, "agent");
            asm volatile("s_waitcnt vmcnt(0)" ::: "memory");
            const unsigned og = xb_add(&bar[XB_TOP], 1u);
            const unsigned tg = og / nx;
            if (og + 1u == (tg + 1u) * nx) xb_add(&bar[XB_TOPGEN], 1u);
            else XB_SPIN(xb_ld(&bar[XB_TOPGEN]) == tg, bar);
            __builtin_amdgcn_fence(__ATOMIC_ACQUIRE, "agent");
            xb_add(&bar[XB_XGEN(b.x)], 1u);
            asm volatile("s_waitcnt vmcnt(0)" ::: "memory");
        } else {
            XB_SPIN(xb_ld(&bar[XB_XGEN(b.x)]) == gen, bar);
            __builtin_amdgcn_fence(__ATOMIC_ACQUIRE, "agent");
            asm volatile("s_waitcnt vmcnt(0)" ::: "memory");
        }
    }
    __syncthreads();
}

namespace pg8 {
constexpr int BM = 256, BK = 64, HALF = 128, HTB = HALF * BK * 2, STAGE_BYTES = 8 * HTB, NXCD = 8, WGM = 8;
__host__ __device__ __forceinline__ int lds_byte(int r, int c) { const int st = (r >> 4) * 2 + (c >> 5), rr = r & 15, cc = c & 31, ob = rr * 64 + cc * 2; return st * 1024 + (ob ^ (((ob >> 9) & 1) << 5)); }
__host__ __device__ __forceinline__ void stage_rc(int b, int& R, int& C) { const int st = b / 1024, sb = b % 1024, swz = sb ^ (((sb >> 9) & 1) << 5); R = (st >> 1) * 16 + swz / 64; C = (st & 1) * 32 + (swz % 64) / 2; }
__host__ __device__ __forceinline__ int perm32(int rho) { const int n = rho >> 4, i = rho & 15; return 8 * (i >> 2) + 4 * n + (i & 3); }

struct Unit { int pm, pn; };
struct Gemm { const bf16* A; const bf16* Bt; int lda, K, blkA; };
constexpr int BLK = 16384;
__host__ __device__ __forceinline__ int perm32inv(int x) { return 16 * ((x >> 2) & 1) + 4 * (x >> 3) + (x & 3); }
__host__ __device__ __forceinline__ size_t blk_off(int row, int k, int K, bool perm) {
    const int r = row & 127, slot = perm ? ((r & ~31) + perm32inv(r & 31)) : r; return ((size_t)(row >> 7) * (K >> 6) + (k >> 6)) * BLK + lds_byte(slot, k & 63); }
__device__ __forceinline__ const char* a_base(const Gemm& g, const Unit& u) { return g.blkA ? (const char*)g.A + (size_t)u.pm * 2 * (g.K >> 6) * BLK : (const char*)(g.A + (size_t)u.pm * BM * g.lda); }
__device__ __forceinline__ const char* b_base(const Gemm& g, const Unit& u) { return (const char*)g.Bt + (size_t)u.pn * 2 * (g.K >> 6) * BLK; }

struct StaticOrder {
    int nM, nN, nwg, G, c, wgm;
    __host__ __device__ void init(int M, int N, int G_, int c_, int wgm_ = 4) { nM = M / BM; nN = N / BM; nwg = nM * nN; G = G_; c = c_; wgm = wgm_; }
    __host__ __device__ bool next(int i, Unit& u) const {
        const long L = (long)i * G + c; if (L >= nwg) return false;
        int wgid = (int)L; { const int q = nwg / NXCD, r = nwg % NXCD, xcd = wgid % NXCD, off = wgid / NXCD; wgid = (xcd < r ? xcd * (q + 1) : r * (q + 1) + (xcd - r) * q) + off; }
        const int nig = wgm * nN, gid = wgid / nig, fm = gid * wgm, gsz = (nM - fm) < wgm ? (nM - fm) : wgm;
        u.pm = fm + ((wgid % nig) % gsz); u.pn = (wgid % nig) / gsz; return true;
    }
};

template <class Epi, bool ALIGN_EPI = true, bool SP2 = true>
__device__ __forceinline__ void gemm_phase(LAS unsigned char* lds, const Gemm g, const StaticOrder& S, const Epi& E, unsigned long long& tacc, const int tmode) {
    int tid_o = threadIdx.x; asm volatile("" : "+v"(tid_o));
    const int tid = tid_o, wid = __builtin_amdgcn_readfirstlane(tid >> 6), lane = tid & 63, wr = wid >> 2, wc = wid & 3, fr = lane & 15, fq = lane >> 4;
    const int K = g.K, nt = K / BK;
    unsigned voffA[2], voffB[2];
    static_assert(Epi::PERM, "the blocked weight layout bakes in the PERM row order");
#pragma unroll
    for (int i = 0; i < 2; ++i) { int R, C; stage_rc(tid * 16 + i * 8192, R, C);
        voffA[i] = g.blkA ? (unsigned)(tid * 16 + i * 8192) : (unsigned)(R * g.lda + C) * 2u; voffB[i] = (unsigned)(tid * 16 + i * 8192); }
    const size_t kstepA = g.blkA ? (size_t)BLK : (size_t)(BK * 2), kstepB = (size_t)BLK;
    const size_t hstepA = g.blkA ? (size_t)(K >> 6) * BLK : (size_t)HALF * g.lda * 2, hstepB = (size_t)(K >> 6) * BLK;
    const unsigned ldsw = (unsigned)wid * 1024u;
    const int aoff = lds_byte(wr * 64 + fr, fq * 8), boff = lds_byte(wc * 32 + fr, fq * 8);
#define PG8_SA(b, h) (((b) * 2 + (h)) * HTB)
#define PG8_SB(b, h) ((4 + (b) * 2 + (h)) * HTB)
#define PG8_STAGE(bufoff, gbase, voff) do { _Pragma("unroll") for (int _i = 0; _i < 2; ++_i) \
        __builtin_amdgcn_global_load_lds((const unsigned*)((const char*)(gbase) + (voff)[_i]), (LAS unsigned*)(lds + (bufoff) + ldsw + _i * 8192), 16, 0, 0); } while (0)
#define PG8_LDA(dst, b, h) do { _Pragma("unroll") for (int m = 0; m < 4; ++m) _Pragma("unroll") for (int k = 0; k < 2; ++k) dst[m][k] = *(const LAS bf16x8*)(lds + PG8_SA(b, h) + aoff + m * 2048 + k * 1024); } while (0)
#define PG8_LDB(dst, b, h) do { _Pragma("unroll") for (int n = 0; n < 2; ++n) _Pragma("unroll") for (int k = 0; k < 2; ++k) dst[n][k] = *(const LAS bf16x8*)(lds + PG8_SB(b, h) + boff + n * 2048 + k * 1024); } while (0)
#define PG8_MMA(ai, bj, At, Bt) do { __builtin_amdgcn_s_setprio(1); _Pragma("unroll") for (int m = 0; m < 4; ++m) _Pragma("unroll") for (int n = 0; n < 2; ++n) _Pragma("unroll") for (int k = 0; k < 2; ++k) \
        acc[ai][bj][m][n] = __builtin_amdgcn_mfma_f32_16x16x32_bf16(Bt[n][k], At[m][k], acc[ai][bj][m][n], 0, 0, 0); __builtin_amdgcn_s_setprio(0); } while (0)
#define PG8_WAIT_V(n) asm volatile("s_waitcnt vmcnt(" #n ")" ::: "memory")
#define PG8_WAIT_L(n) asm volatile("s_waitcnt lgkmcnt(" #n ")" ::: "memory")
#define PG8_BAR __builtin_amdgcn_s_barrier()
#define PG8_SCHED __builtin_amdgcn_sched_barrier(0)
    Unit cur, nxt; int ui = 0;
    if (!S.next(0, cur)) return;
    f32x4 acc[2][2][4][2];
#pragma unroll
    for (int a = 0; a < 2; ++a)
#pragma unroll
        for (int b = 0; b < 2; ++b)
#pragma unroll
            for (int m = 0; m < 4; ++m)
#pragma unroll
                for (int n = 0; n < 2; ++n) acc[a][b][m][n] = (f32x4){0.f, 0.f, 0.f, 0.f};
    bf16x8 At[4][2], B0[2][2], B1[2][2];
    const char* cA = a_base(g, cur); const char* cB = b_base(g, cur);
    if constexpr (SP2) {
        PG8_STAGE(PG8_SB(0, 0), cB, voffB); PG8_STAGE(PG8_SB(0, 1), cB + hstepB, voffB); PG8_STAGE(PG8_SA(0, 0), cA, voffA); PG8_STAGE(PG8_SA(0, 1), cA + hstepA, voffA);
        if (wr == 1) PG8_BAR;
        PG8_WAIT_V(2); PG8_BAR;
        PG8_STAGE(PG8_SB(1, 0), cB + kstepB, voffB); PG8_STAGE(PG8_SA(1, 0), cA + kstepA, voffA); PG8_STAGE(PG8_SB(1, 1), cB + hstepB + kstepB, voffB);
        PG8_WAIT_V(6); PG8_BAR;
    } else {
        PG8_STAGE(PG8_SB(0, 0), cB, voffB); PG8_STAGE(PG8_SA(0, 0), cA, voffA); PG8_STAGE(PG8_SB(0, 1), cB + hstepB, voffB); PG8_STAGE(PG8_SA(0, 1), cA + hstepA, voffA);
        if (wr == 1) PG8_BAR;
        PG8_WAIT_V(4); PG8_BAR;
        PG8_STAGE(PG8_SB(1, 0), cB + kstepB, voffB); PG8_STAGE(PG8_SA(1, 0), cA + kstepA, voffA); PG8_STAGE(PG8_SB(1, 1), cB + hstepB + kstepB, voffB);
        PG8_WAIT_V(6); PG8_BAR;
    }
    for (;;) {
        const bool has_next = S.next(ui + 1, nxt);
        const char* nA = has_next ? a_base(g, nxt) : cA; const char* nB = has_next ? b_base(g, nxt) : cB;
        unsigned long long tk0 = 0ull; if (tmode == 1) tk0 = __builtin_amdgcn_s_memrealtime(); if (tmode == 3) tk0 = (unsigned long long)clock64();
#pragma unroll 1
        for (int t = 0; t < nt; t += 2) {
            const bool last = (t == nt - 2);
            const char* a1 = cA + (size_t)(t + 1) * kstepA;
            const char* a2 = last ? nA : cA + (size_t)(t + 2) * kstepA; const char* b2 = last ? nB : cB + (size_t)(t + 2) * kstepB;
            const char* a3 = a2 + kstepA; const char* b3 = b2 + kstepB;
            if constexpr (SP2) {
            PG8_LDB(B0, 0, 0); PG8_LDB(B1, 0, 1); PG8_SCHED; PG8_LDA(At, 0, 0); PG8_STAGE(PG8_SA(1, 1), a1 + hstepA, voffA);
            PG8_WAIT_V(8); PG8_WAIT_L(0); PG8_BAR; PG8_MMA(0, 0, At, B0); PG8_MMA(0, 1, At, B1); PG8_BAR; PG8_SCHED;
            PG8_LDA(At, 0, 1); PG8_STAGE(PG8_SB(0, 0), b2, voffB); PG8_STAGE(PG8_SB(0, 1), b2 + hstepB, voffB); PG8_STAGE(PG8_SA(0, 0), a2, voffA);
            PG8_WAIT_V(8); PG8_WAIT_L(0); PG8_BAR; PG8_MMA(1, 0, At, B0); PG8_MMA(1, 1, At, B1); PG8_BAR; PG8_SCHED;
            PG8_LDB(B0, 1, 0); PG8_LDB(B1, 1, 1); PG8_SCHED; PG8_LDA(At, 1, 0); PG8_STAGE(PG8_SA(0, 1), a2 + hstepA, voffA);
            PG8_WAIT_V(8); PG8_WAIT_L(0); PG8_BAR; PG8_MMA(0, 0, At, B0); PG8_MMA(0, 1, At, B1); PG8_BAR; PG8_SCHED;
            PG8_LDA(At, 1, 1); PG8_STAGE(PG8_SB(1, 0), b3, voffB); PG8_STAGE(PG8_SB(1, 1), b3 + hstepB, voffB); PG8_STAGE(PG8_SA(1, 0), a3, voffA);
            PG8_WAIT_V(8); PG8_WAIT_L(0); PG8_BAR; PG8_MMA(1, 0, At, B0); PG8_MMA(1, 1, At, B1); PG8_BAR; PG8_SCHED;
            } else {
            PG8_LDB(B0, 0, 0); PG8_SCHED; PG8_LDA(At, 0, 0); PG8_STAGE(PG8_SA(1, 1), a1 + hstepA, voffA);
            PG8_WAIT_L(8); PG8_BAR; PG8_WAIT_L(0); PG8_MMA(0, 0, At, B0); PG8_BAR; PG8_SCHED;
            PG8_LDB(B1, 0, 1); PG8_STAGE(PG8_SB(0, 0), b2, voffB);
            PG8_BAR; PG8_WAIT_L(0); PG8_MMA(0, 1, At, B1); PG8_BAR;
            PG8_LDA(At, 0, 1); PG8_STAGE(PG8_SA(0, 0), a2, voffA);
            PG8_BAR; PG8_WAIT_L(0); PG8_MMA(1, 0, At, B0); PG8_BAR; PG8_SCHED;
            PG8_STAGE(PG8_SB(0, 1), b2 + hstepB, voffB);
            PG8_WAIT_V(6); PG8_BAR; PG8_MMA(1, 1, At, B1); PG8_BAR;
            PG8_LDB(B0, 1, 0); PG8_SCHED; PG8_LDA(At, 1, 0); PG8_STAGE(PG8_SA(0, 1), a2 + hstepA, voffA);
            PG8_WAIT_L(8); PG8_BAR; PG8_WAIT_L(0); PG8_MMA(0, 0, At, B0); PG8_BAR; PG8_SCHED;
            PG8_LDB(B1, 1, 1); PG8_STAGE(PG8_SB(1, 0), b3, voffB);
            PG8_BAR; PG8_WAIT_L(0); PG8_MMA(0, 1, At, B1); PG8_BAR;
            PG8_LDA(At, 1, 1); PG8_STAGE(PG8_SA(1, 0), a3, voffA);
            PG8_BAR; PG8_WAIT_L(0); PG8_MMA(1, 0, At, B0); PG8_BAR; PG8_SCHED;
            PG8_STAGE(PG8_SB(1, 1), b3 + hstepB, voffB);
            PG8_WAIT_V(6); PG8_BAR; PG8_MMA(1, 1, At, B1); PG8_BAR;
            }
        }
        if (tmode == 1) tacc += __builtin_amdgcn_s_memrealtime() - tk0;
        if (tmode == 3) tacc += ((unsigned long long)clock64() - tk0) / 24ull;
        if (tmode == 2) tk0 = __builtin_amdgcn_s_memrealtime();
        if constexpr (ALIGN_EPI) { if (wr == 0) PG8_BAR; }
        if constexpr (!Epi::AFTER_DRAIN) E(acc, cur, wr, wc, fr, fq);
        if (!has_next) { if (tmode == 2) tacc += __builtin_amdgcn_s_memrealtime() - tk0; break; }
#pragma unroll
        for (int a = 0; a < 2; ++a)
#pragma unroll
            for (int b = 0; b < 2; ++b)
#pragma unroll
                for (int m = 0; m < 4; ++m)
#pragma unroll
                    for (int n = 0; n < 2; ++n) acc[a][b][m][n] = (f32x4){0.f, 0.f, 0.f, 0.f};
        cur = nxt; cA = nA; cB = nB; ++ui;
        if constexpr (ALIGN_EPI) { if (wr == 1) PG8_BAR; }
        if (tmode == 2) tacc += __builtin_amdgcn_s_memrealtime() - tk0;
    }
    PG8_WAIT_V(0);
    if constexpr (!ALIGN_EPI) { if (wr == 0) PG8_BAR; }
    PG8_BAR;
    if constexpr (Epi::AFTER_DRAIN) E.fused(acc, cur, wr, wc, fr, fq, lds, wid, lane);
#undef PG8_SA
#undef PG8_SB
#undef PG8_STAGE
#undef PG8_LDA
#undef PG8_LDB
#undef PG8_MMA
#undef PG8_WAIT_V
#undef PG8_WAIT_L
#undef PG8_BAR
#undef PG8_SCHED
}

typedef f32x4 AccT[2][2][4][2];
template <bool F32OUT> struct EpiResidLn {
    static constexpr bool PERM = true, AFTER_DRAIN = true;
    const bf16* XinB; float* XoutF; bf16* XBout; const float* g; const float* b; float alpha;
    unsigned long long* xbuf; unsigned* cnt; unsigned want; unsigned* tmo;
    __device__ __forceinline__ void operator()(const AccT&, const Unit&, int, int, int, int) const {}
    __device__ __forceinline__ void fused(AccT& acc, const Unit& u, int wr, int wc, int fr_in, int fq_in, LAS unsigned char* lds, int wid, int lane_in) const {
        int fr = fr_in, fq = fq_in, lane = lane_in; asm volatile("" : "+v"(fr), "+v"(fq), "+v"(lane));
        LAS f32x2* P = (LAS f32x2*)lds;
        LAS f32x2* S = (LAS f32x2*)(lds + 8192);
        const int col0 = u.pn * BM + wc * 32 + 8 * fq;
        {
            u32x4 xr[2][4][2];
#pragma unroll
            for (int ai = 0; ai < 2; ++ai)
#pragma unroll
                for (int m = 0; m < 4; ++m) { const int rowi = u.pm * BM + ai * HALF + wr * 64 + m * 16 + fr;
#pragma unroll
                    for (int bj = 0; bj < 2; ++bj) xr[ai][m][bj] = *(const u32x4*)((const char*)XinB + blk_off(rowi, col0 + bj * HALF, D, false)); }
#pragma unroll
            for (int ai = 0; ai < 2; ++ai)
#pragma unroll
                for (int m = 0; m < 4; ++m)
#pragma unroll
                    for (int bj = 0; bj < 2; ++bj) { const u32x4 w = xr[ai][m][bj];
                        acc[ai][bj][m][0] += (f32x4){bflo(w.x), bfhi(w.x), bflo(w.y), bfhi(w.y)} * alpha; acc[ai][bj][m][1] += (f32x4){bflo(w.z), bfhi(w.z), bflo(w.w), bfhi(w.w)} * alpha;
                        asm volatile("" : "+v"(acc[ai][bj][m][0]), "+v"(acc[ai][bj][m][1])); }
            asm volatile("" ::: "memory");
        }
#pragma unroll
        for (int ai = 0; ai < 2; ++ai)
#pragma unroll
            for (int m = 0; m < 4; ++m) {
                float s = 0.f;
#pragma unroll
                for (int bj = 0; bj < 2; ++bj)
#pragma unroll
                    for (int n = 0; n < 2; ++n) { const f32x4 x = acc[ai][bj][m][n]; s += (x[0] + x[1]) + (x[2] + x[3]); }
                s += shfl_lane(s, lane ^ 16); s += shfl_lane(s, lane ^ 32);
                const float mw = s * (1.0f / 64.0f); float q = 0.f;
#pragma unroll
                for (int bj = 0; bj < 2; ++bj)
#pragma unroll
                    for (int n = 0; n < 2; ++n) { const f32x4 d = acc[ai][bj][m][n] - mw; q += (d[0] * d[0] + d[1] * d[1]) + (d[2] * d[2] + d[3] * d[3]); }
                q += shfl_lane(q, lane ^ 16); q += shfl_lane(q, lane ^ 32);
                if (fq == 0) P[(ai * HALF + wr * 64 + m * 16 + fr) * 4 + wc] = (f32x2){mw, q};
            }
        const int col5 = u.pn * BM + wc * 32 + 8 * fq;
        f32x4 gg[2][2], bv[2][2];
#pragma unroll
        for (int bj = 0; bj < 2; ++bj)
#pragma unroll
            for (int n = 0; n < 2; ++n) { gg[bj][n] = *(const f32x4*)(g + col5 + bj * HALF + n * 4); bv[bj][n] = *(const f32x4*)(b + col5 + bj * HALF + n * 4); }
        asm volatile("s_waitcnt lgkmcnt(0)" ::: "memory"); __builtin_amdgcn_s_barrier(); asm volatile("" ::: "memory");
        const int row = wid * 32 + (lane & 31);
        if (lane < 32) {
            const f32x2 a = P[row * 4 + 0], bb = P[row * 4 + 1], c = P[row * 4 + 2], d = P[row * 4 + 3];
            const float mt = (a.x + bb.x + c.x + d.x) * 0.25f;
            const float da = a.x - mt, db = bb.x - mt, dc = c.x - mt, dd = d.x - mt;
            const float m2 = (a.y + bb.y) + (c.y + d.y) + 64.0f * ((da * da + db * db) + (dc * dc + dd * dd));
            unsigned long long* slot = xbuf + ((size_t)(u.pm * BM + row) * 8 + u.pn);
            __hip_atomic_store(slot, ((unsigned long long)__float_as_uint(m2) << 32) | __float_as_uint(mt), __ATOMIC_RELAXED, __HIP_MEMORY_SCOPE_AGENT);
        }
        asm volatile("s_waitcnt vmcnt(0)" ::: "memory");
        if (lane == 0) __hip_atomic_fetch_add(cnt + 64 * u.pm, 1u, __ATOMIC_RELAXED, __HIP_MEMORY_SCOPE_AGENT);
        if (wid == 0) {
            unsigned sp = 0;
            while ((unsigned)__builtin_amdgcn_readfirstlane(__hip_atomic_load(cnt + 64 * u.pm, __ATOMIC_RELAXED, __HIP_MEMORY_SCOPE_AGENT)) < want) {
                __builtin_amdgcn_s_sleep(1);
                if ((++sp & 1023u) == 0u) { if (__builtin_amdgcn_readfirstlane(__hip_atomic_load(tmo, __ATOMIC_RELAXED, __HIP_MEMORY_SCOPE_AGENT)) != 0u) break;
                    if (sp > (1u << 22)) { if (lane == 0) __hip_atomic_store(tmo, 1u, __ATOMIC_RELAXED, __HIP_MEMORY_SCOPE_AGENT); break; } } }
            __builtin_amdgcn_fence(__ATOMIC_ACQUIRE, "agent");
        }
        asm volatile("s_waitcnt vmcnt(0) lgkmcnt(0)" ::: "memory"); __builtin_amdgcn_s_barrier(); asm volatile("" ::: "memory");
        if (lane < 32) {
            const unsigned long long* slot = xbuf + (size_t)(u.pm * BM + row) * 8; float mt[8], m2[8]; float ms = 0.f;
#pragma unroll
            for (int t = 0; t < 8; ++t) { const unsigned long long w = __hip_atomic_load(slot + t, __ATOMIC_RELAXED, __HIP_MEMORY_SCOPE_AGENT); mt[t] = __uint_as_float((unsigned)w); m2[t] = __uint_as_float((unsigned)(w >> 32)); ms += mt[t]; }
            const float mean = ms * 0.125f; float q = 0.f;
#pragma unroll
            for (int t = 0; t < 8; ++t) { const float dm = mt[t] - mean; q += m2[t] + 256.0f * dm * dm; }
            S[row] = (f32x2){mean, rsqrtf(q * (1.0f / 2048.0f) + LN_EPS)};
        }
        asm volatile("s_waitcnt lgkmcnt(0)" ::: "memory"); __builtin_amdgcn_s_barrier(); asm volatile("" ::: "memory");
#pragma unroll
        for (int ai = 0; ai < 2; ++ai)
#pragma unroll
            for (int m = 0; m < 4; ++m) { const int r = ai * HALF + wr * 64 + m * 16 + fr; const f32x2 sr = S[r]; const size_t off = (size_t)(u.pm * BM + r) * D + col5;
#pragma unroll
                for (int bj = 0; bj < 2; ++bj) { const f32x4 o0 = (acc[ai][bj][m][0] - sr.x) * sr.y * gg[bj][0] + bv[bj][0], o1 = (acc[ai][bj][m][1] - sr.x) * sr.y * gg[bj][1] + bv[bj][1];
                    if constexpr (F32OUT) { *(f32x4*)(XoutF + off + bj * HALF) = o0; *(f32x4*)(XoutF + off + bj * HALF + 4) = o1; }
                    else { u32x4 w; w.x = pk2(o0[0], o0[1]); w.y = pk2(o0[2], o0[3]); w.z = pk2(o1[0], o1[1]); w.w = pk2(o1[2], o1[3]); *(u32x4*)((char*)XBout + blk_off(u.pm * BM + r, col5 + bj * HALF, D, false)) = w; } }
                asm volatile("" ::: "memory"); }
    }
};
struct EpiRelu2 {
    static constexpr bool PERM = true, AFTER_DRAIN = false;
    bf16* O; int Kd;
    __device__ __forceinline__ void operator()(const AccT& acc, const Unit& u, int wr, int wc, int fr_in, int fq_in) const {
        int fr = fr_in, fq = fq_in; asm volatile("" : "+v"(fr), "+v"(fq));
        const int row0 = u.pm * BM + wr * 64 + fr, col0 = u.pn * BM + wc * 32 + 8 * fq;
#pragma unroll
        for (int ai = 0; ai < 2; ++ai)
#pragma unroll
            for (int m = 0; m < 4; ++m) { const int row = row0 + ai * HALF + m * 16;
#pragma unroll
                for (int bj = 0; bj < 2; ++bj) { f32x4 v0 = acc[ai][bj][m][0], v1 = acc[ai][bj][m][1];
#pragma unroll
                    for (int j = 0; j < 4; ++j) { const float a = fmaxf(v0[j], 0.f), b = fmaxf(v1[j], 0.f); v0[j] = a * a; v1[j] = b * b; }
                    u32x4 w; w.x = pk2(v0[0], v0[1]); w.y = pk2(v0[2], v0[3]); w.z = pk2(v1[0], v1[1]); w.w = pk2(v1[2], v1[3]);
                    *(u32x4*)((char*)O + blk_off(row, col0 + bj * HALF, Kd, false)) = w; } }
    }
};
struct EpiRgIn {
    static constexpr bool PERM = true, AFTER_DRAIN = false;
    bf16* GATE; bf16* URAW;
    __device__ __forceinline__ void operator()(const AccT& acc, const Unit& u, int wr, int wc, int fr_in, int fq_in) const {
        int fr = fr_in, fq = fq_in; asm volatile("" : "+v"(fr), "+v"(fq));
        const bool isg = u.pn < 8; bf16* base = isg ? GATE : URAW;
        const int row0 = u.pm * BM + wr * 64 + fr, col0 = (u.pn & 7) * BM + wc * 32 + 8 * fq;
#pragma unroll
        for (int ai = 0; ai < 2; ++ai)
#pragma unroll
            for (int m = 0; m < 4; ++m) { bf16* rowp = base + (size_t)(row0 + ai * HALF + m * 16) * D + col0;
#pragma unroll
                for (int bj = 0; bj < 2; ++bj) { f32x4 v0 = acc[ai][bj][m][0], v1 = acc[ai][bj][m][1];
                    if (isg) {
#pragma unroll
                        for (int j = 0; j < 4; ++j) { v0[j] = gelu_tanh_(v0[j]); v1[j] = gelu_tanh_(v1[j]); } }
                    u32x4 w; w.x = pk2(v0[0], v0[1]); w.y = pk2(v0[2], v0[3]); w.z = pk2(v1[0], v1[1]); w.w = pk2(v1[2], v1[3]);
                    *(u32x4*)(rowp + bj * HALF) = w; } }
    }
};
struct EpiSsdIn {
    static constexpr bool PERM = true, AFTER_DRAIN = false;
    bf16* ZS; bf16* XBCR;
    __device__ __forceinline__ void operator()(const AccT& acc, const Unit& u, int wr, int wc, int fr_in, int fq_in) const {
        int fr = fr_in, fq = fq_in; asm volatile("" : "+v"(fr), "+v"(fq));
        const int row0 = u.pm * BM + wr * 64 + fr, cw = wc * 32 + 8 * fq;
        const bool isz = u.pn < 16; bf16* base = isz ? ZS + (size_t)u.pn * BM : XBCR + (size_t)(u.pn - 16) * BM; const int ldc = isz ? SSD_DI : SSD_XBC;
#pragma unroll
        for (int ai = 0; ai < 2; ++ai)
#pragma unroll
            for (int m = 0; m < 4; ++m) { bf16* rowp = base + (size_t)(row0 + ai * HALF + m * 16) * ldc + cw;
#pragma unroll
                for (int bj = 0; bj < 2; ++bj) { f32x4 v0 = acc[ai][bj][m][0], v1 = acc[ai][bj][m][1];
                    if (isz) {
#pragma unroll
                        for (int j = 0; j < 4; ++j) { v0[j] = siluf_(v0[j]); v1[j] = siluf_(v1[j]); } }
                    u32x4 w; w.x = pk2(v0[0], v0[1]); w.y = pk2(v0[2], v0[3]); w.z = pk2(v1[0], v1[1]); w.w = pk2(v1[2], v1[3]);
                    *(u32x4*)(rowp + bj * HALF) = w; } }
    }
};
struct EpiQkv {
    static constexpr bool PERM = true, AFTER_DRAIN = false;
    bf16* Q; const float* bias;
    __device__ __forceinline__ void operator()(const AccT& acc, const Unit& u, int wr, int wc, int fr_in, int fq_in) const {
        int fr = fr_in, fq = fq_in; asm volatile("" : "+v"(fr), "+v"(fq));
        const int t = u.pn >> 3; bf16* base = Q + (size_t)t * TG * D; const float sc = t == 0 ? 0.08838834764831845f : 1.0f;
        const int row0 = u.pm * BM + wr * 64 + fr, col0 = (u.pn & 7) * BM + wc * 32 + 8 * fq, bcol0 = u.pn * BM + wc * 32 + 8 * fq;
#pragma unroll
        for (int bj = 0; bj < 2; ++bj) {
            const f32x4 bv0 = *(const f32x4*)(bias + bcol0 + bj * HALF), bv1 = *(const f32x4*)(bias + bcol0 + bj * HALF + 4);
#pragma unroll
            for (int ai = 0; ai < 2; ++ai)
#pragma unroll
                for (int m = 0; m < 4; ++m) { bf16* rowp = base + (size_t)(row0 + ai * HALF + m * 16) * D + col0;
                    const f32x4 v0 = (acc[ai][bj][m][0] + bv0) * sc, v1 = (acc[ai][bj][m][1] + bv1) * sc;
                    u32x4 w; w.x = pk2(v0[0], v0[1]); w.y = pk2(v0[2], v0[3]); w.z = pk2(v1[0], v1[1]); w.w = pk2(v1[2], v1[3]);
                    *(u32x4*)(rowp + bj * HALF) = w; }
            asm volatile("" ::: "memory");
        }
    }
};
}

struct Frame {
    LAS unsigned char* lds;
    int tid, lane, wave, G, gw, ngw;
};

__device__ __forceinline__ Frame phase_frame(const Frame& F0) {
    Frame F = F0; int t = threadIdx.x; asm volatile("" : "+v"(t));
    F.tid = t; F.lane = t & 63; F.wave = __builtin_amdgcn_readfirstlane(t >> 6); F.gw = F.wave * F0.G + (int)blockIdx.x; return F;
}
template <int FRAG16 = 0>
__device__ __forceinline__ void transpose_item(const float* W, int ldw, bf16* WT, int ldt, int k0, int n0, int drow0, LAS float* scr, int lane) {
#pragma unroll
    for (int i = 0; i < 16; ++i) { const int kk = 4 * i + (lane >> 4), c2 = 2 * (lane & 15); const f32x2 v = *(const f32x2*)(W + (size_t)(k0 + kk) * ldw + n0 + c2); scr[kk * 33 + c2] = v.x; scr[kk * 33 + c2 + 1] = v.y; }
    LDS_WAIT(); asm volatile("" ::: "memory");
    const int c = lane & 7;
#pragma unroll
    for (int j = 0; j < 4; ++j) { const int n = (lane >> 3) + 8 * j; const LAS float* s = scr + (8 * c) * 33 + n;
        u32x4 o; o.x = pk2(s[0 * 33], s[1 * 33]); o.y = pk2(s[2 * 33], s[3 * 33]); o.z = pk2(s[4 * 33], s[5 * 33]); o.w = pk2(s[6 * 33], s[7 * 33]);
        if constexpr (FRAG16 == 2) { *(GAS u32x4*)((GAS char*)WT + pg8::blk_off(drow0 + n, k0 + 8 * c, ldt, true)) = o; }
        else if constexpr (FRAG16 == 1) { const int r = drow0 + n, k = k0 + 8 * c;
            *(GAS u32x4*)(WT + (((r >> 4) * 8 + (k >> 5)) * 64 + (r & 15) + 16 * ((k >> 3) & 3)) * 8) = o; }
        else *(GAS u32x4*)(WT + (size_t)(drow0 + n) * ldt + k0 + 8 * c) = o; }
    LDS_WAIT(); asm volatile("" ::: "memory");
}
__device__ __forceinline__ void conv_matrix(const Frame& F, const float* W, int K, int N, bf16* WT, LAS float* scr, int nblocked = 1 << 30) {
    const int nblk = N / 32, nitems = (K / 64) * nblk;
    for (int it = F.gw; it < nitems; it += F.ngw) { const int kb = it / nblk, nb = it % nblk;
        if (32 * nb < nblocked) transpose_item<2>(W, N, WT, K, 64 * kb, 32 * nb, 32 * nb, scr, F.lane); else transpose_item<0>(W, N, WT, K, 64 * kb, 32 * nb, 32 * nb, scr, F.lane); }
}
__device__ __forceinline__ void p_prologue(const Frame& F0, const float* const* in, bf16* Wb, float* spt, bf16* XB0) {
    const Frame F = phase_frame(F0);
    { const int nsub = (NGROUP * TG / 16) * (D / 32);
      for (int s0 = F.gw; s0 < nsub; s0 += 4 * F.ngw) {
          f32x4 v0[4], v1[4];
#pragma unroll
          for (int q = 0; q < 4; ++q) { const int sidx = s0 + q * F.ngw, rb = sidx / (D / 32), cbk = sidx % (D / 32), row = rb * 16 + (F.lane >> 2), col = cbk * 32 + (F.lane & 3) * 8;
              const float* srow = row < 2 * TG ? in[0] + (size_t)row * D : in[1] + (size_t)(row - 2 * TG) * D;
              v0[q] = *(const f32x4*)(srow + col); v1[q] = *(const f32x4*)(srow + col + 4); }
#pragma unroll
          for (int q = 0; q < 4; ++q) { const int sidx = s0 + q * F.ngw, rb = sidx / (D / 32), cbk = sidx % (D / 32), row = rb * 16 + (F.lane >> 2), col = cbk * 32 + (F.lane & 3) * 8;
              u32x4 w; w.x = pk2(v0[q].x, v0[q].y); w.y = pk2(v0[q].z, v0[q].w); w.z = pk2(v1[q].x, v1[q].y); w.w = pk2(v1[q].z, v1[q].w);
              *(u32x4*)((char*)(XB0 + (size_t)(row >> 13) * TG * D) + pg8::blk_off(row & (TG - 1), col, D, false)) = w; } } }
    LAS float* scr = (LAS float*)(F.lds + F.wave * 16384);
    for (int l = 0; l < 2; ++l) {
        conv_matrix(F, in[2] + (size_t)l * 2048 * 4096, 2048, 4096, Wb + W_RGIN + (size_t)l * 4096 * 2048, scr);
        conv_matrix(F, in[10] + (size_t)l * 2048 * 2048, 2048, 2048, Wb + W_RGOUT + (size_t)l * 2048 * 2048, scr);
    }
    for (int it = F.gw; it < 2 * 2 * 16 * 32; it += F.ngw) {
        const int sub = it & 31, mat = it >> 5;
        const int dn = mat & 15, ax = (mat >> 4) & 1, l = mat >> 5;
        const int kb = sub >> 3, nb = sub & 7, j0 = 32 * nb;
        const float* W = in[ax ? 7 : 5] + ((size_t)(l * 16 + dn)) * 65536;
        bf16* WT = Wb + W_RGGATE + (size_t)l * 32 * 65536 + (size_t)(dn * 2 + (j0 >> 7)) * 65536;
        transpose_item<1>(W, 256, WT, 256, 64 * kb, j0, (j0 & 127) + 128 * ax, scr, F.lane);
    }
    for (int i = F.gw * 64 + F.lane; i < 2 * 2 * 2048; i += F.ngw * 64) spt[i] = -8.0f * softplusf_(-in[9][i]);
    conv_matrix(F, in[11], 2048, SSD_NIN, Wb + W_SSDIN, scr, 10240);
    { u32x4* z = (u32x4*)(Wb + W_SSDIN + (size_t)SSD_NIN * 2048); const int n16 = (SSD_NIN_PAD - SSD_NIN) * 2048 / 8;
      for (int i = F.gw * 64 + F.lane; i < n16; i += F.ngw * 64) z[i] = (u32x4){0u, 0u, 0u, 0u}; }
    conv_matrix(F, in[18], 4096, 2048, Wb + W_SSDOUT, scr);
    conv_matrix(F, in[19], 2048, 6144, Wb + W_NAQKV, scr);
    conv_matrix(F, in[22], 2048, 2048, Wb + W_NAOUT, scr);
    for (int l = 0; l < 4; ++l) {
        conv_matrix(F, in[23] + (size_t)l * 2048 * 8192, 2048, 8192, Wb + W_UP + (size_t)l * 8192 * 2048, scr);
        conv_matrix(F, in[24] + (size_t)l * 8192 * 2048, 8192, 2048, Wb + W_DOWN + (size_t)l * 2048 * 8192, scr);
    }
}

__device__ __forceinline__ void p_conv_ssd(const Frame& F0, const bf16* in, int L, const float* cw, const float* cb, bf16* XT, bf16* BMo, bf16* CMo) {
    const Frame F = phase_frame(F0);
    constexpr int C = SSD_XBC, NCB = C / 512, TP = 144;
    LAS unsigned char* tile = F.lds;
    const int co = F.tid & 63, tr = F.tid >> 6;
    for (int it = blockIdx.x; it < NCB * (TG / 64); it += F.G) {
        const int cbk = it % NCB, tb = it / NCB, t0 = tb * 64, c0 = cbk * 512 + co * 8, r0 = t0 + 8 * tr, rl = r0 % L;
        float w[4][8], bias[8];
#pragma unroll
        for (int k = 0; k < 4; ++k) { const f32x4 a = *(const f32x4*)(cw + (size_t)k * C + c0), b = *(const f32x4*)(cw + (size_t)k * C + c0 + 4);
            w[k][0] = a.x; w[k][1] = a.y; w[k][2] = a.z; w[k][3] = a.w; w[k][4] = b.x; w[k][5] = b.y; w[k][6] = b.z; w[k][7] = b.w; }
        { const f32x4 a = *(const f32x4*)(cb + c0), b = *(const f32x4*)(cb + c0 + 4); bias[0] = a.x; bias[1] = a.y; bias[2] = a.z; bias[3] = a.w; bias[4] = b.x; bias[5] = b.y; bias[6] = b.z; bias[7] = b.w; }
        u32x4 rows[11];
#pragma unroll
        for (int i = 0; i < 11; ++i) { const int tt = rl - 1 + i; const bool ok = (tt >= 0) && (tt < L);
            rows[i] = ok ? *(const u32x4*)(in + (size_t)(r0 - 1 + i) * C + c0) : (u32x4){0u, 0u, 0u, 0u}; }
        unsigned outw[8][4];
#pragma unroll
        for (int i = 0; i < 8; ++i) {
            float y[8];
#pragma unroll
            for (int j = 0; j < 8; ++j) y[j] = bias[j];
#pragma unroll
            for (int k = 0; k < 4; ++k) { const u32x4 r = rows[i + k];
                y[0] += w[k][0] * bflo(r.x); y[1] += w[k][1] * bfhi(r.x); y[2] += w[k][2] * bflo(r.y); y[3] += w[k][3] * bfhi(r.y);
                y[4] += w[k][4] * bflo(r.z); y[5] += w[k][5] * bfhi(r.z); y[6] += w[k][6] * bflo(r.w); y[7] += w[k][7] * bfhi(r.w); }
#pragma unroll
            for (int j = 0; j < 8; ++j) y[j] = siluf_(y[j]);
            outw[i][0] = pk2(y[0], y[1]); outw[i][1] = pk2(y[2], y[3]); outw[i][2] = pk2(y[4], y[5]); outw[i][3] = pk2(y[6], y[7]);
        }
        if (cbk >= 8) {
            bf16* ob = cbk < 10 ? BMo : CMo; const int cc = cbk < 10 ? c0 - 4096 : c0 - 5120;
#pragma unroll
            for (int i = 0; i < 8; ++i) *(u32x4*)(ob + (size_t)(r0 + i) * 1024 + cc) = (u32x4){outw[i][0], outw[i][1], outw[i][2], outw[i][3]};
        } else {
#pragma unroll
            for (int j = 0; j < 8; ++j) {
                unsigned e[4];
#pragma unroll
                for (int q = 0; q < 4; ++q) { const unsigned a = outw[2 * q][j >> 1], b = outw[2 * q + 1][j >> 1];
                    e[q] = (j & 1) ? ((a >> 16) | (b & 0xffff0000u)) : ((a & 0xffffu) | (b << 16)); }
                *(LAS u32x4*)(tile + (co * 8 + j) * TP + tr * 16) = (u32x4){e[0], e[1], e[2], e[3]};
            }
            __syncthreads();
            const int chunk = t0 >> 7, s0 = t0 & 127;
#pragma unroll
            for (int i = 0; i < 8; ++i) { const int idx = F.tid + 512 * i, piece = idx >> 9, row = idx & 511, c = cbk * 512 + row, p = c & 63, s = s0 + 8 * piece;
                *(u32x4*)(XT + (size_t)(chunk * 64 + (c >> 6)) * 8192 + (((s >> 4) * 2 + (p >> 5)) * 64 + (p & 31) + 32 * ((s >> 3) & 1)) * 8) = *(const LAS u32x4*)(tile + row * TP + piece * 16); }
            __syncthreads();
        }
    }
}

constexpr int RGF_PITCH = 528;
__device__ __forceinline__ void p_rg_fused(const Frame& F0, const bf16* URAW, int L, const float* cw, const float* cbias, const bf16* Wg, const float* ba, const float* bx, const float* spt,
                                           bf16* LA, bf16* INP, float* HEND, float* PROD) {
    const Frame F = phase_frame(F0);
    LAS unsigned char* ut = F.lds;
    for (int it = blockIdx.x; it < 64 * 8; it += F.G) {
        const int nb = it & 7, run = it >> 3, t0 = run * 128;
        { const int co = F.tid & 31, tq = F.tid >> 5, c0 = nb * 256 + co * 8, tb = t0 + 8 * tq, tl = tb % L;
          float w[4][8], bias[8];
#pragma unroll
          for (int k = 0; k < 4; ++k) { const f32x4 a = *(const f32x4*)(cw + (size_t)k * D + c0), b = *(const f32x4*)(cw + (size_t)k * D + c0 + 4);
              w[k][0] = a.x; w[k][1] = a.y; w[k][2] = a.z; w[k][3] = a.w; w[k][4] = b.x; w[k][5] = b.y; w[k][6] = b.z; w[k][7] = b.w; }
          { const f32x4 a = *(const f32x4*)(cbias + c0), b = *(const f32x4*)(cbias + c0 + 4); bias[0] = a.x; bias[1] = a.y; bias[2] = a.z; bias[3] = a.w; bias[4] = b.x; bias[5] = b.y; bias[6] = b.z; bias[7] = b.w; }
          u32x4 rows[11];
#pragma unroll
          for (int i = 0; i < 11; ++i) { const int tt = tl - 1 + i; const bool ok = (tt >= 0) && (tt < L);
              rows[i] = ok ? *(const u32x4*)(URAW + (size_t)(tb - 1 + i) * D + c0) : (u32x4){0u, 0u, 0u, 0u}; }
#pragma unroll
          for (int i = 0; i < 8; ++i) {
              float y[8];
#pragma unroll
              for (int j = 0; j < 8; ++j) y[j] = bias[j];
#pragma unroll
              for (int k = 0; k < 4; ++k) { const u32x4 r = rows[i + k];
                  y[0] += w[k][0] * bflo(r.x); y[1] += w[k][1] * bfhi(r.x); y[2] += w[k][2] * bflo(r.y); y[3] += w[k][3] * bfhi(r.y);
                  y[4] += w[k][4] * bflo(r.z); y[5] += w[k][5] * bfhi(r.z); y[6] += w[k][6] * bflo(r.w); y[7] += w[k][7] * bfhi(r.w); }
              *(LAS u32x4*)(ut + (8 * tq + i) * RGF_PITCH + co * 16) = (u32x4){pk2(y[0], y[1]), pk2(y[2], y[3]), pk2(y[4], y[5]), pk2(y[6], y[7])};
          } }
        __syncthreads();
#pragma unroll 1
        for (int d = 0; d < 2; ++d) {
            int Lq = F.lane; asm volatile("" : "+v"(Lq));
            const int g = Lq >> 4, l15 = Lq & 15, w8 = F.wave;
            f32x4 acc[8][4];
#pragma unroll
            for (int m = 0; m < 8; ++m)
#pragma unroll
                for (int n = 0; n < 4; ++n) acc[m][n] = (f32x4){0.f, 0.f, 0.f, 0.f};
            const bf16* wtile = Wg + (size_t)((d * 8 + nb) * 2 + (w8 >> 2)) * 65536 + Lq * 8;
            bf16x8 bq[3][4];
#pragma unroll
            for (int q = 0; q < 3; ++q)
#pragma unroll
                for (int n = 0; n < 4; ++n) bq[q][n] = *(const bf16x8*)(wtile + ((((w8 & 3) * 2 + (n & 1) + (n >> 1) * 8) * 8 + q) * 512));
#pragma unroll 1
            for (int ks = 0; ks < 8; ++ks) {
                bf16x8 bn[4];
#pragma unroll
                for (int n = 0; n < 4; ++n) bn[n] = *(const bf16x8*)(wtile + ((((w8 & 3) * 2 + (n & 1) + (n >> 1) * 8) * 8 + ((ks + 3) & 7)) * 512));
#pragma unroll
                for (int m = 0; m < 8; ++m) { const bf16x8 a = *(const LAS bf16x8*)(ut + (16 * m + l15) * RGF_PITCH + (32 * ks + 8 * g) * 2);
#pragma unroll
                    for (int n = 0; n < 4; ++n) acc[m][n] = __builtin_amdgcn_mfma_f32_16x16x32_bf16(a, bq[0][n], acc[m][n], 0, 0, 0); }
#pragma unroll
                for (int n = 0; n < 4; ++n) { bq[0][n] = bq[1][n]; bq[1][n] = bq[2][n]; bq[2][n] = bn[n]; }
            }
            bf16* la = LA + (size_t)d * TG * D + (size_t)t0 * D + nb * 256; bf16* in = INP + (size_t)d * TG * D + (size_t)t0 * D + nb * 256;
#pragma unroll
            for (int np = 0; np < 2; ++np) {
                const int cl = 32 * w8 + 16 * np + l15, c = nb * 256 + cl;
                const float pba = ba[d * D + c], pbx = bx[d * D + c], psp = spt[d * D + c];
                float Lm[8], Hm[8];
#pragma unroll
                for (int m = 0; m < 8; ++m) {
                    float lr[4], xr[4], ea[4]; unsigned lwv[4], xwv[4];
                    int gq = g; asm volatile("" : "+v"(gq));
                    {
                        f32x4 u4;
#pragma unroll
                        for (int e = 0; e < 4; ++e) u4[e] = bf2f(*(const LAS bf16*)(ut + (16 * m + 4 * gq + e) * RGF_PITCH + cl * 2));
                        const f32x4 na = -(acc[m][np] + pba), nb2 = -(acc[m][2 + np] + pbx); f32x4 e1, e2;
#pragma unroll
                        for (int e = 0; e < 4; ++e) { e1[e] = __expf(fminf(na[e], 80.f)); e2[e] = __expf(fminf(nb2[e], 80.f)); }
                        const f32x4 d1 = e1 + 1.0f, d2 = e2 + 1.0f, dp = d1 * d2; f32x4 rc;
#pragma unroll
                        for (int e = 0; e < 4; ++e) rc[e] = frcp_(dp[e]);
                        const f32x4 l4 = (d2 * rc) * psp, ig = d1 * rc;
                        const unsigned lw01 = pk2(l4[0], l4[1]), lw23 = pk2(l4[2], l4[3]);
                        lr[0] = bflo(lw01); lr[1] = bfhi(lw01); lr[2] = bflo(lw23); lr[3] = bfhi(lw23);
                        f32x4 ea4, sq;
#pragma unroll
                        for (int e = 0; e < 4; ++e) { ea4[e] = __expf(lr[e]); ea[e] = ea4[e]; }
                        const f32x4 om = 1.0f - ea4 * ea4;
#pragma unroll
                        for (int e = 0; e < 4; ++e) sq[e] = fsqrt_(fmaxf(om[e], 0.f));
                        const f32x4 x4 = sq * ig * u4;
                        const unsigned xw01 = pk2(x4[0], x4[1]), xw23 = pk2(x4[2], x4[3]);
                        xr[0] = bflo(xw01); xr[1] = bfhi(xw01); xr[2] = bflo(xw23); xr[3] = bfhi(xw23);
                        lwv[0] = lw01 & 0xffffu; lwv[1] = lw01 >> 16; lwv[2] = lw23 & 0xffffu; lwv[3] = lw23 >> 16;
                        xwv[0] = xw01 & 0xffffu; xwv[1] = xw01 >> 16; xwv[2] = xw23 & 0xffffu; xwv[3] = xw23 >> 16; }
#pragma unroll
                    for (int ep = 0; ep < 2; ++ep) { const bool odd = (Lq & 1) != 0; const int tok = 16 * m + 4 * gq + 2 * ep + (odd ? 1 : 0);
                        const unsigned sl = odd ? lwv[2 * ep] : lwv[2 * ep + 1], sx = odd ? xwv[2 * ep] : xwv[2 * ep + 1];
                        const unsigned rl = (unsigned)__builtin_amdgcn_update_dpp(0, (int)sl, 0xB1, 0xf, 0xf, true), rx = (unsigned)__builtin_amdgcn_update_dpp(0, (int)sx, 0xB1, 0xf, 0xf, true);
                        const unsigned wl = odd ? (rl | (lwv[2 * ep + 1] << 16)) : (lwv[2 * ep] | (rl << 16)), wx = odd ? (rx | (xwv[2 * ep + 1] << 16)) : (xwv[2 * ep] | (rx << 16));
                        const int c2 = cl & ~1;
                        *(unsigned*)(la + (size_t)tok * D + c2) = wl; *(unsigned*)(in + (size_t)tok * D + c2) = wx; }
                    const float Hf = ((xr[0] * ea[1] + xr[1]) * ea[2] + xr[2]) * ea[3] + xr[3], Hb = ((xr[3] * ea[2] + xr[2]) * ea[1] + xr[1]) * ea[0] + xr[0];
                    float Ls = (lr[0] + lr[1]) + (lr[2] + lr[3]), Hs = d ? Hb : Hf;
#pragma unroll
                    for (int st = 0; st < 2; ++st) { const int bit = st ? 2 : 1; const int pl = Lq ^ (st ? 32 : 16);
                        const float Lp = shfl_lane(Ls, pl), Hp = shfl_lane(Hs, pl);
                        const bool mine_first = (((g & bit) == 0) != (d != 0));
                        Hs = mine_first ? Hs * __expf(Lp) + Hp : Hp * __expf(Ls) + Hs; Ls += Lp; }
                    Lm[m] = Ls; Hm[m] = Hs;
                }
                float Lc[2], Hc[2];
#pragma unroll
                for (int ch = 0; ch < 2; ++ch) {
                    if (d == 0) { float H = Hm[4 * ch]; H = H * __expf(Lm[4 * ch + 1]) + Hm[4 * ch + 1]; H = H * __expf(Lm[4 * ch + 2]) + Hm[4 * ch + 2]; H = H * __expf(Lm[4 * ch + 3]) + Hm[4 * ch + 3]; Hc[ch] = H; }
                    else        { float H = Hm[4 * ch + 3]; H = H * __expf(Lm[4 * ch + 2]) + Hm[4 * ch + 2]; H = H * __expf(Lm[4 * ch + 1]) + Hm[4 * ch + 1]; H = H * __expf(Lm[4 * ch]) + Hm[4 * ch]; Hc[ch] = H; }
                    Lc[ch] = (Lm[4 * ch] + Lm[4 * ch + 1]) + (Lm[4 * ch + 2] + Lm[4 * ch + 3]);
                }
                if (g == 0) {
#pragma unroll
                    for (int ch = 0; ch < 2; ++ch) { const size_t o = ((size_t)(run * 2 + ch) * 2 + d) * D + c; HEND[o] = Hc[ch]; PROD[o] = __expf(Lc[ch]); } }
            }
        }
        __syncthreads();
    }
}
__device__ __forceinline__ void p_rg_scan_b(const Frame& F0, const float* __restrict__ HEND, const float* __restrict__ PROD, float* __restrict__ HIN, int L) {
    const Frame F = phase_frame(F0);
    const int nck = L / 64, nseq = TG / L, total = nseq * 2 * D;
    for (int e = F.gw * 64 + F.lane; e < total; e += F.ngw * 64) {
        const int c = e % D, d = (e / D) & 1, sq = e / (2 * D);
        float h = 0.f;
        for (int k0 = 0; k0 < nck; k0 += 16) {
            float p[16], he[16];
#pragma unroll
            for (int j = 0; j < 16; ++j) { const int k = k0 + j, ck = sq * nck + (d ? nck - 1 - k : k); const size_t o = ((size_t)ck * 2 + d) * D + c; p[j] = PROD[o]; he[j] = HEND[o]; }
#pragma unroll
            for (int j = 0; j < 16; ++j) { const int k = k0 + j, ck = sq * nck + (d ? nck - 1 - k : k); const size_t o = ((size_t)ck * 2 + d) * D + c; HIN[o] = h; h = p[j] * h + he[j]; }
        }
    }
}
__device__ __forceinline__ void p_rg_scan_c(const Frame& F0, const bf16* LA, const bf16* INP, const float* HIN, const bf16* GATE, bf16* Y) {
    const Frame F = phase_frame(F0);
    for (int it = F.gw; it < 128 * 16; it += F.ngw) {
        const int cb = it & 15, ck = it >> 4, c0 = cb * 128 + F.lane * 2;
        const size_t base = (size_t)ck * 64 * D + c0;
        const unsigned* la0 = (const unsigned*)(LA + base); const unsigned* ip0 = (const unsigned*)(INP + base);
        const unsigned* la1 = (const unsigned*)(LA + (size_t)TG * D + base); const unsigned* ip1 = (const unsigned*)(INP + (size_t)TG * D + base);
        const unsigned* gt = (const unsigned*)(GATE + base); unsigned* yo = (unsigned*)(Y + base);
        constexpr int RS = D / 2;
        f32x2 hf[64];
        { const f32x2 hi = *(const f32x2*)(HIN + ((size_t)ck * 2 + 0) * D + c0); float h0 = hi.x, h1 = hi.y;
          unsigned cl[8], cx[8];
#pragma unroll
          for (int j = 0; j < 8; ++j) { cl[j] = la0[(size_t)j * RS]; cx[j] = ip0[(size_t)j * RS]; }
#pragma unroll
          for (int blk = 0; blk < 8; ++blk) {
              unsigned nl[8], nx[8];
              if (blk < 7) {
#pragma unroll
                  for (int j = 0; j < 8; ++j) { const int t = 8 * (blk + 1) + j; nl[j] = la0[(size_t)t * RS]; nx[j] = ip0[(size_t)t * RS]; } }
#pragma unroll
              for (int j = 0; j < 8; ++j) { const unsigned lw = cl[j], iw = cx[j]; h0 = __expf(bflo(lw)) * h0 + bflo(iw); h1 = __expf(bfhi(lw)) * h1 + bfhi(iw); hf[8 * blk + j] = (f32x2){h0, h1}; }
#pragma unroll
              for (int j = 0; j < 8; ++j) { cl[j] = nl[j]; cx[j] = nx[j]; }
          } }
        { const f32x2 hi = *(const f32x2*)(HIN + ((size_t)ck * 2 + 1) * D + c0); float h0 = hi.x, h1 = hi.y;
          unsigned cl[8], cx[8], cg[8];
#pragma unroll
          for (int j = 0; j < 8; ++j) { const int t = 63 - j; cl[j] = la1[(size_t)t * RS]; cx[j] = ip1[(size_t)t * RS]; cg[j] = gt[(size_t)t * RS]; }
#pragma unroll
          for (int blk = 0; blk < 8; ++blk) {
              unsigned nl[8], nx[8], ng[8];
              if (blk < 7) {
#pragma unroll
                  for (int j = 0; j < 8; ++j) { const int t = 63 - (8 * (blk + 1) + j); nl[j] = la1[(size_t)t * RS]; nx[j] = ip1[(size_t)t * RS]; ng[j] = gt[(size_t)t * RS]; } }
#pragma unroll
              for (int j = 0; j < 8; ++j) { const int t = 63 - (8 * blk + j); const unsigned lw = cl[j], iw = cx[j], gw = cg[j];
                  h0 = __expf(bflo(lw)) * h0 + bflo(iw); h1 = __expf(bfhi(lw)) * h1 + bfhi(iw);
                  yo[(size_t)t * RS] = pk2((hf[t].x + h0) * bflo(gw), (hf[t].y + h1) * bfhi(gw)); }
#pragma unroll
              for (int j = 0; j < 8; ++j) { cl[j] = nl[j]; cx[j] = nx[j]; cg[j] = ng[j]; }
          } }
    }
}

constexpr int PB = 272;
__device__ __forceinline__ s16x4 tr_read(const LAS unsigned char* p) { return __builtin_bit_cast(s16x4, __builtin_amdgcn_ds_read_tr16_b64_v4i16((LAS v4i16_t*)p)); }
__device__ __forceinline__ bf16x8 cat8(s16x4 lo, s16x4 hi) { return __builtin_shufflevector(lo, hi, 0, 1, 2, 3, 4, 5, 6, 7); }
__device__ __forceinline__ bf16x8 scale8(bf16x8 v, const float* w) {
    const u32x4 u = __builtin_bit_cast(u32x4, v); u32x4 o;
    o.x = pk2(bflo(u.x) * w[0], bfhi(u.x) * w[1]); o.y = pk2(bflo(u.y) * w[2], bfhi(u.y) * w[3]); o.z = pk2(bflo(u.z) * w[4], bfhi(u.z) * w[5]); o.w = pk2(bflo(u.w) * w[6], bfhi(u.w) * w[7]);
    return __builtin_bit_cast(bf16x8, o);
}
__device__ __forceinline__ bf16x8 scale8s(bf16x8 v, float w) {
    const u32x4 u = __builtin_bit_cast(u32x4, v); u32x4 o;
    o.x = pk2(bflo(u.x) * w, bfhi(u.x) * w); o.y = pk2(bflo(u.y) * w, bfhi(u.y) * w); o.z = pk2(bflo(u.z) * w, bfhi(u.z) * w); o.w = pk2(bflo(u.w) * w, bfhi(u.w) * w);
    return __builtin_bit_cast(bf16x8, o);
}
__device__ __forceinline__ void stage_img(const Frame& F, const bf16* src, int ld, LAS unsigned char* img) {
#pragma unroll
    for (int i = 0; i < 4; ++i) { const int idx = F.tid + 512 * i, r = idx >> 4, ch = idx & 15; *(LAS u32x4*)(img + r * PB + ch * 16) = *(const u32x4*)(src + (size_t)r * ld + ch * 8); }
}
__device__ __forceinline__ void ssd_tables(const Frame& F, const float* DT, int t0, int head, float A0, float A1, LAS float* tab) {
    const int L = F.lane; const float* dp = DT + (size_t)(t0 + 2 * L) * 128 + head;
    const float a0 = dp[0], a1 = dp[128], b0 = dp[64], b1 = dp[128 + 64];
    float sa = a0 + a1, sb = b0 + b1, ia = sa, ib = sb;
#pragma unroll
    for (int o = 1; o < 64; o <<= 1) { const float xa = shfl_lane(ia, (L - o) & 63), xb = shfl_lane(ib, (L - o) & 63); if (L >= o) { ia += xa; ib += xb; } }
    const float totb = shfl_lane(ib, 63);
    const float ea = ia - sa, eb = ib - sb;
    tab[2 * L] = A0 * (ea + a0); tab[2 * L + 1] = A0 * (ea + a0 + a1);
    tab[128 + 2 * L] = A1 * (totb - eb); tab[128 + 2 * L + 1] = A1 * (totb - eb - b0);
    tab[256 + 2 * L] = a0; tab[256 + 2 * L + 1] = a1; tab[384 + 2 * L] = b0; tab[384 + 2 * L + 1] = b1;
}
__device__ __forceinline__ void p_ssd_dt(const Frame& F0, const bf16* XA, const bf16* Wdt  , const float* dtb, float* DT) {
    const Frame F = phase_frame(F0);
    LAS float* part = (LAS float*)F.lds;
    const int L = F.lane, g = L >> 4, l15 = L & 15;
    for (int rb = blockIdx.x; rb < TG / 32; rb += F.G) {
        const int r0 = rb * 32, kb = F.wave * 256;
        f32x4 acc[2][8];
#pragma unroll
        for (int m = 0; m < 2; ++m)
#pragma unroll
            for (int n = 0; n < 8; ++n) acc[m][n] = (f32x4){0.f, 0.f, 0.f, 0.f};
#pragma unroll 2
        for (int ks = 0; ks < 8; ++ks) {
            bf16x8 a[2], b[8];
#pragma unroll
            for (int m = 0; m < 2; ++m) a[m] = *(const bf16x8*)((const char*)XA + pg8::blk_off(r0 + 16 * m + l15, kb + 32 * ks + 8 * g, D, false));
#pragma unroll
            for (int n = 0; n < 8; ++n) b[n] = *(const bf16x8*)(Wdt + (size_t)(16 * n + l15) * D + kb + 32 * ks + 8 * g);
#pragma unroll
            for (int m = 0; m < 2; ++m)
#pragma unroll
                for (int n = 0; n < 8; ++n) acc[m][n] = __builtin_amdgcn_mfma_f32_16x16x32_bf16(a[m], b[n], acc[m][n], 0, 0, 0);
        }
#pragma unroll
        for (int m = 0; m < 2; ++m)
#pragma unroll
            for (int n = 0; n < 8; ++n)
#pragma unroll
                for (int e = 0; e < 4; ++e) part[(F.wave * 32 + 16 * m + 4 * g + e) * 128 + 16 * n + l15] = acc[m][n][e];
        __syncthreads();
        { const int row = F.tid >> 4, cb = (F.tid & 15) * 8;
          f32x4 s0 = *(const f32x4*)(dtb + cb), s1 = *(const f32x4*)(dtb + cb + 4);
#pragma unroll
          for (int w = 0; w < 8; ++w) { s0 += *(const LAS f32x4*)(part + (w * 32 + row) * 128 + cb); s1 += *(const LAS f32x4*)(part + (w * 32 + row) * 128 + cb + 4); }
#pragma unroll
          for (int j = 0; j < 4; ++j) { s0[j] = softplusf_(s0[j]); s1[j] = softplusf_(s1[j]); }
          float* o = DT + (size_t)(r0 + row) * 128 + cb; *(f32x4*)o = s0; *(f32x4*)(o + 4) = s1; }
        __syncthreads();
    }
}
__device__ __forceinline__ void p_ssd_states(const Frame& F0, const bf16* XT, const bf16* BMt, const float* DT, const float* alog, bf16* ST, float* DEC) {
    const Frame F = phase_frame(F0);
    LAS unsigned char* img = F.lds; LAS float* tab = (LAS float*)(F.lds + 36864 + F.wave * 2048);
    const int L = F.lane, h = L >> 5, l31 = L & 31, q = (L & 15) >> 2, p4 = L & 3, blk = (L >> 4) & 1;
    for (int it = blockIdx.x; it < 64 * 8; it += F.G) {
        const int c = it >> 3, g = it & 7, head = g * 8 + F.wave, t0 = c * 128;
        const bf16* xt = XT + (size_t)(c * 64 + head) * 64 * 128;
        bf16x8 xc[2][2];
#pragma unroll
        for (int k2 = 0; k2 < 2; ++k2)
#pragma unroll
            for (int pt = 0; pt < 2; ++pt) xc[k2][pt] = *(const bf16x8*)(xt + ((k2 * 2 + pt) * 64 + L) * 8);
        stage_img(F, BMt + (size_t)t0 * 1024 + g * 128, 1024, img);
        const float A0 = -__expf(alog[head]), A1 = -__expf(alog[64 + head]);
        ssd_tables(F, DT, t0, head, A0, A1, tab);
        __syncthreads();
        const float afe = tab[127], ab0 = tab[128];
        if (L == 0) { DEC[(c * 2 + 0) * 64 + head] = __expf(afe); DEC[(c * 2 + 1) * 64 + head] = __expf(ab0); }
#pragma unroll 1
        for (int dir = 0; dir < 2; ++dir) {
            f32x16 acc[4][2];
#pragma unroll
            for (int a = 0; a < 4; ++a)
#pragma unroll
                for (int b = 0; b < 2; ++b)
#pragma unroll
                    for (int r = 0; r < 16; ++r) acc[a][b][r] = 0.f;
            const float eref = dir ? ab0 : afe;
#pragma unroll 1
            for (int kp = 0; kp < 4; ++kp) {
                bf16x8 xn[2][2];
                { const int kn0 = (kp < 3) ? 2 * (kp + 1) : 0;
#pragma unroll
                  for (int k2 = 0; k2 < 2; ++k2)
#pragma unroll
                      for (int pt = 0; pt < 2; ++pt) xn[k2][pt] = *(const bf16x8*)(xt + (((kn0 + k2) * 2 + pt) * 64 + L) * 8); }
#pragma unroll
                for (int k2 = 0; k2 < 2; ++k2) {
                    const int ks = 2 * kp + k2, s0 = 16 * ks + 8 * h;
                    float w[8];
#pragma unroll
                    for (int j = 0; j < 8; ++j) w[j] = __expf(eref - tab[dir * 128 + s0 + j]) * tab[256 + dir * 128 + s0 + j];
                    bf16x8 bfr[2];
#pragma unroll
                    for (int pt = 0; pt < 2; ++pt) bfr[pt] = scale8(xc[k2][pt], w);
#pragma unroll
                    for (int nt = 0; nt < 4; ++nt) {
                        const LAS unsigned char* ad = img + (16 * ks + 8 * h + q) * PB + (32 * nt + 16 * blk + 4 * p4) * 2;
                        const bf16x8 afr = cat8(tr_read(ad), tr_read(ad + 4 * PB));
#pragma unroll
                        for (int pt = 0; pt < 2; ++pt) acc[nt][pt] = __builtin_amdgcn_mfma_f32_32x32x16_bf16(afr, bfr[pt], acc[nt][pt], 0, 0, 0);
                    }
                }
#pragma unroll
                for (int k2 = 0; k2 < 2; ++k2)
#pragma unroll
                    for (int pt = 0; pt < 2; ++pt) xc[k2][pt] = xn[k2][pt];
            }
            bf16* st = ST + ((size_t)(c * 2 + dir) * 64 + head) * 8192;
#pragma unroll
            for (int nt = 0; nt < 4; ++nt)
#pragma unroll
                for (int pt = 0; pt < 2; ++pt)
#pragma unroll
                    for (int qd = 0; qd < 4; ++qd) { u32x2 w2; w2.x = pk2(acc[nt][pt][4 * qd], acc[nt][pt][4 * qd + 1]); w2.y = pk2(acc[nt][pt][4 * qd + 2], acc[nt][pt][4 * qd + 3]);
                        *(u32x2*)(st + (((2 * nt + (qd >> 1)) * 2 + pt) * 64 + l31 + 32 * (qd & 1)) * 8 + 4 * h) = w2; }
        }
        __syncthreads();
    }
}
__device__ __forceinline__ void p_ssd_rec(const Frame& F0, bf16* ST, const float* __restrict__ DEC, int L) {
    const Frame F = phase_frame(F0);
    const int nck = L / 128, nseq = TG / L, total = nseq * 131072;
    for (int e = F.gw * 64 + F.lane; e < total; e += F.ngw * 64) {
        const int oct = e & 1023, head = (e >> 10) & 63, dir = (e >> 16) & 1, sq = e >> 17;
        float hst[8];
#pragma unroll
        for (int j = 0; j < 8; ++j) hst[j] = 0.f;
        for (int k0 = 0; k0 < nck; k0 += 8) {
            u32x4 v[8]; float dec[8];
#pragma unroll
            for (int j = 0; j < 8; ++j) { const int k = k0 + j, c = sq * nck + (dir ? nck - 1 - k : k);
                v[j] = *(const u32x4*)(ST + ((size_t)(c * 2 + dir) * 64 + head) * 8192 + oct * 8); dec[j] = DEC[(c * 2 + dir) * 64 + head]; }
#pragma unroll
            for (int j = 0; j < 8; ++j) { const int k = k0 + j, c = sq * nck + (dir ? nck - 1 - k : k);
                u32x4 o; o.x = pk2(hst[0], hst[1]); o.y = pk2(hst[2], hst[3]); o.z = pk2(hst[4], hst[5]); o.w = pk2(hst[6], hst[7]);
                *(u32x4*)(ST + ((size_t)(c * 2 + dir) * 64 + head) * 8192 + oct * 8) = o;
                const float dc = dec[j]; const u32x4 x = v[j];
                hst[0] = hst[0] * dc + bflo(x.x); hst[1] = hst[1] * dc + bfhi(x.x); hst[2] = hst[2] * dc + bflo(x.y); hst[3] = hst[3] * dc + bfhi(x.y);
                hst[4] = hst[4] * dc + bflo(x.z); hst[5] = hst[5] * dc + bfhi(x.z); hst[6] = hst[6] * dc + bflo(x.w); hst[7] = hst[7] * dc + bfhi(x.w); }
        }
    }
}
__device__ __forceinline__ void p_ssd_out(const Frame& F0, const bf16* XT, const bf16* BMt, const bf16* CMt, const float* DT, const float* alog, const float* dskip, const bf16* ST,
                                          const bf16* ZS, const float* ng, bf16* Y) {
    const Frame F = phase_frame(F0);
    LAS unsigned char* imgB = F.lds; LAS unsigned char* imgC = F.lds + 34816; LAS float* tab = (LAS float*)(F.lds + 69632 + F.wave * 2048); LAS float* part = (LAS float*)(F.lds + 69632 + 16384);
    const int L0 = F.lane;
    for (int it = blockIdx.x; it < 64 * 8; it += F.G) {
        const int c = it >> 3, g = it & 7, head = g * 8 + F.wave, t0 = c * 128;
        stage_img(F, BMt + (size_t)t0 * 1024 + g * 128, 1024, imgB);
        stage_img(F, CMt + (size_t)t0 * 1024 + g * 128, 1024, imgC);
        const float A0 = -__expf(alog[head]), A1 = -__expf(alog[64 + head]), dsk = dskip[head];
        ssd_tables(F, DT, t0, head, A0, A1, tab);
        __syncthreads();
        const bf16* xt = XT + (size_t)(c * 64 + head) * 64 * 128;
#pragma unroll 1
        for (int half = 0; half < 2; ++half) {
            f32x16 acc[2][2];
#pragma unroll
            for (int a = 0; a < 2; ++a)
#pragma unroll
                for (int b = 0; b < 2; ++b)
#pragma unroll
                    for (int r = 0; r < 16; ++r) acc[a][b][r] = 0.f;
            { int L = L0; asm volatile("" : "+v"(L)); const int h = L >> 5, l31 = L & 31;
#pragma unroll 1
            for (int st = 0; st < 4; ++st) {
                bf16x8 xa[2][2];
#pragma unroll
                for (int ks = 0; ks < 2; ++ks)
#pragma unroll
                    for (int pt = 0; pt < 2; ++pt) { const bf16* xp = xt + (((2 * st + ks) * 2 + pt) * 64 + l31) * 8 + 4 * h;
                        const s16x4 lo = *(const s16x4*)xp, hi = *(const s16x4*)(xp + 32 * 8); xa[ks][pt] = cat8(lo, hi); }
#pragma unroll
                for (int tt = 0; tt < 2; ++tt) {
                    const int tg = 2 * half + tt;
                    f32x16 dg;
#pragma unroll
                    for (int r = 0; r < 16; ++r) dg[r] = 0.f;
#pragma unroll 2
                    for (int kn = 0; kn < 8; ++kn) { const bf16x8 a = *(const LAS bf16x8*)(imgB + (32 * st + l31) * PB + (16 * kn + 8 * h) * 2), b = *(const LAS bf16x8*)(imgC + (32 * tg + l31) * PB + (16 * kn + 8 * h) * 2);
                        dg = __builtin_amdgcn_mfma_f32_32x32x16_bf16(a, b, dg, 0, 0, 0); }
                    const int t = 32 * tg + l31; const float aft = tab[t], abt = tab[128 + t];
                    float v[16];
#pragma unroll
                    for (int qd = 0; qd < 4; ++qd) { const int sb = 32 * st + 8 * qd + 4 * h;
                        const f32x4 afs = *(const LAS f32x4*)(tab + sb), abs_ = *(const LAS f32x4*)(tab + 128 + sb), d0 = *(const LAS f32x4*)(tab + 256 + sb), d1 = *(const LAS f32x4*)(tab + 384 + sb);
                        if (st < tg) {
#pragma unroll
                            for (int e = 0; e < 4; ++e) v[4 * qd + e] = dg[4 * qd + e] * (__expf(aft - afs[e]) * d0[e]);
                        } else if (st > tg) {
#pragma unroll
                            for (int e = 0; e < 4; ++e) v[4 * qd + e] = dg[4 * qd + e] * (__expf(abt - abs_[e]) * d1[e]);
                        } else {
#pragma unroll
                            for (int e = 0; e < 4; ++e) { const int s = sb + e; float m = 0.f;
                                if (s <= t) m += __expf(aft - afs[e]) * d0[e];
                                if (s >= t) m += __expf(abt - abs_[e]) * d1[e];
                                float x = dg[4 * qd + e] * m; if (s == t) x += dsk; v[4 * qd + e] = x; } } }
                    bf16x8 gf[2];
#pragma unroll
                    for (int ks = 0; ks < 2; ++ks) { u32x4 o; o.x = pk2(v[8 * ks], v[8 * ks + 1]); o.y = pk2(v[8 * ks + 2], v[8 * ks + 3]); o.z = pk2(v[8 * ks + 4], v[8 * ks + 5]); o.w = pk2(v[8 * ks + 6], v[8 * ks + 7]); gf[ks] = __builtin_bit_cast(bf16x8, o); }
#pragma unroll
                    for (int pt = 0; pt < 2; ++pt)
#pragma unroll
                        for (int ks = 0; ks < 2; ++ks) acc[tt][pt] = __builtin_amdgcn_mfma_f32_32x32x16_bf16(xa[ks][pt], gf[ks], acc[tt][pt], 0, 0, 0);
                }
            }
            }
            { int L = L0; asm volatile("" : "+v"(L)); const int h = L >> 5, l31 = L & 31;
            const bf16* hs0 = ST + ((size_t)(c * 2) * 64 + head) * 8192;
            bf16x8 hc[4][2];
#pragma unroll
            for (int k4 = 0; k4 < 4; ++k4)
#pragma unroll
                for (int pt = 0; pt < 2; ++pt) hc[k4][pt] = *(const bf16x8*)(hs0 + ((k4 * 2 + pt) * 64 + L) * 8);
#pragma unroll 1
            for (int bt = 0; bt < 4; ++bt) {
                const int dir = bt >> 1, kh = bt & 1;
                bf16x8 hn[4][2];
                { const int nb2 = (bt + 1) & 3; const bf16* hsn = hs0 + (size_t)(nb2 >> 1) * 64 * 8192;
#pragma unroll
                  for (int k4 = 0; k4 < 4; ++k4)
#pragma unroll
                      for (int pt = 0; pt < 2; ++pt) hn[k4][pt] = *(const bf16x8*)(hsn + (((4 * (nb2 & 1) + k4) * 2 + pt) * 64 + L) * 8); }
                float et[2];
#pragma unroll
                for (int tt = 0; tt < 2; ++tt) et[tt] = __expf(tab[dir * 128 + 32 * (2 * half + tt) + l31]);
#pragma unroll
                for (int k4 = 0; k4 < 4; ++k4) { const int kn = 4 * kh + k4;
#pragma unroll
                    for (int tt = 0; tt < 2; ++tt) { const bf16x8 cb = scale8s(*(const LAS bf16x8*)(imgC + (32 * (2 * half + tt) + l31) * PB + (16 * kn + 8 * h) * 2), et[tt]);
#pragma unroll
                        for (int pt = 0; pt < 2; ++pt) acc[tt][pt] = __builtin_amdgcn_mfma_f32_32x32x16_bf16(hc[k4][pt], cb, acc[tt][pt], 0, 0, 0); }
                }
#pragma unroll
                for (int k4 = 0; k4 < 4; ++k4)
#pragma unroll
                    for (int pt = 0; pt < 2; ++pt) hc[k4][pt] = hn[k4][pt];
            }
            }
            { int L = L0; asm volatile("" : "+v"(L)); const int h = L >> 5, l31 = L & 31, lr8 = L >> 3, lp8 = L & 7;
              LAS unsigned char* wt = F.lds + 88064 + F.wave * 4608;
#pragma unroll
            for (int tt = 0; tt < 2; ++tt) { const size_t rowb = (size_t)(t0 + 32 * (2 * half + tt)); float ssq = 0.f;
                u32x4 zl[4];
#pragma unroll
                for (int i = 0; i < 4; ++i) zl[i] = *(const u32x4*)(ZS + (rowb + lr8 + 8 * i) * SSD_DI + head * 64 + lp8 * 8);
#pragma unroll
                for (int i = 0; i < 4; ++i) *(LAS u32x4*)(wt + (lr8 + 8 * i) * 144 + lp8 * 16) = zl[i];
                asm volatile("s_waitcnt lgkmcnt(0)" ::: "memory");
#pragma unroll
                for (int pt = 0; pt < 2; ++pt)
#pragma unroll
                    for (int qd = 0; qd < 4; ++qd) { const u32x2 z = *(const LAS u32x2*)(wt + l31 * 144 + (32 * pt + 8 * qd + 4 * h) * 2);
                        const float y0 = acc[tt][pt][4 * qd] * bflo(z.x), y1 = acc[tt][pt][4 * qd + 1] * bfhi(z.x), y2 = acc[tt][pt][4 * qd + 2] * bflo(z.y), y3 = acc[tt][pt][4 * qd + 3] * bfhi(z.y);
                        acc[tt][pt][4 * qd] = y0; acc[tt][pt][4 * qd + 1] = y1; acc[tt][pt][4 * qd + 2] = y2; acc[tt][pt][4 * qd + 3] = y3; ssq += (y0 * y0 + y1 * y1) + (y2 * y2 + y3 * y3); }
                asm volatile("s_waitcnt lgkmcnt(0)" ::: "memory");
                ssq += shfl_lane(ssq, L ^ 32);
                if (h == 0) part[F.wave * 64 + 32 * tt + l31] = ssq; }
            __syncthreads();
#pragma unroll
            for (int tt = 0; tt < 2; ++tt) { const int tl = 32 * tt + l31; const size_t rowb = (size_t)(t0 + 64 * half + 32 * tt); float tot = 0.f;
#pragma unroll
                for (int w = 0; w < 8; ++w) tot += part[w * 64 + tl];
                const float rstd = rsqrtf(tot * (1.0f / 512.0f) + LN_EPS);
#pragma unroll
                for (int pt = 0; pt < 2; ++pt)
#pragma unroll
                    for (int qd = 0; qd < 4; ++qd) { const int cc = head * 64 + 32 * pt + 8 * qd + 4 * h; const f32x4 gg = *(const f32x4*)(ng + cc);
                        u32x2 o; o.x = pk2(acc[tt][pt][4 * qd] * rstd * gg.x, acc[tt][pt][4 * qd + 1] * rstd * gg.y); o.y = pk2(acc[tt][pt][4 * qd + 2] * rstd * gg.z, acc[tt][pt][4 * qd + 3] * rstd * gg.w);
                        *(LAS u32x2*)(wt + l31 * 144 + (32 * pt + 8 * qd + 4 * h) * 2) = o; }
                asm volatile("s_waitcnt lgkmcnt(0)" ::: "memory");
#pragma unroll
                for (int i = 0; i < 4; ++i) *(u32x4*)(Y + (rowb + lr8 + 8 * i) * SSD_DI + head * 64 + lp8 * 8) = *(const LAS u32x4*)(wt + (lr8 + 8 * i) * 144 + lp8 * 16);
                asm volatile("s_waitcnt lgkmcnt(0)" ::: "memory"); }
            }
            __syncthreads();
        }
    }
}

constexpr int NA_STG = 2 * 64 * PB;
__device__ __forceinline__ void p_natt(const Frame& F0, const bf16* Q, const bf16* Kb, const bf16* V, const float* rpb, bf16* O, int L) {
    const Frame F = phase_frame(F0);
    LAS unsigned char* ringb = F.lds;
    LAS float* rp = (LAS float*)(F.lds + 3 * NA_STG);
    const int Ln = F.lane, g = Ln >> 4, l15 = Ln & 15, q4 = l15 >> 2, p4 = Ln & 3;
    const int rps = L / 64, nrb = 128 / 4;
    const int wrow = F.wave >> 1, chf = F.wave & 1;
    for (int it = blockIdx.x; it < nrb * 16; it += F.G) {
        const int head = it & 15, rb = it >> 4, grow0 = rb * 4, sq = grow0 / rps, r0 = grow0 % rps;
        const size_t rowbase = (size_t)sq * rps * 64;
        int klo = r0 - 4; klo = klo < 0 ? 0 : (klo > rps - 8 ? rps - 8 : klo);
        int khi = r0 + 3 - 4; khi = khi < 0 ? 0 : (khi > rps - 8 ? rps - 8 : khi); khi += 7;
        const int nst = khi - klo + 1;
        const int r = r0 + wrow; int rs = r - 4; rs = rs < 0 ? 0 : (rs > rps - 8 ? rps - 8 : rs);
        for (int i = F.tid; i < 465; i += NTHR) rp[i] = rpb[(size_t)head * 465 + i];
        u32x4 st0[4], st1[4];
        auto gload = [&](u32x4 (&d)[4], int s) {
#pragma unroll
            for (int i = 0; i < 2; ++i) { const int idx = F.tid + 512 * i, key = idx >> 4, ch = idx & 15; const size_t off = (rowbase + (size_t)(klo + s) * 64 + key) * D + head * 128 + ch * 8;
                d[i] = *(const u32x4*)(Kb + off); d[2 + i] = *(const u32x4*)(V + off); } };
        auto lstore = [&](const u32x4 (&d)[4], int s) { LAS unsigned char* b = ringb + (s % 3) * NA_STG;
#pragma unroll
            for (int i = 0; i < 2; ++i) { const int idx = F.tid + 512 * i, key = idx >> 4, ch = idx & 15; *(LAS u32x4*)(b + key * PB + ch * 16) = d[i]; *(LAS u32x4*)(b + 64 * PB + key * PB + ch * 16) = d[2 + i]; } };
        gload(st0, 0); gload(st1, 1);
        bf16x8 qf[2][4];
#pragma unroll
        for (int jt = 0; jt < 2; ++jt)
#pragma unroll
            for (int kd = 0; kd < 4; ++kd) qf[jt][kd] = *(const bf16x8*)(Q + (rowbase + (size_t)r * 64 + 16 * (2 * chf + jt) + l15) * D + head * 128 + 32 * kd + 8 * g);
        lstore(st0, 0); lstore(st1, 1);
        gload(st0, 2); if (nst > 3) gload(st1, 3);
        float mrun[2] = {-3.0e38f, -3.0e38f}, lrun[2] = {0.f, 0.f};
        f32x4 oacc[2][8];
#pragma unroll
        for (int jt = 0; jt < 2; ++jt)
#pragma unroll
            for (int dt = 0; dt < 8; ++dt) oacc[jt][dt] = (f32x4){0.f, 0.f, 0.f, 0.f};
        __syncthreads();
#pragma unroll 1
        for (int s = 0; s < nst; ++s) {
            const int kr = klo + s;
            const LAS unsigned char* kb = ringb + (s % 3) * NA_STG; const LAS unsigned char* vb = kb + 64 * PB;
            if (kr >= rs && kr <= rs + 7) {
                const int dy = kr - r + 7;
                int Lq = Ln; asm volatile("" : "+v"(Lq));
                const int g = Lq >> 4, l15 = Lq & 15, q4 = l15 >> 2, p4 = Lq & 3;
#pragma unroll
                for (int jt = 0; jt < 2; ++jt) {
                    const int j = 2 * chf + jt, kstart = (j == 0) ? 0 : (j == 1 ? 8 : (j == 2 ? 24 : 32)), qcol = 16 * j + l15;
                    int wst = qcol - 8; wst = wst < 0 ? 0 : (wst > 48 ? 48 : wst);
                    f32x4 sA = {0.f, 0.f, 0.f, 0.f}, sB = {0.f, 0.f, 0.f, 0.f};
                    const LAS unsigned char* ka = kb + (kstart + 8 * q4 + p4) * PB + 16 * g;
#pragma unroll
                    for (int kd = 0; kd < 4; ++kd) { const bf16x8 fa = *(const LAS bf16x8*)(ka + 64 * kd), fb = *(const LAS bf16x8*)(ka + 4 * PB + 64 * kd);
                        sA = __builtin_amdgcn_mfma_f32_16x16x32_bf16(fa, qf[jt][kd], sA, 0, 0, 0); sB = __builtin_amdgcn_mfma_f32_16x16x32_bf16(fb, qf[jt][kd], sB, 0, 0, 0); }
                    float sv[8]; float mx = mrun[jt];
#pragma unroll
                    for (int e = 0; e < 8; ++e) { const int kcol = kstart + 8 * g + e; const bool ok = (kcol >= wst) && (kcol < wst + 16);
                        int dx = kcol - qcol + 15; dx = dx < 0 ? 0 : (dx > 30 ? 30 : dx);
                        const float x = (e < 4 ? sA[e] : sB[e - 4]) + rp[dy * 31 + dx]; sv[e] = ok ? x : -3.0e38f; mx = fmaxf(mx, sv[e]); }
                    mx = fmaxf(mx, shfl_lane(mx, Lq ^ 16)); mx = fmaxf(mx, shfl_lane(mx, Lq ^ 32));
                    const float alpha = __expf(mrun[jt] - mx); mrun[jt] = mx;
                    float ps = 0.f;
#pragma unroll
                    for (int e = 0; e < 8; ++e) { sv[e] = __expf(sv[e] - mx); ps += sv[e]; }
                    ps += shfl_lane(ps, Lq ^ 16); ps += shfl_lane(ps, Lq ^ 32);
                    lrun[jt] = lrun[jt] * alpha + ps;
                    u32x4 pw; pw.x = pk2(sv[0], sv[1]); pw.y = pk2(sv[2], sv[3]); pw.z = pk2(sv[4], sv[5]); pw.w = pk2(sv[6], sv[7]);
                    const bf16x8 pf = __builtin_bit_cast(bf16x8, pw);
                    const LAS unsigned char* va = vb + (kstart + 8 * g + q4) * PB + 8 * p4;
#pragma unroll
                    for (int dt = 0; dt < 8; ++dt) { const bf16x8 vf = cat8(tr_read(va + 32 * dt), tr_read(va + 4 * PB + 32 * dt));
                        oacc[jt][dt] = oacc[jt][dt] * alpha; oacc[jt][dt] = __builtin_amdgcn_mfma_f32_16x16x32_bf16(vf, pf, oacc[jt][dt], 0, 0, 0); }
                }
            }
            if (s + 2 < nst) { if (s & 1) lstore(st1, s + 2); else lstore(st0, s + 2); }
            if (s + 4 < nst) { if (s & 1) gload(st1, s + 4); else gload(st0, s + 4); }
            __syncthreads();
        }
#pragma unroll
        for (int jt = 0; jt < 2; ++jt) { const float inv = frcp_(lrun[jt]); bf16* op = O + (rowbase + (size_t)r * 64 + 16 * (2 * chf + jt) + l15) * D + head * 128 + 4 * g;
#pragma unroll
            for (int dt = 0; dt < 8; ++dt) { u32x2 o; o.x = pk2(oacc[jt][dt][0] * inv, oacc[jt][dt][1] * inv); o.y = pk2(oacc[jt][dt][2] * inv, oacc[jt][dt][3] * inv); *(u32x2*)(op + 16 * dt) = o; } }
    }
}

struct Args { const float* in[29]; float* out; unsigned char* ws; int g_lo, g_hi, l_lo, l_hi, ph, pad; };

__global__ void __launch_bounds__(NTHR, 2) enc_fwd(Args args) {
    extern __shared__ __attribute__((aligned(16))) unsigned char lds[];
    Frame F;
    F.lds = (LAS unsigned char*)lds;
    F.tid = threadIdx.x; F.lane = F.tid & 63; F.wave = __builtin_amdgcn_readfirstlane(F.tid >> 6);
    F.G = gridDim.x; F.gw = F.wave * F.G + (int)blockIdx.x; F.ngw = F.G * NWAVES;
    unsigned char* ws = args.ws;
    gu32* ctl = (gu32*)(ws + WS_CTL);
    for (int u = F.tid; u < (LDS_BYTES - LDSCTL_OFF) / 4; u += NTHR) ((LAS unsigned*)(F.lds + LDSCTL_OFF))[u] = 0u;
    __syncthreads();
    const int ph = args.ph;
    XcdBarrier bar; bar.bar = (unsigned*)(ctl + CW_BAR); bar.x = 0; bar.st = nullptr;
    if (ph < 0) bar = xcd_barrier_post((unsigned*)(ctl + CW_BAR), (volatile LAS unsigned*)(F.lds + MISC_OFF) + 8);
#ifndef PROBE_TMASK
#define PROBE_TMASK 0ull
#endif
    unsigned long long tp0 = 0ull, tpacc = 0ull; int tph = 0;
#define RUN(k) ((ph < 0 || ph == (k)) && (tph = (k), tp0 = (PROBE_TMASK ? __builtin_amdgcn_s_memrealtime() : 0ull), true))
#ifndef PROBE_MASK
#define PROBE_MASK 0
#endif
#define NREP(bit) (((PROBE_MASK >> (bit)) & 1) ? 2 : 1)
#define REPEAT(bit) _Pragma("unroll 1") for (int rep = 0; rep < NREP(bit); ++rep)
    float* XDUM = (float*)(ws + WS_SCR + S_DUM); bf16* XBDUM = (bf16*)(ws + WS_SCR + S_DUM + 64 * MiB);
#ifndef PROBE_GPART
#define PROBE_GPART 0
#endif
#define TMODE() ((PROBE_GPART && (((unsigned long long)PROBE_TMASK >> tph) & 1ull)) ? PROBE_GPART : 0)
#define GRID_BAR() do { if (ph < 0) xcd_barrier(bar); if (PROBE_TMASK && !PROBE_GPART && (((unsigned long long)PROBE_TMASK >> tph) & 1ull)) tpacc += __builtin_amdgcn_s_memrealtime() - tp0; } while (0)

    bf16* Wb = (bf16*)(ws + WS_W);
    unsigned char* scr = ws + WS_SCR;
    bf16* XB = (bf16*)(scr + S_XB); bf16* YB = (bf16*)(scr + S_YB); bf16* HB = (bf16*)(scr + S_HID);
    LAS unsigned char* ring = F.lds;

    if (RUN(0) && args.g_lo == 0 && args.l_lo == 0) { p_prologue(F, args.in, Wb, (float*)(ws + WS_SPT), (bf16*)(scr + S_XB0)); GRID_BAR(); }

    for (int grp = args.g_lo; grp < args.g_hi; ++grp) {
        float* X = args.out + (size_t)grp * TG * D;
        const int L = grp < 2 ? 2048 : 8192;
        const float* Xin0 = grp < 2 ? args.in[0] + (size_t)grp * TG * D : args.in[1] + (size_t)(grp - 2) * TG * D;
        const bf16* XB0g = (const bf16*)(scr + S_XB0) + (size_t)grp * TG * D;
        for (int layer = args.l_lo; layer < args.l_hi; ++layer) {
            const int kind = layer % 3, jl = layer / 3;
            int Kout = 2048; const bf16* Wout; const bf16* XA = layer == 0 ? XB0g : XB;
            if (kind == 0) {
                bf16* GATE = (bf16*)(scr + S_RG_GATE); bf16* URAW = (bf16*)(scr + S_RG_URAW); bf16* LA = (bf16*)(scr + S_RG_LA); bf16* INP = (bf16*)(scr + S_RG_INP);
                float* HEND = (float*)(scr + S_RG_HEND); float* PROD = (float*)(scr + S_RG_PROD); float* HIN = (float*)(scr + S_RG_HIN);
                if (RUN(10)) REPEAT(1) { pg8::Gemm g{XA, Wb + W_RGIN + (size_t)jl * 4096 * 2048, 2048, 2048, 1}; pg8::StaticOrder S; S.init(TG, 4096, F.G, (int)blockIdx.x);
                    pg8::EpiRgIn E{GATE, URAW}; pg8::gemm_phase<pg8::EpiRgIn>(ring, g, S, E, tpacc, TMODE()); GRID_BAR(); }
                if (RUN(11)) { p_rg_fused(F, URAW, L, args.in[3] + (size_t)jl * 4 * 2048, args.in[4] + (size_t)jl * 2048, Wb + W_RGGATE + (size_t)jl * 32 * 65536,
                                          args.in[6] + (size_t)jl * 2 * 2048, args.in[8] + (size_t)jl * 2 * 2048, (const float*)(ws + WS_SPT) + (size_t)jl * 2 * 2048, LA, INP, HEND, PROD); GRID_BAR(); }
                if (RUN(14)) REPEAT(3) { p_rg_scan_b(F, HEND, PROD, HIN, L); GRID_BAR(); }
                if (RUN(15)) REPEAT(3) { p_rg_scan_c(F, LA, INP, HIN, GATE, YB); GRID_BAR(); }
                Wout = Wb + W_RGOUT + (size_t)jl * 2048 * 2048;
            } else if (kind == 1) {
                bf16* ZS = (bf16*)(scr + S_SSD_ZS); bf16* XBCR = (bf16*)(scr + S_SSD_XBCR); bf16* XT = (bf16*)(scr + S_SSD_XT); bf16* BMt = (bf16*)(scr + S_SSD_BM); bf16* CMt = (bf16*)(scr + S_SSD_CM);
                float* DT = (float*)(scr + S_SSD_DT); float* DEC = (float*)(scr + S_SSD_DEC); bf16* ST = (bf16*)(scr + S_SSD_ST);
                if (RUN(20)) REPEAT(1) { pg8::Gemm g{XA, Wb + W_SSDIN, 2048, 2048, 1}; pg8::StaticOrder S; S.init(TG, 40 * 256, F.G, (int)blockIdx.x);
                    pg8::EpiSsdIn E{ZS, XBCR}; pg8::gemm_phase<pg8::EpiSsdIn>(ring, g, S, E, tpacc, TMODE()); GRID_BAR(); }
                if (RUN(21)) REPEAT(4) { p_ssd_dt(F, XA, Wb + W_SSDIN + (size_t)10240 * 2048, args.in[14], DT); p_conv_ssd(F, XBCR, L, args.in[12], args.in[13], XT, BMt, CMt); GRID_BAR(); }
                if (RUN(22)) REPEAT(4) { p_ssd_states(F, XT, BMt, DT, args.in[15], ST, DEC); GRID_BAR(); }
                if (RUN(23)) { p_ssd_rec(F, ST, DEC, L); GRID_BAR(); }
                if (RUN(24)) REPEAT(4) { p_ssd_out(F, XT, BMt, CMt, DT, args.in[15], args.in[16], ST, ZS, args.in[17], YB); GRID_BAR(); }
                Wout = Wb + W_SSDOUT; Kout = 4096;
            } else {
                bf16* Qb = (bf16*)(scr + S_NA_Q); bf16* Kb = (bf16*)(scr + S_NA_K); bf16* Vb = (bf16*)(scr + S_NA_V);
                if (RUN(30)) REPEAT(1) { pg8::Gemm g{XA, Wb + W_NAQKV, 2048, 2048, 1}; pg8::StaticOrder S; S.init(TG, 6144, F.G, (int)blockIdx.x);
                    pg8::EpiQkv E{Qb, args.in[20]}; pg8::gemm_phase<pg8::EpiQkv>(ring, g, S, E, tpacc, TMODE()); GRID_BAR(); }
                if (RUN(31)) REPEAT(5) { p_natt(F, Qb, Kb, Vb, args.in[21], YB, L); GRID_BAR(); }
                Wout = Wb + W_NAOUT;
            }
            unsigned long long* xslot = (unsigned long long*)(ws + WS_XSLOT); unsigned* pcnt = (unsigned*)(ctl + CW_SEAM); unsigned* ptmo = (unsigned*)(ctl + CW_TMO);
            const unsigned ep = (unsigned)((grp * DEPTH + layer) * 2);
            if (RUN(40)) { pg8::Gemm g{YB, Wout, Kout, Kout, 0}; pg8::StaticOrder S; S.init(TG, D, F.G, (int)blockIdx.x);
                pg8::EpiResidLn<false> E{XA, nullptr, XB, args.in[25] + (size_t)layer * D, args.in[26] + (size_t)layer * D, ALPHA, xslot, pcnt, 64u * (ep + 1u), ptmo};
                pg8::gemm_phase<pg8::EpiResidLn<false>>(ring, g, S, E, tpacc, TMODE()); GRID_BAR(); }
            if (RUN(42)) REPEAT(6) { pg8::Gemm g{XB, Wb + W_UP + (size_t)layer * 8192 * 2048, 2048, 2048, 1}; pg8::StaticOrder S; S.init(TG, HID, F.G, (int)blockIdx.x, WGM_UP);
                pg8::EpiRelu2 E{HB, HID}; pg8::gemm_phase<pg8::EpiRelu2>(ring, g, S, E, tpacc, TMODE()); GRID_BAR(); }
            if (RUN(43)) { pg8::Gemm g{HB, Wb + W_DOWN + (size_t)layer * 2048 * 8192, 8192, 8192, 1}; pg8::StaticOrder S; S.init(TG, D, F.G, (int)blockIdx.x, WGM_DOWN);
                if (layer == DEPTH - 1) { pg8::EpiResidLn<true> E{XB, X, nullptr, args.in[27] + (size_t)layer * D, args.in[28] + (size_t)layer * D, ALPHA, xslot, pcnt, 64u * (ep + 2u), ptmo};
                    pg8::gemm_phase<pg8::EpiResidLn<true>>(ring, g, S, E, tpacc, TMODE()); }
                else { pg8::EpiResidLn<false> E{XB, nullptr, XB, args.in[27] + (size_t)layer * D, args.in[28] + (size_t)layer * D, ALPHA, xslot, pcnt, 64u * (ep + 2u), ptmo};
                    pg8::gemm_phase<pg8::EpiResidLn<false>>(ring, g, S, E, tpacc, TMODE()); }
                GRID_BAR(); }
        }
    }
    if (PROBE_TMASK && blockIdx.x == 0) { const unsigned long long te = __builtin_amdgcn_s_memrealtime(); while (__builtin_amdgcn_s_memrealtime() - te < tpacc) __builtin_amdgcn_s_sleep(8); }
#undef RUN
#undef GRID_BAR
}

extern "C" void kernel_launch(void* const* d_in, const int* in_sizes, int n_in, void* d_out, int out_size, void* d_ws, size_t ws_size, hipStream_t stream) {
    static int grid = 0;
    if (grid == 0) {
        if (n_in != 29 || out_size != NGROUP * TG * D || ws_size < WS_NEED) { fprintf(stderr, "kernel_launch: unexpected problem (n_in %d, out %d, ws %zu, need %zu)\n", n_in, out_size, ws_size, (size_t)WS_NEED); grid = -1; return; }
        int dev = 0, cus = 0, per_cu = 0;
        if (hipGetDevice(&dev) != hipSuccess || hipDeviceGetAttribute(&cus, hipDeviceAttributeMultiprocessorCount, dev) != hipSuccess) { grid = -1; return; }
        if (hipFuncSetAttribute((const void*)enc_fwd, hipFuncAttributeMaxDynamicSharedMemorySize, LDS_BYTES) != hipSuccess) { fprintf(stderr, "kernel_launch: hipFuncSetAttribute failed\n"); grid = -1; return; }
        if (hipOccupancyMaxActiveBlocksPerMultiprocessor(&per_cu, (const void*)enc_fwd, NTHR, LDS_BYTES) != hipSuccess || per_cu < 1) { fprintf(stderr, "kernel_launch: occupancy query says %d\n", per_cu); }
        (void)hipGetLastError();
        grid = cus;
        if (grid != 256) { fprintf(stderr, "kernel_launch: built for 256 CUs (one 256x256 tile per workgroup in the fused LayerNorm phases), got %d\n", cus); grid = -1; return; }
    }
    if (grid < 0) return;
    (void)hipMemsetAsync((char*)d_ws + WS_CTL, 0, CTL_ZERO_BYTES, stream);
    Args a{};
    for (int i = 0; i < 29; ++i) a.in[i] = (const float*)d_in[i];
    a.out = (float*)d_out; a.ws = (unsigned char*)d_ws; a.pad = 0;
    a.g_lo = 0; a.g_hi = NGROUP; a.l_lo = 0; a.l_hi = DEPTH; a.ph = -1;
    hipLaunchKernelGGL(enc_fwd, dim3(grid), dim3(NTHR), LDS_BYTES, stream, a);
}
```

```cpp
#include <hip/hip_runtime.h>
#include <cstdio>
#include <cstdint>

#ifndef WGM_UP
#define WGM_UP 4
#endif
#ifndef WGM_DOWN
#define WGM_DOWN 4
#endif

#define LAS __attribute__((address_space(3)))
#define GAS __attribute__((address_space(1)))
typedef unsigned short bf16;
typedef short bf16x8 __attribute__((ext_vector_type(8)));
typedef short s16x4 __attribute__((ext_vector_type(4)));
typedef float f32x2 __attribute__((ext_vector_type(2)));
typedef float f32x4 __attribute__((ext_vector_type(4)));
typedef float f32x16 __attribute__((ext_vector_type(16)));
typedef unsigned u32x2 __attribute__((ext_vector_type(2)));
typedef unsigned u32x4 __attribute__((ext_vector_type(4)));
typedef __bf16 bf16x2_t __attribute__((ext_vector_type(2)));
typedef short v4i16_t __attribute__((ext_vector_type(4)));
typedef GAS unsigned gu32;

constexpr int D = 2048, TG = 8192, NGROUP = 6, DEPTH = 4, NWAVES = 8, NTHR = 512;
constexpr int HID = 8192;
constexpr int SSD_DI = 4096, SSD_NH = 64, SSD_NG = 8, SSD_NS = 128, SSD_CH = 128, SSD_XBC = 6144, SSD_NIN = 10368, SSD_NIN_PAD = 10496;
constexpr int NA_H = 16, NA_HD = 128;
constexpr float ALPHA = 1.681792830507429f, LN_EPS = 1e-5f;

constexpr size_t MiB = 1u << 20;
constexpr size_t WS_CTL = 0, CTL_ZERO_BYTES = 256 * 1024;
constexpr size_t WS_XSLOT = 1 * MiB;
constexpr size_t WS_W = 2 * MiB;
constexpr size_t W_RGIN = 0;
constexpr size_t W_RGGATE = W_RGIN + 2ull * 4096 * 2048;
constexpr size_t W_RGOUT = W_RGGATE + 2ull * 32 * 256 * 256;
constexpr size_t W_SSDIN = W_RGOUT + 2ull * 2048 * 2048;
constexpr size_t W_SSDOUT = W_SSDIN + (size_t)SSD_NIN_PAD * 2048;
constexpr size_t W_NAQKV = W_SSDOUT + 2048ull * 4096;
constexpr size_t W_NAOUT = W_NAQKV + 6144ull * 2048;
constexpr size_t W_UP = W_NAOUT + 2048ull * 2048;
constexpr size_t W_DOWN = W_UP + 4ull * 8192 * 2048;
constexpr size_t W_END = W_DOWN + 4ull * 8192 * 2048;
constexpr size_t WS_SCR = ((WS_W + W_END * 2 + MiB - 1) / MiB) * MiB;
constexpr size_t S_XB = 0;
constexpr size_t S_YB = 32 * MiB;
constexpr size_t S_MIX = 96 * MiB;
constexpr size_t S_HID = S_MIX;
constexpr size_t S_RG_GATE = S_MIX, S_RG_URAW = S_MIX + 32 * MiB, S_RG_LA = S_MIX + 96 * MiB  , S_RG_INP = S_MIX + 160 * MiB  ;
constexpr size_t S_RG_HEND = S_MIX + 224 * MiB, S_RG_PROD = S_MIX + 226 * MiB, S_RG_HIN = S_MIX + 228 * MiB;
constexpr size_t S_SSD_ZS = S_MIX, S_SSD_XBCR = S_MIX + 64 * MiB, S_SSD_XT = S_MIX + 160 * MiB, S_SSD_BM = S_MIX + 224 * MiB, S_SSD_CM = S_MIX + 240 * MiB;
constexpr size_t S_SSD_DT = S_MIX + 256 * MiB, S_SSD_DEC = S_MIX + 260 * MiB, S_SSD_ST = S_MIX + 261 * MiB;
constexpr size_t S_NA_Q = S_MIX, S_NA_K = S_MIX + 32 * MiB, S_NA_V = S_MIX + 64 * MiB;
constexpr size_t S_END = S_MIX + 389 * MiB;
constexpr size_t S_XB0 = S_END;
constexpr size_t S_DUM = S_XB0 + 192 * MiB;
#ifndef PROBE_MASK
#define PROBE_MASK 0
#endif
constexpr size_t WS_NEED = WS_SCR + S_DUM + (PROBE_MASK ? 96 * MiB : 0);

constexpr int CW_BAR = 4096;
constexpr int CW_SEAM = 16384;
constexpr int CW_TMO = 0;
constexpr int CW_CHK = 1024;
constexpr size_t WS_SPT = 512 * 1024;

constexpr int RING_BYTES = 131072;
constexpr int LDSCTL_OFF = RING_BYTES, MISC_OFF = LDSCTL_OFF + 320;
constexpr int LDS_BYTES = 147456;

#define RLX_AGENT __ATOMIC_RELAXED, __HIP_MEMORY_SCOPE_AGENT
#define LDS_WAIT() asm volatile("s_waitcnt lgkmcnt(0)" ::: "memory")
#define VM_WAIT() asm volatile("s_waitcnt vmcnt(0)" ::: "memory")
__device__ __forceinline__ unsigned pk2(float lo, float hi) { f32x2 v = {lo, hi}; bf16x2_t b = __builtin_convertvector(v, bf16x2_t); return __builtin_bit_cast(unsigned, b); }
__device__ __forceinline__ float bflo(unsigned w) { return __uint_as_float(w << 16); }
__device__ __forceinline__ float bfhi(unsigned w) { return __uint_as_float(w & 0xffff0000u); }
__device__ __forceinline__ float bf2f(bf16 b) { return __uint_as_float(((unsigned)b) << 16); }
__device__ __forceinline__ float frcp_(float x) { return __builtin_amdgcn_rcpf(x); }
__device__ __forceinline__ float fsqrt_(float x) { return __builtin_amdgcn_sqrtf(x); }
__device__ __forceinline__ float fexp2_(float x) { return __builtin_amdgcn_exp2f(x); }
__device__ __forceinline__ float sigmoidf_(float x) { return frcp_(1.0f + __expf(-x)); }
__device__ __forceinline__ float siluf_(float x) { return x * frcp_(1.0f + __expf(-x)); }
__device__ __forceinline__ float gelu_tanh_(float v) { const float u = 1.5957691216057308f * (v + 0.044715f * v * v * v); return v * frcp_(1.0f + __expf(-u)); }
__device__ __forceinline__ float softplusf_(float v) { return v > 20.f ? v : log1pf(__expf(v)); }
__device__ __forceinline__ float shfl_lane(float v, int srclane) { return __int_as_float(__builtin_amdgcn_ds_bpermute(srclane << 2, __float_as_int(v))); }
__device__ __forceinline__ float wave_sum(float v, int lane) {
#pragma unroll
    for (int o = 1; o < 64; o <<= 1) v += shfl_lane(v, lane ^ o);
    return v;
}

#define XB_TMO      128
#define XB_XCNT(j)  (256  + 64 * (j))
#define XB_XSUB(j)  (1280 + 64 * (j))
#define XB_XGEN(j)  (2304 + 64 * (j))
#define XB_TOP      3328
#define XB_TOPGEN   3392
#define XCD_BAR_WORDS 3456
#define XB_SPIN_CAP (1u << 22)

__device__ __forceinline__ unsigned xb_ld(unsigned* p)              { return __hip_atomic_load(p, __ATOMIC_RELAXED, __HIP_MEMORY_SCOPE_AGENT); }
__device__ __forceinline__ unsigned xb_add(unsigned* p, unsigned v) { return __hip_atomic_fetch_add(p, v, __ATOMIC_RELAXED, __HIP_MEMORY_SCOPE_AGENT); }
__device__ __forceinline__ unsigned xb_xcc_id() { return (unsigned)__builtin_amdgcn_s_getreg((3 << 11) | 20) & 0xFu; }
#define XB_SPIN(cond, bar) do { unsigned _sp = 0; while (cond) { __builtin_amdgcn_s_sleep(1); \
    if ((++_sp & 255u) == 0u) { if (xb_ld(&(bar)[XB_TMO])) break; if (_sp > XB_SPIN_CAP) { atomicAdd(&(bar)[XB_TMO], 1u); break; } } } } while (0)

struct XcdBarrier { unsigned* bar; unsigned x; volatile LAS unsigned* st; };

__device__ __forceinline__ XcdBarrier xcd_barrier_post(unsigned* bar, volatile LAS unsigned* st) {
    XcdBarrier b; b.bar = bar; b.x = xb_xcc_id(); b.st = st;
    if (threadIdx.x == 0) (void)xb_add(&bar[XB_XCNT(b.x)], 1u);
    return b;
}
__device__ __forceinline__ void xcd_barrier_complete(unsigned* bar, unsigned x, unsigned& nloc, unsigned& nx) {
    const unsigned G = gridDim.x * gridDim.y * gridDim.z;
    unsigned sum, cnt, mine, sp = 0u;
    for (;;) {
        sum = 0u; cnt = 0u; mine = 0u;
#pragma unroll
        for (unsigned j = 0; j < 16; ++j) { const unsigned c = xb_ld(&bar[XB_XCNT(j)]); sum += c; cnt += (c > 0u) ? 1u : 0u; mine = (j == x) ? c : mine; }
        if (sum == G) break;
        __builtin_amdgcn_s_sleep(1);
        if ((++sp & 255u) == 0u) { if (xb_ld(&bar[XB_TMO])) break; if (sp > XB_SPIN_CAP) { atomicAdd(&bar[XB_TMO], 1u); break; } }
    }
    nloc = mine > 0u ? mine : 1u; nx = cnt > 0u ? cnt : 1u;
}
__device__ __forceinline__ void xcd_barrier(const XcdBarrier& b) {
    asm volatile("s_waitcnt vmcnt(0)" ::: "memory");
    __syncthreads();
    if (threadIdx.x == 0) {
        unsigned* bar = b.bar;
        __builtin_amdgcn_s_waitcnt(0);
        unsigned nloc = b.st[0], nx = b.st[1];
        if (nloc == 0u) { xcd_barrier_complete(bar, b.x, nloc, nx); b.st[0] = nloc; b.st[1] = nx; }
        const unsigned old = xb_add(&bar[XB_XSUB(b.x)], 1u);
        const unsigned gen = old / nloc;
        if (old + 1u == (gen + 1u) * nloc) {
            __builtin_amdgcn_fence(__ATOMIC_RELEASE, "agent");
            asm volatile("s_waitcnt vmcnt(0)" ::: "memory");
            const unsigned og = xb_add(&bar[XB_TOP], 1u);
            const unsigned tg = og / nx;
            if (og + 1u == (tg + 1u) * nx) xb_add(&bar[XB_TOPGEN], 1u);
            else XB_SPIN(xb_ld(&bar[XB_TOPGEN]) == tg, bar);
            __builtin_amdgcn_fence(__ATOMIC_ACQUIRE, "agent");
            xb_add(&bar[XB_XGEN(b.x)], 1u);
            asm volatile("s_waitcnt vmcnt(0)" ::: "memory");
        } else {
            XB_SPIN(xb_ld(&bar[XB_XGEN(b.x)]) == gen, bar);
            __builtin_amdgcn_fence(__ATOMIC_ACQUIRE, "agent");
            asm volatile("s_waitcnt vmcnt(0)" ::: "memory");
        }
    }
    __syncthreads();
}

namespace pg8 {
constexpr int BM = 256, BK = 64, HALF = 128, HTB = HALF * BK * 2, STAGE_BYTES = 8 * HTB, NXCD = 8, WGM = 8;
__host__ __device__ __forceinline__ int lds_byte(int r, int c) { const int st = (r >> 4) * 2 + (c >> 5), rr = r & 15, cc = c & 31, ob = rr * 64 + cc * 2; return st * 1024 + (ob ^ (((ob >> 9) & 1) << 5)); }
__host__ __device__ __forceinline__ void stage_rc(int b, int& R, int& C) { const int st = b / 1024, sb = b % 1024, swz = sb ^ (((sb >> 9) & 1) << 5); R = (st >> 1) * 16 + swz / 64; C = (st & 1) * 32 + (swz % 64) / 2; }
__host__ __device__ __forceinline__ int perm32(int rho) { const int n = rho >> 4, i = rho & 15; return 8 * (i >> 2) + 4 * n + (i & 3); }

struct Unit { int pm, pn; };
struct Gemm { const bf16* A; const bf16* Bt; int lda, K, blkA; };
constexpr int BLK = 16384;
__host__ __device__ __forceinline__ int perm32inv(int x) { return 16 * ((x >> 2) & 1) + 4 * (x >> 3) + (x & 3); }
__host__ __device__ __forceinline__ size_t blk_off(int row, int k, int K, bool perm) {
    const int r = row & 127, slot = perm ? ((r & ~31) + perm32inv(r & 31)) : r; return ((size_t)(row >> 7) * (K >> 6) + (k >> 6)) * BLK + lds_byte(slot, k & 63); }
__device__ __forceinline__ const char* a_base(const Gemm& g, const Unit& u) { return g.blkA ? (const char*)g.A + (size_t)u.pm * 2 * (g.K >> 6) * BLK : (const char*)(g.A + (size_t)u.pm * BM * g.lda); }
__device__ __forceinline__ const char* b_base(const Gemm& g, const Unit& u) { return (const char*)g.Bt + (size_t)u.pn * 2 * (g.K >> 6) * BLK; }

struct StaticOrder {
    int nM, nN, nwg, G, c, wgm;
    __host__ __device__ void init(int M, int N, int G_, int c_, int wgm_ = 4) { nM = M / BM; nN = N / BM; nwg = nM * nN; G = G_; c = c_; wgm = wgm_; }
    __host__ __device__ bool next(int i, Unit& u) const {
        const long L = (long)i * G + c; if (L >= nwg) return false;
        int wgid = (int)L; { const int q = nwg / NXCD, r = nwg % NXCD, xcd = wgid % NXCD, off = wgid / NXCD; wgid = (xcd < r ? xcd * (q + 1) : r * (q + 1) + (xcd - r) * q) + off; }
        const int nig = wgm * nN, gid = wgid / nig, fm = gid * wgm, gsz = (nM - fm) < wgm ? (nM - fm) : wgm;
        u.pm = fm + ((wgid % nig) % gsz); u.pn = (wgid % nig) / gsz; return true;
    }
};

template <class Epi, bool ALIGN_EPI = true, bool SP2 = true>
__device__ __forceinline__ void gemm_phase(LAS unsigned char* lds, const Gemm g, const StaticOrder& S, const Epi& E, unsigned long long& tacc, const int tmode) {
    int tid_o = threadIdx.x; asm volatile("" : "+v"(tid_o));
    const int tid = tid_o, wid = __builtin_amdgcn_readfirstlane(tid >> 6), lane = tid & 63, wr = wid >> 2, wc = wid & 3, fr = lane & 15, fq = lane >> 4;
    const int K = g.K, nt = K / BK;
    unsigned voffA[2], voffB[2];
    static_assert(Epi::PERM, "the blocked weight layout bakes in the PERM row order");
#pragma unroll
    for (int i = 0; i < 2; ++i) { int R, C; stage_rc(tid * 16 + i * 8192, R, C);
        voffA[i] = g.blkA ? (unsigned)(tid * 16 + i * 8192) : (unsigned)(R * g.lda + C) * 2u; voffB[i] = (unsigned)(tid * 16 + i * 8192); }
    const size_t kstepA = g.blkA ? (size_t)BLK : (size_t)(BK * 2), kstepB = (size_t)BLK;
    const size_t hstepA = g.blkA ? (size_t)(K >> 6) * BLK : (size_t)HALF * g.lda * 2, hstepB = (size_t)(K >> 6) * BLK;
    const unsigned ldsw = (unsigned)wid * 1024u;
    const int aoff = lds_byte(wr * 64 + fr, fq * 8), boff = lds_byte(wc * 32 + fr, fq * 8);
#define PG8_SA(b, h) (((b) * 2 + (h)) * HTB)
#define PG8_SB(b, h) ((4 + (b) * 2 + (h)) * HTB)
#define PG8_STAGE(bufoff, gbase, voff) do { _Pragma("unroll") for (int _i = 0; _i < 2; ++_i) \
        __builtin_amdgcn_global_load_lds((const unsigned*)((const char*)(gbase) + (voff)[_i]), (LAS unsigned*)(lds + (bufoff) + ldsw + _i * 8192), 16, 0, 0); } while (0)
#define PG8_LDA(dst, b, h) do { _Pragma("unroll") for (int m = 0; m < 4; ++m) _Pragma("unroll") for (int k = 0; k < 2; ++k) dst[m][k] = *(const LAS bf16x8*)(lds + PG8_SA(b, h) + aoff + m * 2048 + k * 1024); } while (0)
#define PG8_LDB(dst, b, h) do { _Pragma("unroll") for (int n = 0; n < 2; ++n) _Pragma("unroll") for (int k = 0; k < 2; ++k) dst[n][k] = *(const LAS bf16x8*)(lds + PG8_SB(b, h) + boff + n * 2048 + k * 1024); } while (0)
#define PG8_MMA(ai, bj, At, Bt) do { __builtin_amdgcn_s_setprio(1); _Pragma("unroll") for (int m = 0; m < 4; ++m) _Pragma("unroll") for (int n = 0; n < 2; ++n) _Pragma("unroll") for (int k = 0; k < 2; ++k) \
        acc[ai][bj][m][n] = __builtin_amdgcn_mfma_f32_16x16x32_bf16(Bt[n][k], At[m][k], acc[ai][bj][m][n], 0, 0, 0); __builtin_amdgcn_s_setprio(0); } while (0)
#define PG8_WAIT_V(n) asm volatile("s_waitcnt vmcnt(" #n ")" ::: "memory")
#define PG8_WAIT_L(n) asm volatile("s_waitcnt lgkmcnt(" #n ")" ::: "memory")
#define PG8_BAR __builtin_amdgcn_s_barrier()
#define PG8_SCHED __builtin_amdgcn_sched_barrier(0)
    Unit cur, nxt; int ui = 0;
    if (!S.next(0, cur)) return;
    f32x4 acc[2][2][4][2];
#pragma unroll
    for (int a = 0; a < 2; ++a)
#pragma unroll
        for (int b = 0; b < 2; ++b)
#pragma unroll
            for (int m = 0; m < 4; ++m)
#pragma unroll
                for (int n = 0; n < 2; ++n) acc[a][b][m][n] = (f32x4){0.f, 0.f, 0.f, 0.f};
    bf16x8 At[4][2], B0[2][2], B1[2][2];
    const char* cA = a_base(g, cur); const char* cB = b_base(g, cur);
    if constexpr (SP2) {
        PG8_STAGE(PG8_SB(0, 0), cB, voffB); PG8_STAGE(PG8_SB(0, 1), cB + hstepB, voffB); PG8_STAGE(PG8_SA(0, 0), cA, voffA); PG8_STAGE(PG8_SA(0, 1), cA + hstepA, voffA);
        if (wr == 1) PG8_BAR;
        PG8_WAIT_V(2); PG8_BAR;
        PG8_STAGE(PG8_SB(1, 0), cB + kstepB, voffB); PG8_STAGE(PG8_SA(1, 0), cA + kstepA, voffA); PG8_STAGE(PG8_SB(1, 1), cB + hstepB + kstepB, voffB);
        PG8_WAIT_V(6); PG8_BAR;
    } else {
        PG8_STAGE(PG8_SB(0, 0), cB, voffB); PG8_STAGE(PG8_SA(0, 0), cA, voffA); PG8_STAGE(PG8_SB(0, 1), cB + hstepB, voffB); PG8_STAGE(PG8_SA(0, 1), cA + hstepA, voffA);
        if (wr == 1) PG8_BAR;
        PG8_WAIT_V(4); PG8_BAR;
        PG8_STAGE(PG8_SB(1, 0), cB + kstepB, voffB); PG8_STAGE(PG8_SA(1, 0), cA + kstepA, voffA); PG8_STAGE(PG8_SB(1, 1), cB + hstepB + kstepB, voffB);
        PG8_WAIT_V(6); PG8_BAR;
    }
    for (;;) {
        const bool has_next = S.next(ui + 1, nxt);
        const char* nA = has_next ? a_base(g, nxt) : cA; const char* nB = has_next ? b_base(g, nxt) : cB;
        unsigned long long tk0 = 0ull; if (tmode == 1) tk0 = __builtin_amdgcn_s_memrealtime(); if (tmode == 3) tk0 = (unsigned long long)clock64();
#pragma unroll 1
        for (int t = 0; t < nt; t += 2) {
            const bool last = (t == nt - 2);
            const char* a1 = cA + (size_t)(t + 1) * kstepA;
            const char* a2 = last ? nA : cA + (size_t)(t + 2) * kstepA; const char* b2 = last ? nB : cB + (size_t)(t + 2) * kstepB;
            const char* a3 = a2 + kstepA; const char* b3 = b2 + kstepB;
            if constexpr (SP2) {
            PG8_LDB(B0, 0, 0); PG8_LDB(B1, 0, 1); PG8_SCHED; PG8_LDA(At, 0, 0); PG8_STAGE(PG8_SA(1, 1), a1 + hstepA, voffA);
            PG8_WAIT_V(8); PG8_WAIT_L(0); PG8_BAR; PG8_MMA(0, 0, At, B0); PG8_MMA(0, 1, At, B1); PG8_BAR; PG8_SCHED;
            PG8_LDA(At, 0, 1); PG8_STAGE(PG8_SB(0, 0), b2, voffB); PG8_STAGE(PG8_SB(0, 1), b2 + hstepB, voffB); PG8_STAGE(PG8_SA(0, 0), a2, voffA);
            PG8_WAIT_V(8); PG8_WAIT_L(0); PG8_BAR; PG8_MMA(1, 0, At, B0); PG8_MMA(1, 1, At, B1); PG8_BAR; PG8_SCHED;
            PG8_LDB(B0, 1, 0); PG8_LDB(B1, 1, 1); PG8_SCHED; PG8_LDA(At, 1, 0); PG8_STAGE(PG8_SA(0, 1), a2 + hstepA, voffA);
            PG8_WAIT_V(8); PG8_WAIT_L(0); PG8_BAR; PG8_MMA(0, 0, At, B0); PG8_MMA(0, 1, At, B1); PG8_BAR; PG8_SCHED;
            PG8_LDA(At, 1, 1); PG8_STAGE(PG8_SB(1, 0), b3, voffB); PG8_STAGE(PG8_SB(1, 1), b3 + hstepB, voffB); PG8_STAGE(PG8_SA(1, 0), a3, voffA);
            PG8_WAIT_V(8); PG8_WAIT_L(0); PG8_BAR; PG8_MMA(1, 0, At, B0); PG8_MMA(1, 1, At, B1); PG8_BAR; PG8_SCHED;
            } else {
            PG8_LDB(B0, 0, 0); PG8_SCHED; PG8_LDA(At, 0, 0); PG8_STAGE(PG8_SA(1, 1), a1 + hstepA, voffA);
            PG8_WAIT_L(8); PG8_BAR; PG8_WAIT_L(0); PG8_MMA(0, 0, At, B0); PG8_BAR; PG8_SCHED;
            PG8_LDB(B1, 0, 1); PG8_STAGE(PG8_SB(0, 0), b2, voffB);
            PG8_BAR; PG8_WAIT_L(0); PG8_MMA(0, 1, At, B1); PG8_BAR;
            PG8_LDA(At, 0, 1); PG8_STAGE(PG8_SA(0, 0), a2, voffA);
            PG8_BAR; PG8_WAIT_L(0); PG8_MMA(1, 0, At, B0); PG8_BAR; PG8_SCHED;
            PG8_STAGE(PG8_SB(0, 1), b2 + hstepB, voffB);
            PG8_WAIT_V(6); PG8_BAR; PG8_MMA(1, 1, At, B1); PG8_BAR;
            PG8_LDB(B0, 1, 0); PG8_SCHED; PG8_LDA(At, 1, 0); PG8_STAGE(PG8_SA(0, 1), a2 + hstepA, voffA);
            PG8_WAIT_L(8); PG8_BAR; PG8_WAIT_L(0); PG8_MMA(0, 0, At, B0); PG8_BAR; PG8_SCHED;
            PG8_LDB(B1, 1, 1); PG8_STAGE(PG8_SB(1, 0), b3, voffB);
            PG8_BAR; PG8_WAIT_L(0); PG8_MMA(0, 1, At, B1); PG8_BAR;
            PG8_LDA(At, 1, 1); PG8_STAGE(PG8_SA(1, 0), a3, voffA);
            PG8_BAR; PG8_WAIT_L(0); PG8_MMA(1, 0, At, B0); PG8_BAR; PG8_SCHED;
            PG8_STAGE(PG8_SB(1, 1), b3 + hstepB, voffB);
            PG8_WAIT_V(6); PG8_BAR; PG8_MMA(1, 1, At, B1); PG8_BAR;
            }
        }
        if (tmode == 1) tacc += __builtin_amdgcn_s_memrealtime() - tk0;
        if (tmode == 3) tacc += ((unsigned long long)clock64() - tk0) / 24ull;
        if (tmode == 2) tk0 = __builtin_amdgcn_s_memrealtime();
        if constexpr (ALIGN_EPI) { if (wr == 0) PG8_BAR; }
        if constexpr (!Epi::AFTER_DRAIN) E(acc, cur, wr, wc, fr, fq);
        if (!has_next) { if (tmode == 2) tacc += __builtin_amdgcn_s_memrealtime() - tk0; break; }
#pragma unroll
        for (int a = 0; a < 2; ++a)
#pragma unroll
            for (int b = 0; b < 2; ++b)
#pragma unroll
                for (int m = 0; m < 4; ++m)
#pragma unroll
                    for (int n = 0; n < 2; ++n) acc[a][b][m][n] = (f32x4){0.f, 0.f, 0.f, 0.f};
        cur = nxt; cA = nA; cB = nB; ++ui;
        if constexpr (ALIGN_EPI) { if (wr == 1) PG8_BAR; }
        if (tmode == 2) tacc += __builtin_amdgcn_s_memrealtime() - tk0;
    }
    PG8_WAIT_V(0);
    if constexpr (!ALIGN_EPI) { if (wr == 0) PG8_BAR; }
    PG8_BAR;
    if constexpr (Epi::AFTER_DRAIN) E.fused(acc, cur, wr, wc, fr, fq, lds, wid, lane);
#undef PG8_SA
#undef PG8_SB
#undef PG8_STAGE
#undef PG8_LDA
#undef PG8_LDB
#undef PG8_MMA
#undef PG8_WAIT_V
#undef PG8_WAIT_L
#undef PG8_BAR
#undef PG8_SCHED
}

typedef f32x4 AccT[2][2][4][2];
template <bool F32OUT> struct EpiResidLn {
    static constexpr bool PERM = true, AFTER_DRAIN = true;
    const bf16* XinB; float* XoutF; bf16* XBout; const float* g; const float* b; float alpha;
    unsigned long long* xbuf; unsigned* cnt; unsigned want; unsigned* tmo;
    __device__ __forceinline__ void operator()(const AccT&, const Unit&, int, int, int, int) const {}
    __device__ __forceinline__ void fused(AccT& acc, const Unit& u, int wr, int wc, int fr_in, int fq_in, LAS unsigned char* lds, int wid, int lane_in) const {
        int fr = fr_in, fq = fq_in, lane = lane_in; asm volatile("" : "+v"(fr), "+v"(fq), "+v"(lane));
        LAS f32x2* P = (LAS f32x2*)lds;
        LAS f32x2* S = (LAS f32x2*)(lds + 8192);
        const int col0 = u.pn * BM + wc * 32 + 8 * fq;
        {
            u32x4 xr[2][4][2];
#pragma unroll
            for (int ai = 0; ai < 2; ++ai)
#pragma unroll
                for (int m = 0; m < 4; ++m) { const int rowi = u.pm * BM + ai * HALF + wr * 64 + m * 16 + fr;
#pragma unroll
                    for (int bj = 0; bj < 2; ++bj) xr[ai][m][bj] = *(const u32x4*)((const char*)XinB + blk_off(rowi, col0 + bj * HALF, D, false)); }
#pragma unroll
            for (int ai = 0; ai < 2; ++ai)
#pragma unroll
                for (int m = 0; m < 4; ++m)
#pragma unroll
                    for (int bj = 0; bj < 2; ++bj) { const u32x4 w = xr[ai][m][bj];
                        acc[ai][bj][m][0] += (f32x4){bflo(w.x), bfhi(w.x), bflo(w.y), bfhi(w.y)} * alpha; acc[ai][bj][m][1] += (f32x4){bflo(w.z), bfhi(w.z), bflo(w.w), bfhi(w.w)} * alpha;
                        asm volatile("" : "+v"(acc[ai][bj][m][0]), "+v"(acc[ai][bj][m][1])); }
            asm volatile("" ::: "memory");
        }
#pragma unroll
        for (int ai = 0; ai < 2; ++ai)
#pragma unroll
            for (int m = 0; m < 4; ++m) {
                float s = 0.f;
#pragma unroll
                for (int bj = 0; bj < 2; ++bj)
#pragma unroll
                    for (int n = 0; n < 2; ++n) { const f32x4 x = acc[ai][bj][m][n]; s += (x[0] + x[1]) + (x[2] + x[3]); }
                s += shfl_lane(s, lane ^ 16); s += shfl_lane(s, lane ^ 32);
                const float mw = s * (1.0f / 64.0f); float q = 0.f;
#pragma unroll
                for (int bj = 0; bj < 2; ++bj)
#pragma unroll
                    for (int n = 0; n < 2; ++n) { const f32x4 d = acc[ai][bj][m][n] - mw; q += (d[0] * d[0] + d[1] * d[1]) + (d[2] * d[2] + d[3] * d[3]); }
                q += shfl_lane(q, lane ^ 16); q += shfl_lane(q, lane ^ 32);
                if (fq == 0) P[(ai * HALF + wr * 64 + m * 16 + fr) * 4 + wc] = (f32x2){mw, q};
            }
        const int col5 = u.pn * BM + wc * 32 + 8 * fq;
        f32x4 gg[2][2], bv[2][2];
#pragma unroll
        for (int bj = 0; bj < 2; ++bj)
#pragma unroll
            for (int n = 0; n < 2; ++n) { gg[bj][n] = *(const f32x4*)(g + col5 + bj * HALF + n * 4); bv[bj][n] = *(const f32x4*)(b + col5 + bj * HALF + n * 4); }
        asm volatile("s_waitcnt lgkmcnt(0)" ::: "memory"); __builtin_amdgcn_s_barrier(); asm volatile("" ::: "memory");
        const int row = wid * 32 + (lane & 31);
        if (lane < 32) {
            const f32x2 a = P[row * 4 + 0], bb = P[row * 4 + 1], c = P[row * 4 + 2], d = P[row * 4 + 3];
            const float mt = (a.x + bb.x + c.x + d.x) * 0.25f;
            const float da = a.x - mt, db = bb.x - mt, dc = c.x - mt, dd = d.x - mt;
            const float m2 = (a.y + bb.y) + (c.y + d.y) + 64.0f * ((da * da + db * db) + (dc * dc + dd * dd));
            unsigned long long* slot = xbuf + ((size_t)(u.pm * BM + row) * 8 + u.pn);
            __hip_atomic_store(slot, ((unsigned long long)__float_as_uint(m2) << 32) | __float_as_uint(mt), __ATOMIC_RELAXED, __HIP_MEMORY_SCOPE_AGENT);
        }
        asm volatile("s_waitcnt vmcnt(0)" ::: "memory");
        if (lane == 0) __hip_atomic_fetch_add(cnt + 64 * u.pm, 1u, __ATOMIC_RELAXED, __HIP_MEMORY_SCOPE_AGENT);
        if (wid == 0) {
            unsigned sp = 0;
            while ((unsigned)__builtin_amdgcn_readfirstlane(__hip_atomic_load(cnt + 64 * u.pm, __ATOMIC_RELAXED, __HIP_MEMORY_SCOPE_AGENT)) < want) {
                __builtin_amdgcn_s_sleep(1);
                if ((++sp & 1023u) == 0u) { if (__builtin_amdgcn_readfirstlane(__hip_atomic_load(tmo, __ATOMIC_RELAXED, __HIP_MEMORY_SCOPE_AGENT)) != 0u) break;
                    if (sp > (1u << 22)) { if (lane == 0) __hip_atomic_store(tmo, 1u, __ATOMIC_RELAXED, __HIP_MEMORY_SCOPE_AGENT); break; } } }
            __builtin_amdgcn_fence(__ATOMIC_ACQUIRE, "agent");
        }
        asm volatile("s_waitcnt vmcnt(0) lgkmcnt(0)" ::: "memory"); __builtin_amdgcn_s_barrier(); asm volatile("" ::: "memory");
        if (lane < 32) {
            const unsigned long long* slot = xbuf + (size_t)(u.pm * BM + row) * 8; float mt[8], m2[8]; float ms = 0.f;
#pragma unroll
            for (int t = 0; t < 8; ++t) { const unsigned long long w = __hip_atomic_load(slot + t, __ATOMIC_RELAXED, __HIP_MEMORY_SCOPE_AGENT); mt[t] = __uint_as_float((unsigned)w); m2[t] = __uint_as_float((unsigned)(w >> 32)); ms += mt[t]; }
            const float mean = ms * 0.125f; float q = 0.f;
#pragma unroll
            for (int t = 0; t < 8; ++t) { const float dm = mt[t] - mean; q += m2[t] + 256.0f * dm * dm; }
            S[row] = (f32x2){mean, rsqrtf(q * (1.0f / 2048.0f) + LN_EPS)};
        }
        asm volatile("s_waitcnt lgkmcnt(0)" ::: "memory"); __builtin_amdgcn_s_barrier(); asm volatile("" ::: "memory");
#pragma unroll
        for (int ai = 0; ai < 2; ++ai)
#pragma unroll
            for (int m = 0; m < 4; ++m) { const int r = ai * HALF + wr * 64 + m * 16 + fr; const f32x2 sr = S[r]; const size_t off = (size_t)(u.pm * BM + r) * D + col5;
#pragma unroll
                for (int bj = 0; bj < 2; ++bj) { const f32x4 o0 = (acc[ai][bj][m][0] - sr.x) * sr.y * gg[bj][0] + bv[bj][0], o1 = (acc[ai][bj][m][1] - sr.x) * sr.y * gg[bj][1] + bv[bj][1];
                    if constexpr (F32OUT) { *(f32x4*)(XoutF + off + bj * HALF) = o0; *(f32x4*)(XoutF + off + bj * HALF + 4) = o1; }
                    else { u32x4 w; w.x = pk2(o0[0], o0[1]); w.y = pk2(o0[2], o0[3]); w.z = pk2(o1[0], o1[1]); w.w = pk2(o1[2], o1[3]); *(u32x4*)((char*)XBout + blk_off(u.pm * BM + r, col5 + bj * HALF, D, false)) = w; } }
                asm volatile("" ::: "memory"); }
    }
};
struct EpiRelu2 {
    static constexpr bool PERM = true, AFTER_DRAIN = false;
    bf16* O; int Kd;
    __device__ __forceinline__ void operator()(const AccT& acc, const Unit& u, int wr, int wc, int fr_in, int fq_in) const {
        int fr = fr_in, fq = fq_in; asm volatile("" : "+v"(fr), "+v"(fq));
        const int row0 = u.pm * BM + wr * 64 + fr, col0 = u.pn * BM + wc * 32 + 8 * fq;
#pragma unroll
        for (int ai = 0; ai < 2; ++ai)
#pragma unroll
            for (int m = 0; m < 4; ++m) { const int row = row0 + ai * HALF + m * 16;
#pragma unroll
                for (int bj = 0; bj < 2; ++bj) { f32x4 v0 = acc[ai][bj][m][0], v1 = acc[ai][bj][m][1];
#pragma unroll
                    for (int j = 0; j < 4; ++j) { const float a = fmaxf(v0[j], 0.f), b = fmaxf(v1[j], 0.f); v0[j] = a * a; v1[j] = b * b; }
                    u32x4 w; w.x = pk2(v0[0], v0[1]); w.y = pk2(v0[2], v0[3]); w.z = pk2(v1[0], v1[1]); w.w = pk2(v1[2], v1[3]);
                    *(u32x4*)((char*)O + blk_off(row, col0 + bj * HALF, Kd, false)) = w; } }
    }
};
struct EpiRgIn {
    static constexpr bool PERM = true, AFTER_DRAIN = false;
    bf16* GATE; bf16* URAW;
    __device__ __forceinline__ void operator()(const AccT& acc, const Unit& u, int wr, int wc, int fr_in, int fq_in) const {
        int fr = fr_in, fq = fq_in; asm volatile("" : "+v"(fr), "+v"(fq));
        const bool isg = u.pn < 8; bf16* base = isg ? GATE : URAW;
        const int row0 = u.pm * BM + wr * 64 + fr, col0 = (u.pn & 7) * BM + wc * 32 + 8 * fq;
#pragma unroll
        for (int ai = 0; ai < 2; ++ai)
#pragma unroll
            for (int m = 0; m < 4; ++m) { bf16* rowp = base + (size_t)(row0 + ai * HALF + m * 16) * D + col0;
#pragma unroll
                for (int bj = 0; bj < 2; ++bj) { f32x4 v0 = acc[ai][bj][m][0], v1 = acc[ai][bj][m][1];
                    if (isg) {
#pragma unroll
                        for (int j = 0; j < 4; ++j) { v0[j] = gelu_tanh_(v0[j]); v1[j] = gelu_tanh_(v1[j]); } }
                    u32x4 w; w.x = pk2(v0[0], v0[1]); w.y = pk2(v0[2], v0[3]); w.z = pk2(v1[0], v1[1]); w.w = pk2(v1[2], v1[3]);
                    *(u32x4*)(rowp + bj * HALF) = w; } }
    }
};
struct EpiSsdIn {
    static constexpr bool PERM = true, AFTER_DRAIN = false;
    bf16* ZS; bf16* XBCR;
    __device__ __forceinline__ void operator()(const AccT& acc, const Unit& u, int wr, int wc, int fr_in, int fq_in) const {
        int fr = fr_in, fq = fq_in; asm volatile("" : "+v"(fr), "+v"(fq));
        const int row0 = u.pm * BM + wr * 64 + fr, cw = wc * 32 + 8 * fq;
        const bool isz = u.pn < 16; bf16* base = isz ? ZS + (size_t)u.pn * BM : XBCR + (size_t)(u.pn - 16) * BM; const int ldc = isz ? SSD_DI : SSD_XBC;
#pragma unroll
        for (int ai = 0; ai < 2; ++ai)
#pragma unroll
            for (int m = 0; m < 4; ++m) { bf16* rowp = base + (size_t)(row0 + ai * HALF + m * 16) * ldc + cw;
#pragma unroll
                for (int bj = 0; bj < 2; ++bj) { f32x4 v0 = acc[ai][bj][m][0], v1 = acc[ai][bj][m][1];
                    if (isz) {
#pragma unroll
                        for (int j = 0; j < 4; ++j) { v0[j] = siluf_(v0[j]); v1[j] = siluf_(v1[j]); } }
                    u32x4 w; w.x = pk2(v0[0], v0[1]); w.y = pk2(v0[2], v0[3]); w.z = pk2(v1[0], v1[1]); w.w = pk2(v1[2], v1[3]);
                    *(u32x4*)(rowp + bj * HALF) = w; } }
    }
};
struct EpiQkv {
    static constexpr bool PERM = true, AFTER_DRAIN = false;
    bf16* Q; const float* bias;
    __device__ __forceinline__ void operator()(const AccT& acc, const Unit& u, int wr, int wc, int fr_in, int fq_in) const {
        int fr = fr_in, fq = fq_in; asm volatile("" : "+v"(fr), "+v"(fq));
        const int t = u.pn >> 3; bf16* base = Q + (size_t)t * TG * D; const float sc = t == 0 ? 0.08838834764831845f : 1.0f;
        const int row0 = u.pm * BM + wr * 64 + fr, col0 = (u.pn & 7) * BM + wc * 32 + 8 * fq, bcol0 = u.pn * BM + wc * 32 + 8 * fq;
#pragma unroll
        for (int bj = 0; bj < 2; ++bj) {
            const f32x4 bv0 = *(const f32x4*)(bias + bcol0 + bj * HALF), bv1 = *(const f32x4*)(bias + bcol0 + bj * HALF + 4);
#pragma unroll
            for (int ai = 0; ai < 2; ++ai)
#pragma unroll
                for (int m = 0; m < 4; ++m) { bf16* rowp = base + (size_t)(row0 + ai * HALF + m * 16) * D + col0;
                    const f32x4 v0 = (acc[ai][bj][m][0] + bv0) * sc, v1 = (acc[ai][bj][m][1] + bv1) * sc;
                    u32x4 w; w.x = pk2(v0[0], v0[1]); w.y = pk2(v0[2], v0[3]); w.z = pk2(v1[0], v1[1]); w.w = pk2(v1[2], v1[3]);
                    *(u32x4*)(rowp + bj * HALF) = w; }
            asm volatile("" ::: "memory");
        }
    }
};
}

struct Frame {
    LAS unsigned char* lds;
    int tid, lane, wave, G, gw, ngw;
};

__device__ __forceinline__ Frame phase_frame(const Frame& F0) {
    Frame F = F0; int t = threadIdx.x; asm volatile("" : "+v"(t));
    F.tid = t; F.lane = t & 63; F.wave = __builtin_amdgcn_readfirstlane(t >> 6); F.gw = F.wave * F0.G + (int)blockIdx.x; return F;
}
template <int FRAG16 = 0>
__device__ __forceinline__ void transpose_item(const float* W, int ldw, bf16* WT, int ldt, int k0, int n0, int drow0, LAS float* scr, int lane) {
#pragma unroll
    for (int i = 0; i < 16; ++i) { const int kk = 4 * i + (lane >> 4), c2 = 2 * (lane & 15); const f32x2 v = *(const f32x2*)(W + (size_t)(k0 + kk) * ldw + n0 + c2); scr[kk * 33 + c2] = v.x; scr[kk * 33 + c2 + 1] = v.y; }
    LDS_WAIT(); asm volatile("" ::: "memory");
    const int c = lane & 7;
#pragma unroll
    for (int j = 0; j < 4; ++j) { const int n = (lane >> 3) + 8 * j; const LAS float* s = scr + (8 * c) * 33 + n;
        constexpr float sc = FRAG16 == 1 ? -1.4426950408889634f : 1.0f;
        u32x4 o; o.x = pk2(s[0 * 33] * sc, s[1 * 33] * sc); o.y = pk2(s[2 * 33] * sc, s[3 * 33] * sc); o.z = pk2(s[4 * 33] * sc, s[5 * 33] * sc); o.w = pk2(s[6 * 33] * sc, s[7 * 33] * sc);
        if constexpr (FRAG16 == 2) { *(GAS u32x4*)((GAS char*)WT + pg8::blk_off(drow0 + n, k0 + 8 * c, ldt, true)) = o; }
        else if constexpr (FRAG16 == 1) { const int r = drow0 + n, k = k0 + 8 * c;
            *(GAS u32x4*)(WT + (((r >> 4) * 8 + (k >> 5)) * 64 + (r & 15) + 16 * ((k >> 3) & 3)) * 8) = o; }
        else *(GAS u32x4*)(WT + (size_t)(drow0 + n) * ldt + k0 + 8 * c) = o; }
    LDS_WAIT(); asm volatile("" ::: "memory");
}
__device__ __forceinline__ void conv_matrix(const Frame& F, const float* W, int K, int N, bf16* WT, LAS float* scr, int nblocked = 1 << 30) {
    const int nblk = N / 32, nitems = (K / 64) * nblk;
    for (int it = F.gw; it < nitems; it += F.ngw) { const int kb = it / nblk, nb = it % nblk;
        if (32 * nb < nblocked) transpose_item<2>(W, N, WT, K, 64 * kb, 32 * nb, 32 * nb, scr, F.lane); else transpose_item<0>(W, N, WT, K, 64 * kb, 32 * nb, 32 * nb, scr, F.lane); }
}
__device__ __forceinline__ void p_prologue(const Frame& F0, const float* const* in, bf16* Wb, float* spt, bf16* XB0) {
    const Frame F = phase_frame(F0);
    { const int nsub = (NGROUP * TG / 16) * (D / 32);
      for (int s0 = F.gw; s0 < nsub; s0 += 4 * F.ngw) {
          f32x4 v0[4], v1[4];
#pragma unroll
          for (int q = 0; q < 4; ++q) { const int sidx = s0 + q * F.ngw, rb = sidx / (D / 32), cbk = sidx % (D / 32), row = rb * 16 + (F.lane >> 2), col = cbk * 32 + (F.lane & 3) * 8;
              const float* srow = row < 2 * TG ? in[0] + (size_t)row * D : in[1] + (size_t)(row - 2 * TG) * D;
              v0[q] = *(const f32x4*)(srow + col); v1[q] = *(const f32x4*)(srow + col + 4); }
#pragma unroll
          for (int q = 0; q < 4; ++q) { const int sidx = s0 + q * F.ngw, rb = sidx / (D / 32), cbk = sidx % (D / 32), row = rb * 16 + (F.lane >> 2), col = cbk * 32 + (F.lane & 3) * 8;
              u32x4 w; w.x = pk2(v0[q].x, v0[q].y); w.y = pk2(v0[q].z, v0[q].w); w.z = pk2(v1[q].x, v1[q].y); w.w = pk2(v1[q].z, v1[q].w);
              *(u32x4*)((char*)(XB0 + (size_t)(row >> 13) * TG * D) + pg8::blk_off(row & (TG - 1), col, D, false)) = w; } } }
    LAS float* scr = (LAS float*)(F.lds + F.wave * 16384);
    for (int l = 0; l < 2; ++l) {
        conv_matrix(F, in[2] + (size_t)l * 2048 * 4096, 2048, 4096, Wb + W_RGIN + (size_t)l * 4096 * 2048, scr);
        conv_matrix(F, in[10] + (size_t)l * 2048 * 2048, 2048, 2048, Wb + W_RGOUT + (size_t)l * 2048 * 2048, scr);
    }
    for (int it = F.gw; it < 2 * 2 * 16 * 32; it += F.ngw) {
        const int sub = it & 31, mat = it >> 5;
        const int dn = mat & 15, ax = (mat >> 4) & 1, l = mat >> 5;
        const int kb = sub >> 3, nb = sub & 7, j0 = 32 * nb;
        const float* W = in[ax ? 7 : 5] + ((size_t)(l * 16 + dn)) * 65536;
        bf16* WT = Wb + W_RGGATE + (size_t)l * 32 * 65536 + (size_t)(dn * 2 + (j0 >> 7)) * 65536;
        transpose_item<1>(W, 256, WT, 256, 64 * kb, j0, (j0 & 127) + 128 * ax, scr, F.lane);
    }
    for (int i = F.gw * 64 + F.lane; i < 2 * 2 * 2048; i += F.ngw * 64) spt[i] = -8.0f * 1.4426950408889634f * softplusf_(-in[9][i]);
    conv_matrix(F, in[11], 2048, SSD_NIN, Wb + W_SSDIN, scr, 10240);
    { u32x4* z = (u32x4*)(Wb + W_SSDIN + (size_t)SSD_NIN * 2048); const int n16 = (SSD_NIN_PAD - SSD_NIN) * 2048 / 8;
      for (int i = F.gw * 64 + F.lane; i < n16; i += F.ngw * 64) z[i] = (u32x4){0u, 0u, 0u, 0u}; }
    conv_matrix(F, in[18], 4096, 2048, Wb + W_SSDOUT, scr);
    conv_matrix(F, in[19], 2048, 6144, Wb + W_NAQKV, scr);
    conv_matrix(F, in[22], 2048, 2048, Wb + W_NAOUT, scr);
    for (int l = 0; l < 4; ++l) {
        conv_matrix(F, in[23] + (size_t)l * 2048 * 8192, 2048, 8192, Wb + W_UP + (size_t)l * 8192 * 2048, scr);
        conv_matrix(F, in[24] + (size_t)l * 8192 * 2048, 8192, 2048, Wb + W_DOWN + (size_t)l * 2048 * 8192, scr);
    }
}

__device__ __forceinline__ void p_conv_ssd(const Frame& F0, const bf16* in, int L, const float* cw, const float* cb, bf16* XT, bf16* BMo, bf16* CMo) {
    const Frame F = phase_frame(F0);
    constexpr int C = SSD_XBC, NCB = C / 512, TP = 144;
    LAS unsigned char* tile = F.lds;
    const int co = F.tid & 63, tr = F.tid >> 6;
    for (int it = blockIdx.x; it < NCB * (TG / 64); it += F.G) {
        const int cbk = it % NCB, tb = it / NCB, t0 = tb * 64, c0 = cbk * 512 + co * 8, r0 = t0 + 8 * tr, rl = r0 % L;
        float w[4][8], bias[8];
#pragma unroll
        for (int k = 0; k < 4; ++k) { const f32x4 a = *(const f32x4*)(cw + (size_t)k * C + c0), b = *(const f32x4*)(cw + (size_t)k * C + c0 + 4);
            w[k][0] = a.x; w[k][1] = a.y; w[k][2] = a.z; w[k][3] = a.w; w[k][4] = b.x; w[k][5] = b.y; w[k][6] = b.z; w[k][7] = b.w; }
        { const f32x4 a = *(const f32x4*)(cb + c0), b = *(const f32x4*)(cb + c0 + 4); bias[0] = a.x; bias[1] = a.y; bias[2] = a.z; bias[3] = a.w; bias[4] = b.x; bias[5] = b.y; bias[6] = b.z; bias[7] = b.w; }
        u32x4 rows[11];
#pragma unroll
        for (int i = 0; i < 11; ++i) { const int tt = rl - 1 + i; const bool ok = (tt >= 0) && (tt < L);
            rows[i] = ok ? *(const u32x4*)(in + (size_t)(r0 - 1 + i) * C + c0) : (u32x4){0u, 0u, 0u, 0u}; }
        unsigned outw[8][4];
#pragma unroll
        for (int i = 0; i < 8; ++i) {
            float y[8];
#pragma unroll
            for (int j = 0; j < 8; ++j) y[j] = bias[j];
#pragma unroll
            for (int k = 0; k < 4; ++k) { const u32x4 r = rows[i + k];
                y[0] += w[k][0] * bflo(r.x); y[1] += w[k][1] * bfhi(r.x); y[2] += w[k][2] * bflo(r.y); y[3] += w[k][3] * bfhi(r.y);
                y[4] += w[k][4] * bflo(r.z); y[5] += w[k][5] * bfhi(r.z); y[6] += w[k][6] * bflo(r.w); y[7] += w[k][7] * bfhi(r.w); }
#pragma unroll
            for (int j = 0; j < 8; ++j) y[j] = siluf_(y[j]);
            outw[i][0] = pk2(y[0], y[1]); outw[i][1] = pk2(y[2], y[3]); outw[i][2] = pk2(y[4], y[5]); outw[i][3] = pk2(y[6], y[7]);
        }
        if (cbk >= 8) {
            bf16* ob = cbk < 10 ? BMo : CMo; const int cc = cbk < 10 ? c0 - 4096 : c0 - 5120;
#pragma unroll
            for (int i = 0; i < 8; ++i) *(u32x4*)(ob + (size_t)(r0 + i) * 1024 + cc) = (u32x4){outw[i][0], outw[i][1], outw[i][2], outw[i][3]};
        } else {
#pragma unroll
            for (int j = 0; j < 8; ++j) {
                unsigned e[4];
#pragma unroll
                for (int q = 0; q < 4; ++q) { const unsigned a = outw[2 * q][j >> 1], b = outw[2 * q + 1][j >> 1];
                    e[q] = (j & 1) ? ((a >> 16) | (b & 0xffff0000u)) : ((a & 0xffffu) | (b << 16)); }
                *(LAS u32x4*)(tile + (co * 8 + j) * TP + tr * 16) = (u32x4){e[0], e[1], e[2], e[3]};
            }
            __syncthreads();
            const int chunk = t0 >> 7, s0 = t0 & 127;
#pragma unroll
            for (int i = 0; i < 8; ++i) { const int idx = F.tid + 512 * i, piece = idx >> 9, row = idx & 511, c = cbk * 512 + row, p = c & 63, s = s0 + 8 * piece;
                *(u32x4*)(XT + (size_t)(chunk * 64 + (c >> 6)) * 8192 + (((s >> 4) * 2 + (p >> 5)) * 64 + (p & 31) + 32 * ((s >> 3) & 1)) * 8) = *(const LAS u32x4*)(tile + row * TP + piece * 16); }
            __syncthreads();
        }
    }
}

constexpr int RGF_PITCH = 528;
__device__ __forceinline__ void p_rg_fused(const Frame& F0, const bf16* URAW, int L, const float* cw, const float* cbias, const bf16* Wg, const float* ba, const float* bx, const float* spt,
                                           bf16* LA, bf16* INP, float* HEND, float* PROD) {
    const Frame F = phase_frame(F0);
    LAS unsigned char* ut = F.lds;
    for (int it = blockIdx.x; it < 64 * 8; it += F.G) {
        const int nb = it & 7, run = it >> 3, t0 = run * 128;
        { const int co = F.tid & 31, tq = F.tid >> 5, c0 = nb * 256 + co * 8, tb = t0 + 8 * tq, tl = tb % L;
          float w[4][8], bias[8];
#pragma unroll
          for (int k = 0; k < 4; ++k) { const f32x4 a = *(const f32x4*)(cw + (size_t)k * D + c0), b = *(const f32x4*)(cw + (size_t)k * D + c0 + 4);
              w[k][0] = a.x; w[k][1] = a.y; w[k][2] = a.z; w[k][3] = a.w; w[k][4] = b.x; w[k][5] = b.y; w[k][6] = b.z; w[k][7] = b.w; }
          { const f32x4 a = *(const f32x4*)(cbias + c0), b = *(const f32x4*)(cbias + c0 + 4); bias[0] = a.x; bias[1] = a.y; bias[2] = a.z; bias[3] = a.w; bias[4] = b.x; bias[5] = b.y; bias[6] = b.z; bias[7] = b.w; }
          u32x4 rows[11];
#pragma unroll
          for (int i = 0; i < 11; ++i) { const int tt = tl - 1 + i; const bool ok = (tt >= 0) && (tt < L);
              rows[i] = ok ? *(const u32x4*)(URAW + (size_t)(tb - 1 + i) * D + c0) : (u32x4){0u, 0u, 0u, 0u}; }
#pragma unroll
          for (int i = 0; i < 8; ++i) {
              float y[8];
#pragma unroll
              for (int j = 0; j < 8; ++j) y[j] = bias[j];
#pragma unroll
              for (int k = 0; k < 4; ++k) { const u32x4 r = rows[i + k];
                  y[0] += w[k][0] * bflo(r.x); y[1] += w[k][1] * bfhi(r.x); y[2] += w[k][2] * bflo(r.y); y[3] += w[k][3] * bfhi(r.y);
                  y[4] += w[k][4] * bflo(r.z); y[5] += w[k][5] * bfhi(r.z); y[6] += w[k][6] * bflo(r.w); y[7] += w[k][7] * bfhi(r.w); }
              *(LAS u32x4*)(ut + (8 * tq + i) * RGF_PITCH + co * 16) = (u32x4){pk2(y[0], y[1]), pk2(y[2], y[3]), pk2(y[4], y[5]), pk2(y[6], y[7])};
          } }
        __syncthreads();
#pragma unroll 1
        for (int d = 0; d < 2; ++d) {
            int Lq = F.lane; asm volatile("" : "+v"(Lq));
            const int g = Lq >> 4, l15 = Lq & 15, w8 = F.wave;
            bf16x8 wq[3][4];
            const unsigned wvo = (unsigned)Lq * 16u;
            const bf16* wtile0 = Wg + (size_t)((d * 8 + nb) * 2 + (w8 >> 2)) * 65536;
            const bf16* wb[4];
#pragma unroll
            for (int n = 0; n < 4; ++n) wb[n] = wtile0 + (((w8 & 3) * 2 + (n & 1) + (n >> 1) * 8) * 8) * 512 + 2048;
#define RG_WLD(q, ksv) do { _Pragma("unroll") for (int n = 0; n < 4; ++n) \
                asm volatile("global_load_dwordx4 %0, %1, %2 offset:%3" : "=&v"(wq[q][n]) : "v"(wvo), "s"(wb[n]), "n"((ksv) * 1024 - 4096) : "memory"); } while (0)
#define RG_WWAIT(q, cnt) asm volatile("s_waitcnt vmcnt(" #cnt ")" : "+v"(wq[q][0]), "+v"(wq[q][1]), "+v"(wq[q][2]), "+v"(wq[q][3]) :: "memory")
            RG_WLD(0, 0); RG_WLD(1, 1);
            f32x4 acc[8][4];
            {
                float bn[4];
#pragma unroll
                for (int n = 0; n < 4; ++n) { const int c = nb * 256 + 32 * w8 + 16 * (n & 1) + l15; bn[n] = -1.4426950408889634f * ((n >> 1) ? bx[d * D + c] : ba[d * D + c]); }
#pragma unroll
                for (int m = 0; m < 8; ++m)
#pragma unroll
                    for (int n = 0; n < 4; ++n) acc[m][n] = (f32x4){bn[n], bn[n], bn[n], bn[n]};
#pragma unroll
                for (int n = 0; n < 4; ++n) asm volatile("" : "+v"(acc[0][n]));
            }
#pragma unroll
            for (int ks = 0; ks < 8; ++ks) {
                if (ks + 2 < 8) RG_WLD((ks + 2) % 3, ks + 2);
                if (ks <= 5) RG_WWAIT(ks % 3, 8); else if (ks == 6) RG_WWAIT(ks % 3, 4); else RG_WWAIT(ks % 3, 0);
#pragma unroll
                for (int m = 0; m < 8; ++m) { const bf16x8 a = *(const LAS bf16x8*)(ut + (16 * m + l15) * RGF_PITCH + (32 * ks + 8 * g) * 2);
#pragma unroll
                    for (int n = 0; n < 4; ++n) acc[m][n] = __builtin_amdgcn_mfma_f32_16x16x32_bf16(a, wq[ks % 3][n], acc[m][n], 0, 0, 0); }
                __builtin_amdgcn_sched_barrier(0);
            }
#undef RG_WLD
#undef RG_WWAIT
            bf16* la = LA + (size_t)d * TG * D + (size_t)t0 * D + nb * 256; bf16* in = INP + (size_t)d * TG * D + (size_t)t0 * D + nb * 256;
#pragma unroll
            for (int np = 0; np < 2; ++np) {
                const int cl = 32 * w8 + 16 * np + l15, c = nb * 256 + cl;
                const float psp = spt[d * D + c];
                float Lm[8], Hm[8];
#pragma unroll
                for (int m = 0; m < 8; ++m) {
                    float lr[4], xr[4], ea[4]; unsigned lwv[4], xwv[4];
                    int gq = g; asm volatile("" : "+v"(gq));
                    {
                        f32x4 u4;
#pragma unroll
                        for (int e = 0; e < 4; ++e) u4[e] = bf2f(*(const LAS bf16*)(ut + (16 * m + 4 * gq + e) * RGF_PITCH + cl * 2));
                        const f32x4 na = acc[m][np], nb2 = acc[m][2 + np]; f32x4 e1, e2;
#pragma unroll
                        for (int e = 0; e < 4; ++e) { e1[e] = fexp2_(fminf(na[e], 115.f)); e2[e] = fexp2_(fminf(nb2[e], 115.f)); }
                        const f32x4 d1 = e1 + 1.0f, d2 = e2 + 1.0f, dp = d1 * d2; f32x4 rc;
#pragma unroll
                        for (int e = 0; e < 4; ++e) rc[e] = frcp_(dp[e]);
                        const f32x4 l4 = (d2 * rc) * psp, ig = d1 * rc;
                        const unsigned lw01 = pk2(l4[0], l4[1]), lw23 = pk2(l4[2], l4[3]);
                        lr[0] = bflo(lw01); lr[1] = bfhi(lw01); lr[2] = bflo(lw23); lr[3] = bfhi(lw23);
                        f32x4 ea4, sq;
#pragma unroll
                        for (int e = 0; e < 4; ++e) { ea4[e] = fexp2_(lr[e]); ea[e] = ea4[e]; }
#pragma unroll
                        for (int e = 0; e < 4; ++e) sq[e] = fsqrt_(__builtin_fabsf(__builtin_fmaf(-ea4[e], ea4[e], 1.0f)));
                        const f32x4 x4 = sq * ig * u4;
                        const unsigned xw01 = pk2(x4[0], x4[1]), xw23 = pk2(x4[2], x4[3]);
                        xr[0] = bflo(xw01); xr[1] = bfhi(xw01); xr[2] = bflo(xw23); xr[3] = bfhi(xw23);
                        lwv[0] = lw01 & 0xffffu; lwv[1] = lw01 >> 16; lwv[2] = lw23 & 0xffffu; lwv[3] = lw23 >> 16;
                        xwv[0] = xw01 & 0xffffu; xwv[1] = xw01 >> 16; xwv[2] = xw23 & 0xffffu; xwv[3] = xw23 >> 16; }
#pragma unroll
                    for (int ep = 0; ep < 2; ++ep) { const bool odd = (Lq & 1) != 0; const int tok = 16 * m + 4 * gq + 2 * ep + (odd ? 1 : 0);
                        const unsigned sl = odd ? lwv[2 * ep] : lwv[2 * ep + 1], sx = odd ? xwv[2 * ep] : xwv[2 * ep + 1];
                        const unsigned rl = (unsigned)__builtin_amdgcn_update_dpp(0, (int)sl, 0xB1, 0xf, 0xf, true), rx = (unsigned)__builtin_amdgcn_update_dpp(0, (int)sx, 0xB1, 0xf, 0xf, true);
                        const unsigned wl = odd ? (rl | (lwv[2 * ep + 1] << 16)) : (lwv[2 * ep] | (rl << 16)), wx = odd ? (rx | (xwv[2 * ep + 1] << 16)) : (xwv[2 * ep] | (rx << 16));
                        const int c2 = cl & ~1;
                        *(unsigned*)(la + (size_t)tok * D + c2) = wl; *(unsigned*)(in + (size_t)tok * D + c2) = wx; }
                    const float Hf = ((xr[0] * ea[1] + xr[1]) * ea[2] + xr[2]) * ea[3] + xr[3], Hb = ((xr[3] * ea[2] + xr[2]) * ea[1] + xr[1]) * ea[0] + xr[0];
                    float Ls = (lr[0] + lr[1]) + (lr[2] + lr[3]), Hs = d ? Hb : Hf;
#pragma unroll
                    for (int st = 0; st < 2; ++st) { const int bit = st ? 2 : 1; const int pl = Lq ^ (st ? 32 : 16);
                        const float Lp = shfl_lane(Ls, pl), Hp = shfl_lane(Hs, pl);
                        const bool mine_first = (((g & bit) == 0) != (d != 0));
                        Hs = mine_first ? Hs * fexp2_(Lp) + Hp : Hp * fexp2_(Ls) + Hs; Ls += Lp; }
                    Lm[m] = Ls; Hm[m] = Hs;
                }
                float Lc[2], Hc[2];
#pragma unroll
                for (int ch = 0; ch < 2; ++ch) {
                    if (d == 0) { float H = Hm[4 * ch]; H = H * fexp2_(Lm[4 * ch + 1]) + Hm[4 * ch + 1]; H = H * fexp2_(Lm[4 * ch + 2]) + Hm[4 * ch + 2]; H = H * fexp2_(Lm[4 * ch + 3]) + Hm[4 * ch + 3]; Hc[ch] = H; }
                    else        { float H = Hm[4 * ch + 3]; H = H * fexp2_(Lm[4 * ch + 2]) + Hm[4 * ch + 2]; H = H * fexp2_(Lm[4 * ch + 1]) + Hm[4 * ch + 1]; H = H * fexp2_(Lm[4 * ch]) + Hm[4 * ch]; Hc[ch] = H; }
                    Lc[ch] = (Lm[4 * ch] + Lm[4 * ch + 1]) + (Lm[4 * ch + 2] + Lm[4 * ch + 3]);
                }
                if (g == 0) {
#pragma unroll
                    for (int ch = 0; ch < 2; ++ch) { const size_t o = ((size_t)(run * 2 + ch) * 2 + d) * D + c; HEND[o] = Hc[ch]; PROD[o] = fexp2_(Lc[ch]); } }
            }
        }
        __syncthreads();
    }
}
__device__ __forceinline__ void p_rg_scan_b(const Frame& F0, const float* __restrict__ HEND, const float* __restrict__ PROD, float* __restrict__ HIN, int L) {
    const Frame F = phase_frame(F0);
    const int nck = L / 64, nseg = nck / 16, cpw = NWAVES / nseg;
    const int nitems = ((TG / L) * 2 * (D / 64)) / cpw;
    LAS float* xs = (LAS float*)F.lds;
    for (int it = blockIdx.x; it < nitems; it += F.G) {
        const int chain = it * cpw + F.wave / nseg, seg = F.wave % nseg;
        const int cg = chain & 31, d = (chain >> 5) & 1, sq = chain >> 6, c = cg * 64 + F.lane;
        float p[16], he[16];
#pragma unroll
        for (int j = 0; j < 16; ++j) { const int k = seg * 16 + j, ck = sq * nck + (d ? nck - 1 - k : k); const size_t o = ((size_t)ck * 2 + d) * D + c; p[j] = PROD[o]; he[j] = HEND[o]; }
        float P = 1.f, H = 0.f;
#pragma unroll
        for (int j = 0; j < 16; ++j) { H = p[j] * H + he[j]; P *= p[j]; }
        xs[(F.wave * 2 + 0) * 64 + F.lane] = P; xs[(F.wave * 2 + 1) * 64 + F.lane] = H;
        __syncthreads();
        float h = 0.f;
        for (int s = 0; s < seg; ++s) { const int w2 = F.wave - seg + s; h = xs[(w2 * 2 + 0) * 64 + F.lane] * h + xs[(w2 * 2 + 1) * 64 + F.lane]; }
#pragma unroll
        for (int j = 0; j < 16; ++j) { const int k = seg * 16 + j, ck = sq * nck + (d ? nck - 1 - k : k); const size_t o = ((size_t)ck * 2 + d) * D + c; HIN[o] = h; h = p[j] * h + he[j]; }
        __syncthreads();
    }
}
__device__ __forceinline__ void p_rg_scan_c(const Frame& F0, const bf16* LA, const bf16* INP, const float* HIN, const bf16* GATE, bf16* Y) {
    const Frame F = phase_frame(F0);
    for (int it = F.gw; it < 128 * 16; it += F.ngw) {
        const int cb = it & 15, ck = it >> 4, c0 = cb * 128 + F.lane * 2;
        const size_t base = (size_t)ck * 64 * D + c0;
        const unsigned* la0 = (const unsigned*)(LA + base); const unsigned* ip0 = (const unsigned*)(INP + base);
        const unsigned* la1 = (const unsigned*)(LA + (size_t)TG * D + base); const unsigned* ip1 = (const unsigned*)(INP + (size_t)TG * D + base);
        const unsigned* gt = (const unsigned*)(GATE + base); unsigned* yo = (unsigned*)(Y + base);
        constexpr int RS = D / 2;
        f32x2 hf[64];
        { const f32x2 hi = *(const f32x2*)(HIN + ((size_t)ck * 2 + 0) * D + c0); float h0 = hi.x, h1 = hi.y;
          unsigned cl[8], cx[8];
#pragma unroll
          for (int j = 0; j < 8; ++j) { cl[j] = la0[(size_t)j * RS]; cx[j] = ip0[(size_t)j * RS]; }
#pragma unroll
          for (int blk = 0; blk < 8; ++blk) {
              unsigned nl[8], nx[8];
              if (blk < 7) {
#pragma unroll
                  for (int j = 0; j < 8; ++j) { const int t = 8 * (blk + 1) + j; nl[j] = la0[(size_t)t * RS]; nx[j] = ip0[(size_t)t * RS]; } }
              __builtin_amdgcn_sched_barrier(0);
#pragma unroll
              for (int j = 0; j < 8; ++j) { const unsigned lw = cl[j], iw = cx[j]; h0 = fexp2_(bflo(lw)) * h0 + bflo(iw); h1 = fexp2_(bfhi(lw)) * h1 + bfhi(iw); hf[8 * blk + j] = (f32x2){h0, h1}; }
#pragma unroll
              for (int j = 0; j < 8; ++j) { cl[j] = nl[j]; cx[j] = nx[j]; }
              __builtin_amdgcn_sched_barrier(0);
          } }
        { const f32x2 hi = *(const f32x2*)(HIN + ((size_t)ck * 2 + 1) * D + c0); float h0 = hi.x, h1 = hi.y;
          unsigned cl[8], cx[8], cg[8];
#pragma unroll
          for (int j = 0; j < 8; ++j) { const int t = 63 - j; cl[j] = la1[(size_t)t * RS]; cx[j] = ip1[(size_t)t * RS]; cg[j] = gt[(size_t)t * RS]; }
#pragma unroll
          for (int blk = 0; blk < 8; ++blk) {
              unsigned nl[8], nx[8], ng[8];
              if (blk < 7) {
#pragma unroll
                  for (int j = 0; j < 8; ++j) { const int t = 63 - (8 * (blk + 1) + j); nl[j] = la1[(size_t)t * RS]; nx[j] = ip1[(size_t)t * RS]; ng[j] = gt[(size_t)t * RS]; } }
              __builtin_amdgcn_sched_barrier(0);
#pragma unroll
              for (int j = 0; j < 8; ++j) { const int t = 63 - (8 * blk + j); const unsigned lw = cl[j], iw = cx[j], gw = cg[j];
                  h0 = fexp2_(bflo(lw)) * h0 + bflo(iw); h1 = fexp2_(bfhi(lw)) * h1 + bfhi(iw);
                  yo[(size_t)t * RS] = pk2((hf[t].x + h0) * bflo(gw), (hf[t].y + h1) * bfhi(gw)); }
#pragma unroll
              for (int j = 0; j < 8; ++j) { cl[j] = nl[j]; cx[j] = nx[j]; cg[j] = ng[j]; }
              __builtin_amdgcn_sched_barrier(0);
          } }
    }
}

constexpr int PB = 272;
__device__ __forceinline__ s16x4 tr_read(const LAS unsigned char* p) { return __builtin_bit_cast(s16x4, __builtin_amdgcn_ds_read_tr16_b64_v4i16((LAS v4i16_t*)p)); }
__device__ __forceinline__ bf16x8 cat8(s16x4 lo, s16x4 hi) { return __builtin_shufflevector(lo, hi, 0, 1, 2, 3, 4, 5, 6, 7); }
__device__ __forceinline__ bf16x8 scale8(bf16x8 v, const float* w) {
    const u32x4 u = __builtin_bit_cast(u32x4, v); u32x4 o;
    o.x = pk2(bflo(u.x) * w[0], bfhi(u.x) * w[1]); o.y = pk2(bflo(u.y) * w[2], bfhi(u.y) * w[3]); o.z = pk2(bflo(u.z) * w[4], bfhi(u.z) * w[5]); o.w = pk2(bflo(u.w) * w[6], bfhi(u.w) * w[7]);
    return __builtin_bit_cast(bf16x8, o);
}
__device__ __forceinline__ bf16x8 scale8s(bf16x8 v, float w) {
    const u32x4 u = __builtin_bit_cast(u32x4, v); u32x4 o;
    o.x = pk2(bflo(u.x) * w, bfhi(u.x) * w); o.y = pk2(bflo(u.y) * w, bfhi(u.y) * w); o.z = pk2(bflo(u.z) * w, bfhi(u.z) * w); o.w = pk2(bflo(u.w) * w, bfhi(u.w) * w);
    return __builtin_bit_cast(bf16x8, o);
}
__device__ __forceinline__ void stage_img(const Frame& F, const bf16* src, int ld, LAS unsigned char* img) {
#pragma unroll
    for (int i = 0; i < 4; ++i) { const int idx = F.tid + 512 * i, r = idx >> 4, ch = idx & 15; *(LAS u32x4*)(img + r * PB + ch * 16) = *(const u32x4*)(src + (size_t)r * ld + ch * 8); }
}
__device__ __forceinline__ void ssd_tables(const Frame& F, const float* DT, int t0, int head, float A0, float A1, LAS float* tab) {
    const int L = F.lane; const float* dp = DT + (size_t)(t0 + 2 * L) * 128 + head;
    const float a0 = dp[0], a1 = dp[128], b0 = dp[64], b1 = dp[128 + 64];
    float sa = a0 + a1, sb = b0 + b1, ia = sa, ib = sb;
#pragma unroll
    for (int o = 1; o < 64; o <<= 1) { const float xa = shfl_lane(ia, (L - o) & 63), xb = shfl_lane(ib, (L - o) & 63); if (L >= o) { ia += xa; ib += xb; } }
    const float totb = shfl_lane(ib, 63);
    const float ea = ia - sa, eb = ib - sb;
    tab[2 * L] = A0 * (ea + a0); tab[2 * L + 1] = A0 * (ea + a0 + a1);
    tab[128 + 2 * L] = A1 * (totb - eb); tab[128 + 2 * L + 1] = A1 * (totb - eb - b0);
    tab[256 + 2 * L] = a0; tab[256 + 2 * L + 1] = a1; tab[384 + 2 * L] = b0; tab[384 + 2 * L + 1] = b1;
}
__device__ __forceinline__ void p_ssd_dt(const Frame& F0, const bf16* XA, const bf16* Wdt  , const float* dtb, float* DT) {
    const Frame F = phase_frame(F0);
    LAS float* part = (LAS float*)F.lds;
    const int L = F.lane, g = L >> 4, l15 = L & 15;
    for (int rb = blockIdx.x; rb < TG / 32; rb += F.G) {
        const int r0 = rb * 32, kb = F.wave * 256;
        f32x4 acc[2][8];
#pragma unroll
        for (int m = 0; m < 2; ++m)
#pragma unroll
            for (int n = 0; n < 8; ++n) acc[m][n] = (f32x4){0.f, 0.f, 0.f, 0.f};
#pragma unroll 4
        for (int ks = 0; ks < 8; ++ks) {
            bf16x8 a[2], b[8];
#pragma unroll
            for (int m = 0; m < 2; ++m) a[m] = *(const bf16x8*)((const char*)XA + pg8::blk_off(r0 + 16 * m + l15, kb + 32 * ks + 8 * g, D, false));
#pragma unroll
            for (int n = 0; n < 8; ++n) b[n] = *(const bf16x8*)(Wdt + (size_t)(16 * n + l15) * D + kb + 32 * ks + 8 * g);
#pragma unroll
            for (int m = 0; m < 2; ++m)
#pragma unroll
                for (int n = 0; n < 8; ++n) acc[m][n] = __builtin_amdgcn_mfma_f32_16x16x32_bf16(a[m], b[n], acc[m][n], 0, 0, 0);
        }
#pragma unroll
        for (int m = 0; m < 2; ++m)
#pragma unroll
            for (int n = 0; n < 8; ++n)
#pragma unroll
                for (int e = 0; e < 4; ++e) part[(F.wave * 32 + 16 * m + 4 * g + e) * 128 + 16 * n + l15] = acc[m][n][e];
        __syncthreads();
        { const int row = F.tid >> 4, cb = (F.tid & 15) * 8;
          f32x4 s0 = *(const f32x4*)(dtb + cb), s1 = *(const f32x4*)(dtb + cb + 4);
#pragma unroll
          for (int w = 0; w < 8; ++w) { s0 += *(const LAS f32x4*)(part + (w * 32 + row) * 128 + cb); s1 += *(const LAS f32x4*)(part + (w * 32 + row) * 128 + cb + 4); }
#pragma unroll
          for (int j = 0; j < 4; ++j) { s0[j] = softplusf_(s0[j]); s1[j] = softplusf_(s1[j]); }
          float* o = DT + (size_t)(r0 + row) * 128 + cb; *(f32x4*)o = s0; *(f32x4*)(o + 4) = s1; }
        __syncthreads();
    }
}
__device__ __forceinline__ void p_ssd_states(const Frame& F0, const bf16* XT, const bf16* BMt, const float* DT, const float* alog, bf16* ST, float* DEC) {
    const Frame F = phase_frame(F0);
    LAS unsigned char* img = F.lds; LAS float* tab = (LAS float*)(F.lds + 36864 + F.wave * 2048);
    const int L = F.lane, h = L >> 5, l31 = L & 31, q = (L & 15) >> 2, p4 = L & 3, blk = (L >> 4) & 1;
    for (int it = blockIdx.x; it < 64 * 8; it += F.G) {
        const int c = it >> 3, g = it & 7, head = g * 8 + F.wave, t0 = c * 128;
        const bf16* xt = XT + (size_t)(c * 64 + head) * 64 * 128;
        bf16x8 xc[2][2];
#pragma unroll
        for (int k2 = 0; k2 < 2; ++k2)
#pragma unroll
            for (int pt = 0; pt < 2; ++pt) xc[k2][pt] = *(const bf16x8*)(xt + ((k2 * 2 + pt) * 64 + L) * 8);
        stage_img(F, BMt + (size_t)t0 * 1024 + g * 128, 1024, img);
        const float A0 = -1.4426950408889634f * __expf(alog[head]), A1 = -1.4426950408889634f * __expf(alog[64 + head]);
        ssd_tables(F, DT, t0, head, A0, A1, tab);
        __syncthreads();
        const float afe = tab[127], ab0 = tab[128];
        if (L == 0) { DEC[(c * 2 + 0) * 64 + head] = fexp2_(afe); DEC[(c * 2 + 1) * 64 + head] = fexp2_(ab0); }
#pragma unroll 1
        for (int dir = 0; dir < 2; ++dir) {
            f32x16 acc[4][2];
#pragma unroll
            for (int a = 0; a < 4; ++a)
#pragma unroll
                for (int b = 0; b < 2; ++b)
#pragma unroll
                    for (int r = 0; r < 16; ++r) acc[a][b][r] = 0.f;
            const float eref = dir ? ab0 : afe;
#pragma unroll 1
            for (int kp = 0; kp < 4; ++kp) {
                bf16x8 xn[2][2];
                { const int kn0 = (kp < 3) ? 2 * (kp + 1) : 0;
#pragma unroll
                  for (int k2 = 0; k2 < 2; ++k2)
#pragma unroll
                      for (int pt = 0; pt < 2; ++pt) xn[k2][pt] = *(const bf16x8*)(xt + (((kn0 + k2) * 2 + pt) * 64 + L) * 8); }
#pragma unroll
                for (int k2 = 0; k2 < 2; ++k2) {
                    const int ks = 2 * kp + k2, s0 = 16 * ks + 8 * h;
                    float w[8];
#pragma unroll
                    for (int j = 0; j < 8; ++j) w[j] = fexp2_(eref - tab[dir * 128 + s0 + j]) * tab[256 + dir * 128 + s0 + j];
                    bf16x8 bfr[2];
#pragma unroll
                    for (int pt = 0; pt < 2; ++pt) bfr[pt] = scale8(xc[k2][pt], w);
#pragma unroll
                    for (int nt = 0; nt < 4; ++nt) {
                        const LAS unsigned char* ad = img + (16 * ks + 8 * h + q) * PB + (32 * nt + 16 * blk + 4 * p4) * 2;
                        const bf16x8 afr = cat8(tr_read(ad), tr_read(ad + 4 * PB));
#pragma unroll
                        for (int pt = 0; pt < 2; ++pt) acc[nt][pt] = __builtin_amdgcn_mfma_f32_32x32x16_bf16(afr, bfr[pt], acc[nt][pt], 0, 0, 0);
                    }
                }
#pragma unroll
                for (int k2 = 0; k2 < 2; ++k2)
#pragma unroll
                    for (int pt = 0; pt < 2; ++pt) xc[k2][pt] = xn[k2][pt];
            }
            bf16* st = ST + ((size_t)(c * 2 + dir) * 64 + head) * 8192;
#pragma unroll
            for (int nt = 0; nt < 4; ++nt)
#pragma unroll
                for (int pt = 0; pt < 2; ++pt)
#pragma unroll
                    for (int qd = 0; qd < 4; ++qd) { u32x2 w2; w2.x = pk2(acc[nt][pt][4 * qd], acc[nt][pt][4 * qd + 1]); w2.y = pk2(acc[nt][pt][4 * qd + 2], acc[nt][pt][4 * qd + 3]);
                        *(u32x2*)(st + (((2 * nt + (qd >> 1)) * 2 + pt) * 64 + l31 + 32 * (qd & 1)) * 8 + 4 * h) = w2; }
        }
        __syncthreads();
    }
}
__device__ __forceinline__ void p_ssd_rec(const Frame& F0, bf16* ST, const float* __restrict__ DEC, int L) {
    const Frame F = phase_frame(F0);
    const int nck = L / 128, nseq = TG / L, total = nseq * 131072;
    for (int e = F.gw * 64 + F.lane; e < total; e += F.ngw * 64) {
        const int oct = e & 1023, head = (e >> 10) & 63, dir = (e >> 16) & 1, sq = e >> 17;
        float hst[8];
#pragma unroll
        for (int j = 0; j < 8; ++j) hst[j] = 0.f;
        for (int k0 = 0; k0 < nck; k0 += 8) {
            u32x4 v[8]; float dec[8];
#pragma unroll
            for (int j = 0; j < 8; ++j) { const int k = k0 + j, c = sq * nck + (dir ? nck - 1 - k : k);
                v[j] = *(const u32x4*)(ST + ((size_t)(c * 2 + dir) * 64 + head) * 8192 + oct * 8); dec[j] = DEC[(c * 2 + dir) * 64 + head]; }
#pragma unroll
            for (int j = 0; j < 8; ++j) { const int k = k0 + j, c = sq * nck + (dir ? nck - 1 - k : k);
                u32x4 o; o.x = pk2(hst[0], hst[1]); o.y = pk2(hst[2], hst[3]); o.z = pk2(hst[4], hst[5]); o.w = pk2(hst[6], hst[7]);
                *(u32x4*)(ST + ((size_t)(c * 2 + dir) * 64 + head) * 8192 + oct * 8) = o;
                const float dc = dec[j]; const u32x4 x = v[j];
                hst[0] = hst[0] * dc + bflo(x.x); hst[1] = hst[1] * dc + bfhi(x.x); hst[2] = hst[2] * dc + bflo(x.y); hst[3] = hst[3] * dc + bfhi(x.y);
                hst[4] = hst[4] * dc + bflo(x.z); hst[5] = hst[5] * dc + bfhi(x.z); hst[6] = hst[6] * dc + bflo(x.w); hst[7] = hst[7] * dc + bfhi(x.w); }
        }
    }
}
__device__ __forceinline__ void p_ssd_out(const Frame& F0, const bf16* XT, const bf16* BMt, const bf16* CMt, const float* DT, const float* alog, const float* dskip, const bf16* ST,
                                          const bf16* ZS, const float* ng, bf16* Y) {
    const Frame F = phase_frame(F0);
    LAS unsigned char* imgB = F.lds; LAS unsigned char* imgC = F.lds + 34816; LAS float* tab = (LAS float*)(F.lds + 69632 + F.wave * 2048); LAS float* part = (LAS float*)(F.lds + 69632 + 16384);
    const int L0 = F.lane;
    for (int it = blockIdx.x; it < 64 * 8; it += F.G) {
        const int c = it >> 3, g = it & 7, head = g * 8 + F.wave, t0 = c * 128;
        stage_img(F, BMt + (size_t)t0 * 1024 + g * 128, 1024, imgB);
        stage_img(F, CMt + (size_t)t0 * 1024 + g * 128, 1024, imgC);
        const float A0 = -1.4426950408889634f * __expf(alog[head]), A1 = -1.4426950408889634f * __expf(alog[64 + head]), dsk = dskip[head];
        ssd_tables(F, DT, t0, head, A0, A1, tab);
        __syncthreads();
        const bf16* xt = XT + (size_t)(c * 64 + head) * 64 * 128;
#pragma unroll 1
        for (int half = 0; half < 2; ++half) {
            f32x16 acc[2][2];
#pragma unroll
            for (int a = 0; a < 2; ++a)
#pragma unroll
                for (int b = 0; b < 2; ++b)
#pragma unroll
                    for (int r = 0; r < 16; ++r) acc[a][b][r] = 0.f;
            { int L = L0; asm volatile("" : "+v"(L)); const int h = L >> 5, l31 = L & 31;
#pragma unroll 1
            for (int st = 0; st < 4; ++st) {
                bf16x8 xa[2][2];
#pragma unroll
                for (int ks = 0; ks < 2; ++ks)
#pragma unroll
                    for (int pt = 0; pt < 2; ++pt) { const bf16* xp = xt + (((2 * st + ks) * 2 + pt) * 64 + l31) * 8 + 4 * h;
                        const s16x4 lo = *(const s16x4*)xp, hi = *(const s16x4*)(xp + 32 * 8); xa[ks][pt] = cat8(lo, hi); }
#pragma unroll
                for (int tt = 0; tt < 2; ++tt) {
                    const int tg = 2 * half + tt;
                    f32x16 dg;
#pragma unroll
                    for (int r = 0; r < 16; ++r) dg[r] = 0.f;
#pragma unroll 2
                    for (int kn = 0; kn < 8; ++kn) { const bf16x8 a = *(const LAS bf16x8*)(imgB + (32 * st + l31) * PB + (16 * kn + 8 * h) * 2), b = *(const LAS bf16x8*)(imgC + (32 * tg + l31) * PB + (16 * kn + 8 * h) * 2);
                        dg = __builtin_amdgcn_mfma_f32_32x32x16_bf16(a, b, dg, 0, 0, 0); }
                    const int t = 32 * tg + l31; const float aft = tab[t], abt = tab[128 + t];
                    float v[16];
#pragma unroll
                    for (int qd = 0; qd < 4; ++qd) { const int sb = 32 * st + 8 * qd + 4 * h;
                        const f32x4 afs = *(const LAS f32x4*)(tab + sb), abs_ = *(const LAS f32x4*)(tab + 128 + sb), d0 = *(const LAS f32x4*)(tab + 256 + sb), d1 = *(const LAS f32x4*)(tab + 384 + sb);
                        if (st < tg) {
#pragma unroll
                            for (int e = 0; e < 4; ++e) v[4 * qd + e] = dg[4 * qd + e] * (fexp2_(aft - afs[e]) * d0[e]);
                        } else if (st > tg) {
#pragma unroll
                            for (int e = 0; e < 4; ++e) v[4 * qd + e] = dg[4 * qd + e] * (fexp2_(abt - abs_[e]) * d1[e]);
                        } else {
#pragma unroll
                            for (int e = 0; e < 4; ++e) { const int s = sb + e; float m = 0.f;
                                if (s <= t) m += fexp2_(aft - afs[e]) * d0[e];
                                if (s >= t) m += fexp2_(abt - abs_[e]) * d1[e];
                                float x = dg[4 * qd + e] * m; if (s == t) x += dsk; v[4 * qd + e] = x; } } }
                    bf16x8 gf[2];
#pragma unroll
                    for (int ks = 0; ks < 2; ++ks) { u32x4 o; o.x = pk2(v[8 * ks], v[8 * ks + 1]); o.y = pk2(v[8 * ks + 2], v[8 * ks + 3]); o.z = pk2(v[8 * ks + 4], v[8 * ks + 5]); o.w = pk2(v[8 * ks + 6], v[8 * ks + 7]); gf[ks] = __builtin_bit_cast(bf16x8, o); }
#pragma unroll
                    for (int pt = 0; pt < 2; ++pt)
#pragma unroll
                        for (int ks = 0; ks < 2; ++ks) acc[tt][pt] = __builtin_amdgcn_mfma_f32_32x32x16_bf16(xa[ks][pt], gf[ks], acc[tt][pt], 0, 0, 0);
                }
            }
            }
            { int L = L0; asm volatile("" : "+v"(L)); const int h = L >> 5, l31 = L & 31;
            const bf16* hs0 = ST + ((size_t)(c * 2) * 64 + head) * 8192;
            const unsigned hvo = (unsigned)L * 16u;
            bf16x8 hb[2][4][2];
#define SO_HLD(q, btv) do { const bf16* sb_ = hs0 + (size_t)((btv) >> 1) * 64 * 8192 + ((btv) & 1) * 4096 + 2048; \
                _Pragma("unroll") for (int k4 = 0; k4 < 4; ++k4) _Pragma("unroll") for (int pt = 0; pt < 2; ++pt) \
                    asm volatile("global_load_dwordx4 %0, %1, %2 offset:%3" : "=&v"(hb[q][k4][pt]) : "v"(hvo), "s"(sb_), "n"((2 * k4 + pt) * 1024 - 4096) : "memory"); } while (0)
#define SO_HWAIT(q, cnt) asm volatile("s_waitcnt vmcnt(" #cnt ")" : "+v"(hb[q][0][0]), "+v"(hb[q][0][1]), "+v"(hb[q][1][0]), "+v"(hb[q][1][1]), "+v"(hb[q][2][0]), "+v"(hb[q][2][1]), "+v"(hb[q][3][0]), "+v"(hb[q][3][1]) :: "memory")
            SO_HLD(0, 0);
#pragma unroll
            for (int bt = 0; bt < 4; ++bt) {
                const int dir = bt >> 1, kh = bt & 1;
                if (bt < 3) { SO_HLD((bt + 1) & 1, bt + 1); SO_HWAIT(bt & 1, 8); } else { SO_HWAIT(bt & 1, 0); }
                float et[2];
#pragma unroll
                for (int tt = 0; tt < 2; ++tt) et[tt] = fexp2_(tab[dir * 128 + 32 * (2 * half + tt) + l31]);
#pragma unroll
                for (int k4 = 0; k4 < 4; ++k4) { const int kn = 4 * kh + k4;
#pragma unroll
                    for (int tt = 0; tt < 2; ++tt) { const bf16x8 cb = scale8s(*(const LAS bf16x8*)(imgC + (32 * (2 * half + tt) + l31) * PB + (16 * kn + 8 * h) * 2), et[tt]);
#pragma unroll
                        for (int pt = 0; pt < 2; ++pt) acc[tt][pt] = __builtin_amdgcn_mfma_f32_32x32x16_bf16(hb[bt & 1][k4][pt], cb, acc[tt][pt], 0, 0, 0); }
                }
                __builtin_amdgcn_sched_barrier(0);
            }
#undef SO_HLD
#undef SO_HWAIT
            }
            { int L = L0; asm volatile("" : "+v"(L)); const int h = L >> 5, l31 = L & 31, lr8 = L >> 3, lp8 = L & 7;
              LAS unsigned char* wt = F.lds + 88064 + F.wave * 4608;
              u32x4 zl[2][4]; f32x4 gw[2][4];
#pragma unroll
              for (int tt = 0; tt < 2; ++tt)
#pragma unroll
                  for (int i = 0; i < 4; ++i) zl[tt][i] = *(const u32x4*)(ZS + ((size_t)(t0 + 32 * (2 * half + tt)) + lr8 + 8 * i) * SSD_DI + head * 64 + lp8 * 8);
#pragma unroll
              for (int pt = 0; pt < 2; ++pt)
#pragma unroll
                  for (int qd = 0; qd < 4; ++qd) gw[pt][qd] = *(const f32x4*)(ng + head * 64 + 32 * pt + 8 * qd + 4 * h);
              asm volatile("" ::: "memory");
#pragma unroll
            for (int tt = 0; tt < 2; ++tt) { float ssq = 0.f;
#pragma unroll
                for (int i = 0; i < 4; ++i) *(LAS u32x4*)(wt + (lr8 + 8 * i) * 144 + lp8 * 16) = zl[tt][i];
                asm volatile("s_waitcnt lgkmcnt(0)" ::: "memory");
#pragma unroll
                for (int pt = 0; pt < 2; ++pt)
#pragma unroll
                    for (int qd = 0; qd < 4; ++qd) { const u32x2 z = *(const LAS u32x2*)(wt + l31 * 144 + (32 * pt + 8 * qd + 4 * h) * 2);
                        const float y0 = acc[tt][pt][4 * qd] * bflo(z.x), y1 = acc[tt][pt][4 * qd + 1] * bfhi(z.x), y2 = acc[tt][pt][4 * qd + 2] * bflo(z.y), y3 = acc[tt][pt][4 * qd + 3] * bfhi(z.y);
                        acc[tt][pt][4 * qd] = y0; acc[tt][pt][4 * qd + 1] = y1; acc[tt][pt][4 * qd + 2] = y2; acc[tt][pt][4 * qd + 3] = y3; ssq += (y0 * y0 + y1 * y1) + (y2 * y2 + y3 * y3); }
                asm volatile("s_waitcnt lgkmcnt(0)" ::: "memory");
                ssq += shfl_lane(ssq, L ^ 32);
                if (h == 0) part[F.wave * 64 + 32 * tt + l31] = ssq; }
            __syncthreads();
#pragma unroll
            for (int tt = 0; tt < 2; ++tt) { const int tl = 32 * tt + l31; const size_t rowb = (size_t)(t0 + 64 * half + 32 * tt); float tot = 0.f;
#pragma unroll
                for (int w = 0; w < 8; ++w) tot += part[w * 64 + tl];
                const float rstd = rsqrtf(tot * (1.0f / 512.0f) + LN_EPS);
#pragma unroll
                for (int pt = 0; pt < 2; ++pt)
#pragma unroll
                    for (int qd = 0; qd < 4; ++qd) { const f32x4 gg = gw[pt][qd];
                        u32x2 o; o.x = pk2(acc[tt][pt][4 * qd] * rstd * gg.x, acc[tt][pt][4 * qd + 1] * rstd * gg.y); o.y = pk2(acc[tt][pt][4 * qd + 2] * rstd * gg.z, acc[tt][pt][4 * qd + 3] * rstd * gg.w);
                        *(LAS u32x2*)(wt + l31 * 144 + (32 * pt + 8 * qd + 4 * h) * 2) = o; }
                asm volatile("s_waitcnt lgkmcnt(0)" ::: "memory");
#pragma unroll
                for (int i = 0; i < 4; ++i) *(u32x4*)(Y + (rowb + lr8 + 8 * i) * SSD_DI + head * 64 + lp8 * 8) = *(const LAS u32x4*)(wt + (lr8 + 8 * i) * 144 + lp8 * 16);
                asm volatile("s_waitcnt lgkmcnt(0)" ::: "memory"); }
            }
            __syncthreads();
        }
    }
}

constexpr int NA_STG = 2 * 64 * PB;
__device__ __forceinline__ void p_natt(const Frame& F0, const bf16* Q, const bf16* Kb, const bf16* V, const float* rpb, bf16* O, int L) {
    const Frame F = phase_frame(F0);
    LAS unsigned char* ringb = F.lds;
    LAS float* rp = (LAS float*)(F.lds + 3 * NA_STG);
    const int Ln = F.lane, g = Ln >> 4, l15 = Ln & 15, q4 = l15 >> 2, p4 = Ln & 3;
    const int rps = L / 64, nrb = 128 / 4;
    const int wrow = F.wave >> 1, chf = F.wave & 1;
    for (int it = blockIdx.x; it < nrb * 16; it += F.G) {
        const int head = it & 15, rb = it >> 4, grow0 = rb * 4, sq = grow0 / rps, r0 = grow0 % rps;
        const size_t rowbase = (size_t)sq * rps * 64;
        int klo = r0 - 4; klo = klo < 0 ? 0 : (klo > rps - 8 ? rps - 8 : klo);
        int khi = r0 + 3 - 4; khi = khi < 0 ? 0 : (khi > rps - 8 ? rps - 8 : khi); khi += 7;
        const int nst = khi - klo + 1;
        const int r = r0 + wrow; int rs = r - 4; rs = rs < 0 ? 0 : (rs > rps - 8 ? rps - 8 : rs);
        u32x4 st0[4], st1[4];
        auto gload = [&](u32x4 (&d)[4], int s) {
#pragma unroll
            for (int i = 0; i < 2; ++i) { const int idx = F.tid + 512 * i, key = idx >> 4, ch = idx & 15; const size_t off = (rowbase + (size_t)(klo + s) * 64 + key) * D + head * 128 + ch * 8;
                d[i] = *(const u32x4*)(Kb + off); d[2 + i] = *(const u32x4*)(V + off); } };
        auto lstore = [&](const u32x4 (&d)[4], int s) { LAS unsigned char* b = ringb + (s % 3) * NA_STG;
#pragma unroll
            for (int i = 0; i < 2; ++i) { const int idx = F.tid + 512 * i, key = idx >> 4, ch = idx & 15; *(LAS u32x4*)(b + key * PB + ch * 16) = d[i]; *(LAS u32x4*)(b + 64 * PB + key * PB + ch * 16) = d[2 + i]; } };
        gload(st0, 0); gload(st1, 1);
        float rpv = 0.f; if (F.tid < 465) rpv = rpb[(size_t)head * 465 + F.tid];
        bf16x8 qf[2][4];
#pragma unroll
        for (int jt = 0; jt < 2; ++jt)
#pragma unroll
            for (int kd = 0; kd < 4; ++kd) qf[jt][kd] = *(const bf16x8*)(Q + (rowbase + (size_t)r * 64 + 16 * (2 * chf + jt) + l15) * D + head * 128 + 32 * kd + 8 * g);
        lstore(st0, 0); lstore(st1, 1);
        if (F.tid < 465) rp[F.tid] = rpv;
        gload(st0, 2); if (nst > 3) gload(st1, 3);
        float mrun[2] = {-3.0e38f, -3.0e38f}, lrun[2] = {0.f, 0.f};
        f32x4 oacc[2][8];
#pragma unroll
        for (int jt = 0; jt < 2; ++jt)
#pragma unroll
            for (int dt = 0; dt < 8; ++dt) oacc[jt][dt] = (f32x4){0.f, 0.f, 0.f, 0.f};
        __syncthreads();
#pragma unroll 1
        for (int s = 0; s < nst; ++s) {
            const int kr = klo + s;
            const LAS unsigned char* kb = ringb + (s % 3) * NA_STG; const LAS unsigned char* vb = kb + 64 * PB;
            if (kr >= rs && kr <= rs + 7) {
                const int dy = kr - r + 7;
                int Lq = Ln; asm volatile("" : "+v"(Lq));
                const int g = Lq >> 4, l15 = Lq & 15, q4 = l15 >> 2, p4 = Lq & 3;
#pragma unroll
                for (int jt = 0; jt < 2; ++jt) {
                    const int j = 2 * chf + jt, kstart = (j == 0) ? 0 : (j == 1 ? 8 : (j == 2 ? 24 : 32)), qcol = 16 * j + l15;
                    int wst = qcol - 8; wst = wst < 0 ? 0 : (wst > 48 ? 48 : wst);
                    f32x4 sA = {0.f, 0.f, 0.f, 0.f}, sB = {0.f, 0.f, 0.f, 0.f};
                    const LAS unsigned char* ka = kb + (kstart + 8 * q4 + p4) * PB + 16 * g;
#pragma unroll
                    for (int kd = 0; kd < 4; ++kd) { const bf16x8 fa = *(const LAS bf16x8*)(ka + 64 * kd), fb = *(const LAS bf16x8*)(ka + 4 * PB + 64 * kd);
                        sA = __builtin_amdgcn_mfma_f32_16x16x32_bf16(fa, qf[jt][kd], sA, 0, 0, 0); sB = __builtin_amdgcn_mfma_f32_16x16x32_bf16(fb, qf[jt][kd], sB, 0, 0, 0); }
                    float sv[8]; float mx = mrun[jt];
                    const LAS float* rpq = rp + dy * 31 + (kstart + 8 * g - qcol + 15); const unsigned wrel = (unsigned)(kstart + 8 * g - wst);
#pragma unroll
                    for (int e = 0; e < 8; ++e) { const bool ok = (wrel + (unsigned)e) < 16u;
                        const float x = (e < 4 ? sA[e] : sB[e - 4]) + rpq[e]; sv[e] = ok ? x : -3.0e38f; mx = fmaxf(mx, sv[e]); }
                    mx = fmaxf(mx, shfl_lane(mx, Lq ^ 16)); mx = fmaxf(mx, shfl_lane(mx, Lq ^ 32));
                    float alpha = 1.0f;
                    if (__builtin_amdgcn_ballot_w64(mx > mrun[jt] + 8.0f) != 0ull) { alpha = __expf(mrun[jt] - mx); mrun[jt] = mx;
#pragma unroll
                        for (int dt = 0; dt < 8; ++dt) oacc[jt][dt] = oacc[jt][dt] * alpha; }
                    mx = mrun[jt];
                    float ps = 0.f;
#pragma unroll
                    for (int e = 0; e < 8; ++e) { sv[e] = __expf(sv[e] - mx); ps += sv[e]; }
                    ps += shfl_lane(ps, Lq ^ 16); ps += shfl_lane(ps, Lq ^ 32);
                    lrun[jt] = lrun[jt] * alpha + ps;
                    u32x4 pw; pw.x = pk2(sv[0], sv[1]); pw.y = pk2(sv[2], sv[3]); pw.z = pk2(sv[4], sv[5]); pw.w = pk2(sv[6], sv[7]);
                    const bf16x8 pf = __builtin_bit_cast(bf16x8, pw);
                    const LAS unsigned char* va = vb + (kstart + 8 * g + q4) * PB + 8 * p4;
#pragma unroll
                    for (int dt = 0; dt < 8; ++dt) { const bf16x8 vf = cat8(tr_read(va + 32 * dt), tr_read(va + 4 * PB + 32 * dt));
                        oacc[jt][dt] = __builtin_amdgcn_mfma_f32_16x16x32_bf16(vf, pf, oacc[jt][dt], 0, 0, 0); }
                }
            }
            if (s + 2 < nst) { if (s & 1) lstore(st1, s + 2); else lstore(st0, s + 2); }
            if (s + 4 < nst) { if (s & 1) gload(st1, s + 4); else gload(st0, s + 4); }
            __syncthreads();
        }
#pragma unroll
        for (int jt = 0; jt < 2; ++jt) { const float inv = frcp_(lrun[jt]); bf16* op = O + (rowbase + (size_t)r * 64 + 16 * (2 * chf + jt) + l15) * D + head * 128 + 4 * g;
#pragma unroll
            for (int dt = 0; dt < 8; ++dt) { u32x2 o; o.x = pk2(oacc[jt][dt][0] * inv, oacc[jt][dt][1] * inv); o.y = pk2(oacc[jt][dt][2] * inv, oacc[jt][dt][3] * inv); *(u32x2*)(op + 16 * dt) = o; } }
    }
}

struct Args { const float* in[29]; float* out; unsigned char* ws; int g_lo, g_hi, l_lo, l_hi, ph, pad; };

__global__ void __launch_bounds__(NTHR, 2) enc_fwd(Args args) {
    extern __shared__ __attribute__((aligned(16))) unsigned char lds[];
    Frame F;
    F.lds = (LAS unsigned char*)lds;
    F.tid = threadIdx.x; F.lane = F.tid & 63; F.wave = __builtin_amdgcn_readfirstlane(F.tid >> 6);
    F.G = gridDim.x; F.gw = F.wave * F.G + (int)blockIdx.x; F.ngw = F.G * NWAVES;
    unsigned char* ws = args.ws;
    gu32* ctl = (gu32*)(ws + WS_CTL);
    for (int u = F.tid; u < (LDS_BYTES - LDSCTL_OFF) / 4; u += NTHR) ((LAS unsigned*)(F.lds + LDSCTL_OFF))[u] = 0u;
    __syncthreads();
    const int ph = args.ph;
    XcdBarrier bar; bar.bar = (unsigned*)(ctl + CW_BAR); bar.x = 0; bar.st = nullptr;
    if (ph < 0) bar = xcd_barrier_post((unsigned*)(ctl + CW_BAR), (volatile LAS unsigned*)(F.lds + MISC_OFF) + 8);
#ifndef PROBE_TMASK
#define PROBE_TMASK 0ull
#endif
    unsigned long long tp0 = 0ull, tpacc = 0ull; int tph = 0;
#define RUN(k) ((ph < 0 || ph == (k)) && (tph = (k), tp0 = (PROBE_TMASK ? __builtin_amdgcn_s_memrealtime() : 0ull), true))
#ifndef PROBE_MASK
#define PROBE_MASK 0
#endif
#define NREP(bit) (((PROBE_MASK >> (bit)) & 1) ? 2 : 1)
#define REPEAT(bit) _Pragma("unroll 1") for (int rep = 0; rep < NREP(bit); ++rep)
    float* XDUM = (float*)(ws + WS_SCR + S_DUM); bf16* XBDUM = (bf16*)(ws + WS_SCR + S_DUM + 64 * MiB);
#ifndef PROBE_GPART
#define PROBE_GPART 0
#endif
#define TMODE() ((PROBE_GPART && (((unsigned long long)PROBE_TMASK >> tph) & 1ull)) ? PROBE_GPART : 0)
#define GRID_BAR() do { if (ph < 0) xcd_barrier(bar); if (PROBE_TMASK && !PROBE_GPART && (((unsigned long long)PROBE_TMASK >> tph) & 1ull)) tpacc += __builtin_amdgcn_s_memrealtime() - tp0; } while (0)

    bf16* Wb = (bf16*)(ws + WS_W);
    unsigned char* scr = ws + WS_SCR;
    bf16* XB = (bf16*)(scr + S_XB); bf16* YB = (bf16*)(scr + S_YB); bf16* HB = (bf16*)(scr + S_HID);
    LAS unsigned char* ring = F.lds;

    if (RUN(0) && args.g_lo == 0 && args.l_lo == 0) { p_prologue(F, args.in, Wb, (float*)(ws + WS_SPT), (bf16*)(scr + S_XB0)); GRID_BAR(); }

    for (int grp = args.g_lo; grp < args.g_hi; ++grp) {
        float* X = args.out + (size_t)grp * TG * D;
        const int L = grp < 2 ? 2048 : 8192;
        const float* Xin0 = grp < 2 ? args.in[0] + (size_t)grp * TG * D : args.in[1] + (size_t)(grp - 2) * TG * D;
        const bf16* XB0g = (const bf16*)(scr + S_XB0) + (size_t)grp * TG * D;
        for (int layer = args.l_lo; layer < args.l_hi; ++layer) {
            const int kind = layer % 3, jl = layer / 3;
            int Kout = 2048; const bf16* Wout; const bf16* XA = layer == 0 ? XB0g : XB;
            if (kind == 0) {
                bf16* GATE = (bf16*)(scr + S_RG_GATE); bf16* URAW = (bf16*)(scr + S_RG_URAW); bf16* LA = (bf16*)(scr + S_RG_LA); bf16* INP = (bf16*)(scr + S_RG_INP);
                float* HEND = (float*)(scr + S_RG_HEND); float* PROD = (float*)(scr + S_RG_PROD); float* HIN = (float*)(scr + S_RG_HIN);
                if (RUN(10)) REPEAT(1) { pg8::Gemm g{XA, Wb + W_RGIN + (size_t)jl * 4096 * 2048, 2048, 2048, 1}; pg8::StaticOrder S; S.init(TG, 4096, F.G, (int)blockIdx.x);
                    pg8::EpiRgIn E{GATE, URAW}; pg8::gemm_phase<pg8::EpiRgIn>(ring, g, S, E, tpacc, TMODE()); GRID_BAR(); }
                if (RUN(11)) { p_rg_fused(F, URAW, L, args.in[3] + (size_t)jl * 4 * 2048, args.in[4] + (size_t)jl * 2048, Wb + W_RGGATE + (size_t)jl * 32 * 65536,
                                          args.in[6] + (size_t)jl * 2 * 2048, args.in[8] + (size_t)jl * 2 * 2048, (const float*)(ws + WS_SPT) + (size_t)jl * 2 * 2048, LA, INP, HEND, PROD); GRID_BAR(); }
                if (RUN(14)) REPEAT(3) { p_rg_scan_b(F, HEND, PROD, HIN, L); GRID_BAR(); }
                if (RUN(15)) REPEAT(3) { p_rg_scan_c(F, LA, INP, HIN, GATE, YB); GRID_BAR(); }
                Wout = Wb + W_RGOUT + (size_t)jl * 2048 * 2048;
            } else if (kind == 1) {
                bf16* ZS = (bf16*)(scr + S_SSD_ZS); bf16* XBCR = (bf16*)(scr + S_SSD_XBCR); bf16* XT = (bf16*)(scr + S_SSD_XT); bf16* BMt = (bf16*)(scr + S_SSD_BM); bf16* CMt = (bf16*)(scr + S_SSD_CM);
                float* DT = (float*)(scr + S_SSD_DT); float* DEC = (float*)(scr + S_SSD_DEC); bf16* ST = (bf16*)(scr + S_SSD_ST);
                if (RUN(20)) REPEAT(1) { pg8::Gemm g{XA, Wb + W_SSDIN, 2048, 2048, 1}; pg8::StaticOrder S; S.init(TG, 40 * 256, F.G, (int)blockIdx.x);
                    pg8::EpiSsdIn E{ZS, XBCR}; pg8::gemm_phase<pg8::EpiSsdIn>(ring, g, S, E, tpacc, TMODE()); GRID_BAR(); }
                if (RUN(21)) REPEAT(4) { p_ssd_dt(F, XA, Wb + W_SSDIN + (size_t)10240 * 2048, args.in[14], DT); p_conv_ssd(F, XBCR, L, args.in[12], args.in[13], XT, BMt, CMt); GRID_BAR(); }
                if (RUN(22)) REPEAT(4) { p_ssd_states(F, XT, BMt, DT, args.in[15], ST, DEC); GRID_BAR(); }
                if (RUN(23)) { p_ssd_rec(F, ST, DEC, L); GRID_BAR(); }
                if (RUN(24)) REPEAT(4) { p_ssd_out(F, XT, BMt, CMt, DT, args.in[15], args.in[16], ST, ZS, args.in[17], YB); GRID_BAR(); }
                Wout = Wb + W_SSDOUT; Kout = 4096;
            } else {
                bf16* Qb = (bf16*)(scr + S_NA_Q); bf16* Kb = (bf16*)(scr + S_NA_K); bf16* Vb = (bf16*)(scr + S_NA_V);
                if (RUN(30)) REPEAT(1) { pg8::Gemm g{XA, Wb + W_NAQKV, 2048, 2048, 1}; pg8::StaticOrder S; S.init(TG, 6144, F.G, (int)blockIdx.x);
                    pg8::EpiQkv E{Qb, args.in[20]}; pg8::gemm_phase<pg8::EpiQkv>(ring, g, S, E, tpacc, TMODE()); GRID_BAR(); }
                if (RUN(31)) REPEAT(5) { p_natt(F, Qb, Kb, Vb, args.in[21], YB, L); GRID_BAR(); }
                Wout = Wb + W_NAOUT;
            }
            unsigned long long* xslot = (unsigned long long*)(ws + WS_XSLOT); unsigned* pcnt = (unsigned*)(ctl + CW_SEAM); unsigned* ptmo = (unsigned*)(ctl + CW_TMO);
            const unsigned ep = (unsigned)((grp * DEPTH + layer) * 2);
            if (RUN(40)) { pg8::Gemm g{YB, Wout, Kout, Kout, 0}; pg8::StaticOrder S; S.init(TG, D, F.G, (int)blockIdx.x);
                pg8::EpiResidLn<false> E{XA, nullptr, XB, args.in[25] + (size_t)layer * D, args.in[26] + (size_t)layer * D, ALPHA, xslot, pcnt, 64u * (ep + 1u), ptmo};
                pg8::gemm_phase<pg8::EpiResidLn<false>>(ring, g, S, E, tpacc, TMODE()); GRID_BAR(); }
            if (RUN(42)) REPEAT(6) { pg8::Gemm g{XB, Wb + W_UP + (size_t)layer * 8192 * 2048, 2048, 2048, 1}; pg8::StaticOrder S; S.init(TG, HID, F.G, (int)blockIdx.x, WGM_UP);
                pg8::EpiRelu2 E{HB, HID}; pg8::gemm_phase<pg8::EpiRelu2>(ring, g, S, E, tpacc, TMODE()); GRID_BAR(); }
            if (RUN(43)) { pg8::Gemm g{HB, Wb + W_DOWN + (size_t)layer * 2048 * 8192, 8192, 8192, 1}; pg8::StaticOrder S; S.init(TG, D, F.G, (int)blockIdx.x, WGM_DOWN);
                if (layer == DEPTH - 1) { pg8::EpiResidLn<true> E{XB, X, nullptr, args.in[27] + (size_t)layer * D, args.in[28] + (size_t)layer * D, ALPHA, xslot, pcnt, 64u * (ep + 2u), ptmo};
                    pg8::gemm_phase<pg8::EpiResidLn<true>>(ring, g, S, E, tpacc, TMODE()); }
                else { pg8::EpiResidLn<false> E{XB, nullptr, XB, args.in[27] + (size_t)layer * D, args.in[28] + (size_t)layer * D, ALPHA, xslot, pcnt, 64u * (ep + 2u), ptmo};
                    pg8::gemm_phase<pg8::EpiResidLn<false>>(ring, g, S, E, tpacc, TMODE()); }
                GRID_BAR(); }
        }
    }
    if (PROBE_TMASK && blockIdx.x == 0) { const unsigned long long te = __builtin_amdgcn_s_memrealtime(); while (__builtin_amdgcn_s_memrealtime() - te < tpacc) __builtin_amdgcn_s_sleep(8); }
#undef RUN
#undef GRID_BAR
}

extern "C" void kernel_launch(void* const* d_in, const int* in_sizes, int n_in, void* d_out, int out_size, void* d_ws, size_t ws_size, hipStream_t stream) {
    static int grid = 0;
    if (grid == 0) {
        if (n_in != 29 || out_size != NGROUP * TG * D || ws_size < WS_NEED) { fprintf(stderr, "kernel_launch: unexpected problem (n_in %d, out %d, ws %zu, need %zu)\n", n_in, out_size, ws_size, (size_t)WS_NEED); grid = -1; return; }
        int dev = 0, cus = 0, per_cu = 0;
        if (hipGetDevice(&dev) != hipSuccess || hipDeviceGetAttribute(&cus, hipDeviceAttributeMultiprocessorCount, dev) != hipSuccess) { grid = -1; return; }
        if (hipFuncSetAttribute((const void*)enc_fwd, hipFuncAttributeMaxDynamicSharedMemorySize, LDS_BYTES) != hipSuccess) { fprintf(stderr, "kernel_launch: hipFuncSetAttribute failed\n"); grid = -1; return; }
        if (hipOccupancyMaxActiveBlocksPerMultiprocessor(&per_cu, (const void*)enc_fwd, NTHR, LDS_BYTES) != hipSuccess || per_cu < 1) { fprintf(stderr, "kernel_launch: occupancy query says %d\n", per_cu); }
        (void)hipGetLastError();
        grid = cus;
        if (grid != 256) { fprintf(stderr, "kernel_launch: built for 256 CUs (one 256x256 tile per workgroup in the fused LayerNorm phases), got %d\n", cus); grid = -1; return; }
    }
    if (grid < 0) return;
    (void)hipMemsetAsync((char*)d_ws + WS_CTL, 0, CTL_ZERO_BYTES, stream);
    Args a{};
    for (int i = 0; i < 29; ++i) a.in[i] = (const float*)d_in[i];
    a.out = (float*)d_out; a.ws = (unsigned char*)d_ws; a.pad = 0;
    a.g_lo = 0; a.g_hi = NGROUP; a.l_lo = 0; a.l_hi = DEPTH; a.ph = -1;
    hipLaunchKernelGGL(enc_fwd, dim3(grid), dim3(NTHR), LDS_BYTES, stream, a);
}
```
